# Optimizing an MI355X kernel written in HIP

```python
import math
import jax
import jax.numpy as jnp
from jax import lax
import numpy as np

D_MODEL = 1024
BATCH = 8
SEQ = 2048
DEPTH = 1
DEC_BATCH = 32
DEC_SEQ = 4
PAST_LEN = 16384
PAGE_SIZE = 128

N_META = 16
EPS = 1e-6
GDN_HEADS = 8
GDN_DK = 64
GDN_DV = 64
CONV_W = 4
GDN_CHUNK = 64
MLA_HEADS = 8
MLA_D_NOPE = 64
MLA_D_ROPE = 32
MLA_D_V = 64
Q_LORA = 384
KV_LORA = 256
ROPE_THETA = 10000.0
Q_BLOCK = 128
D_FF = 4 * D_MODEL
GDN_QK_W = GDN_HEADS * GDN_DK
GDN_V_W = GDN_HEADS * GDN_DV
CONV_CH = 2 * GDN_QK_W + GDN_V_W
MLA_V_W = MLA_HEADS * MLA_D_V
MIX_WIDTH = GDN_V_W + MLA_V_W
IN_SIZES = (CONV_CH, GDN_V_W, GDN_HEADS, GDN_HEADS, Q_LORA, KV_LORA, MLA_D_ROPE)
IN_COLS = CONV_CH + GDN_V_W + 2 * GDN_HEADS + Q_LORA + KV_LORA + MLA_D_ROPE
MLA_SCALE = (MLA_D_NOPE + MLA_D_ROPE) ** -0.5

kernel_name = 'hymba_gdn_mla_step'


def split_cols(x, sizes):
    idx, s = [], 0
    for n in sizes[:-1]:
        s += n
        idx.append(s)
    return jnp.split(x, idx, axis=-1)


def rmsnorm(x, g):
    xf = x.astype(jnp.float32)
    y = xf * lax.rsqrt(jnp.mean(xf * xf, axis=-1, keepdims=True) + EPS)
    return (y * g.astype(jnp.float32)).astype(x.dtype)


def l2norm(x):
    xf = x.astype(jnp.float32)
    return xf * lax.rsqrt(jnp.sum(xf * xf, axis=-1, keepdims=True) + EPS)


def rope(x, pos):
    half = MLA_D_ROPE // 2
    inv = ROPE_THETA ** (-jnp.arange(half, dtype=jnp.float32) / half)
    ang = pos.astype(jnp.float32)[:, None] * inv[None, :]
    shape = (pos.shape[0],) + (1,) * (x.ndim - 3) + (MLA_D_ROPE,)
    cos = jnp.concatenate([jnp.cos(ang), jnp.cos(ang)], -1).reshape(shape)
    sin = jnp.concatenate([jnp.sin(ang), jnp.sin(ang)], -1).reshape(shape)
    xf = x.astype(jnp.float32)
    x1, x2 = xf[..., :half], xf[..., half:]
    rot = jnp.concatenate([-x2, x1], -1)
    return (xf * cos + rot * sin).astype(x.dtype)


def causal_conv(x, buf, w):
    T = x.shape[1]
    xp = jnp.concatenate([buf.astype(x.dtype), x], axis=1)
    y = xp[:, 0:T] * w[0]
    for j in range(1, CONV_W):
        y = y + xp[:, j:j + T] * w[j]
    return jax.nn.silu(y), xp[:, -(CONV_W - 1):]


def mixer_projections(hn, w_in, w_q_b, q_norm_g, kv_norm_g, w_kv_b, pos):
    p = hn @ w_in
    qkv, z, b, a, c_q, c_kv, k_pe = split_cols(p, IN_SIZES)
    q = jnp.einsum('btc,chd->bthd', rmsnorm(c_q, q_norm_g), w_q_b)
    q_nope, q_pe = q[..., :MLA_D_NOPE], q[..., MLA_D_NOPE:]
    q_lat = jnp.einsum('bthn,chn->bthc', q_nope, w_kv_b[..., :MLA_D_NOPE])
    q_pe = rope(q_pe, pos)
    latent = rmsnorm(c_kv, kv_norm_g)
    k_pe = rope(k_pe, pos)
    return qkv, z, b, a, q_lat, q_pe, latent, k_pe


def gdn_inputs(qkv_c, b, a, a_log, dt_bias):
    B, T, _ = qkv_c.shape
    q, k, v = split_cols(qkv_c, (GDN_QK_W, GDN_QK_W, GDN_V_W))
    q = l2norm(q.reshape(B, T, GDN_HEADS, GDN_DK)) * (GDN_DK ** -0.5)
    k = l2norm(k.reshape(B, T, GDN_HEADS, GDN_DK))
    v = v.reshape(B, T, GDN_HEADS, GDN_DV).astype(jnp.float32)
    beta = jax.nn.sigmoid(b.astype(jnp.float32))
    g = -jnp.exp(a_log.astype(jnp.float32)) * jax.nn.softplus(a.astype(jnp.float32) + dt_bias.astype(jnp.float32))
    return q, k, v, g, beta


def gdn_chunked(q, k, v, g, beta, s0, chunk):
    B, T, H, DK = q.shape
    DV = v.shape[-1]
    n = T // chunk

    def to_chunks(x):
        return x.reshape((B, n, chunk, H) + x.shape[3:]).swapaxes(2, 3)

    q, k, v, g, beta = [to_chunks(x) for x in (q, k, v, g, beta)]
    g = jnp.cumsum(g, axis=-1)
    idx = jnp.arange(chunk)
    lower = idx[:, None] >= idx[None, :]
    strict = idx[:, None] > idx[None, :]
    diff = g[..., :, None] - g[..., None, :]
    decay = jnp.where(lower, jnp.exp(jnp.where(lower, diff, 0.0)), 0.0)
    k_beta = k * beta[..., None]
    v_beta = v * beta[..., None]
    lmat = jnp.where(strict, jnp.einsum('bnhid,bnhjd->bnhij', k_beta, k) * decay, 0.0)
    amat = lmat + jnp.eye(chunk, dtype=jnp.float32)
    rhs = jnp.concatenate([v_beta, k_beta * jnp.exp(g)[..., None]], axis=-1)
    sol = lax.linalg.triangular_solve(amat, rhs, left_side=True, lower=True, unit_diagonal=True)
    u, w = sol[..., :DV], sol[..., DV:]
    qk = jnp.where(lower, jnp.einsum('bnhid,bnhjd->bnhij', q, k) * decay, 0.0)
    g_last = g[..., -1]

    def step(s, xs):
        q_c, k_c, u_c, w_c, qk_c, g_c, gl = xs
        v_new = u_c - jnp.einsum('bhcd,bhde->bhce', w_c, s)
        o = jnp.einsum('bhcd,bhde->bhce', q_c * jnp.exp(g_c)[..., None], s) + jnp.einsum('bhij,bhje->bhie', qk_c, v_new)
        k_dec = k_c * jnp.exp(gl[..., None] - g_c)[..., None]
        s = s * jnp.exp(gl)[..., None, None] + jnp.einsum('bhcd,bhce->bhde', k_dec, v_new)
        return s, o

    xs = tuple(x.swapaxes(0, 1) for x in (q, k, u, w, qk, g, g_last))
    s_fin, o = lax.scan(step, s0, xs)
    o = jnp.transpose(o, (1, 0, 3, 2, 4)).reshape(B, T, H, DV)
    return o, s_fin


def gdn_output(o, z, norm_g, dtype):
    B, T = o.shape[:2]
    gate = jax.nn.silu(z.astype(jnp.float32)).reshape(B, T, GDN_HEADS, GDN_DV)
    return (rmsnorm(o, norm_g) * gate).reshape(B, T, GDN_V_W).astype(dtype)


def mla_output(out_lat, w_kv_b):
    B, T = out_lat.shape[:2]
    o = jnp.einsum('bthc,chv->bthv', out_lat, w_kv_b[..., MLA_D_NOPE:])
    return o.reshape(B, T, MLA_V_W)


def latent_scores(q_lat, q_pe, c, k_pe):
    s = jnp.einsum('bqhc,bkc->bhqk', q_lat, c) + jnp.einsum('bqhr,bkr->bhqk', q_pe, k_pe)
    return s.astype(jnp.float32) * MLA_SCALE


def masked_latent_attention(q_lat, q_pe, c, k_pe, q_pos, k_pos):
    s = latent_scores(q_lat, q_pe, c, k_pe)
    s = jnp.where((k_pos[None, :] <= q_pos[:, None])[None, None], s, -jnp.inf)
    p = jax.nn.softmax(s, axis=-1).astype(c.dtype)
    return jnp.einsum('bhqk,bkc->bqhc', p, c)


def prompt_attention(q_lat, q_pe, c, k_pe):
    B, T_all = c.shape[:2]
    pos = jnp.arange(T_all)
    meta_out = masked_latent_attention(q_lat[:, :N_META], q_pe[:, :N_META], c[:, :N_META], k_pe[:, :N_META], pos[:N_META], pos[:N_META])
    n_real = T_all - N_META
    n_blk = n_real // Q_BLOCK
    ql = q_lat[:, N_META:].reshape(B, n_blk, Q_BLOCK, MLA_HEADS, KV_LORA).swapaxes(0, 1)
    qp = q_pe[:, N_META:].reshape(B, n_blk, Q_BLOCK, MLA_HEADS, MLA_D_ROPE).swapaxes(0, 1)

    def block(args):
        ql_b, qp_b, i = args
        q_pos = N_META + i * Q_BLOCK + jnp.arange(Q_BLOCK)
        return masked_latent_attention(ql_b, qp_b, c, k_pe, q_pos, pos)

    out = lax.map(block, (ql, qp, jnp.arange(n_blk)))
    out = out.swapaxes(0, 1).reshape(B, n_real, MLA_HEADS, KV_LORA)
    return jnp.concatenate([meta_out, out], axis=1)


def sample_attention(q_lat, q_pe, c_new, kpe_new, c_past, kpe_past):
    T = q_lat.shape[1]
    P = c_past.shape[1]
    s_past = latent_scores(q_lat, q_pe, c_past, kpe_past)
    idx = jnp.arange(T)
    s_new = jnp.where((idx[None, :] <= idx[:, None])[None, None], latent_scores(q_lat, q_pe, c_new, kpe_new), -jnp.inf)
    p = jax.nn.softmax(jnp.concatenate([s_past, s_new], axis=-1), axis=-1).astype(c_new.dtype)
    return jnp.einsum('bhqk,bkc->bqhc', p[..., :P], c_past) + jnp.einsum('bhqk,bkc->bqhc', p[..., P:], c_new)


def sq_relu_mlp(hn, w_up, w_down):
    return jnp.square(jax.nn.relu(hn @ w_up)) @ w_down


def setup_inputs(seed: int = 0) -> dict:
    key = jax.random.key(seed)
    ks = jax.random.split(key, 24)
    f32 = jnp.float32
    n_pages = PAST_LEN // PAGE_SIZE
    n_used = DEC_BATCH * n_pages
    n_pool = (5 * n_used) // 4

    def nrm(k, shape, scale):
        return jax.random.normal(k, shape, f32) * scale

    def gain(k, shape):
        return 1.0 + 0.1 * jax.random.normal(k, shape, f32)

    page_table = jax.random.permutation(ks[6], n_pool)[:n_used].reshape(DEC_BATCH, n_pages).astype(jnp.int32)
    dt = jnp.exp(jax.random.uniform(ks[10], (DEPTH, GDN_HEADS), f32, math.log(1e-3), math.log(1e-1)))
    dt_bias = dt + jnp.log(-jnp.expm1(-dt))
    a_log = jnp.log(jax.random.uniform(ks[9], (DEPTH, GDN_HEADS), f32, 1.0, 16.0))
    return {
        'x_prompt': nrm(ks[0], (BATCH, SEQ, D_MODEL), 1.0),
        'x_sample': nrm(ks[1], (DEC_BATCH, DEC_SEQ, D_MODEL), 1.0),
        'cache_latent': nrm(ks[2], (DEPTH, n_pool, PAGE_SIZE, KV_LORA), 1.0),
        'cache_krope': nrm(ks[3], (DEPTH, n_pool, PAGE_SIZE, MLA_D_ROPE), 1.0),
        'state_conv': nrm(ks[4], (DEPTH, DEC_BATCH, CONV_W - 1, CONV_CH), 1.0),
        'state_ssm': nrm(ks[5], (DEPTH, DEC_BATCH, GDN_HEADS, GDN_DK, GDN_DV), GDN_DK ** -0.5),
        'page_table': page_table,
        'meta_tokens': nrm(ks[7], (N_META, D_MODEL), 1.0),
        'norm_mix_g': gain(ks[8], (DEPTH, D_MODEL)),
        'w_in': nrm(ks[11], (DEPTH, D_MODEL, IN_COLS), D_MODEL ** -0.5),
        'conv_w': nrm(ks[12], (DEPTH, CONV_W, CONV_CH), CONV_W ** -0.5),
        'a_log': a_log,
        'dt_bias': dt_bias,
        'gdn_norm_g': gain(ks[13], (DEPTH, GDN_DV)),
        'q_norm_g': gain(ks[14], (DEPTH, Q_LORA)),
        'w_q_b': nrm(ks[15], (DEPTH, Q_LORA, MLA_HEADS, MLA_D_NOPE + MLA_D_ROPE), Q_LORA ** -0.5),
        'kv_norm_g': gain(ks[16], (DEPTH, KV_LORA)),
        'w_kv_b': nrm(ks[17], (DEPTH, KV_LORA, MLA_HEADS, MLA_D_NOPE + MLA_D_V), KV_LORA ** -0.5),
        'w_out': nrm(ks[18], (DEPTH, MIX_WIDTH, D_MODEL), MIX_WIDTH ** -0.5),
        'norm_mlp_g': gain(ks[19], (DEPTH, D_MODEL)),
        'w_up': nrm(ks[20], (DEPTH, D_MODEL, D_FF), D_MODEL ** -0.5),
        'w_down': nrm(ks[21], (DEPTH, D_FF, D_MODEL), D_FF ** -0.5),
        'final_norm_g': gain(ks[22], (D_MODEL,)),
    }


def reference(x_prompt, x_sample, cache_latent, cache_krope, state_conv, state_ssm, page_table,
              meta_tokens, norm_mix_g, w_in, conv_w, a_log, dt_bias, gdn_norm_g, q_norm_g, w_q_b,
              kv_norm_g, w_kv_b, w_out, norm_mlp_g, w_up, w_down, final_norm_g):
    dt = x_prompt.dtype
    B = x_prompt.shape[0]
    Bs, Ts = x_sample.shape[:2]
    h_p = jnp.concatenate([jnp.broadcast_to(meta_tokens.astype(dt)[None], (B, N_META, D_MODEL)), x_prompt], axis=1)
    h_s = x_sample
    pos_p = jnp.arange(h_p.shape[1])
    pos_s = PAST_LEN + jnp.arange(Ts)
    lat_p, krope_p, conv_p, ssm_p = [], [], [], []
    lat_s, krope_s, conv_s, ssm_s = [], [], [], []
    for l in range(DEPTH):
        hn = rmsnorm(h_p, norm_mix_g[l])
        qkv, z, b, a, q_lat, q_pe, lat, kpe = mixer_projections(hn, w_in[l], w_q_b[l], q_norm_g[l], kv_norm_g[l], w_kv_b[l], pos_p)
        qkv_c, cbuf = causal_conv(qkv, jnp.zeros((B, CONV_W - 1, CONV_CH), dt), conv_w[l])
        q, k, v, g, beta = gdn_inputs(qkv_c, b, a, a_log[l], dt_bias[l])
        s0 = jnp.zeros((B, GDN_HEADS, GDN_DK, GDN_DV), jnp.float32)
        o_m, s1 = gdn_chunked(q[:, :N_META], k[:, :N_META], v[:, :N_META], g[:, :N_META], beta[:, :N_META], s0, N_META)
        o_r, s2 = gdn_chunked(q[:, N_META:], k[:, N_META:], v[:, N_META:], g[:, N_META:], beta[:, N_META:], s1, GDN_CHUNK)
        o_gdn = gdn_output(jnp.concatenate([o_m, o_r], axis=1), z, gdn_norm_g[l], dt)
        o_mla = mla_output(prompt_attention(q_lat, q_pe, lat, kpe), w_kv_b[l])
        h_p = h_p + jnp.concatenate([o_gdn, o_mla], axis=-1) @ w_out[l]
        h_p = h_p + sq_relu_mlp(rmsnorm(h_p, norm_mlp_g[l]), w_up[l], w_down[l])
        lat_p.append(lat)
        krope_p.append(kpe)
        conv_p.append(cbuf)
        ssm_p.append(s2.astype(dt))
        hn_s = rmsnorm(h_s, norm_mix_g[l])
        qkv_s, z_s, b_s, a_s, q_lat_s, q_pe_s, lat_new, kpe_new = mixer_projections(hn_s, w_in[l], w_q_b[l], q_norm_g[l], kv_norm_g[l], w_kv_b[l], pos_s)
        qkv_cs, cbuf_s = causal_conv(qkv_s, state_conv[l], conv_w[l])
        qs, ks_, vs, gs, betas = gdn_inputs(qkv_cs, b_s, a_s, a_log[l], dt_bias[l])
        o_s, s_new = gdn_chunked(qs, ks_, vs, gs, betas, state_ssm[l].astype(jnp.float32), Ts)
        o_gdn_s = gdn_output(o_s, z_s, gdn_norm_g[l], dt)
        c_past = cache_latent[l][page_table].reshape(Bs, -1, KV_LORA)
        kpe_past = cache_krope[l][page_table].reshape(Bs, -1, MLA_D_ROPE)
        o_mla_s = mla_output(sample_attention(q_lat_s, q_pe_s, lat_new, kpe_new, c_past.astype(dt), kpe_past.astype(dt)), w_kv_b[l])
        h_s = h_s + jnp.concatenate([o_gdn_s, o_mla_s], axis=-1) @ w_out[l]
        h_s = h_s + sq_relu_mlp(rmsnorm(h_s, norm_mlp_g[l]), w_up[l], w_down[l])
        lat_s.append(lat_new)
        krope_s.append(kpe_new)
        conv_s.append(cbuf_s)
        ssm_s.append(s_new.astype(dt))
    y_prompt = rmsnorm(h_p[:, N_META:], final_norm_g)
    y_sample = rmsnorm(h_s, final_norm_g)
    return (y_prompt, y_sample,
            jnp.stack(lat_p), jnp.stack(krope_p), jnp.stack(conv_p), jnp.stack(ssm_p),
            jnp.stack(lat_s), jnp.stack(krope_s), jnp.stack(conv_s), jnp.stack(ssm_s))
```

```cpp
#include <hip/hip_runtime.h>
#include <cstdio>
#include <cstdint>
#include <cmath>
namespace pg8 {
#define PG8_LAS __attribute__((address_space(3)))
typedef unsigned short bf16_t;
typedef short bf16x8 __attribute__((ext_vector_type(8)));
typedef float f32x4 __attribute__((ext_vector_type(4)));
typedef unsigned u32x4 __attribute__((ext_vector_type(4)));
constexpr int BM = 256, BK = 64, HALF = 128, HTB = HALF * BK * 2  , STAGE_BYTES = 8 * HTB, NXCD = 8, WGM = 8;

__host__ __device__ __forceinline__ int lds_byte(int r, int c) { const int st = (r >> 4) * 2 + (c >> 5), rr = r & 15, cc = c & 31, ob = rr * 64 + cc * 2; return st * 1024 + (ob ^ (((ob >> 9) & 1) << 5)); }
__host__ __device__ __forceinline__ void stage_rc(int b, int& R, int& C) { const int st = b / 1024, sb = b % 1024, swz = sb ^ (((sb >> 9) & 1) << 5); R = (st >> 1) * 16 + swz / 64; C = (st & 1) * 32 + (swz % 64) / 2; }
__host__ __device__ __forceinline__ int perm32(int rho) { const int n = rho >> 4, i = rho & 15; return 8 * (i >> 2) + 4 * n + (i & 3); }

struct Unit { int pm, pn; };
struct Gemm { const bf16_t* A; const bf16_t* Bt; int M, N, K; };

struct StaticOrder {
    int nM, nN, nwg, G, c;
    __host__ __device__ void init(int M, int N, int G_, int c_) { nM = M / BM; nN = N / BM; nwg = nM * nN; G = G_; c = c_; }
    __host__ __device__ bool next(int i, Unit& u) const {
        const long L = (long)i * G + c; if (L >= nwg) return false;
        int wgid = (int)L; { const int q = nwg / NXCD, r = nwg % NXCD, xcd = wgid % NXCD, off = wgid / NXCD; wgid = (xcd < r ? xcd * (q + 1) : r * (q + 1) + (xcd - r) * q) + off; }
        const int nig = WGM * nN, gid = wgid / nig, fm = gid * WGM, gsz = (nM - fm) < WGM ? (nM - fm) : WGM;
        u.pm = fm + ((wgid % nig) % gsz); u.pn = (wgid % nig) / gsz; return true;
    }
    __device__ __forceinline__ void a_ready(const Unit&) const {}
    __device__ __forceinline__ void done(const Unit&) const {}
};

__device__ __forceinline__ unsigned cvt_pk_bf16(float lo, float hi) { unsigned r; asm volatile("v_cvt_pk_bf16_f32 %0, %1, %2" : "=v"(r) : "v"(lo), "v"(hi)); return r; }
constexpr int ROWS_REAL = 16384, ROW_META = 16384, ROW_SAMP = 16400, ROW_END = 16528;
__device__ __forceinline__ const float* x_row_ptr(const float* xp, const float* xm, const float* xs, int row) {
    if (row < ROW_META) return xp + (size_t)row * 1024;
    if (row < ROW_SAMP) return xm + (size_t)(row - ROW_META) * 1024;
    if (row < ROW_END) return xs + (size_t)(row - ROW_SAMP) * 1024;
    return nullptr;
}
struct EpiStoreBf16 {
    static constexpr bool PERM = true, AFTER_DRAIN = false;
    bf16_t* O; int ldc;
    __device__ __forceinline__ void operator()(const f32x4 (&acc)[2][2][4][2], const Unit& u, int wr, int wc, int fr, int fq) const {
        const int row0 = u.pm * BM + wr * 64 + fr, col0 = u.pn * BM + wc * 32 + 8 * fq;
#pragma unroll
        for (int ai = 0; ai < 2; ++ai)
#pragma unroll
            for (int m = 0; m < 4; ++m) { bf16_t* rowp = O + (size_t)(row0 + ai * HALF + m * 16) * ldc + col0;
#pragma unroll
                for (int bj = 0; bj < 2; ++bj) { const f32x4 v0 = acc[ai][bj][m][0], v1 = acc[ai][bj][m][1];
                    u32x4 w; w.x = cvt_pk_bf16(v0[0], v0[1]); w.y = cvt_pk_bf16(v0[2], v0[3]); w.z = cvt_pk_bf16(v1[0], v1[1]); w.w = cvt_pk_bf16(v1[2], v1[3]);
                    *(u32x4*)(rowp + bj * HALF) = w; } }
    }
};
struct EpiResid1 {
    static constexpr bool PERM = true, AFTER_DRAIN = false;
    const float* xp; const float* xm; const float* xs; float* H1; bf16_t* H1B; float* ss;
    __device__ __forceinline__ void operator()(const f32x4 (&acc)[2][2][4][2], const Unit& u, int wr, int wc, int fr, int fq) const {
        const int row0 = u.pm * BM + wr * 64 + fr, col0 = u.pn * BM + wc * 32 + 8 * fq;
#pragma unroll
        for (int ai = 0; ai < 2; ++ai)
#pragma unroll
            for (int m = 0; m < 4; ++m) { const int row = row0 + ai * HALF + m * 16; const float* xr = x_row_ptr(xp, xm, xs, row); float part = 0.f;
#pragma unroll
                for (int bj = 0; bj < 2; ++bj) { const int col = col0 + bj * HALF;
                    f32x4 x0 = (f32x4){0.f, 0.f, 0.f, 0.f}, x1 = x0; if (xr) { x0 = *(const f32x4*)(xr + col); x1 = *(const f32x4*)(xr + col + 4); }
                    const f32x4 v0 = acc[ai][bj][m][0] + x0, v1 = acc[ai][bj][m][1] + x1;
                    *(f32x4*)(H1 + (size_t)row * 1024 + col) = v0; *(f32x4*)(H1 + (size_t)row * 1024 + col + 4) = v1;
                    u32x4 w; w.x = cvt_pk_bf16(v0[0], v0[1]); w.y = cvt_pk_bf16(v0[2], v0[3]); w.z = cvt_pk_bf16(v1[0], v1[1]); w.w = cvt_pk_bf16(v1[2], v1[3]);
                    *(u32x4*)(H1B + (size_t)row * 1024 + col) = w;
                    part += (v0[0] * v0[0] + v0[1] * v0[1]) + (v0[2] * v0[2] + v0[3] * v0[3]) + (v1[0] * v1[0] + v1[1] * v1[1]) + (v1[2] * v1[2] + v1[3] * v1[3]); }
                part += __shfl_xor(part, 16); part += __shfl_xor(part, 32);
                if (fq == 0) __hip_atomic_fetch_add(ss + row, part, __ATOMIC_RELAXED, __HIP_MEMORY_SCOPE_AGENT); }
    }
};
struct EpiUp {
    static constexpr bool PERM = true, AFTER_DRAIN = false;
    bf16_t* O; int ldc; const float* ss;
    __device__ __forceinline__ void operator()(const f32x4 (&acc)[2][2][4][2], const Unit& u, int wr, int wc, int fr, int fq) const {
        const int row0 = u.pm * BM + wr * 64 + fr, col0 = u.pn * BM + wc * 32 + 8 * fq;
#pragma unroll
        for (int ai = 0; ai < 2; ++ai)
#pragma unroll
            for (int m = 0; m < 4; ++m) { const int row = row0 + ai * HALF + m * 16; bf16_t* rowp = O + (size_t)row * ldc + col0;
                const float rs = 1.0f / sqrtf(__hip_atomic_load(ss + row, __ATOMIC_RELAXED, __HIP_MEMORY_SCOPE_AGENT) * (1.0f / 1024.0f) + 1e-6f);
#pragma unroll
                for (int bj = 0; bj < 2; ++bj) { f32x4 v0 = acc[ai][bj][m][0] * rs, v1 = acc[ai][bj][m][1] * rs;
#pragma unroll
                    for (int e = 0; e < 4; ++e) { const float a = fmaxf(v0[e], 0.f), b = fmaxf(v1[e], 0.f); v0[e] = a * a; v1[e] = b * b; }
                    u32x4 w; w.x = cvt_pk_bf16(v0[0], v0[1]); w.y = cvt_pk_bf16(v0[2], v0[3]); w.z = cvt_pk_bf16(v1[0], v1[1]); w.w = cvt_pk_bf16(v1[2], v1[3]);
                    *(u32x4*)(rowp + bj * HALF) = w; } }
    }
};
struct EpiResid2 {
    static constexpr bool PERM = true, AFTER_DRAIN = false;
    const float* H1; float* H2; float* ss;
    __device__ __forceinline__ void operator()(const f32x4 (&acc)[2][2][4][2], const Unit& u, int wr, int wc, int fr, int fq) const {
        const int row0 = u.pm * BM + wr * 64 + fr, col0 = u.pn * BM + wc * 32 + 8 * fq;
#pragma unroll
        for (int ai = 0; ai < 2; ++ai)
#pragma unroll
            for (int m = 0; m < 4; ++m) { const int row = row0 + ai * HALF + m * 16; float part = 0.f;
#pragma unroll
                for (int bj = 0; bj < 2; ++bj) { const size_t off = (size_t)row * 1024 + col0 + bj * HALF;
                    const f32x4 v0 = acc[ai][bj][m][0] + *(const f32x4*)(H1 + off), v1 = acc[ai][bj][m][1] + *(const f32x4*)(H1 + off + 4);
                    *(f32x4*)(H2 + off) = v0; *(f32x4*)(H2 + off + 4) = v1;
                    part += (v0[0] * v0[0] + v0[1] * v0[1]) + (v0[2] * v0[2] + v0[3] * v0[3]) + (v1[0] * v1[0] + v1[1] * v1[1]) + (v1[2] * v1[2] + v1[3] * v1[3]); }
                part += __shfl_xor(part, 16); part += __shfl_xor(part, 32);
                if (fq == 0) __hip_atomic_fetch_add(ss + row, part, __ATOMIC_RELAXED, __HIP_MEMORY_SCOPE_AGENT); }
    }
};
template <class Epi, class Sched, bool ALIGN_EPI = false, bool SP2 = false>
__device__ __forceinline__ void gemm_phase(PG8_LAS unsigned char* lds, const Gemm g, const Sched& S, const Epi& E) {
    const int tid = threadIdx.x, wid = __builtin_amdgcn_readfirstlane(tid >> 6), lane = tid & 63, wr = wid >> 2, wc = wid & 3, fr = lane & 15, fq = lane >> 4;
    const int K = g.K, nt = K / BK;
    unsigned voffA[2], voffB[2];
#pragma unroll
    for (int i = 0; i < 2; ++i) { int R, C; stage_rc(tid * 16 + i * 8192, R, C); const int Rb = Epi::PERM ? ((R & ~31) + perm32(R & 31)) : R;
        voffA[i] = (unsigned)(R * K + C) * 2u; voffB[i] = (unsigned)(Rb * K + C) * 2u; }
    const size_t kstep = (size_t)(BK * 2);
    const size_t hstep = (size_t)HALF * K * 2;
    const size_t tstep = 2 * hstep;
    const unsigned ldsw = (unsigned)wid * 1024u;
    const int aoff = lds_byte(wr * 64 + fr, fq * 8), boff = lds_byte(wc * 32 + fr, fq * 8);
#define PG8_SA(b, h) (((b) * 2 + (h)) * HTB)
#define PG8_SB(b, h) ((4 + (b) * 2 + (h)) * HTB)
#define PG8_STAGE(bufoff, gbase, voff) do { _Pragma("unroll") for (int _i = 0; _i < 2; ++_i) \
        __builtin_amdgcn_global_load_lds((const unsigned*)((const char*)(gbase) + (voff)[_i]), (PG8_LAS unsigned*)(lds + (bufoff) + ldsw + _i * 8192), 16, 0, 0); } while (0)
#define PG8_LDA(dst, b, h) do { _Pragma("unroll") for (int m = 0; m < 4; ++m) _Pragma("unroll") for (int k = 0; k < 2; ++k) dst[m][k] = *(const PG8_LAS bf16x8*)(lds + PG8_SA(b, h) + aoff + m * 2048 + k * 1024); } while (0)
#define PG8_LDB(dst, b, h) do { _Pragma("unroll") for (int n = 0; n < 2; ++n) _Pragma("unroll") for (int k = 0; k < 2; ++k) dst[n][k] = *(const PG8_LAS bf16x8*)(lds + PG8_SB(b, h) + boff + n * 2048 + k * 1024); } while (0)
#define PG8_MMA(ai, bj, At, Bt) do { __builtin_amdgcn_s_setprio(1); _Pragma("unroll") for (int m = 0; m < 4; ++m) _Pragma("unroll") for (int n = 0; n < 2; ++n) _Pragma("unroll") for (int k = 0; k < 2; ++k) \
        acc[ai][bj][m][n] = __builtin_amdgcn_mfma_f32_16x16x32_bf16(Bt[n][k], At[m][k], acc[ai][bj][m][n], 0, 0, 0); __builtin_amdgcn_s_setprio(0); } while (0)
#define PG8_WAIT_V(n) asm volatile("s_waitcnt vmcnt(" #n ")" ::: "memory")
#define PG8_WAIT_L(n) asm volatile("s_waitcnt lgkmcnt(" #n ")" ::: "memory")
#define PG8_BAR __builtin_amdgcn_s_barrier()
#define PG8_SCHED __builtin_amdgcn_sched_barrier(0)
    Unit cur, nxt; int ui = 0;
    if (!S.next(0, cur)) return;
    f32x4 acc[2][2][4][2];
#pragma unroll
    for (int a = 0; a < 2; ++a)
#pragma unroll
        for (int b = 0; b < 2; ++b)
#pragma unroll
            for (int m = 0; m < 4; ++m)
#pragma unroll
                for (int n = 0; n < 2; ++n) acc[a][b][m][n] = (f32x4){0.f, 0.f, 0.f, 0.f};
    bf16x8 At[4][2], B0[2][2], B1[2][2];
    const char* cA = (const char*)g.A + (size_t)cur.pm * tstep; const char* cB = (const char*)g.Bt + (size_t)cur.pn * tstep;
    S.a_ready(cur);
    if constexpr (SP2) {
        PG8_STAGE(PG8_SB(0, 0), cB, voffB); PG8_STAGE(PG8_SB(0, 1), cB + hstep, voffB); PG8_STAGE(PG8_SA(0, 0), cA, voffA); PG8_STAGE(PG8_SA(0, 1), cA + hstep, voffA);
        if (wr == 1) PG8_BAR;
        PG8_WAIT_V(2); PG8_BAR;
        PG8_STAGE(PG8_SB(1, 0), cB + kstep, voffB); PG8_STAGE(PG8_SA(1, 0), cA + kstep, voffA); PG8_STAGE(PG8_SB(1, 1), cB + hstep + kstep, voffB);
        PG8_WAIT_V(6); PG8_BAR;
    } else {
        PG8_STAGE(PG8_SB(0, 0), cB, voffB); PG8_STAGE(PG8_SA(0, 0), cA, voffA); PG8_STAGE(PG8_SB(0, 1), cB + hstep, voffB); PG8_STAGE(PG8_SA(0, 1), cA + hstep, voffA);
        if (wr == 1) PG8_BAR;
        PG8_WAIT_V(4); PG8_BAR;
        PG8_STAGE(PG8_SB(1, 0), cB + kstep, voffB); PG8_STAGE(PG8_SA(1, 0), cA + kstep, voffA); PG8_STAGE(PG8_SB(1, 1), cB + hstep + kstep, voffB);
        PG8_WAIT_V(6); PG8_BAR;
    }
    for (;;) {
        const bool has_next = S.next(ui + 1, nxt);
        const char* nA = has_next ? (const char*)g.A + (size_t)nxt.pm * tstep : cA; const char* nB = has_next ? (const char*)g.Bt + (size_t)nxt.pn * tstep : cB;
        for (int t = 0; t < nt; t += 2) {
            const bool last = (t == nt - 2);
            const char* a1 = cA + (size_t)(t + 1) * kstep;
            const char* a2 = last ? nA : cA + (size_t)(t + 2) * kstep; const char* b2 = last ? nB : cB + (size_t)(t + 2) * kstep;
            const char* a3 = a2 + kstep; const char* b3 = b2 + kstep;
            if (last && has_next) S.a_ready(nxt);
            if constexpr (SP2) {
            PG8_LDB(B0, 0, 0); PG8_LDB(B1, 0, 1); PG8_SCHED; PG8_LDA(At, 0, 0); PG8_STAGE(PG8_SA(1, 1), a1 + hstep, voffA);
            PG8_WAIT_V(8); PG8_WAIT_L(0); PG8_BAR; PG8_MMA(0, 0, At, B0); PG8_MMA(0, 1, At, B1); PG8_BAR; PG8_SCHED;
            PG8_LDA(At, 0, 1); PG8_STAGE(PG8_SB(0, 0), b2, voffB); PG8_STAGE(PG8_SB(0, 1), b2 + hstep, voffB); PG8_STAGE(PG8_SA(0, 0), a2, voffA);
            PG8_WAIT_V(8); PG8_WAIT_L(0); PG8_BAR; PG8_MMA(1, 0, At, B0); PG8_MMA(1, 1, At, B1); PG8_BAR; PG8_SCHED;
            PG8_LDB(B0, 1, 0); PG8_LDB(B1, 1, 1); PG8_SCHED; PG8_LDA(At, 1, 0); PG8_STAGE(PG8_SA(0, 1), a2 + hstep, voffA);
            PG8_WAIT_V(8); PG8_WAIT_L(0); PG8_BAR; PG8_MMA(0, 0, At, B0); PG8_MMA(0, 1, At, B1); PG8_BAR; PG8_SCHED;
            PG8_LDA(At, 1, 1); PG8_STAGE(PG8_SB(1, 0), b3, voffB); PG8_STAGE(PG8_SB(1, 1), b3 + hstep, voffB); PG8_STAGE(PG8_SA(1, 0), a3, voffA);
            PG8_WAIT_V(8); PG8_WAIT_L(0); PG8_BAR; PG8_MMA(1, 0, At, B0); PG8_MMA(1, 1, At, B1); PG8_BAR; PG8_SCHED;
            } else {
            PG8_LDB(B0, 0, 0); PG8_SCHED; PG8_LDA(At, 0, 0); PG8_STAGE(PG8_SA(1, 1), a1 + hstep, voffA);
            PG8_WAIT_L(8); PG8_BAR; PG8_WAIT_L(0); PG8_MMA(0, 0, At, B0); PG8_BAR; PG8_SCHED;
            PG8_LDB(B1, 0, 1); PG8_STAGE(PG8_SB(0, 0), b2, voffB);
            PG8_BAR; PG8_WAIT_L(0); PG8_MMA(0, 1, At, B1); PG8_BAR;
            PG8_LDA(At, 0, 1); PG8_STAGE(PG8_SA(0, 0), a2, voffA);
            PG8_BAR; PG8_WAIT_L(0); PG8_MMA(1, 0, At, B0); PG8_BAR; PG8_SCHED;
            PG8_STAGE(PG8_SB(0, 1), b2 + hstep, voffB);
            PG8_WAIT_V(6); PG8_BAR; PG8_MMA(1, 1, At, B1); PG8_BAR;
            PG8_LDB(B0, 1, 0); PG8_SCHED; PG8_LDA(At, 1, 0); PG8_STAGE(PG8_SA(0, 1), a2 + hstep, voffA);
            PG8_WAIT_L(8); PG8_BAR; PG8_WAIT_L(0); PG8_MMA(0, 0, At, B0); PG8_BAR; PG8_SCHED;
            PG8_LDB(B1, 1, 1); PG8_STAGE(PG8_SB(1, 0), b3, voffB);
            PG8_BAR; PG8_WAIT_L(0); PG8_MMA(0, 1, At, B1); PG8_BAR;
            PG8_LDA(At, 1, 1); PG8_STAGE(PG8_SA(1, 0), a3, voffA);
            PG8_BAR; PG8_WAIT_L(0); PG8_MMA(1, 0, At, B0); PG8_BAR; PG8_SCHED;
            PG8_STAGE(PG8_SB(1, 1), b3 + hstep, voffB);
            PG8_WAIT_V(6); PG8_BAR; PG8_MMA(1, 1, At, B1); PG8_BAR;
            }
        }
        if constexpr (ALIGN_EPI) { if (wr == 0) PG8_BAR; }
        if constexpr (!Epi::AFTER_DRAIN) { E(acc, cur, wr, wc, fr, fq); S.done(cur); }
        if (!has_next) break;
#pragma unroll
        for (int a = 0; a < 2; ++a)
#pragma unroll
            for (int b = 0; b < 2; ++b)
#pragma unroll
                for (int m = 0; m < 4; ++m)
#pragma unroll
                    for (int n = 0; n < 2; ++n) acc[a][b][m][n] = (f32x4){0.f, 0.f, 0.f, 0.f};
        cur = nxt; cA = nA; cB = nB; ++ui;
        if constexpr (ALIGN_EPI) { if (wr == 1) PG8_BAR; }
    }
    PG8_WAIT_V(0);
    if constexpr (!ALIGN_EPI) { if (wr == 0) PG8_BAR; }
    PG8_BAR;
    if constexpr (Epi::AFTER_DRAIN) { E.fused(acc, cur, wr, wc, fr, fq, lds, wid, lane); S.done(cur); }
#undef PG8_SA
#undef PG8_SB
#undef PG8_STAGE
#undef PG8_LDA
#undef PG8_LDB
#undef PG8_MMA
#undef PG8_WAIT_V
#undef PG8_WAIT_L
#undef PG8_BAR
#undef PG8_SCHED
}
}
constexpr int NWAVES = 8;
constexpr int NPHASES = 10;
#ifndef MK_N_LAUNCHES
#define MK_N_LAUNCHES 10
#endif
constexpr int N_LAUNCHES = MK_N_LAUNCHES;

constexpr int D = 1024, NB = 8, SEQ = 2048, NREAL = NB * SEQ, NMETA = 16, NSB = 32, NST = 4, NSAMP = NSB * NST;
constexpr int R_META = NREAL, R_SAMP = NREAL + NMETA, R_END = R_SAMP + NSAMP, MT = 16640;
constexpr int TP = NMETA + SEQ;
constexpr int NPRJ = 2816;
constexpr int C_QKV = 0, C_Z = 1536, C_CQ = 2048, C_CKV = 2432, C_KPE = 2688, C_B = 2720, C_A = 2728, C_PAD = 2736;
constexpr int IN_COLS = 2736, FF = 4096, QLORA = 384, KVLORA = 256, NH = 8;
constexpr int PAST = 16384, PAGE = 128, NPAGES = 128;
constexpr float EPS = 1e-6f;
constexpr float MLA_SCALE = 0.10206207261596577f;
constexpr size_t O_YP = 0, O_YS = 16777216, O_LATP = 16908288, O_KRP = 21135360, O_CONVP = 21663744, O_SSMP = 21700608,
                 O_LATS = 21962752, O_KRS = 21995520, O_CONVS = 21999616, O_SSMS = 22147072, O_END = 23195648;
constexpr int NSPLIT = 32, SPLIT_KEYS = PAST / NSPLIT  , NSPLITX = NSPLIT + 1;

constexpr size_t MiB = 1u << 20;
constexpr size_t al(size_t x) { return (x + MiB - 1) / MiB * MiB; }
constexpr size_t WS_CTL = 0, CTL_ZERO_BYTES = 1 * MiB;
constexpr size_t WS_WIN = 1 * MiB;
constexpr size_t WS_WQB = WS_WIN + al((size_t)NPRJ * D * 2);
constexpr size_t WS_WKVB = WS_WQB + al((size_t)768 * 384 * 2);
constexpr size_t WS_WOUT = WS_WKVB + al((size_t)1024 * 256 * 2);
constexpr size_t WS_WUP = WS_WOUT + al((size_t)1024 * 1024 * 2);
constexpr size_t WS_WDN = WS_WUP + al((size_t)4096 * 1024 * 2);
constexpr size_t WS_XN = WS_WDN + al((size_t)4096 * 1024 * 2);
constexpr size_t WS_PRJ = WS_XN + al((size_t)MT * D * 2);
constexpr size_t WS_CQN = WS_PRJ + al((size_t)MT * NPRJ * 2);
constexpr size_t WS_LATN = WS_CQN + al((size_t)MT * QLORA * 2);
constexpr size_t WS_KPE = WS_LATN + al((size_t)MT * KVLORA * 2);
constexpr size_t WS_GQKV = WS_KPE + al((size_t)MT * 32 * 4);
constexpr size_t WS_GB = WS_GQKV + al((size_t)MT * 1536 * 4);
constexpr size_t WS_QM = WS_GB + al((size_t)MT * 16 * 4);
constexpr size_t WS_KV = WS_QM + al((size_t)MT * 768 * 2);
constexpr size_t WS_GO = WS_KV + al((size_t)MT * 1024 * 2);
constexpr size_t WS_MIX = WS_GO + al((size_t)MT * 512 * 4);
constexpr size_t WS_H1 = WS_MIX + al((size_t)MT * D * 2);
constexpr size_t WS_H1B = WS_H1 + al((size_t)MT * D * 4);
constexpr size_t WS_HFF = WS_H1B + al((size_t)MT * D * 2);
constexpr size_t WS_H2 = WS_HFF + al((size_t)MT * FF * 2);
constexpr size_t WS_PART = WS_H2 + al((size_t)MT * D * 4);
constexpr size_t WS_PSTAT = WS_PART + al((size_t)NSB * NSPLITX * 32 * 256 * 4);
constexpr size_t WS_END = WS_PSTAT + al((size_t)NSB * NSPLITX * 32 * 2 * 4);
constexpr int CW_TMO = 0, CW_CODE = 1;
constexpr int CW_BAR = 4096;
constexpr int CW_SS1 = 32768, CW_SS2 = CW_SS1 + MT;
static_assert((size_t)(CW_SS2 + MT) * 4 <= CTL_ZERO_BYTES, "CTL words inside the memset region");

constexpr int RING_OFF = 0, RING_BYTES = 131072;
constexpr int LDSCTL_OFF = RING_BYTES, MISC_OFF = LDSCTL_OFF + 320;
constexpr int LDS_BYTES = 147456;
static_assert(MISC_OFF + 128 <= LDS_BYTES, "LDS map");
#define GAS __attribute__((address_space(1)))
#define LAS __attribute__((address_space(3)))
typedef unsigned short bf16;
typedef unsigned v4u __attribute__((ext_vector_type(4)));
typedef float f32x4 __attribute__((ext_vector_type(4)));
typedef short bf16x8 __attribute__((ext_vector_type(8)));
typedef GAS unsigned gu32;
typedef GAS unsigned long long gu64;
#define RLX_AGENT __ATOMIC_RELAXED, __HIP_MEMORY_SCOPE_AGENT
#define LDS_WAIT() asm volatile("s_waitcnt lgkmcnt(0)" ::: "memory")
#define VM_WAIT() asm volatile("s_waitcnt vmcnt(0)" ::: "memory")
__device__ __forceinline__ unsigned long long rt() { return __builtin_amdgcn_s_memrealtime(); }
__device__ __forceinline__ unsigned f2bf(float f) { unsigned u = __builtin_bit_cast(unsigned, f); return (u + 0x7fffu + ((u >> 16) & 1u)) >> 16; }
__device__ __forceinline__ unsigned pk2(float lo, float hi) { return f2bf(lo) | (f2bf(hi) << 16); }

#define XB_TMO      128
#define XB_XCNT(j)  (256  + 64 * (j))
#define XB_XSUB(j)  (1280 + 64 * (j))
#define XB_XGEN(j)  (2304 + 64 * (j))
#define XB_TOP      3328
#define XB_TOPGEN   3392
#define XCD_BAR_WORDS 3456
#define XB_SPIN_CAP (1u << 18)

__device__ __forceinline__ unsigned xb_ld(unsigned* p)              { return __hip_atomic_load(p, __ATOMIC_RELAXED, __HIP_MEMORY_SCOPE_AGENT); }
__device__ __forceinline__ unsigned xb_add(unsigned* p, unsigned v) { return __hip_atomic_fetch_add(p, v, __ATOMIC_RELAXED, __HIP_MEMORY_SCOPE_AGENT); }
__device__ __forceinline__ unsigned xb_xcc_id() { return (unsigned)__builtin_amdgcn_s_getreg((3 << 11) | 20) & 0xFu; }
#define XB_SPIN(cond, bar) do { unsigned _sp = 0; while (cond) { __builtin_amdgcn_s_sleep(1); \
    if ((++_sp & 255u) == 0u) { if (xb_ld(&(bar)[XB_TMO])) break; if (_sp > XB_SPIN_CAP) { atomicAdd(&(bar)[XB_TMO], 1u); break; } } } } while (0)

struct XcdBarrier {
    unsigned* bar; unsigned x;
    volatile LAS unsigned* st;
};

__device__ __forceinline__ XcdBarrier xcd_barrier_post(unsigned* bar, volatile LAS unsigned* st) {
    XcdBarrier b; b.bar = bar; b.x = xb_xcc_id(); b.st = st;
    if (threadIdx.x == 0) (void)xb_add(&bar[XB_XCNT(b.x)], 1u);
    return b;
}
__device__ __forceinline__ void xcd_barrier_complete(unsigned* bar, unsigned x, unsigned& nloc, unsigned& nx) {
    const unsigned G = gridDim.x * gridDim.y * gridDim.z;
    unsigned sum, cnt, mine, sp = 0u;
    for (;;) {
        sum = 0u; cnt = 0u; mine = 0u;
#pragma unroll
        for (unsigned j = 0; j < 16; ++j) { const unsigned c = xb_ld(&bar[XB_XCNT(j)]); sum += c; cnt += (c > 0u) ? 1u : 0u; mine = (j == x) ? c : mine; }
        if (sum == G) break;
        __builtin_amdgcn_s_sleep(1);
        if ((++sp & 255u) == 0u) { if (xb_ld(&bar[XB_TMO])) break; if (sp > XB_SPIN_CAP) { atomicAdd(&bar[XB_TMO], 1u); break; } }
    }
    nloc = mine > 0u ? mine : 1u; nx = cnt > 0u ? cnt : 1u;
}

__device__ __forceinline__ void xcd_barrier(const XcdBarrier& b) {
    asm volatile("s_waitcnt vmcnt(0)" ::: "memory");
    __syncthreads();
    if (threadIdx.x == 0) {
        unsigned* bar = b.bar;
        __builtin_amdgcn_s_waitcnt(0);
        unsigned nloc = b.st[0], nx = b.st[1];
        if (nloc == 0u) { xcd_barrier_complete(bar, b.x, nloc, nx); b.st[0] = nloc; b.st[1] = nx; }
        const unsigned old = xb_add(&bar[XB_XSUB(b.x)], 1u);
        const unsigned gen = old / nloc;
        if (old + 1u == (gen + 1u) * nloc) {
            __builtin_amdgcn_fence(__ATOMIC_RELEASE, "agent");
            asm volatile("s_waitcnt vmcnt(0)" ::: "memory");
            const unsigned og = xb_add(&bar[XB_TOP], 1u);
            const unsigned tg = og / nx;
            if (og + 1u == (tg + 1u) * nx) xb_add(&bar[XB_TOPGEN], 1u);
            else XB_SPIN(xb_ld(&bar[XB_TOPGEN]) == tg, bar);
            __builtin_amdgcn_fence(__ATOMIC_ACQUIRE, "agent");
            xb_add(&bar[XB_XGEN(b.x)], 1u);
            asm volatile("s_waitcnt vmcnt(0)" ::: "memory");
        } else {
            XB_SPIN(xb_ld(&bar[XB_XGEN(b.x)]) == gen, bar);
            __builtin_amdgcn_fence(__ATOMIC_ACQUIRE, "agent");
            asm volatile("s_waitcnt vmcnt(0)" ::: "memory");
        }
    }
    __syncthreads();
}
struct Frame {
    LAS unsigned char* lds;
    volatile LAS unsigned* MISC;
    gu32* ctl;
    int tid, lane, wave, vcu, G;
    const float *x_prompt, *x_sample, *cache_latent, *cache_krope, *state_conv, *state_ssm; const int* page_table;
    const float *meta, *norm_mix_g, *w_in, *conv_w, *a_log, *dt_bias, *gdn_norm_g, *q_norm_g, *w_q_b, *kv_norm_g, *w_kv_b, *w_out, *norm_mlp_g, *w_up, *w_down, *final_g;
    float* out;
    bf16 *WIN, *WQB, *WKVB, *WOUT, *WUP, *WDN, *XN, *PRJ, *CQN, *LATN, *QM, *KV, *MIX, *H1B, *HFF;
    float *KPE, *GQKV, *GB, *GO, *H1, *H2, *PART, *PSTAT, *SS1, *SS2;
};
__device__ __forceinline__ float bf2f(bf16 v) { return __uint_as_float((unsigned)v << 16); }
__device__ __forceinline__ float wave_sum(float v) {
#pragma unroll
    for (int o = 1; o < 64; o <<= 1) v += __shfl_xor(v, o);
    return v;
}
__device__ __forceinline__ float wave_max(float v) {
#pragma unroll
    for (int o = 1; o < 64; o <<= 1) v = fmaxf(v, __shfl_xor(v, o));
    return v;
}
__device__ __forceinline__ float silu_f(float y) { return y / (1.0f + __expf(-y)); }
__device__ __forceinline__ float rdlane(float v, int l) { return __int_as_float(__builtin_amdgcn_readlane(__float_as_int(v), l)); }
__device__ __forceinline__ int row_pos(int r) { return r < R_META ? NMETA + (r & (SEQ - 1)) : (r < R_SAMP ? r - R_META : PAST + ((r - R_SAMP) & (NST - 1))); }

__device__ __forceinline__ float wsrc(const Frame& F, int mat, int k, int n) {
    switch (mat) {
    case 0: { int c;
        if (n < C_CQ) c = n; else if (n < C_CKV) c = 2064 + (n - C_CQ); else if (n < C_KPE) c = 2448 + (n - C_CKV); else if (n < C_B) c = 2704 + (n - C_KPE);
        else if (n < C_A) c = 2048 + (n - C_B); else if (n < C_PAD) c = 2056 + (n - C_A); else return 0.f;
        return F.w_in[(size_t)k * IN_COLS + c]; }
    case 1: { const int c = n < 512 ? (n >> 6) * 96 + (n & 63) : ((n - 512) >> 5) * 96 + 64 + ((n - 512) & 31); return F.w_q_b[(size_t)k * 768 + c]; }
    case 2: { const int c = n < 512 ? (n >> 6) * 128 + (n & 63) : ((n - 512) >> 6) * 128 + 64 + ((n - 512) & 63); return F.w_kv_b[(size_t)k * 1024 + c]; }
    case 3: return F.w_out[(size_t)k * 1024 + n];
    case 4: return F.norm_mlp_g[k] * F.w_up[(size_t)k * 4096 + n];
    default: return F.w_down[(size_t)k * 1024 + n];
    }
}
__device__ __forceinline__ void p0_transpose_item(const Frame& F, int mat, int K, int N, bf16* WT, LAS float* scr, int item, int lane) {
    const int nblk = N / 32, kb = item / nblk, nb = item % nblk, k0 = 64 * kb, n0 = 32 * nb;
#pragma unroll 4
    for (int i = 0; i < 32; ++i) { const int kk = 2 * i + (lane >> 5); scr[kk * 33 + (lane & 31)] = wsrc(F, mat, k0 + kk, n0 + (lane & 31)); }
    LDS_WAIT(); asm volatile("" ::: "memory");
    const int c = lane & 7;
#pragma unroll
    for (int j = 0; j < 4; ++j) { const int n = (lane >> 3) + 8 * j; const LAS float* s = scr + (8 * c) * 33 + n;
        v4u o; o.x = pk2(s[0 * 33], s[1 * 33]); o.y = pk2(s[2 * 33], s[3 * 33]); o.z = pk2(s[4 * 33], s[5 * 33]); o.w = pk2(s[6 * 33], s[7 * 33]);
        *(GAS v4u*)(WT + (size_t)(n0 + n) * K + k0 + 8 * c) = o; }
    LDS_WAIT(); asm volatile("" ::: "memory");
}
__device__ __forceinline__ const float* x_row(const Frame& F, int r) {
    if (r < R_META) return F.x_prompt + (size_t)r * D;
    if (r < R_SAMP) return F.meta + (size_t)(r - R_META) * D;
    if (r < R_END) return F.x_sample + (size_t)(r - R_SAMP) * D;
    return nullptr;
}
__device__ __forceinline__ void p0_prologue(Frame& F) {
    LAS float* scr = (LAS float*)(F.lds + RING_OFF + F.wave * 16384);
    const int gw = F.vcu * NWAVES + F.wave, NGW = F.G * NWAVES;
    constexpr int I0 = (D / 64) * (NPRJ / 32), I1 = (QLORA / 64) * (768 / 32), I2 = (KVLORA / 64) * (1024 / 32), I3 = (1024 / 64) * (1024 / 32), I4 = (D / 64) * (FF / 32), I5 = (FF / 64) * (D / 32);
    constexpr int NITEMS = I0 + I1 + I2 + I3 + I4 + I5;
    for (int it = gw; it < NITEMS; it += NGW) {
        int r = it;
        if (r < I0) { p0_transpose_item(F, 0, D, NPRJ, F.WIN, scr, r, F.lane); continue; } r -= I0;
        if (r < I1) { p0_transpose_item(F, 1, QLORA, 768, F.WQB, scr, r, F.lane); continue; } r -= I1;
        if (r < I2) { p0_transpose_item(F, 2, KVLORA, 1024, F.WKVB, scr, r, F.lane); continue; } r -= I2;
        if (r < I3) { p0_transpose_item(F, 3, 1024, 1024, F.WOUT, scr, r, F.lane); continue; } r -= I3;
        if (r < I4) { p0_transpose_item(F, 4, D, FF, F.WUP, scr, r, F.lane); continue; } r -= I4;
        p0_transpose_item(F, 5, FF, D, F.WDN, scr, r, F.lane);
    }
    for (int m = gw; m < MT; m += NGW) {
        const float* xr = x_row(F, m);
        GAS unsigned long long* o8 = (GAS unsigned long long*)(F.XN + (size_t)m * D) + F.lane;
        if (!xr) {
#pragma unroll
            for (int j = 0; j < 4; ++j) o8[64 * j] = 0ull;
            continue; }
        const f32x4* xv = (const f32x4*)xr + F.lane; const f32x4* gv = (const f32x4*)F.norm_mix_g + F.lane;
        f32x4 v[4]; float s = 0.f;
#pragma unroll
        for (int j = 0; j < 4; ++j) { v[j] = xv[64 * j]; s += (v[j].x * v[j].x + v[j].y * v[j].y) + (v[j].z * v[j].z + v[j].w * v[j].w); }
        const float rstd = 1.0f / sqrtf(wave_sum(s) * (1.0f / D) + EPS);
#pragma unroll
        for (int j = 0; j < 4; ++j) { const f32x4 g = gv[64 * j]; const f32x4 y = v[j] * rstd * g;
            o8[64 * j] = (unsigned long long)pk2(y.x, y.y) | ((unsigned long long)pk2(y.z, y.w) << 32); }
    }
}

struct TapSrc { const bf16* pb; const float* pf; };
__device__ __forceinline__ TapSrc tap_src(const Frame& F, int r, int d) {
    TapSrc t; t.pb = nullptr; t.pf = nullptr;
    if (r < R_META) { const int s = r & (SEQ - 1); if (s - d >= 0) t.pb = F.PRJ + (size_t)(r - d) * NPRJ; else t.pb = F.PRJ + (size_t)(R_META + NMETA + (s - d)) * NPRJ; }
    else if (r < R_SAMP) { const int m = r - R_META; if (m - d >= 0) t.pb = F.PRJ + (size_t)(r - d) * NPRJ; }
    else if (r < R_END) { const int i = r - R_SAMP, bs = i >> 2, tt = i & 3; if (tt - d >= 0) t.pb = F.PRJ + (size_t)(r - d) * NPRJ; else t.pf = F.state_conv + ((size_t)bs * 3 + (3 + tt - d)) * 1536; }
    return t;
}
__device__ __forceinline__ void p2_row(Frame& F, int r) {
    const int lane = F.lane;
    const bf16* p = F.PRJ + (size_t)r * NPRJ;
    if (r >= R_END) {
        for (int c = lane; c < QLORA; c += 64) F.CQN[(size_t)r * QLORA + c] = 0;
        for (int c = lane; c < KVLORA; c += 64) F.LATN[(size_t)r * KVLORA + c] = 0;
        return; }
    { float v[6]; float s = 0.f;
#pragma unroll
      for (int j = 0; j < 3; ++j) { const unsigned w = *(const unsigned*)(p + C_CQ + 128 * j + 2 * lane); v[2 * j] = __uint_as_float(w << 16); v[2 * j + 1] = __uint_as_float(w & 0xffff0000u); s += v[2 * j] * v[2 * j] + v[2 * j + 1] * v[2 * j + 1]; }
      const float rstd = 1.0f / sqrtf(wave_sum(s) * (1.0f / QLORA) + EPS);
#pragma unroll
      for (int j = 0; j < 3; ++j) { const int c = 128 * j + 2 * lane; *(unsigned*)(F.CQN + (size_t)r * QLORA + c) = pk2(v[2 * j] * rstd * F.q_norm_g[c], v[2 * j + 1] * rstd * F.q_norm_g[c + 1]); } }
    { const unsigned long long w = *(const unsigned long long*)(p + C_CKV + 4 * lane); float v[4];
      v[0] = __uint_as_float((unsigned)(w << 16) & 0xffff0000u); v[1] = __uint_as_float((unsigned)w & 0xffff0000u); v[2] = __uint_as_float((unsigned)(w >> 16) & 0xffff0000u); v[3] = __uint_as_float((unsigned)(w >> 32) & 0xffff0000u);
      const float s = (v[0] * v[0] + v[1] * v[1]) + (v[2] * v[2] + v[3] * v[3]);
      const float rstd = 1.0f / sqrtf(wave_sum(s) * (1.0f / KVLORA) + EPS);
      const f32x4 g = *((const f32x4*)F.kv_norm_g + lane);
      const f32x4 y = {v[0] * rstd * g.x, v[1] * rstd * g.y, v[2] * rstd * g.z, v[3] * rstd * g.w};
      *(unsigned long long*)(F.LATN + (size_t)r * KVLORA + 4 * lane) = (unsigned long long)pk2(y.x, y.y) | ((unsigned long long)pk2(y.z, y.w) << 32);
      if (r < R_META) { const int b = r >> 11, s2 = r & (SEQ - 1); *((f32x4*)(F.out + O_LATP + ((size_t)b * TP + NMETA + s2) * KVLORA) + lane) = y; }
      else if (r < R_SAMP) { const int m = r - R_META;
#pragma unroll
          for (int b = 0; b < NB; ++b) *((f32x4*)(F.out + O_LATP + ((size_t)b * TP + m) * KVLORA) + lane) = y; }
      else *((f32x4*)(F.out + O_LATS + (size_t)(r - R_SAMP) * KVLORA) + lane) = y; }
    if (lane < 16) { const float x1 = bf2f(p[C_KPE + lane]), x2 = bf2f(p[C_KPE + 16 + lane]);
      const double ang = (double)row_pos(r) * pow(10000.0, -(double)lane / 16.0); double sn, cs; sincos(ang, &sn, &cs);
      const float c = (float)cs, s = (float)sn, o1 = x1 * c - x2 * s, o2 = x2 * c + x1 * s;
      F.KPE[(size_t)r * 32 + lane] = o1; F.KPE[(size_t)r * 32 + 16 + lane] = o2;
      if (r < R_META) { const int b = r >> 11, s2 = r & (SEQ - 1); float* o = F.out + O_KRP + ((size_t)b * TP + NMETA + s2) * 32; o[lane] = o1; o[16 + lane] = o2; }
      else if (r < R_SAMP) { const int m = r - R_META; for (int b = 0; b < NB; ++b) { float* o = F.out + O_KRP + ((size_t)b * TP + m) * 32; o[lane] = o1; o[16 + lane] = o2; } }
      else { float* o = F.out + O_KRS + (size_t)(r - R_SAMP) * 32; o[lane] = o1; o[16 + lane] = o2; } }
    if (lane < 8) { const float bb = bf2f(p[C_B + lane]), aa = bf2f(p[C_A + lane]);
      const float beta = 1.0f / (1.0f + expf(-bb)); const float xx = aa + F.dt_bias[lane];
      const float sp = xx > 20.f ? xx : log1pf(expf(xx));
      F.GB[(size_t)r * 16 + lane] = beta; F.GB[(size_t)r * 16 + 8 + lane] = -expf(F.a_log[lane]) * sp; }
    { TapSrc ts[4];
#pragma unroll
      for (int j = 0; j < 4; ++j) ts[j] = tap_src(F, r, 3 - j);
#pragma unroll 4
      for (int grp = 0; grp < 24; ++grp) { const int ch = grp * 64 + lane; float y = 0.f;
#pragma unroll
          for (int j = 0; j < 4; ++j) { float x = 0.f; if (ts[j].pb) x = bf2f(ts[j].pb[ch]); else if (ts[j].pf) x = ts[j].pf[ch]; y += x * F.conv_w[j * 1536 + ch]; }
          y = silu_f(y);
          if (grp < 16) { const float ssq = wave_sum(y * y); y *= 1.0f / sqrtf(ssq + EPS); if (grp < 8) y *= 0.125f; }
          F.GQKV[(size_t)r * 1536 + ch] = y; } }
    if (r < R_META) { const int b = r >> 11, s2 = r & (SEQ - 1); if (s2 >= SEQ - 3) { float* o = F.out + O_CONVP + ((size_t)b * 3 + (s2 - (SEQ - 3))) * 1536; for (int c = lane; c < 1536; c += 64) o[c] = bf2f(p[c]); } }
    else if (r >= R_SAMP) { const int i = r - R_SAMP, bs = i >> 2, tt = i & 3; if (tt >= 1) { float* o = F.out + O_CONVS + ((size_t)bs * 3 + (tt - 1)) * 1536; for (int c = lane; c < 1536; c += 64) o[c] = bf2f(p[c]); } }
}

__device__ __forceinline__ void gdn_chain_naive(Frame& F, int task) {
    const int lane = F.lane; const bool prompt = task < 64;
    int h, b, total; float S[64];
    if (prompt) { b = task >> 3; h = task & 7; total = TP;
#pragma unroll
        for (int d = 0; d < 64; ++d) S[d] = 0.f; }
    else { b = (task - 64) >> 3; h = (task - 64) & 7; total = NST;
#pragma unroll
        for (int d = 0; d < 64; ++d) S[d] = F.state_ssm[(((size_t)b * NH + h) * 64 + d) * 64 + lane]; }
#define GDN_ROW(i) (prompt ? ((i) < NMETA ? R_META + (i) : b * SEQ + ((i) - NMETA)) : R_SAMP + b * NST + (i))
    int r = GDN_ROW(0);
    float nq = F.GQKV[(size_t)r * 1536 + h * 64 + lane], nk = F.GQKV[(size_t)r * 1536 + 512 + h * 64 + lane], nv = F.GQKV[(size_t)r * 1536 + 1024 + h * 64 + lane];
    float nbeta = F.GB[(size_t)r * 16 + h], ng = F.GB[(size_t)r * 16 + 8 + h];
    for (int i = 0; i < total; ++i) {
        const float q = nq, k = nk, v = nv, beta = nbeta, g = ng; const int rc = r;
        if (i + 1 < total) { r = GDN_ROW(i + 1);
            nq = F.GQKV[(size_t)r * 1536 + h * 64 + lane]; nk = F.GQKV[(size_t)r * 1536 + 512 + h * 64 + lane]; nv = F.GQKV[(size_t)r * 1536 + 1024 + h * 64 + lane];
            nbeta = F.GB[(size_t)r * 16 + h]; ng = F.GB[(size_t)r * 16 + 8 + h]; }
        const float eg = expf(g);
        float k0 = 0.f, k1 = 0.f, k2 = 0.f, k3 = 0.f;
#pragma unroll
        for (int d = 0; d < 64; d += 4) { k0 += rdlane(k, d) * S[d]; k1 += rdlane(k, d + 1) * S[d + 1]; k2 += rdlane(k, d + 2) * S[d + 2]; k3 += rdlane(k, d + 3) * S[d + 3]; }
        const float kS = (k0 + k1) + (k2 + k3);
        const float vnew = beta * (v - eg * kS);
        float o0 = 0.f, o1 = 0.f, o2 = 0.f, o3 = 0.f;
#pragma unroll
        for (int d = 0; d < 64; d += 4) {
            S[d] = eg * S[d] + rdlane(k, d) * vnew; o0 += rdlane(q, d) * S[d];
            S[d + 1] = eg * S[d + 1] + rdlane(k, d + 1) * vnew; o1 += rdlane(q, d + 1) * S[d + 1];
            S[d + 2] = eg * S[d + 2] + rdlane(k, d + 2) * vnew; o2 += rdlane(q, d + 2) * S[d + 2];
            S[d + 3] = eg * S[d + 3] + rdlane(k, d + 3) * vnew; o3 += rdlane(q, d + 3) * S[d + 3]; }
        F.GO[(size_t)rc * 512 + h * 64 + lane] = (o0 + o1) + (o2 + o3);
    }
#undef GDN_ROW
    float* so = F.out + (prompt ? O_SSMP : O_SSMS) + ((size_t)b * NH + h) * 4096;
#pragma unroll
    for (int d = 0; d < 64; ++d) so[d * 64 + lane] = S[d];
}
__device__ __forceinline__ void attn_prompt_naive(Frame& F, int task, LAS float* wl) {
    const int lane = F.lane; const int s = task & (SEQ - 1), h = (task >> 11) & 7, b = task >> 14; const int r = b * SEQ + s;
    LAS float* qs = wl; LAS float* sc = wl + 96;
    { const bf16* qrow = F.QM + (size_t)r * 768;
      qs[lane] = bf2f(qrow[h * 64 + lane]) * MLA_SCALE;
      if (lane < 16) { const float x1 = bf2f(qrow[512 + h * 32 + lane]), x2 = bf2f(qrow[512 + h * 32 + 16 + lane]);
          const double ang = (double)(NMETA + s) * pow(10000.0, -(double)lane / 16.0); double sn, cs; sincos(ang, &sn, &cs);
          const float c = (float)cs, sn_ = (float)sn; qs[64 + lane] = (x1 * c - x2 * sn_) * MLA_SCALE; qs[80 + lane] = (x2 * c + x1 * sn_) * MLA_SCALE; } }
    LDS_WAIT(); asm volatile("" ::: "memory");
    const int nk = NMETA + s + 1; float mx = -INFINITY;
    for (int j = lane; j < nk; j += 64) { const int kr = j < NMETA ? R_META + j : b * SEQ + (j - NMETA);
        const bf16* kn = F.KV + (size_t)kr * 1024 + h * 64; const float* kp = F.KPE + (size_t)kr * 32; float a = 0.f;
#pragma unroll
        for (int d8 = 0; d8 < 8; ++d8) { const v4u w = *(const v4u*)(kn + d8 * 8);
            a += qs[d8 * 8 + 0] * __uint_as_float(w.x << 16) + qs[d8 * 8 + 1] * __uint_as_float(w.x & 0xffff0000u) + qs[d8 * 8 + 2] * __uint_as_float(w.y << 16) + qs[d8 * 8 + 3] * __uint_as_float(w.y & 0xffff0000u)
               + qs[d8 * 8 + 4] * __uint_as_float(w.z << 16) + qs[d8 * 8 + 5] * __uint_as_float(w.z & 0xffff0000u) + qs[d8 * 8 + 6] * __uint_as_float(w.w << 16) + qs[d8 * 8 + 7] * __uint_as_float(w.w & 0xffff0000u); }
#pragma unroll
        for (int d4 = 0; d4 < 8; ++d4) { const f32x4 w = *(const f32x4*)(kp + d4 * 4); a += qs[64 + d4 * 4] * w.x + qs[65 + d4 * 4] * w.y + qs[66 + d4 * 4] * w.z + qs[67 + d4 * 4] * w.w; }
        sc[j] = a; mx = fmaxf(mx, a); }
    mx = wave_max(mx); float sum = 0.f;
    for (int j = lane; j < nk; j += 64) { const float pe = __expf(sc[j] - mx); sc[j] = pe; sum += pe; }
    sum = wave_sum(sum);
    LDS_WAIT(); asm volatile("" ::: "memory");
    float o0 = 0.f, o1 = 0.f, o2 = 0.f, o3 = 0.f; int j = 0;
    const bf16* vb = F.KV + 512 + h * 64 + lane;
    for (; j + 4 <= nk; j += 4) {
        const int r0 = j < NMETA ? R_META + j : b * SEQ + (j - NMETA);
        o0 += sc[j] * bf2f(vb[(size_t)r0 * 1024]); o1 += sc[j + 1] * bf2f(vb[(size_t)(r0 + 1) * 1024]); o2 += sc[j + 2] * bf2f(vb[(size_t)(r0 + 2) * 1024]); o3 += sc[j + 3] * bf2f(vb[(size_t)(r0 + 3) * 1024]); }
    for (; j < nk; ++j) { const int r0 = j < NMETA ? R_META + j : b * SEQ + (j - NMETA); o0 += sc[j] * bf2f(vb[(size_t)r0 * 1024]); }
    F.MIX[(size_t)r * 1024 + 512 + h * 64 + lane] = (bf16)f2bf(((o0 + o1) + (o2 + o3)) / sum);
    LDS_WAIT(); asm volatile("" ::: "memory");
}
__device__ __forceinline__ void attn_sample_partial(Frame& F, int task) {
    const int tid = F.tid, lane = F.lane, wave = F.wave; const int bs = task / NSPLITX, split = task % NSPLITX;
    LAS float* qf = (LAS float*)(F.lds + RING_OFF);
    LAS float* Kc = qf + 32 * 288;
    LAS float* pp = Kc + 64 * 289;
    LAS float* st = pp + 32 * 64;
    __syncthreads();
    { for (int e = tid; e < 32 * 64; e += 512) { const int rr = e >> 6, n = e & 63, t = rr >> 3, h = rr & 7; Kc[e] = bf2f(F.QM[(size_t)(R_SAMP + bs * 4 + t) * 768 + h * 64 + n]); }
      { const int rr = tid >> 4, i = tid & 15, t = rr >> 3, h = rr & 7; const bf16* qrow = F.QM + (size_t)(R_SAMP + bs * 4 + t) * 768 + 512 + h * 32;
        const float x1 = bf2f(qrow[i]), x2 = bf2f(qrow[16 + i]); const double ang = (double)(PAST + t) * pow(10000.0, -(double)i / 16.0); double sn, cs; sincos(ang, &sn, &cs);
        const float c = (float)cs, s = (float)sn; qf[rr * 288 + 256 + i] = (x1 * c - x2 * s) * MLA_SCALE; qf[rr * 288 + 272 + i] = (x2 * c + x1 * s) * MLA_SCALE; } }
    __syncthreads();
    { const int rr = tid & 31, h = rr & 7;
      for (int i = 0; i < 16; ++i) { const int c = (tid >> 5) + 16 * i; const float* w = F.w_kv_b + (size_t)c * 1024 + h * 128; float a = 0.f;
#pragma unroll 8
          for (int n = 0; n < 64; ++n) a += Kc[rr * 64 + n] * w[n];
          qf[rr * 288 + c] = a * MLA_SCALE; } }
    if (tid < 32) { st[tid] = -INFINITY; st[32 + tid] = 0.f; }
    __syncthreads();
    float acc[16];
#pragma unroll
    for (int i = 0; i < 16; ++i) acc[i] = 0.f;
    const int nchunk = split < NSPLIT ? SPLIT_KEYS / 64 : 1;
    for (int ch = 0; ch < nchunk; ++ch) {
        if (split < NSPLIT) { const int key0 = split * SPLIT_KEYS + ch * 64;
            for (int i = 0; i < 8; ++i) { const int e = i * 512 + tid, key = e >> 6, c4 = e & 63; const int kk = key0 + key; const int page = F.page_table[bs * NPAGES + (kk >> 7)];
                const f32x4 v = *((const f32x4*)(F.cache_latent + ((size_t)page * PAGE + (kk & 127)) * 256) + c4); LAS float* d = Kc + key * 289 + c4 * 4; d[0] = v.x; d[1] = v.y; d[2] = v.z; d[3] = v.w; }
            { const int key = tid >> 3, c4 = tid & 7; const int kk = key0 + key; const int page = F.page_table[bs * NPAGES + (kk >> 7)];
              const f32x4 v = *((const f32x4*)(F.cache_krope + ((size_t)page * PAGE + (kk & 127)) * 32) + c4); LAS float* d = Kc + key * 289 + 256 + c4 * 4; d[0] = v.x; d[1] = v.y; d[2] = v.z; d[3] = v.w; } }
        else { for (int e = tid; e < 64 * 288; e += 512) { const int key = e / 288, c = e % 288; float v = 0.f;
                if (key < NST) v = c < 256 ? F.out[O_LATS + ((size_t)bs * NST + key) * 256 + c] : F.KPE[(size_t)(R_SAMP + bs * NST + key) * 32 + (c - 256)];
                Kc[key * 289 + c] = v; } }
        __syncthreads();
        { float s4[4] = {0.f, 0.f, 0.f, 0.f}; const LAS float* kr = Kc + lane * 289;
          for (int c = 0; c < 288; ++c) { const float kv = kr[c];
#pragma unroll
              for (int i = 0; i < 4; ++i) s4[i] += qf[(wave + 8 * i) * 288 + c] * kv; }
#pragma unroll
          for (int i = 0; i < 4; ++i) { const int rr = wave + 8 * i; float v = s4[i]; if (split == NSPLIT && lane > (rr >> 3)) v = -INFINITY; pp[rr * 64 + lane] = v; } }
        __syncthreads();
#pragma unroll
        for (int i = 0; i < 4; ++i) { const int rr = wave * 4 + i; const float v = pp[rr * 64 + lane]; const float mo = st[rr], mn = fmaxf(mo, wave_max(v));
            const float pe = __expf(v - mn); const float sm = wave_sum(pe); const float scl = __expf(mo - mn);
            pp[rr * 64 + lane] = pe; if (lane == 0) { st[rr] = mn; st[32 + rr] = st[32 + rr] * scl + sm; st[64 + rr] = scl; } }
        __syncthreads();
        { const int rr = tid >> 4, c0 = tid & 15; const float scl = st[64 + rr];
#pragma unroll
          for (int i = 0; i < 16; ++i) acc[i] *= scl;
          for (int j = 0; j < 64; ++j) { const float pj = pp[rr * 64 + j]; const LAS float* kr = Kc + j * 289 + c0;
#pragma unroll
              for (int i = 0; i < 16; ++i) acc[i] += pj * kr[16 * i]; } }
        __syncthreads();
    }
    { const int rr = tid >> 4, c0 = tid & 15; float* po = F.PART + (((size_t)bs * NSPLITX + split) * 32 + rr) * 256;
#pragma unroll
      for (int i = 0; i < 16; ++i) po[c0 + 16 * i] = acc[i];
      if (tid < 32) { float* ps = F.PSTAT + (((size_t)bs * NSPLITX + split) * 32 + tid) * 2; ps[0] = st[tid]; ps[1] = st[32 + tid]; } }
    __syncthreads();
}
__device__ __forceinline__ void p4_mixers(Frame& F) {
    if (F.vcu < 64) { if (F.wave == 0) gdn_chain_naive(F, F.vcu); }
    else if (F.vcu < 96) gdn_chain_naive(F, 64 + (F.vcu - 64) * 8 + F.wave);
    { LAS float* wl = (LAS float*)(F.lds + RING_OFF) + F.wave * 2176;
      const int gw = F.vcu * NWAVES + F.wave, NGW = F.G * NWAVES;
      for (int t = gw; t < NB * NH * SEQ; t += NGW) attn_prompt_naive(F, t, wl); }
    for (int t = F.vcu; t < NSB * NSPLITX; t += F.G) attn_sample_partial(F, t);
}
__device__ __forceinline__ void p5_post(Frame& F) {
    const int lane = F.lane; const int gw = F.vcu * NWAVES + F.wave, NGW = F.G * NWAVES;
    LAS float* wl = (LAS float*)(F.lds + RING_OFF) + F.wave * 256;
    for (int t = gw; t < NSB * 32; t += NGW) { const int bs = t >> 5, rr = t & 31, tt = rr >> 3, h = rr & 7;
        float M = -INFINITY;
        for (int s = 0; s < NSPLITX; ++s) M = fmaxf(M, F.PSTAT[(((size_t)bs * NSPLITX + s) * 32 + rr) * 2]);
        float L = 0.f, o[4] = {0.f, 0.f, 0.f, 0.f};
        for (int s = 0; s < NSPLITX; ++s) { const float* ps = F.PSTAT + (((size_t)bs * NSPLITX + s) * 32 + rr) * 2; const float w = __expf(ps[0] - M); L += w * ps[1];
            const float* po = F.PART + (((size_t)bs * NSPLITX + s) * 32 + rr) * 256;
#pragma unroll
            for (int k = 0; k < 4; ++k) o[k] += w * po[lane + 64 * k]; }
        const float inv = 1.0f / L;
#pragma unroll
        for (int k = 0; k < 4; ++k) wl[lane + 64 * k] = o[k] * inv;
        LDS_WAIT(); asm volatile("" ::: "memory");
        float a = 0.f; const float* w = F.w_kv_b + h * 128 + 64 + lane;
        for (int c = 0; c < 256; ++c) a += wl[c] * w[(size_t)c * 1024];
        F.MIX[(size_t)(R_SAMP + bs * NST + tt) * 1024 + 512 + h * 64 + lane] = (bf16)f2bf(a);
        LDS_WAIT(); asm volatile("" ::: "memory"); }
    for (int r = gw; r < MT; r += NGW) {
        if (r >= R_END) { for (int c = lane; c < 1024; c += 64) F.MIX[(size_t)r * 1024 + c] = 0; continue; }
        const float gn = F.gdn_norm_g[lane];
#pragma unroll
        for (int h = 0; h < NH; ++h) { const float o = F.GO[(size_t)r * 512 + h * 64 + lane]; const float ms = wave_sum(o * o) * (1.0f / 64.0f);
            const float z = bf2f(F.PRJ[(size_t)r * NPRJ + C_Z + h * 64 + lane]);
            F.MIX[(size_t)r * 1024 + h * 64 + lane] = (bf16)f2bf(o * (1.0f / sqrtf(ms + EPS)) * gn * silu_f(z)); }
        if (r >= R_META && r < R_SAMP) for (int c = lane; c < 512; c += 64) F.MIX[(size_t)r * 1024 + 512 + c] = 0;
    }
}
__device__ __forceinline__ void p9_final(Frame& F) {
    const int gw = F.vcu * NWAVES + F.wave, NGW = F.G * NWAVES;
    for (int r = gw; r < R_END; r += NGW) {
        if (r >= R_META && r < R_SAMP) continue;
        float* o = r < R_META ? F.out + O_YP + (size_t)r * D : F.out + O_YS + (size_t)(r - R_SAMP) * D;
        const float rstd = 1.0f / sqrtf(F.SS2[r] * (1.0f / D) + EPS);
        const f32x4* hv = (const f32x4*)(F.H2 + (size_t)r * D) + F.lane; const f32x4* gv = (const f32x4*)F.final_g + F.lane;
#pragma unroll
        for (int j = 0; j < 4; ++j) *((f32x4*)o + F.lane + 64 * j) = hv[64 * j] * rstd * gv[64 * j];
    }
}

struct Args { const void* in[23]; float* out; unsigned char* ws; int ph_lo, ph_hi, li, pad; };
__global__ void __launch_bounds__(NWAVES * 64, 2) mk_fwd(Args args) {
    extern __shared__ __attribute__((aligned(16))) unsigned char lds[];
    Frame F;
    F.lds = (LAS unsigned char*)lds;
    F.MISC = (volatile LAS unsigned*)(F.lds + MISC_OFF);
    F.tid = threadIdx.x; F.lane = F.tid & 63; F.wave = __builtin_amdgcn_readfirstlane(F.tid >> 6);
    F.G = gridDim.x; F.vcu = blockIdx.x;
    unsigned char* ws = args.ws;
    F.ctl = (gu32*)(ws + WS_CTL);
    F.x_prompt = (const float*)args.in[0]; F.x_sample = (const float*)args.in[1]; F.cache_latent = (const float*)args.in[2]; F.cache_krope = (const float*)args.in[3];
    F.state_conv = (const float*)args.in[4]; F.state_ssm = (const float*)args.in[5]; F.page_table = (const int*)args.in[6]; F.meta = (const float*)args.in[7];
    F.norm_mix_g = (const float*)args.in[8]; F.w_in = (const float*)args.in[9]; F.conv_w = (const float*)args.in[10]; F.a_log = (const float*)args.in[11]; F.dt_bias = (const float*)args.in[12];
    F.gdn_norm_g = (const float*)args.in[13]; F.q_norm_g = (const float*)args.in[14]; F.w_q_b = (const float*)args.in[15]; F.kv_norm_g = (const float*)args.in[16]; F.w_kv_b = (const float*)args.in[17];
    F.w_out = (const float*)args.in[18]; F.norm_mlp_g = (const float*)args.in[19]; F.w_up = (const float*)args.in[20]; F.w_down = (const float*)args.in[21]; F.final_g = (const float*)args.in[22];
    F.out = args.out;
    F.WIN = (bf16*)(ws + WS_WIN); F.WQB = (bf16*)(ws + WS_WQB); F.WKVB = (bf16*)(ws + WS_WKVB); F.WOUT = (bf16*)(ws + WS_WOUT); F.WUP = (bf16*)(ws + WS_WUP); F.WDN = (bf16*)(ws + WS_WDN);
    F.XN = (bf16*)(ws + WS_XN); F.PRJ = (bf16*)(ws + WS_PRJ); F.CQN = (bf16*)(ws + WS_CQN); F.LATN = (bf16*)(ws + WS_LATN); F.QM = (bf16*)(ws + WS_QM); F.KV = (bf16*)(ws + WS_KV);
    F.MIX = (bf16*)(ws + WS_MIX); F.H1B = (bf16*)(ws + WS_H1B); F.HFF = (bf16*)(ws + WS_HFF);
    F.KPE = (float*)(ws + WS_KPE); F.GQKV = (float*)(ws + WS_GQKV); F.GB = (float*)(ws + WS_GB); F.GO = (float*)(ws + WS_GO); F.H1 = (float*)(ws + WS_H1); F.H2 = (float*)(ws + WS_H2);
    F.PART = (float*)(ws + WS_PART); F.PSTAT = (float*)(ws + WS_PSTAT); F.SS1 = (float*)(ws + WS_CTL) + CW_SS1; F.SS2 = (float*)(ws + WS_CTL) + CW_SS2;
    for (int u = F.tid; u < (LDS_BYTES - LDSCTL_OFF) / 4; u += NWAVES * 64) ((LAS unsigned*)(F.lds + LDSCTL_OFF))[u] = 0u;
    __syncthreads();
    XcdBarrier bar; bar.bar = (unsigned*)(F.ctl + CW_BAR); bar.x = 0; bar.st = nullptr;
    if (N_LAUNCHES == 1) bar = xcd_barrier_post((unsigned*)(F.ctl + CW_BAR), F.MISC + 8);
#define GRID_BAR() do { if (N_LAUNCHES == 1) xcd_barrier(bar); } while (0)
    const int lo = args.ph_lo, hi = args.ph_hi;
#define IN(k) (lo <= (k) && (k) < hi)
#define BOTH(k) (IN(k) && IN((k) + 1))

    if (IN(0)) { p0_prologue(F); VM_WAIT(); __syncthreads(); if (BOTH(0)) GRID_BAR(); }
    if (IN(1)) {
        pg8::Gemm g{F.XN, F.WIN, MT, NPRJ, D}; pg8::StaticOrder S; S.init(MT, NPRJ, F.G, (int)blockIdx.x);
        pg8::EpiStoreBf16 E{F.PRJ, NPRJ};
        pg8::gemm_phase<pg8::EpiStoreBf16, pg8::StaticOrder, true, true>(F.lds + RING_OFF, g, S, E);
        if (BOTH(1)) GRID_BAR();
    }
    if (IN(2)) {
        const int gw = F.vcu * NWAVES + F.wave, NGW = F.G * NWAVES;
        for (int r = gw; r < MT; r += NGW) p2_row(F, r);
        VM_WAIT(); __syncthreads();
        if (BOTH(2)) GRID_BAR();
    }
    if (IN(3)) {
        { pg8::Gemm g{F.CQN, F.WQB, MT, 768, QLORA}; pg8::StaticOrder S; S.init(MT, 768, F.G, (int)blockIdx.x);
          pg8::EpiStoreBf16 E{F.QM, 768};
          pg8::gemm_phase<pg8::EpiStoreBf16, pg8::StaticOrder, true, true>(F.lds + RING_OFF, g, S, E); }
        { pg8::Gemm g{F.LATN, F.WKVB, MT, 1024, KVLORA}; pg8::StaticOrder S; S.init(MT, 1024, F.G, (int)blockIdx.x);
          pg8::EpiStoreBf16 E{F.KV, 1024};
          pg8::gemm_phase<pg8::EpiStoreBf16, pg8::StaticOrder, true, true>(F.lds + RING_OFF, g, S, E); }
        if (BOTH(3)) GRID_BAR();
    }
    if (IN(4)) { p4_mixers(F); VM_WAIT(); __syncthreads(); if (BOTH(4)) GRID_BAR(); }
    if (IN(5)) { p5_post(F); VM_WAIT(); __syncthreads(); if (BOTH(5)) GRID_BAR(); }
    if (IN(6)) {
        pg8::Gemm g{F.MIX, F.WOUT, MT, D, 1024}; pg8::StaticOrder S; S.init(MT, D, F.G, (int)blockIdx.x);
        pg8::EpiResid1 E{F.x_prompt, F.meta, F.x_sample, F.H1, F.H1B, F.SS1};
        pg8::gemm_phase<pg8::EpiResid1, pg8::StaticOrder, true, true>(F.lds + RING_OFF, g, S, E);
        if (BOTH(6)) GRID_BAR();
    }
    if (IN(7)) {
        pg8::Gemm g{F.H1B, F.WUP, MT, FF, D}; pg8::StaticOrder S; S.init(MT, FF, F.G, (int)blockIdx.x);
        pg8::EpiUp E{F.HFF, FF, F.SS1};
        pg8::gemm_phase<pg8::EpiUp, pg8::StaticOrder, true, true>(F.lds + RING_OFF, g, S, E);
        if (BOTH(7)) GRID_BAR();
    }
    if (IN(8)) {
        pg8::Gemm g{F.HFF, F.WDN, MT, D, FF}; pg8::StaticOrder S; S.init(MT, D, F.G, (int)blockIdx.x);
        pg8::EpiResid2 E{F.H1, F.H2, F.SS2};
        pg8::gemm_phase<pg8::EpiResid2, pg8::StaticOrder, true, true>(F.lds + RING_OFF, g, S, E);
        if (BOTH(8)) GRID_BAR();
    }
    if (IN(9)) { p9_final(F); }
#undef IN
#undef BOTH
}

extern "C" void kernel_launch(void* const* d_in, const int* in_sizes, int n_in, void* d_out, int out_size, void* d_ws, size_t ws_size, hipStream_t stream) {
    static int grid = 0;
    if (grid == 0) {
        if (n_in != 23 || out_size != (int)O_END || ws_size < WS_END) { fprintf(stderr, "kernel_launch: unexpected shapes: n_in %d out %d ws %zu (need %zu); nothing launched\n", n_in, out_size, ws_size, (size_t)WS_END); grid = -1; return; }
        int dev = 0, cus = 0, per_cu = 0;
        if (hipGetDevice(&dev) != hipSuccess || hipDeviceGetAttribute(&cus, hipDeviceAttributeMultiprocessorCount, dev) != hipSuccess) { fprintf(stderr, "kernel_launch: device query failed\n"); grid = -1; return; }
        if (hipFuncSetAttribute((const void*)mk_fwd, hipFuncAttributeMaxDynamicSharedMemorySize, LDS_BYTES) != hipSuccess) { fprintf(stderr, "kernel_launch: hipFuncSetAttribute failed\n"); grid = -1; return; }
        if (hipOccupancyMaxActiveBlocksPerMultiprocessor(&per_cu, (const void*)mk_fwd, NWAVES * 64, LDS_BYTES) != hipSuccess || per_cu < 1) { fprintf(stderr, "kernel_launch: occupancy query says %d blocks per CU\n", per_cu); per_cu = 1; }
        (void)hipGetLastError();
        grid = cus;
        fprintf(stderr, "kernel_launch: grid %d (cus %d, per_cu %d)\n", grid, cus, per_cu);
    }
    if (grid < 0) return;
    if (hipMemsetAsync((char*)d_ws + WS_CTL, 0, CTL_ZERO_BYTES, stream) != hipSuccess) { fprintf(stderr, "kernel_launch: memset failed\n"); return; }
    Args a{};
    for (int i = 0; i < 23; ++i) a.in[i] = d_in[i];
    a.out = (float*)d_out; a.ws = (unsigned char*)d_ws;
    for (int li = 0; li < N_LAUNCHES; ++li) {
        if (N_LAUNCHES == 1) { a.ph_lo = 0; a.ph_hi = NPHASES; } else { a.ph_lo = li * NPHASES / N_LAUNCHES; a.ph_hi = (li + 1) * NPHASES / N_LAUNCHES; }
        a.li = li;
        hipLaunchKernelGGL(mk_fwd, dim3(grid), dim3(NWAVES * 64), LDS_BYTES, stream, a);
        const hipError_t le = hipPeekAtLastError();
        if (le != hipSuccess) { fprintf(stderr, "kernel_launch: launch %d failed: %s\n", li, hipGetErrorName(le)); break; }
    }
}
```

```cpp
#include <hip/hip_runtime.h>
#include <cstdio>
#include <cstdint>
#include <cmath>
namespace pg8 {
#define PG8_LAS __attribute__((address_space(3)))
typedef unsigned short bf16_t;
typedef short bf16x8 __attribute__((ext_vector_type(8)));
typedef float f32x4 __attribute__((ext_vector_type(4)));
typedef unsigned u32x4 __attribute__((ext_vector_type(4)));
constexpr int BM = 256, BK = 64, HALF = 128, HTB = HALF * BK * 2  , STAGE_BYTES = 8 * HTB, NXCD = 8, WGM = 8;

__host__ __device__ __forceinline__ int lds_byte(int r, int c) { const int st = (r >> 4) * 2 + (c >> 5), rr = r & 15, cc = c & 31, ob = rr * 64 + cc * 2; return st * 1024 + (ob ^ (((ob >> 9) & 1) << 5)); }
__host__ __device__ __forceinline__ void stage_rc(int b, int& R, int& C) { const int st = b / 1024, sb = b % 1024, swz = sb ^ (((sb >> 9) & 1) << 5); R = (st >> 1) * 16 + swz / 64; C = (st & 1) * 32 + (swz % 64) / 2; }
__host__ __device__ __forceinline__ int perm32(int rho) { const int n = rho >> 4, i = rho & 15; return 8 * (i >> 2) + 4 * n + (i & 3); }

struct Unit { int pm, pn, ko; };
struct Gemm { const bf16_t* A; const bf16_t* Bt; int M, N, K, ld; };

struct StaticOrder {
    int nM, nN, nwg, G, c;
    __host__ __device__ void init(int M, int N, int G_, int c_) { nM = M / BM; nN = N / BM; nwg = nM * nN; G = G_; c = c_; }
    __host__ __device__ bool next(int i, Unit& u) const {
        const long L = (long)i * G + c; if (L >= nwg) return false;
        int wgid = (int)L; { const int q = nwg / NXCD, r = nwg % NXCD, xcd = wgid % NXCD, off = wgid / NXCD; wgid = (xcd < r ? xcd * (q + 1) : r * (q + 1) + (xcd - r) * q) + off; }
        const int nig = WGM * nN, gid = wgid / nig, fm = gid * WGM, gsz = (nM - fm) < WGM ? (nM - fm) : WGM;
        u.pm = fm + ((wgid % nig) % gsz); u.pn = (wgid % nig) / gsz; u.ko = 0; return true;
    }
    __device__ __forceinline__ void a_ready(const Unit&) const {}
    __device__ __forceinline__ void done(const Unit&) const {}
};

struct OneUnit {
    int pm, pn;
    __host__ __device__ bool next(int i, Unit& u) const { if (i != 0) return false; u.pm = pm; u.pn = pn; u.ko = 0; return true; }
    __device__ __forceinline__ void a_ready(const Unit&) const {}
    __device__ __forceinline__ void done(const Unit&) const {}
};
struct SplitKOrder {
    int nN, nS, ks, G, c;
    __host__ __device__ void init(int N, int nslices, int kslice, int G_, int c_) { nN = N / BM; nS = nslices; ks = kslice; G = G_; c = c_; }
    __host__ __device__ bool next(int i, Unit& u) const { const long L = (long)i * G + c; if (L >= nN * nS) return false; u.pm = 0; u.pn = (int)(L % nN); u.ko = (int)(L / nN) * ks; return true; }
    __device__ __forceinline__ void a_ready(const Unit&) const {}
    __device__ __forceinline__ void done(const Unit&) const {}
};
__device__ __forceinline__ unsigned cvt_pk_bf16(float lo, float hi) { unsigned r; asm volatile("v_cvt_pk_bf16_f32 %0, %1, %2" : "=v"(r) : "v"(lo), "v"(hi)); return r; }
constexpr int ROWS_REAL = 16384, ROW_META = 16384, ROW_SAMP = 16400, ROW_END = 16528;
__device__ __forceinline__ const float* x_row_ptr(const float* xp, const float* xm, const float* xs, int row) {
    if (row < ROW_META) return xp + (size_t)row * 1024;
    if (row < ROW_SAMP) return xm + (size_t)(row - ROW_META) * 1024;
    if (row < ROW_END) return xs + (size_t)(row - ROW_SAMP) * 1024;
    return nullptr;
}
struct EpiStoreBf16 {
    static constexpr bool PERM = true, AFTER_DRAIN = false;
    bf16_t* O; int ldc;
    __device__ __forceinline__ void operator()(const f32x4 (&acc)[2][2][4][2], const Unit& u, int wr, int wc, int fr, int fq) const {
        asm volatile("" : "+v"(fr), "+v"(fq));
        const int row0 = u.pm * BM + wr * 64 + fr, col0 = u.pn * BM + wc * 32 + 8 * fq;
#pragma unroll
        for (int ai = 0; ai < 2; ++ai)
#pragma unroll
            for (int m = 0; m < 4; ++m) { bf16_t* rowp = O + (size_t)(row0 + ai * HALF + m * 16) * ldc + col0;
#pragma unroll
                for (int bj = 0; bj < 2; ++bj) { const f32x4 v0 = acc[ai][bj][m][0], v1 = acc[ai][bj][m][1];
                    u32x4 w; w.x = cvt_pk_bf16(v0[0], v0[1]); w.y = cvt_pk_bf16(v0[2], v0[3]); w.z = cvt_pk_bf16(v1[0], v1[1]); w.w = cvt_pk_bf16(v1[2], v1[3]);
                    *(u32x4*)(rowp + bj * HALF) = w; } }
    }
};
struct EpiResid1 {
    static constexpr bool PERM = true, AFTER_DRAIN = false;
    const float* xp; const float* xm; const float* xs; bf16_t* H1B; float* ss; float* H2;
    __device__ __forceinline__ void operator()(const f32x4 (&acc)[2][2][4][2], const Unit& u, int wr, int wc, int fr, int fq) const {
        asm volatile("" : "+v"(fr), "+v"(fq));
        const int row0 = u.pm * BM + wr * 64 + fr, col0 = u.pn * BM + wc * 32 + 8 * fq;
#pragma unroll
        for (int ai = 0; ai < 2; ++ai)
#pragma unroll
          for (int mh = 0; mh < 2; ++mh) {
            f32x4 xv[2][2][2]; float fl[2];
#pragma unroll
            for (int mm = 0; mm < 2; ++mm) { const int row = row0 + ai * HALF + (2 * mh + mm) * 16;
                const float* xb = row < ROW_META ? xp : (row < ROW_SAMP ? xm : (row < ROW_END ? xs : xp));
                const int rel = row < ROW_META ? row : (row < ROW_SAMP ? row - ROW_META : (row < ROW_END ? row - ROW_SAMP : 0));
                fl[mm] = row < ROW_END ? 1.f : 0.f; const float* xq = xb + (size_t)rel * 1024;
#pragma unroll
                for (int bj = 0; bj < 2; ++bj) { const int col = col0 + bj * HALF; xv[mm][bj][0] = *(const f32x4*)(xq + col); xv[mm][bj][1] = *(const f32x4*)(xq + col + 4); } }
#pragma unroll
            for (int mm = 0; mm < 2; ++mm) { const int m = 2 * mh + mm; const int row = row0 + ai * HALF + m * 16; float part = 0.f;
#pragma unroll
                for (int bj = 0; bj < 2; ++bj) { const int col = col0 + bj * HALF;
                    const f32x4 v0 = acc[ai][bj][m][0] + xv[mm][bj][0] * fl[mm], v1 = acc[ai][bj][m][1] + xv[mm][bj][1] * fl[mm];
                    u32x4 w; w.x = cvt_pk_bf16(v0[0], v0[1]); w.y = cvt_pk_bf16(v0[2], v0[3]); w.z = cvt_pk_bf16(v1[0], v1[1]); w.w = cvt_pk_bf16(v1[2], v1[3]);
                    *(u32x4*)(H1B + (size_t)row * 1024 + col) = w;
                    if (u.pm == 64) { *(f32x4*)(H2 + (size_t)row * 1024 + col) = v0; *(f32x4*)(H2 + (size_t)row * 1024 + col + 4) = v1; }
                    part += (v0[0] * v0[0] + v0[1] * v0[1]) + (v0[2] * v0[2] + v0[3] * v0[3]) + (v1[0] * v1[0] + v1[1] * v1[1]) + (v1[2] * v1[2] + v1[3] * v1[3]); }
                part += __shfl_xor(part, 16); part += __shfl_xor(part, 32);
                if (fq == 0 && ss) __hip_atomic_fetch_add(ss + row, part, __ATOMIC_RELAXED, __HIP_MEMORY_SCOPE_AGENT); } }
    }
};
struct EpiUp {
    static constexpr bool PERM = true, AFTER_DRAIN = false;
    bf16_t* O; int ldc; const float* ss;
    __device__ __forceinline__ void operator()(const f32x4 (&acc)[2][2][4][2], const Unit& u, int wr, int wc, int fr, int fq) const {
        asm volatile("" : "+v"(fr), "+v"(fq));
        const int row0 = u.pm * BM + wr * 64 + fr, col0 = u.pn * BM + wc * 32 + 8 * fq;
        float ssv[2][4];
#pragma unroll
        for (int ai = 0; ai < 2; ++ai)
#pragma unroll
            for (int m = 0; m < 4; ++m) ssv[ai][m] = ss[row0 + ai * HALF + m * 16];
#pragma unroll
        for (int ai = 0; ai < 2; ++ai)
#pragma unroll
            for (int m = 0; m < 4; ++m) { const int row = row0 + ai * HALF + m * 16; bf16_t* rowp = O + (size_t)row * ldc + col0;
                const float rs = 1.0f / sqrtf(ssv[ai][m] * (1.0f / 1024.0f) + 1e-6f);
#pragma unroll
                for (int bj = 0; bj < 2; ++bj) { f32x4 v0 = acc[ai][bj][m][0] * rs, v1 = acc[ai][bj][m][1] * rs;
#pragma unroll
                    for (int e = 0; e < 4; ++e) { const float a = fmaxf(v0[e], 0.f), b = fmaxf(v1[e], 0.f); v0[e] = a * a; v1[e] = b * b; }
                    u32x4 w; w.x = cvt_pk_bf16(v0[0], v0[1]); w.y = cvt_pk_bf16(v0[2], v0[3]); w.z = cvt_pk_bf16(v1[0], v1[1]); w.w = cvt_pk_bf16(v1[2], v1[3]);
                    *(u32x4*)(rowp + bj * HALF) = w; } }
    }
};
struct EpiResid2 {
    static constexpr bool PERM = true, AFTER_DRAIN = false;
    const bf16_t* H1B; bf16_t* H2B;
    __device__ __forceinline__ void operator()(const f32x4 (&acc)[2][2][4][2], const Unit& u, int wr, int wc, int fr, int fq) const {
        asm volatile("" : "+v"(fr), "+v"(fq));
        const int row0 = u.pm * BM + wr * 64 + fr, col0 = u.pn * BM + wc * 32 + 8 * fq;
#pragma unroll
        for (int ai = 0; ai < 2; ++ai) {
            u32x4 hv[4][2];
#pragma unroll
            for (int m = 0; m < 4; ++m)
#pragma unroll
                for (int bj = 0; bj < 2; ++bj) hv[m][bj] = *(const u32x4*)(H1B + (size_t)(row0 + ai * HALF + m * 16) * 1024 + col0 + bj * HALF);
#pragma unroll
            for (int m = 0; m < 4; ++m) { const int row = row0 + ai * HALF + m * 16;
#pragma unroll
                for (int bj = 0; bj < 2; ++bj) { const size_t off = (size_t)row * 1024 + col0 + bj * HALF;
                    const u32x4 hb = hv[m][bj];
                    const f32x4 h0 = (f32x4){__uint_as_float(hb.x << 16), __uint_as_float(hb.x & 0xffff0000u), __uint_as_float(hb.y << 16), __uint_as_float(hb.y & 0xffff0000u)};
                    const f32x4 h1 = (f32x4){__uint_as_float(hb.z << 16), __uint_as_float(hb.z & 0xffff0000u), __uint_as_float(hb.w << 16), __uint_as_float(hb.w & 0xffff0000u)};
                    const f32x4 v0 = acc[ai][bj][m][0] + h0, v1 = acc[ai][bj][m][1] + h1;
                    u32x4 w; w.x = cvt_pk_bf16(v0[0], v0[1]); w.y = cvt_pk_bf16(v0[2], v0[3]); w.z = cvt_pk_bf16(v1[0], v1[1]); w.w = cvt_pk_bf16(v1[2], v1[3]);
                    *(u32x4*)(H2B + off) = w; } } }
    }
};
struct EpiAtomicAdd {
    static constexpr bool PERM = true, AFTER_DRAIN = false;
    float* H2;
    __device__ __forceinline__ void operator()(const f32x4 (&acc)[2][2][4][2], const Unit& u, int wr, int wc, int fr, int fq) const {
        asm volatile("" : "+v"(fr), "+v"(fq));
        const int row0 = wr * 64 + fr, col0 = u.pn * BM + wc * 32 + 8 * fq;
#pragma unroll
        for (int ai = 0; ai < 2; ++ai)
#pragma unroll
            for (int m = 0; m < 4; ++m) { const int row = row0 + ai * HALF + m * 16;
                if (row >= 16 && row < 144) {
#pragma unroll
                    for (int bj = 0; bj < 2; ++bj) { float* p = H2 + (size_t)row * 1024 + col0 + bj * HALF;
#pragma unroll
                        for (int e = 0; e < 4; ++e) { __hip_atomic_fetch_add(p + e, acc[ai][bj][m][0][e], __ATOMIC_RELAXED, __HIP_MEMORY_SCOPE_AGENT); __hip_atomic_fetch_add(p + 4 + e, acc[ai][bj][m][1][e], __ATOMIC_RELAXED, __HIP_MEMORY_SCOPE_AGENT); } } } }
    }
};
struct EpiQ {
    static constexpr bool PERM = true, AFTER_DRAIN = false;
    bf16_t* O; const float* rope; float c2;
    __device__ __forceinline__ void operator()(const f32x4 (&acc)[2][2][4][2], const Unit& u, int wr, int wc, int fr, int fq) const {
        asm volatile("" : "+v"(fr), "+v"(fq));
        const int row0 = u.pm * BM + wr * 64 + fr, col0 = u.pn * BM + wc * 32 + 8 * fq;
        const bool dorope = (u.pn == 2);
#pragma unroll
        for (int ai = 0; ai < 2; ++ai) {
            f32x4 cs[4][4];
            if (dorope) {
#pragma unroll
                for (int m = 0; m < 4; ++m) { const int row = row0 + ai * HALF + m * 16;
                    const int pi = row < ROW_META ? 16 + (row & 2047) : (row < ROW_SAMP ? row - ROW_META : (row < ROW_END ? 2064 + ((row - ROW_SAMP) & 3) : 0));
                    const float* tb = rope + (size_t)pi * 32 + ((8 * fq) & 15);
                    cs[m][0] = *(const f32x4*)(tb); cs[m][1] = *(const f32x4*)(tb + 16); cs[m][2] = *(const f32x4*)(tb + 4); cs[m][3] = *(const f32x4*)(tb + 20); } }
#pragma unroll
            for (int m = 0; m < 4; ++m) { const int row = row0 + ai * HALF + m * 16; bf16_t* rowp = O + (size_t)row * 768 + col0;
#pragma unroll
                for (int bj = 0; bj < 2; ++bj) { f32x4 v0 = acc[ai][bj][m][0] * c2, v1 = acc[ai][bj][m][1] * c2;
                    if (dorope) { const f32x4 c0 = cs[m][0], s0 = cs[m][1], c1 = cs[m][2], s1 = cs[m][3];
                        f32x4 p0, p1;
#pragma unroll
                        for (int e = 0; e < 4; ++e) { p0[e] = __shfl_xor(v0[e], 32); p1[e] = __shfl_xor(v1[e], 32); }
                        if (fq < 2) { v0 = v0 * c0 - p0 * s0; v1 = v1 * c1 - p1 * s1; } else { v0 = v0 * c0 + p0 * s0; v1 = v1 * c1 + p1 * s1; } }
                    u32x4 w; w.x = cvt_pk_bf16(v0[0], v0[1]); w.y = cvt_pk_bf16(v0[2], v0[3]); w.z = cvt_pk_bf16(v1[0], v1[1]); w.w = cvt_pk_bf16(v1[2], v1[3]);
                    *(u32x4*)(rowp + bj * HALF) = w; } } }
    }
};
template <class Epi, class Sched, bool ALIGN_EPI = false, bool SP2 = false>
__device__ __forceinline__ void gemm_phase(PG8_LAS unsigned char* lds, const Gemm g, const Sched& S, const Epi& E) {
    int tid_ = threadIdx.x; asm volatile("" : "+v"(tid_));
    const int tid = tid_, wid = __builtin_amdgcn_readfirstlane(tid >> 6), lane = tid & 63, wr = wid >> 2, wc = wid & 3, fr = lane & 15, fq = lane >> 4;
    const int K = g.ld, nt = g.K / BK;
    unsigned voffA[2], voffB[2];
#pragma unroll
    for (int i = 0; i < 2; ++i) { int R, C; stage_rc(tid * 16 + i * 8192, R, C); const int Rb = Epi::PERM ? ((R & ~31) + perm32(R & 31)) : R;
        voffA[i] = (unsigned)(R * K + C) * 2u; voffB[i] = (unsigned)(Rb * K + C) * 2u; }
    const size_t kstep = (size_t)(BK * 2);
    const size_t hstep = (size_t)HALF * K * 2;
    const size_t tstep = 2 * hstep;
    const unsigned ldsw = (unsigned)wid * 1024u;
    const int aoff = lds_byte(wr * 64 + fr, fq * 8), boff = lds_byte(wc * 32 + fr, fq * 8);
#define PG8_SA(b, h) (((b) * 2 + (h)) * HTB)
#define PG8_SB(b, h) ((4 + (b) * 2 + (h)) * HTB)
#define PG8_STAGE(bufoff, gbase, voff) do { _Pragma("unroll") for (int _i = 0; _i < 2; ++_i) \
        __builtin_amdgcn_global_load_lds((const unsigned*)((const char*)(gbase) + (voff)[_i]), (PG8_LAS unsigned*)(lds + (bufoff) + ldsw + _i * 8192), 16, 0, 0); } while (0)
#define PG8_LDA(dst, b, h) do { _Pragma("unroll") for (int m = 0; m < 4; ++m) _Pragma("unroll") for (int k = 0; k < 2; ++k) dst[m][k] = *(const PG8_LAS bf16x8*)(lds + PG8_SA(b, h) + aoff + m * 2048 + k * 1024); } while (0)
#define PG8_LDB(dst, b, h) do { _Pragma("unroll") for (int n = 0; n < 2; ++n) _Pragma("unroll") for (int k = 0; k < 2; ++k) dst[n][k] = *(const PG8_LAS bf16x8*)(lds + PG8_SB(b, h) + boff + n * 2048 + k * 1024); } while (0)
#define PG8_MMA(ai, bj, At, Bt) do { __builtin_amdgcn_s_setprio(1); _Pragma("unroll") for (int m = 0; m < 4; ++m) _Pragma("unroll") for (int n = 0; n < 2; ++n) _Pragma("unroll") for (int k = 0; k < 2; ++k) \
        acc[ai][bj][m][n] = __builtin_amdgcn_mfma_f32_16x16x32_bf16(Bt[n][k], At[m][k], acc[ai][bj][m][n], 0, 0, 0); __builtin_amdgcn_s_setprio(0); } while (0)
#define PG8_WAIT_V(n) asm volatile("s_waitcnt vmcnt(" #n ")" ::: "memory")
#define PG8_WAIT_L(n) asm volatile("s_waitcnt lgkmcnt(" #n ")" ::: "memory")
#define PG8_BAR __builtin_amdgcn_s_barrier()
#define PG8_SCHED __builtin_amdgcn_sched_barrier(0)
    Unit cur, nxt; int ui = 0;
    if (!S.next(0, cur)) return;
    f32x4 acc[2][2][4][2];
#pragma unroll
    for (int a = 0; a < 2; ++a)
#pragma unroll
        for (int b = 0; b < 2; ++b)
#pragma unroll
            for (int m = 0; m < 4; ++m)
#pragma unroll
                for (int n = 0; n < 2; ++n) acc[a][b][m][n] = (f32x4){0.f, 0.f, 0.f, 0.f};
    bf16x8 At[4][2], B0[2][2], B1[2][2];
    const char* cA = (const char*)g.A + (size_t)cur.pm * tstep + (size_t)cur.ko * 2; const char* cB = (const char*)g.Bt + (size_t)cur.pn * tstep + (size_t)cur.ko * 2;
    S.a_ready(cur);
    if constexpr (SP2) {
        PG8_STAGE(PG8_SB(0, 0), cB, voffB); PG8_STAGE(PG8_SB(0, 1), cB + hstep, voffB); PG8_STAGE(PG8_SA(0, 0), cA, voffA); PG8_STAGE(PG8_SA(0, 1), cA + hstep, voffA);
        if (wr == 1) PG8_BAR;
        PG8_WAIT_V(2); PG8_BAR;
        PG8_STAGE(PG8_SB(1, 0), cB + kstep, voffB); PG8_STAGE(PG8_SA(1, 0), cA + kstep, voffA); PG8_STAGE(PG8_SB(1, 1), cB + hstep + kstep, voffB);
        PG8_WAIT_V(6); PG8_BAR;
    } else {
        PG8_STAGE(PG8_SB(0, 0), cB, voffB); PG8_STAGE(PG8_SA(0, 0), cA, voffA); PG8_STAGE(PG8_SB(0, 1), cB + hstep, voffB); PG8_STAGE(PG8_SA(0, 1), cA + hstep, voffA);
        if (wr == 1) PG8_BAR;
        PG8_WAIT_V(4); PG8_BAR;
        PG8_STAGE(PG8_SB(1, 0), cB + kstep, voffB); PG8_STAGE(PG8_SA(1, 0), cA + kstep, voffA); PG8_STAGE(PG8_SB(1, 1), cB + hstep + kstep, voffB);
        PG8_WAIT_V(6); PG8_BAR;
    }
    for (;;) {
        const bool has_next = S.next(ui + 1, nxt);
        const char* nA = has_next ? (const char*)g.A + (size_t)nxt.pm * tstep + (size_t)nxt.ko * 2 : cA; const char* nB = has_next ? (const char*)g.Bt + (size_t)nxt.pn * tstep + (size_t)nxt.ko * 2 : cB;
        asm volatile(".p2align 8" ::: "memory");
#pragma clang loop unroll(disable)
        for (int t = 0; t < nt; t += 2) {
            const bool last = (t == nt - 2);
            const char* a1 = cA + (size_t)(t + 1) * kstep;
            const char* a2 = last ? nA : cA + (size_t)(t + 2) * kstep; const char* b2 = last ? nB : cB + (size_t)(t + 2) * kstep;
            const char* a3 = a2 + kstep; const char* b3 = b2 + kstep;
            if (last && has_next) S.a_ready(nxt);
            if constexpr (SP2) {
            PG8_LDB(B0, 0, 0); PG8_LDB(B1, 0, 1); PG8_SCHED; PG8_LDA(At, 0, 0); PG8_STAGE(PG8_SA(1, 1), a1 + hstep, voffA);
            PG8_WAIT_V(8); PG8_WAIT_L(0); PG8_BAR; PG8_MMA(0, 0, At, B0); PG8_MMA(0, 1, At, B1); PG8_BAR; PG8_SCHED;
            PG8_LDA(At, 0, 1); PG8_STAGE(PG8_SB(0, 0), b2, voffB); PG8_STAGE(PG8_SB(0, 1), b2 + hstep, voffB); PG8_STAGE(PG8_SA(0, 0), a2, voffA);
            PG8_WAIT_V(8); PG8_WAIT_L(0); PG8_BAR; PG8_MMA(1, 0, At, B0); PG8_MMA(1, 1, At, B1); PG8_BAR; PG8_SCHED;
            PG8_LDB(B0, 1, 0); PG8_LDB(B1, 1, 1); PG8_SCHED; PG8_LDA(At, 1, 0); PG8_STAGE(PG8_SA(0, 1), a2 + hstep, voffA);
            PG8_WAIT_V(8); PG8_WAIT_L(0); PG8_BAR; PG8_MMA(0, 0, At, B0); PG8_MMA(0, 1, At, B1); PG8_BAR; PG8_SCHED;
            PG8_LDA(At, 1, 1); PG8_STAGE(PG8_SB(1, 0), b3, voffB); PG8_STAGE(PG8_SB(1, 1), b3 + hstep, voffB); PG8_STAGE(PG8_SA(1, 0), a3, voffA);
            PG8_WAIT_V(8); PG8_WAIT_L(0); PG8_BAR; PG8_MMA(1, 0, At, B0); PG8_MMA(1, 1, At, B1); PG8_BAR; PG8_SCHED;
            } else {
            PG8_LDB(B0, 0, 0); PG8_SCHED; PG8_LDA(At, 0, 0); PG8_STAGE(PG8_SA(1, 1), a1 + hstep, voffA);
            PG8_WAIT_L(8); PG8_BAR; PG8_WAIT_L(0); PG8_MMA(0, 0, At, B0); PG8_BAR; PG8_SCHED;
            PG8_LDB(B1, 0, 1); PG8_STAGE(PG8_SB(0, 0), b2, voffB);
            PG8_BAR; PG8_WAIT_L(0); PG8_MMA(0, 1, At, B1); PG8_BAR;
            PG8_LDA(At, 0, 1); PG8_STAGE(PG8_SA(0, 0), a2, voffA);
            PG8_BAR; PG8_WAIT_L(0); PG8_MMA(1, 0, At, B0); PG8_BAR; PG8_SCHED;
            PG8_STAGE(PG8_SB(0, 1), b2 + hstep, voffB);
            PG8_WAIT_V(6); PG8_BAR; PG8_MMA(1, 1, At, B1); PG8_BAR;
            PG8_LDB(B0, 1, 0); PG8_SCHED; PG8_LDA(At, 1, 0); PG8_STAGE(PG8_SA(0, 1), a2 + hstep, voffA);
            PG8_WAIT_L(8); PG8_BAR; PG8_WAIT_L(0); PG8_MMA(0, 0, At, B0); PG8_BAR; PG8_SCHED;
            PG8_LDB(B1, 1, 1); PG8_STAGE(PG8_SB(1, 0), b3, voffB);
            PG8_BAR; PG8_WAIT_L(0); PG8_MMA(0, 1, At, B1); PG8_BAR;
            PG8_LDA(At, 1, 1); PG8_STAGE(PG8_SA(1, 0), a3, voffA);
            PG8_BAR; PG8_WAIT_L(0); PG8_MMA(1, 0, At, B0); PG8_BAR; PG8_SCHED;
            PG8_STAGE(PG8_SB(1, 1), b3 + hstep, voffB);
            PG8_WAIT_V(6); PG8_BAR; PG8_MMA(1, 1, At, B1); PG8_BAR;
            }
        }
        if constexpr (ALIGN_EPI) { if (wr == 0) PG8_BAR; }
        if constexpr (!Epi::AFTER_DRAIN) { E(acc, cur, wr, wc, fr, fq); S.done(cur); }
        if (!has_next) break;
#pragma unroll
        for (int a = 0; a < 2; ++a)
#pragma unroll
            for (int b = 0; b < 2; ++b)
#pragma unroll
                for (int m = 0; m < 4; ++m)
#pragma unroll
                    for (int n = 0; n < 2; ++n) acc[a][b][m][n] = (f32x4){0.f, 0.f, 0.f, 0.f};
        cur = nxt; cA = nA; cB = nB; ++ui;
        if constexpr (ALIGN_EPI) { if (wr == 1) PG8_BAR; }
    }
    PG8_WAIT_V(0);
    if constexpr (!ALIGN_EPI) { if (wr == 0) PG8_BAR; }
    PG8_BAR;
    if constexpr (Epi::AFTER_DRAIN) { E.fused(acc, cur, wr, wc, fr, fq, lds, wid, lane); S.done(cur); }
#undef PG8_SA
#undef PG8_SB
#undef PG8_STAGE
#undef PG8_LDA
#undef PG8_LDB
#undef PG8_MMA
#undef PG8_WAIT_V
#undef PG8_WAIT_L
#undef PG8_BAR
#undef PG8_SCHED
}
}
constexpr int NWAVES = 8;
constexpr int NPHASES = 10;
#ifndef MK_N_LAUNCHES
#define MK_N_LAUNCHES 1
#endif
#ifndef DUP_PHASE
#define DUP_PHASE -1
#endif
#ifndef DUP_SUB
#define DUP_SUB 0
#endif
constexpr int N_LAUNCHES = MK_N_LAUNCHES;

constexpr int D = 1024, NB = 8, SEQ = 2048, NREAL = NB * SEQ, NMETA = 16, NSB = 32, NST = 4, NSAMP = NSB * NST;
constexpr int R_META = NREAL, R_SAMP = NREAL + NMETA, R_END = R_SAMP + NSAMP, MT = 16640;
constexpr int TP = NMETA + SEQ;
constexpr int NPRJ = 2816;
constexpr int C_QKV = 0, C_Z = 1536, C_CQ = 2048, C_CKV = 2432, C_KPE = 2688, C_B = 2720, C_A = 2728, C_PAD = 2736;
constexpr int IN_COLS = 2736, FF = 4096, QLORA = 384, KVLORA = 256, NH = 8;
constexpr int PAST = 16384, PAGE = 128, NPAGES = 128;
constexpr float EPS = 1e-6f;
constexpr float MLA_SCALE = 0.10206207261596577f;
constexpr size_t O_YP = 0, O_YS = 16777216, O_LATP = 16908288, O_KRP = 21135360, O_CONVP = 21663744, O_SSMP = 21700608,
                 O_LATS = 21962752, O_KRS = 21995520, O_CONVS = 21999616, O_SSMS = 22147072, O_END = 23195648;
constexpr int NSPLIT = 32, SPLIT_KEYS = PAST / NSPLIT  , NSPLITX = NSPLIT + 1;

constexpr size_t MiB = 1u << 20;
constexpr size_t al(size_t x) { return (x + MiB - 1) / MiB * MiB; }
constexpr size_t WS_CTL = 0, CTL_ZERO_BYTES = 100 * 1024;
constexpr size_t WS_WIN = 1 * MiB;
constexpr size_t WS_WQB = WS_WIN + al((size_t)NPRJ * D * 2);
constexpr size_t WS_WKVB = WS_WQB + al((size_t)768 * 384 * 2);
constexpr size_t WS_WOUT = WS_WKVB + al((size_t)1024 * 256 * 2);
constexpr size_t WS_WUP = WS_WOUT + al((size_t)1024 * 1024 * 2);
constexpr size_t WS_WDN = WS_WUP + al((size_t)4096 * 1024 * 2);
constexpr size_t WS_XN = WS_WDN + al((size_t)4096 * 1024 * 2);
constexpr size_t WS_PRJ = WS_XN + al((size_t)MT * D * 2);
constexpr size_t WS_CQN = WS_PRJ + al((size_t)MT * NPRJ * 2);
constexpr size_t WS_LATN = WS_CQN + al((size_t)MT * QLORA * 2);
constexpr size_t WS_KPE = WS_LATN + al((size_t)MT * KVLORA * 2);
constexpr size_t WS_GQKV = WS_KPE + al((size_t)MT * 32 * 4);
constexpr size_t WS_GB = WS_GQKV + al((size_t)MT * 1536 * 4);
constexpr size_t WS_QM = WS_GB + al((size_t)MT * 16 * 4);
constexpr size_t WS_KV = WS_QM + al((size_t)MT * 768 * 2);
constexpr size_t WS_GO = WS_KV + al((size_t)MT * 1024 * 2);
constexpr size_t WS_MIX = WS_GO + al((size_t)MT * 512 * 4);
constexpr size_t WS_H2B = WS_MIX + al((size_t)MT * D * 2);
constexpr size_t WS_H1B = WS_H2B + al((size_t)MT * D * 2);
constexpr size_t WS_HFF = WS_H1B + al((size_t)MT * D * 2);
constexpr size_t WS_H2 = WS_HFF + al((size_t)MT * FF * 2);
constexpr size_t WS_PART = WS_H2 + al((size_t)MT * D * 4);
constexpr size_t WS_PSTAT = WS_PART + al((size_t)NSB * NSPLITX * 32 * 256 * 4);
constexpr int NROPE = TP + NST;
constexpr size_t WS_KPEB = WS_PSTAT + al((size_t)NSB * NSPLITX * 32 * 2 * 4);
constexpr size_t WS_ROPE = WS_KPEB + al((size_t)MT * 32 * 2);
constexpr size_t WS_QLAT = WS_ROPE + al((size_t)NROPE * 32 * 4);
constexpr size_t WS_EGL = WS_QLAT + al((size_t)NSB * 32 * 256 * 4);
constexpr size_t WS_S1 = WS_EGL + MiB;
constexpr size_t WS_GCH = WS_S1 + MiB;
constexpr size_t WS_END = WS_GCH + al((size_t)NB * 32 * NH * 40960);
constexpr int CW_TMO = 0, CW_CODE = 1, CW_CNT6 = 64;
constexpr int CW_BAR = 4096;
constexpr int CW_SS1 = 8192;
static_assert((size_t)(CW_SS1 + MT) * 4 <= CTL_ZERO_BYTES && CW_BAR + 3456 <= CW_SS1, "CTL words inside the memset region");

constexpr int RING_OFF = 0, RING_BYTES = 131072;
constexpr int LDSCTL_OFF = RING_BYTES, MISC_OFF = LDSCTL_OFF + 320;
constexpr int LDS_BYTES = 147456;
static_assert(MISC_OFF + 128 <= LDS_BYTES, "LDS map");
#define GAS __attribute__((address_space(1)))
#define LAS __attribute__((address_space(3)))
typedef unsigned short bf16;
typedef unsigned v4u __attribute__((ext_vector_type(4)));
typedef float f32x4 __attribute__((ext_vector_type(4)));
typedef short bf16x8 __attribute__((ext_vector_type(8)));
typedef GAS unsigned gu32;
typedef GAS unsigned long long gu64;
#define RLX_AGENT __ATOMIC_RELAXED, __HIP_MEMORY_SCOPE_AGENT
#define LDS_WAIT() asm volatile("s_waitcnt lgkmcnt(0)" ::: "memory")
#define VM_WAIT() asm volatile("s_waitcnt vmcnt(0)" ::: "memory")
__device__ __forceinline__ unsigned long long rt() { return __builtin_amdgcn_s_memrealtime(); }
__device__ __forceinline__ unsigned f2bf(float f) { unsigned u = __builtin_bit_cast(unsigned, f); return (u + 0x7fffu + ((u >> 16) & 1u)) >> 16; }
__device__ __forceinline__ unsigned pk2(float lo, float hi) { return f2bf(lo) | (f2bf(hi) << 16); }

#define XB_TMO      128
#define XB_XCNT(j)  (256  + 64 * (j))
#define XB_XSUB(j)  (1280 + 64 * (j))
#define XB_XGEN(j)  (2304 + 64 * (j))
#define XB_TOP      3328
#define XB_TOPGEN   3392
#define XCD_BAR_WORDS 3456
#define XB_SPIN_CAP (1u << 18)

__device__ __forceinline__ unsigned xb_ld(unsigned* p)              { return __hip_atomic_load(p, __ATOMIC_RELAXED, __HIP_MEMORY_SCOPE_AGENT); }
__device__ __forceinline__ unsigned xb_add(unsigned* p, unsigned v) { return __hip_atomic_fetch_add(p, v, __ATOMIC_RELAXED, __HIP_MEMORY_SCOPE_AGENT); }
__device__ __forceinline__ unsigned xb_xcc_id() { return (unsigned)__builtin_amdgcn_s_getreg((3 << 11) | 20) & 0xFu; }
#define XB_SPIN(cond, bar) do { unsigned _sp = 0; while (cond) { __builtin_amdgcn_s_sleep(1); \
    if ((++_sp & 255u) == 0u) { if (xb_ld(&(bar)[XB_TMO])) break; if (_sp > XB_SPIN_CAP) { atomicAdd(&(bar)[XB_TMO], 1u); break; } } } } while (0)

struct XcdBarrier {
    unsigned* bar; unsigned x;
    volatile LAS unsigned* st;
};

__device__ __forceinline__ XcdBarrier xcd_barrier_post(unsigned* bar, volatile LAS unsigned* st) {
    XcdBarrier b; b.bar = bar; b.x = xb_xcc_id(); b.st = st;
    if (threadIdx.x == 0) (void)xb_add(&bar[XB_XCNT(b.x)], 1u);
    return b;
}
__device__ __forceinline__ void xcd_barrier_complete(unsigned* bar, unsigned x, unsigned& nloc, unsigned& nx) {
    const unsigned G = gridDim.x * gridDim.y * gridDim.z;
    unsigned sum, cnt, mine, sp = 0u;
    for (;;) {
        sum = 0u; cnt = 0u; mine = 0u;
#pragma unroll
        for (unsigned j = 0; j < 16; ++j) { const unsigned c = xb_ld(&bar[XB_XCNT(j)]); sum += c; cnt += (c > 0u) ? 1u : 0u; mine = (j == x) ? c : mine; }
        if (sum == G) break;
        __builtin_amdgcn_s_sleep(1);
        if ((++sp & 255u) == 0u) { if (xb_ld(&bar[XB_TMO])) break; if (sp > XB_SPIN_CAP) { atomicAdd(&bar[XB_TMO], 1u); break; } }
    }
    nloc = mine > 0u ? mine : 1u; nx = cnt > 0u ? cnt : 1u;
}

__device__ __forceinline__ void xcd_barrier(const XcdBarrier& b) {
    asm volatile("s_waitcnt vmcnt(0)" ::: "memory");
    __syncthreads();
    if (threadIdx.x == 0) {
        unsigned* bar = b.bar;
        __builtin_amdgcn_s_waitcnt(0);
        unsigned nloc = b.st[0], nx = b.st[1];
        if (nloc == 0u) { xcd_barrier_complete(bar, b.x, nloc, nx); b.st[0] = nloc; b.st[1] = nx; }
        const unsigned old = xb_add(&bar[XB_XSUB(b.x)], 1u);
        const unsigned gen = old / nloc;
        if (old + 1u == (gen + 1u) * nloc) {
            __builtin_amdgcn_fence(__ATOMIC_RELEASE, "agent");
            asm volatile("s_waitcnt vmcnt(0)" ::: "memory");
            const unsigned og = xb_add(&bar[XB_TOP], 1u);
            const unsigned tg = og / nx;
            if (og + 1u == (tg + 1u) * nx) xb_add(&bar[XB_TOPGEN], 1u);
            else XB_SPIN(xb_ld(&bar[XB_TOPGEN]) == tg, bar);
            __builtin_amdgcn_fence(__ATOMIC_ACQUIRE, "agent");
            xb_add(&bar[XB_XGEN(b.x)], 1u);
            asm volatile("s_waitcnt vmcnt(0)" ::: "memory");
        } else {
            XB_SPIN(xb_ld(&bar[XB_XGEN(b.x)]) == gen, bar);
            __builtin_amdgcn_fence(__ATOMIC_ACQUIRE, "agent");
            asm volatile("s_waitcnt vmcnt(0)" ::: "memory");
        }
    }
    __syncthreads();
}
struct Frame {
    LAS unsigned char* lds;
    volatile LAS unsigned* MISC;
    gu32* ctl;
    int tid, lane, wave, vcu, G;
    const float *x_prompt, *x_sample, *cache_latent, *cache_krope, *state_conv, *state_ssm; const int* page_table;
    const float *meta, *norm_mix_g, *w_in, *conv_w, *a_log, *dt_bias, *gdn_norm_g, *q_norm_g, *w_q_b, *kv_norm_g, *w_kv_b, *w_out, *norm_mlp_g, *w_up, *w_down, *final_g;
    float* out;
    bf16 *WIN, *WQB, *WKVB, *WOUT, *WUP, *WDN, *XN, *PRJ, *CQN, *LATN, *QM, *KV, *MIX, *H1B, *HFF, *KPEB, *GQKV;
    bf16* H2B;
    float *KPE, *GB, *GO, *H2, *PART, *PSTAT, *SS1, *ROPE, *QLAT, *EGL, *S1; unsigned char* GCH;
};
__device__ __forceinline__ float bf2f(bf16 v) { return __uint_as_float((unsigned)v << 16); }
__device__ __forceinline__ float wave_sum(float v) {
#pragma unroll
    for (int o = 1; o < 64; o <<= 1) v += __shfl_xor(v, o);
    return v;
}
__device__ __forceinline__ float wave_max(float v) {
#pragma unroll
    for (int o = 1; o < 64; o <<= 1) v = fmaxf(v, __shfl_xor(v, o));
    return v;
}
__device__ __forceinline__ float silu_f(float y) { return y / (1.0f + __expf(-y)); }
__device__ __forceinline__ float rdlane(float v, int l) { return __int_as_float(__builtin_amdgcn_readlane(__float_as_int(v), l)); }
__device__ __forceinline__ int row_pos(int r) { return r < R_META ? NMETA + (r & (SEQ - 1)) : (r < R_SAMP ? r - R_META : PAST + ((r - R_SAMP) & (NST - 1))); }

__device__ __forceinline__ float wsrc(const Frame& F, int mat, int k, int n) {
    switch (mat) {
    case 0: { int c;
        if (n < C_CQ) c = n; else if (n < C_CKV) c = 2064 + (n - C_CQ); else if (n < C_KPE) c = 2448 + (n - C_CKV); else if (n < C_B) c = 2704 + (n - C_KPE);
        else if (n < C_A) c = 2048 + (n - C_B); else if (n < C_PAD) c = 2056 + (n - C_A); else return 0.f;
        return F.w_in[(size_t)k * IN_COLS + c]; }
    case 1: { const int c = n < 512 ? (n >> 6) * 96 + (n & 63) : ((n - 512) >> 5) * 96 + 64 + ((n - 512) & 31); return F.w_q_b[(size_t)k * 768 + c]; }
    case 2: { const int c = n < 512 ? (n >> 6) * 128 + (n & 63) : ((n - 512) >> 6) * 128 + 64 + ((n - 512) & 63); return F.w_kv_b[(size_t)k * 1024 + c]; }
    case 3: return F.w_out[(size_t)k * 1024 + n];
    case 4: return F.norm_mlp_g[k] * F.w_up[(size_t)k * 4096 + n];
    default: return F.w_down[(size_t)k * 1024 + n];
    }
}
__device__ __forceinline__ void p0_transpose_item(const Frame& F, int mat, int K, int N, bf16* WT, LAS float* scr, int item, int lane) {
    const int nblk = N / 32, kb = item / nblk, nb = item % nblk, k0 = 64 * kb, n0 = 32 * nb;
#pragma unroll 4
    for (int i = 0; i < 32; ++i) { const int kk = 2 * i + (lane >> 5); scr[kk * 33 + (lane & 31)] = wsrc(F, mat, k0 + kk, n0 + (lane & 31)); }
    LDS_WAIT(); asm volatile("" ::: "memory");
    const int c = lane & 7;
#pragma unroll
    for (int j = 0; j < 4; ++j) { const int n = (lane >> 3) + 8 * j; const LAS float* s = scr + (8 * c) * 33 + n;
        v4u o; o.x = pk2(s[0 * 33], s[1 * 33]); o.y = pk2(s[2 * 33], s[3 * 33]); o.z = pk2(s[4 * 33], s[5 * 33]); o.w = pk2(s[6 * 33], s[7 * 33]);
        *(GAS v4u*)(WT + (size_t)(n0 + n) * K + k0 + 8 * c) = o; }
    LDS_WAIT(); asm volatile("" ::: "memory");
}
__device__ __forceinline__ const float* x_row(const Frame& F, int r) {
    if (r < R_META) return F.x_prompt + (size_t)r * D;
    if (r < R_SAMP) return F.meta + (size_t)(r - R_META) * D;
    if (r < R_END) return F.x_sample + (size_t)(r - R_SAMP) * D;
    return nullptr;
}
__device__ __forceinline__ void p0_prologue(Frame& F) {
    LAS float* scr = (LAS float*)(F.lds + RING_OFF + F.wave * 16384);
    const int gw = F.vcu * NWAVES + F.wave, NGW = F.G * NWAVES;
    constexpr int I0 = (D / 64) * (NPRJ / 32), I1 = (QLORA / 64) * (768 / 32), I2 = (KVLORA / 64) * (1024 / 32), I3 = (1024 / 64) * (1024 / 32), I4 = (D / 64) * (FF / 32), I5 = (FF / 64) * (D / 32);
    constexpr int NITEMS = I0 + I1 + I2 + I3 + I4 + I5;
    for (int it = gw; it < NITEMS; it += NGW) {
        int r = it;
        if (r < I0) { p0_transpose_item(F, 0, D, NPRJ, F.WIN, scr, r, F.lane); continue; } r -= I0;
        if (r < I1) { p0_transpose_item(F, 1, QLORA, 768, F.WQB, scr, r, F.lane); continue; } r -= I1;
        if (r < I2) { p0_transpose_item(F, 2, KVLORA, 1024, F.WKVB, scr, r, F.lane); continue; } r -= I2;
        if (r < I3) { p0_transpose_item(F, 3, 1024, 1024, F.WOUT, scr, r, F.lane); continue; } r -= I3;
        if (r < I4) { p0_transpose_item(F, 4, D, FF, F.WUP, scr, r, F.lane); continue; } r -= I4;
        p0_transpose_item(F, 5, FF, D, F.WDN, scr, r, F.lane);
    }
    for (int e = (F.vcu * NWAVES * 64 + F.tid); e < NROPE * 16; e += F.G * NWAVES * 64) { const int pi = e >> 4, i = e & 15; const int pos = pi < TP ? pi : PAST + (pi - TP);
        const double ang = (double)pos * exp2(-(double)i * 0.83048202372184059); const double n = rint(ang * 0.15915494309189535); const float rr = (float)fma(-n, 6.2831853071795862, ang);
        F.ROPE[pi * 32 + i] = cosf(rr); F.ROPE[pi * 32 + 16 + i] = sinf(rr); }
    { const f32x4* gv = (const f32x4*)F.norm_mix_g + F.lane; f32x4 g4[4];
#pragma unroll
      for (int j = 0; j < 4; ++j) g4[j] = gv[64 * j];
      for (int m0 = gw; m0 < MT; m0 += 2 * NGW) { const int m1 = m0 + NGW;
        const float* x0 = x_row(F, m0); const float* x1 = m1 < MT ? x_row(F, m1) : nullptr;
        f32x4 v0[4], v1[4];
#pragma unroll
        for (int j = 0; j < 4; ++j) { v0[j] = x0 ? ((const f32x4*)x0 + F.lane)[64 * j] : (f32x4){0.f, 0.f, 0.f, 0.f}; v1[j] = x1 ? ((const f32x4*)x1 + F.lane)[64 * j] : (f32x4){0.f, 0.f, 0.f, 0.f}; }
        float s0 = 0.f, s1 = 0.f;
#pragma unroll
        for (int j = 0; j < 4; ++j) { s0 += (v0[j].x * v0[j].x + v0[j].y * v0[j].y) + (v0[j].z * v0[j].z + v0[j].w * v0[j].w); s1 += (v1[j].x * v1[j].x + v1[j].y * v1[j].y) + (v1[j].z * v1[j].z + v1[j].w * v1[j].w); }
        const float r0 = 1.0f / sqrtf(wave_sum(s0) * (1.0f / D) + EPS), r1 = 1.0f / sqrtf(wave_sum(s1) * (1.0f / D) + EPS);
        GAS unsigned long long* o0 = (GAS unsigned long long*)(F.XN + (size_t)m0 * D) + F.lane;
#pragma unroll
        for (int j = 0; j < 4; ++j) { const f32x4 y = v0[j] * r0 * g4[j]; o0[64 * j] = (unsigned long long)pk2(y.x, y.y) | ((unsigned long long)pk2(y.z, y.w) << 32); }
        if (m1 < MT) { GAS unsigned long long* o1 = (GAS unsigned long long*)(F.XN + (size_t)m1 * D) + F.lane;
#pragma unroll
            for (int j = 0; j < 4; ++j) { const f32x4 y = v1[j] * r1 * g4[j]; o1[64 * j] = (unsigned long long)pk2(y.x, y.y) | ((unsigned long long)pk2(y.z, y.w) << 32); } }
      } }
}

struct TapSrc { const bf16* pb; const float* pf; };
__device__ __forceinline__ TapSrc tap_src(const Frame& F, int r, int d) {
    TapSrc t; t.pb = nullptr; t.pf = nullptr;
    if (r < R_META) { const int s = r & (SEQ - 1); if (s - d >= 0) t.pb = F.PRJ + (size_t)(r - d) * NPRJ; else t.pb = F.PRJ + (size_t)(R_META + NMETA + (s - d)) * NPRJ; }
    else if (r < R_SAMP) { const int m = r - R_META; if (m - d >= 0) t.pb = F.PRJ + (size_t)(r - d) * NPRJ; }
    else if (r < R_END) { const int i = r - R_SAMP, bs = i >> 2, tt = i & 3; if (tt - d >= 0) t.pb = F.PRJ + (size_t)(r - d) * NPRJ; else t.pf = F.state_conv + ((size_t)bs * 3 + (3 + tt - d)) * 1536; }
    return t;
}
struct P2Consts { f32x4 cw[4][3][2]; float qg[6]; f32x4 kvg; float dtb, nal; };
__device__ __forceinline__ void p2_consts(const Frame& F, P2Consts& W, int lane) {
#pragma unroll
    for (int j = 0; j < 4; ++j)
#pragma unroll
        for (int sg = 0; sg < 3; ++sg) { W.cw[j][sg][0] = *(const f32x4*)(F.conv_w + j * 1536 + sg * 512 + 8 * lane); W.cw[j][sg][1] = *(const f32x4*)(F.conv_w + j * 1536 + sg * 512 + 8 * lane + 4); }
#pragma unroll
    for (int j = 0; j < 3; ++j) { W.qg[2 * j] = F.q_norm_g[128 * j + 2 * lane]; W.qg[2 * j + 1] = F.q_norm_g[128 * j + 2 * lane + 1]; }
    W.kvg = *((const f32x4*)F.kv_norm_g + lane); W.dtb = F.dt_bias[lane & 7]; W.nal = -expf(F.a_log[lane & 7]);
}
__device__ __forceinline__ void p2_row_fast(Frame& F, int r, const P2Consts& W, int lane) {
    const bf16* p = F.PRJ + (size_t)r * NPRJ; const int b = r >> 11, s2 = r & (SEQ - 1);
    unsigned cq[3];
#pragma unroll
    for (int j = 0; j < 3; ++j) cq[j] = *(const unsigned*)(p + C_CQ + 128 * j + 2 * lane);
    const unsigned long long ckv = *(const unsigned long long*)(p + C_CKV + 4 * lane);
    const bf16 kp1 = p[C_KPE + (lane & 15)], kp2 = p[C_KPE + 16 + (lane & 15)], bbr = p[C_B + (lane & 7)], aar = p[C_A + (lane & 7)];
    const float rc = F.ROPE[(NMETA + s2) * 32 + (lane & 15)], rs = F.ROPE[(NMETA + s2) * 32 + 16 + (lane & 15)];
    v4u xt[4][3];
#pragma unroll
    for (int j = 0; j < 4; ++j)
#pragma unroll
        for (int sg = 0; sg < 3; ++sg) xt[j][sg] = *(const v4u*)(p - (size_t)(3 - j) * NPRJ + sg * 512 + 8 * lane);
    { float v[6]; float s = 0.f;
#pragma unroll
      for (int j = 0; j < 3; ++j) { v[2 * j] = __uint_as_float(cq[j] << 16); v[2 * j + 1] = __uint_as_float(cq[j] & 0xffff0000u); s += v[2 * j] * v[2 * j] + v[2 * j + 1] * v[2 * j + 1]; }
      const float rstd = 1.0f / sqrtf(wave_sum(s) * (1.0f / QLORA) + EPS);
#pragma unroll
      for (int j = 0; j < 3; ++j) *(unsigned*)(F.CQN + (size_t)r * QLORA + 128 * j + 2 * lane) = pk2(v[2 * j] * rstd * W.qg[2 * j], v[2 * j + 1] * rstd * W.qg[2 * j + 1]); }
    { float v[4]; v[0] = __uint_as_float((unsigned)(ckv << 16) & 0xffff0000u); v[1] = __uint_as_float((unsigned)ckv & 0xffff0000u); v[2] = __uint_as_float((unsigned)(ckv >> 16) & 0xffff0000u); v[3] = __uint_as_float((unsigned)(ckv >> 32) & 0xffff0000u);
      const float s = (v[0] * v[0] + v[1] * v[1]) + (v[2] * v[2] + v[3] * v[3]);
      const float rstd = 1.0f / sqrtf(wave_sum(s) * (1.0f / KVLORA) + EPS);
      const f32x4 y = {v[0] * rstd * W.kvg.x, v[1] * rstd * W.kvg.y, v[2] * rstd * W.kvg.z, v[3] * rstd * W.kvg.w};
      *(unsigned long long*)(F.LATN + (size_t)r * KVLORA + 4 * lane) = (unsigned long long)pk2(y.x, y.y) | ((unsigned long long)pk2(y.z, y.w) << 32);
      *((f32x4*)(F.out + O_LATP + ((size_t)b * TP + NMETA + s2) * KVLORA) + lane) = y; }
    if (lane < 16) { const float x1 = bf2f(kp1), x2 = bf2f(kp2), o1 = x1 * rc - x2 * rs, o2 = x2 * rc + x1 * rs;
      F.KPE[(size_t)r * 32 + lane] = o1; F.KPE[(size_t)r * 32 + 16 + lane] = o2; F.KPEB[(size_t)r * 32 + lane] = (bf16)f2bf(o1); F.KPEB[(size_t)r * 32 + 16 + lane] = (bf16)f2bf(o2);
      float* o = F.out + O_KRP + ((size_t)b * TP + NMETA + s2) * 32; o[lane] = o1; o[16 + lane] = o2; }
    if (lane < 8) { const float beta = 1.0f / (1.0f + expf(-bf2f(bbr))); const float xx = bf2f(aar) + W.dtb; const float sp = xx > 20.f ? xx : log1pf(expf(xx));
      F.GB[(size_t)r * 16 + lane] = beta; F.GB[(size_t)r * 16 + 8 + lane] = W.nal * sp; }
#pragma unroll
    for (int sg = 0; sg < 3; ++sg) { float y[8];
#pragma unroll
        for (int e = 0; e < 8; ++e) y[e] = 0.f;
#pragma unroll
        for (int j = 0; j < 4; ++j) { const v4u w = xt[j][sg]; const f32x4 w0 = W.cw[j][sg][0], w1 = W.cw[j][sg][1];
            y[0] += __uint_as_float(w.x << 16) * w0.x; y[1] += __uint_as_float(w.x & 0xffff0000u) * w0.y; y[2] += __uint_as_float(w.y << 16) * w0.z; y[3] += __uint_as_float(w.y & 0xffff0000u) * w0.w;
            y[4] += __uint_as_float(w.z << 16) * w1.x; y[5] += __uint_as_float(w.z & 0xffff0000u) * w1.y; y[6] += __uint_as_float(w.w << 16) * w1.z; y[7] += __uint_as_float(w.w & 0xffff0000u) * w1.w; }
        float ss = 0.f;
#pragma unroll
        for (int e = 0; e < 8; ++e) { y[e] = silu_f(y[e]); ss += y[e] * y[e]; }
        if (sg < 2) { ss += __shfl_xor(ss, 1); ss += __shfl_xor(ss, 2); ss += __shfl_xor(ss, 4); const float sc = (sg == 0 ? 0.125f : 1.0f) / sqrtf(ss + EPS);
#pragma unroll
            for (int e = 0; e < 8; ++e) y[e] *= sc; }
        v4u o; o.x = pk2(y[0], y[1]); o.y = pk2(y[2], y[3]); o.z = pk2(y[4], y[5]); o.w = pk2(y[6], y[7]);
        *(v4u*)(F.GQKV + (size_t)r * 1536 + sg * 512 + 8 * lane) = o; }
}
__device__ __forceinline__ void p2_row(Frame& F, int r) {
    int lane_ = F.lane; asm volatile("" : "+v"(lane_)); const int lane = lane_;
    const bf16* p = F.PRJ + (size_t)r * NPRJ;
    if (r >= R_END) {
        for (int c = lane; c < QLORA; c += 64) F.CQN[(size_t)r * QLORA + c] = 0;
        for (int c = lane; c < KVLORA; c += 64) F.LATN[(size_t)r * KVLORA + c] = 0;
        return; }
    { float v[6]; float s = 0.f;
#pragma unroll
      for (int j = 0; j < 3; ++j) { const unsigned w = *(const unsigned*)(p + C_CQ + 128 * j + 2 * lane); v[2 * j] = __uint_as_float(w << 16); v[2 * j + 1] = __uint_as_float(w & 0xffff0000u); s += v[2 * j] * v[2 * j] + v[2 * j + 1] * v[2 * j + 1]; }
      const float rstd = 1.0f / sqrtf(wave_sum(s) * (1.0f / QLORA) + EPS);
#pragma unroll
      for (int j = 0; j < 3; ++j) { const int c = 128 * j + 2 * lane; *(unsigned*)(F.CQN + (size_t)r * QLORA + c) = pk2(v[2 * j] * rstd * F.q_norm_g[c], v[2 * j + 1] * rstd * F.q_norm_g[c + 1]); } }
    { const unsigned long long w = *(const unsigned long long*)(p + C_CKV + 4 * lane); float v[4];
      v[0] = __uint_as_float((unsigned)(w << 16) & 0xffff0000u); v[1] = __uint_as_float((unsigned)w & 0xffff0000u); v[2] = __uint_as_float((unsigned)(w >> 16) & 0xffff0000u); v[3] = __uint_as_float((unsigned)(w >> 32) & 0xffff0000u);
      const float s = (v[0] * v[0] + v[1] * v[1]) + (v[2] * v[2] + v[3] * v[3]);
      const float rstd = 1.0f / sqrtf(wave_sum(s) * (1.0f / KVLORA) + EPS);
      const f32x4 g = *((const f32x4*)F.kv_norm_g + lane);
      const f32x4 y = {v[0] * rstd * g.x, v[1] * rstd * g.y, v[2] * rstd * g.z, v[3] * rstd * g.w};
      *(unsigned long long*)(F.LATN + (size_t)r * KVLORA + 4 * lane) = (unsigned long long)pk2(y.x, y.y) | ((unsigned long long)pk2(y.z, y.w) << 32);
      if (r < R_META) { const int b = r >> 11, s2 = r & (SEQ - 1); *((f32x4*)(F.out + O_LATP + ((size_t)b * TP + NMETA + s2) * KVLORA) + lane) = y; }
      else if (r < R_SAMP) { const int m = r - R_META;
#pragma unroll
          for (int b = 0; b < NB; ++b) *((f32x4*)(F.out + O_LATP + ((size_t)b * TP + m) * KVLORA) + lane) = y; }
      else *((f32x4*)(F.out + O_LATS + (size_t)(r - R_SAMP) * KVLORA) + lane) = y; }
    if (lane < 16) { const float x1 = bf2f(p[C_KPE + lane]), x2 = bf2f(p[C_KPE + 16 + lane]);
      const int pi = r < R_META ? NMETA + (r & (SEQ - 1)) : (r < R_SAMP ? r - R_META : TP + ((r - R_SAMP) & (NST - 1)));
      const float c = F.ROPE[pi * 32 + lane], s = F.ROPE[pi * 32 + 16 + lane], o1 = x1 * c - x2 * s, o2 = x2 * c + x1 * s;
      F.KPE[(size_t)r * 32 + lane] = o1; F.KPE[(size_t)r * 32 + 16 + lane] = o2; F.KPEB[(size_t)r * 32 + lane] = (bf16)f2bf(o1); F.KPEB[(size_t)r * 32 + 16 + lane] = (bf16)f2bf(o2);
      if (r < R_META) { const int b = r >> 11, s2 = r & (SEQ - 1); float* o = F.out + O_KRP + ((size_t)b * TP + NMETA + s2) * 32; o[lane] = o1; o[16 + lane] = o2; }
      else if (r < R_SAMP) { const int m = r - R_META; for (int b = 0; b < NB; ++b) { float* o = F.out + O_KRP + ((size_t)b * TP + m) * 32; o[lane] = o1; o[16 + lane] = o2; } }
      else { float* o = F.out + O_KRS + (size_t)(r - R_SAMP) * 32; o[lane] = o1; o[16 + lane] = o2; } }
    if (lane < 8) { const float bb = bf2f(p[C_B + lane]), aa = bf2f(p[C_A + lane]);
      const float beta = 1.0f / (1.0f + expf(-bb)); const float xx = aa + F.dt_bias[lane];
      const float sp = xx > 20.f ? xx : log1pf(expf(xx));
      F.GB[(size_t)r * 16 + lane] = beta; F.GB[(size_t)r * 16 + 8 + lane] = -expf(F.a_log[lane]) * sp; }
    { TapSrc ts[4];
#pragma unroll
      for (int j = 0; j < 4; ++j) ts[j] = tap_src(F, r, 3 - j);
      float y[3][8];
#pragma unroll
      for (int sg = 0; sg < 3; ++sg)
#pragma unroll
          for (int e = 0; e < 8; ++e) y[sg][e] = 0.f;
#pragma unroll
      for (int j = 0; j < 4; ++j) {
          if (!ts[j].pb && !ts[j].pf) continue;
#pragma unroll
          for (int sg = 0; sg < 3; ++sg) { const int ch = sg * 512 + 8 * lane; float x[8];
              if (ts[j].pb) { const v4u w = *(const v4u*)(ts[j].pb + ch);
                  x[0] = __uint_as_float(w.x << 16); x[1] = __uint_as_float(w.x & 0xffff0000u); x[2] = __uint_as_float(w.y << 16); x[3] = __uint_as_float(w.y & 0xffff0000u);
                  x[4] = __uint_as_float(w.z << 16); x[5] = __uint_as_float(w.z & 0xffff0000u); x[6] = __uint_as_float(w.w << 16); x[7] = __uint_as_float(w.w & 0xffff0000u); }
              else { const f32x4 a = *(const f32x4*)(ts[j].pf + ch), b2 = *(const f32x4*)(ts[j].pf + ch + 4); x[0] = a.x; x[1] = a.y; x[2] = a.z; x[3] = a.w; x[4] = b2.x; x[5] = b2.y; x[6] = b2.z; x[7] = b2.w; }
              const f32x4 w0 = *(const f32x4*)(F.conv_w + j * 1536 + ch), w1 = *(const f32x4*)(F.conv_w + j * 1536 + ch + 4);
              y[sg][0] += x[0] * w0.x; y[sg][1] += x[1] * w0.y; y[sg][2] += x[2] * w0.z; y[sg][3] += x[3] * w0.w;
              y[sg][4] += x[4] * w1.x; y[sg][5] += x[5] * w1.y; y[sg][6] += x[6] * w1.z; y[sg][7] += x[7] * w1.w; } }
#pragma unroll
      for (int sg = 0; sg < 3; ++sg) { float ss = 0.f;
#pragma unroll
          for (int e = 0; e < 8; ++e) { y[sg][e] = silu_f(y[sg][e]); ss += y[sg][e] * y[sg][e]; }
          if (sg < 2) { ss += __shfl_xor(ss, 1); ss += __shfl_xor(ss, 2); ss += __shfl_xor(ss, 4); const float sc = (sg == 0 ? 0.125f : 1.0f) / sqrtf(ss + EPS);
#pragma unroll
              for (int e = 0; e < 8; ++e) y[sg][e] *= sc; }
          v4u o; o.x = pk2(y[sg][0], y[sg][1]); o.y = pk2(y[sg][2], y[sg][3]); o.z = pk2(y[sg][4], y[sg][5]); o.w = pk2(y[sg][6], y[sg][7]);
          *(v4u*)(F.GQKV + (size_t)r * 1536 + sg * 512 + 8 * lane) = o; } }
    { float* o = nullptr;
      if (r < R_META) { const int b = r >> 11, s2 = r & (SEQ - 1); if (s2 >= SEQ - 3) o = F.out + O_CONVP + ((size_t)b * 3 + (s2 - (SEQ - 3))) * 1536; }
      else if (r >= R_SAMP) { const int i = r - R_SAMP, bs = i >> 2, tt = i & 3; if (tt >= 1) o = F.out + O_CONVS + ((size_t)bs * 3 + (tt - 1)) * 1536; }
      if (o) {
          v4u w[3];
#pragma unroll
          for (int k = 0; k < 3; ++k) w[k] = *(const v4u*)(p + 512 * k + 8 * lane);
#pragma unroll
          for (int k = 0; k < 3; ++k) { float* ok = o + 512 * k + 8 * lane;
              *(f32x4*)ok = (f32x4){__uint_as_float(w[k].x << 16), __uint_as_float(w[k].x & 0xffff0000u), __uint_as_float(w[k].y << 16), __uint_as_float(w[k].y & 0xffff0000u)};
              *(f32x4*)(ok + 4) = (f32x4){__uint_as_float(w[k].z << 16), __uint_as_float(w[k].z & 0xffff0000u), __uint_as_float(w[k].w << 16), __uint_as_float(w[k].w & 0xffff0000u)}; } } }
}

namespace fa {
typedef float f32x16 __attribute__((ext_vector_type(16)));
typedef short s16x4 __attribute__((ext_vector_type(4)));
typedef short v4i16_t __attribute__((ext_vector_type(4)));
constexpr int KOFF = 0, VOFF = 12288, STAGE = 20480;
constexpr int LDS_WSF = 2 * STAGE, LDS_OST = LDS_WSF + 8 * 256, LDS_TOTAL = LDS_OST + 8 * 4096;
static_assert(LDS_TOTAL <= RING_BYTES, "attention LDS");
__device__ __forceinline__ int crow(int r, int hi) { return (r & 3) + 8 * (r >> 2) + 4 * hi; }
typedef float f32x2_t __attribute__((ext_vector_type(2))); typedef __bf16 bf16x2_t __attribute__((ext_vector_type(2)));
__device__ __forceinline__ unsigned cvtpk(float lo, float hi) { f32x2_t v = {lo, hi}; bf16x2_t b = __builtin_convertvector(v, bf16x2_t); return __builtin_bit_cast(unsigned, b); }
__device__ __forceinline__ s16x4 vtr(const LAS unsigned char* p) { return __builtin_bit_cast(s16x4, __builtin_amdgcn_ds_read_tr16_b64_v4i16((LAS v4i16_t*)p)); }
__device__ __forceinline__ void issue_tile(const Frame& F, LAS unsigned char* st, int b, int h, int t, bool meta, int wid, int lane) {
    { const int key = lane; const int krow = meta ? R_META + (key < NMETA ? key : NMETA - 1) : b * SEQ + 64 * t + key;
      __builtin_amdgcn_global_load_lds((const unsigned*)(F.KV + (size_t)krow * 1024 + h * 64 + wid * 8), (LAS unsigned*)(st + KOFF + wid * 1024), 16, 0, 0);
      if (wid < 4) __builtin_amdgcn_global_load_lds((const unsigned*)(F.KPEB + (size_t)krow * 32 + wid * 8), (LAS unsigned*)(st + KOFF + (8 + wid) * 1024), 16, 0, 0); }
    { const int key = 16 * (wid & 3) + (lane >> 2); const int vrow = meta ? R_META + (key < NMETA ? key : NMETA - 1) : b * SEQ + 64 * t + key;
      __builtin_amdgcn_global_load_lds((const unsigned*)(F.KV + (size_t)vrow * 1024 + 512 + h * 64 + (wid >> 2) * 32 + (lane & 3) * 8), (LAS unsigned*)(st + VOFF + wid * 1024), 16, 0, 0); }
}
__device__ __forceinline__ void attn_unit(const Frame& F, int b, int h, int qb) {
    const int lane = F.lane, wid = F.wave, r32 = lane & 31, hi = lane >> 5;
    LAS unsigned char* base = F.lds + RING_OFF;
    LAS float* wsf = (LAS float*)(base + LDS_WSF) + wid * 64;
    const int s0 = 256 * qb + 32 * wid; const size_t row0 = (size_t)b * SEQ + s0;
    const int NTR = 4 * (qb + 1), NT = NTR + 1;
    const int td = 4 * qb + (wid >> 1);
    __syncthreads();
    issue_tile(F, base, b, h, 0, false, wid, lane);
    bf16x8 qr[6];
    { const bf16* q = F.QM + (row0 + r32) * 768;
#pragma unroll
      for (int d0 = 0; d0 < 4; ++d0) qr[d0] = *(const bf16x8*)(q + h * 64 + d0 * 16 + hi * 8);
#pragma unroll
      for (int d0 = 0; d0 < 2; ++d0) qr[4 + d0] = *(const bf16x8*)(q + 512 + h * 32 + d0 * 16 + hi * 8); }
    f32x16 o0, o1;
#pragma unroll
    for (int r = 0; r < 16; ++r) { o0[r] = 0.f; o1[r] = 0.f; }
    float m = -INFINITY, l = 0.f;
    const int qrel = 32 * (wid & 1) + r32;
    const int vlane = ((lane >> 4) & 1) * 32 + (lane & 3) * 8 + (4 * hi + ((lane & 15) >> 2)) * 64;
    for (int t = 0; t < NT; ++t) {
        const bool meta = (t == NTR);
        asm volatile("s_waitcnt vmcnt(0)" ::: "memory");
        __syncthreads();
        if (t + 1 < NT) issue_tile(F, base + ((t + 1) & 1) * STAGE, b, h, t + 1, t + 1 == NTR, wid, lane);
        if (!meta && t > td) continue;
        const LAS unsigned char* st = base + (t & 1) * STAGE;
        const LAS unsigned char* kb = st + KOFF + hi * 1024 + r32 * 16;
        f32x16 p0, p1;
#pragma unroll
        for (int r = 0; r < 16; ++r) { p0[r] = 0.f; p1[r] = 0.f; }
#pragma unroll
        for (int d0 = 0; d0 < 6; ++d0) {
            const bf16x8 k0 = *(const LAS bf16x8*)(kb + d0 * 2048);
            p0 = __builtin_amdgcn_mfma_f32_32x32x16_bf16(k0, qr[d0], p0, 0, 0, 0);
            if (!meta) { const bf16x8 k1 = *(const LAS bf16x8*)(kb + d0 * 2048 + 512); p1 = __builtin_amdgcn_mfma_f32_32x32x16_bf16(k1, qr[d0], p1, 0, 0, 0); }
        }
        if (meta) {
#pragma unroll
            for (int r = 8; r < 16; ++r) p0[r] = -INFINITY;
#pragma unroll
            for (int r = 0; r < 16; ++r) p1[r] = -INFINITY;
        } else if (t == td) {
#pragma unroll
            for (int r = 0; r < 16; ++r) { const int kk = crow(r, hi); if (kk > qrel) p0[r] = -INFINITY; if (kk + 32 > qrel) p1[r] = -INFINITY; }
        }
        float mx = fmaxf(p0[0], p1[0]);
#pragma unroll
        for (int r = 1; r < 16; ++r) mx = fmaxf(mx, fmaxf(p0[r], p1[r]));
        mx = fmaxf(mx, __shfl_xor(mx, 32));
        const float mn = fmaxf(m, mx);
        if (__any(mn > m)) {
            const float f = __builtin_amdgcn_exp2f(m - mn);
            l *= f; wsf[r32] = f;
#pragma unroll
            for (int r = 0; r < 16; ++r) { const float fr_ = wsf[crow(r, hi)]; o0[r] *= fr_; o1[r] *= fr_; }
            m = mn;
        }
        float sum = 0.f;
#pragma unroll
        for (int r = 0; r < 16; ++r) { p0[r] = __builtin_amdgcn_exp2f(p0[r] - m); p1[r] = __builtin_amdgcn_exp2f(p1[r] - m); sum += p0[r] + p1[r]; }
        l += sum;
        v4u pa0, pa1, pa2, pa3;
        pa0.x = cvtpk(p0[0], p0[1]); pa0.y = cvtpk(p0[2], p0[3]); pa0.z = cvtpk(p0[4], p0[5]); pa0.w = cvtpk(p0[6], p0[7]);
        pa1.x = cvtpk(p0[8], p0[9]); pa1.y = cvtpk(p0[10], p0[11]); pa1.z = cvtpk(p0[12], p0[13]); pa1.w = cvtpk(p0[14], p0[15]);
        pa2.x = cvtpk(p1[0], p1[1]); pa2.y = cvtpk(p1[2], p1[3]); pa2.z = cvtpk(p1[4], p1[5]); pa2.w = cvtpk(p1[6], p1[7]);
        pa3.x = cvtpk(p1[8], p1[9]); pa3.y = cvtpk(p1[10], p1[11]); pa3.z = cvtpk(p1[12], p1[13]); pa3.w = cvtpk(p1[14], p1[15]);
        const LAS unsigned char* vp = st + VOFF + vlane;
#define FA_PV(O, PA, DB, KS) do { const s16x4 lo_ = vtr(vp + (DB) * 4096 + (KS) * 1024), hi_ = vtr(vp + (DB) * 4096 + (KS) * 1024 + 512); \
        const bf16x8 vf_ = {lo_[0], lo_[1], lo_[2], lo_[3], hi_[0], hi_[1], hi_[2], hi_[3]}; \
        O = __builtin_amdgcn_mfma_f32_32x32x16_bf16(__builtin_bit_cast(bf16x8, PA), vf_, O, 0, 0, 0); } while (0)
        FA_PV(o0, pa0, 0, 0); FA_PV(o1, pa0, 1, 0);
        if (!meta) { FA_PV(o0, pa1, 0, 1); FA_PV(o1, pa1, 1, 1); FA_PV(o0, pa2, 0, 2); FA_PV(o1, pa2, 1, 2); FA_PV(o0, pa3, 0, 3); FA_PV(o1, pa3, 1, 3); }
#undef FA_PV
    }
    l += __shfl_xor(l, 32);
    wsf[32 + r32] = l;
    float rli[16];
#pragma unroll
    for (int r = 0; r < 16; ++r) rli[r] = 1.0f / wsf[32 + crow(r, hi)];
    LAS bf16* stg = (LAS bf16*)(base + LDS_OST) + wid * 2048;
#pragma unroll
    for (int r = 0; r < 16; ++r) { const int orow = crow(r, hi); stg[orow * 64 + r32] = (bf16)f2bf(o0[r] * rli[r]); stg[orow * 64 + 32 + r32] = (bf16)f2bf(o1[r] * rli[r]); }
#pragma unroll
    for (int i = 0; i < 4; ++i) { const int row = i * 8 + (lane >> 3), ch = lane & 7; const v4u v = *(const LAS v4u*)(stg + row * 64 + ch * 8);
        *(v4u*)(F.MIX + (row0 + row) * 1024 + 512 + h * 64 + ch * 8) = v; }
}
__device__ __forceinline__ void attn_phase(const Frame& F) {
    for (int u = F.vcu; u < 256; u += F.G) { const int bh = u >> 2, pr = u & 3;
        attn_unit(F, bh >> 3, bh & 7, pr); attn_unit(F, bh >> 3, bh & 7, 7 - pr); }
    __syncthreads();
}
}

namespace sa {
using fa::f32x16; using fa::s16x4; using fa::crow; using fa::cvtpk; using fa::vtr;
constexpr int CS = 528, TILE = 36 * CS  , QF_OFF = 4 * TILE  , WSF_OFF = QF_OFF + 32 * 288 * 2  , LDS_TOTAL = WSF_OFF + 8 * 256;
static_assert(LDS_TOTAL <= RING_BYTES && QF_OFF % 16 == 0 && WSF_OFF % 16 == 0, "sample attention LDS");
constexpr int NUNIT = 8, KEYS_PER = PAST / NUNIT  , NTC = KEYS_PER / 64  , NSPL = 2 * NUNIT  ;
__device__ __forceinline__ void tile_step(const LAS unsigned char* st, const bf16x8 (&qf)[18], f32x16& o0, f32x16& o1, float& m, float& l, LAS float* wsf, int r32, int hi, int vlane) {
        const LAS unsigned char* kb = st + hi * CS + r32 * 16;
        f32x16 p0;
#pragma unroll
        for (int r = 0; r < 16; ++r) p0[r] = 0.f;
#pragma unroll
        for (int s = 0; s < 18; ++s) { const bf16x8 k0 = *(const LAS bf16x8*)(kb + 2 * s * CS); p0 = __builtin_amdgcn_mfma_f32_32x32x16_bf16(k0, qf[s], p0, 0, 0, 0); }
        float mx = p0[0];
#pragma unroll
        for (int r = 1; r < 16; ++r) mx = fmaxf(mx, p0[r]);
        mx = fmaxf(mx, __shfl_xor(mx, 32));
        const float mn = fmaxf(m, mx);
        if (__any(mn > m)) {
            const float f = __builtin_amdgcn_exp2f(m - mn);
            l *= f; wsf[r32] = f;
#pragma unroll
            for (int r = 0; r < 16; ++r) { const float fr_ = wsf[crow(r, hi)]; o0[r] *= fr_; o1[r] *= fr_; }
            m = mn;
        }
        float sum = 0.f;
#pragma unroll
        for (int r = 0; r < 16; ++r) { p0[r] = __builtin_amdgcn_exp2f(p0[r] - m); sum += p0[r]; }
        l += sum;
        v4u pa0, pa1;
        pa0.x = cvtpk(p0[0], p0[1]); pa0.y = cvtpk(p0[2], p0[3]); pa0.z = cvtpk(p0[4], p0[5]); pa0.w = cvtpk(p0[6], p0[7]);
        pa1.x = cvtpk(p0[8], p0[9]); pa1.y = cvtpk(p0[10], p0[11]); pa1.z = cvtpk(p0[12], p0[13]); pa1.w = cvtpk(p0[14], p0[15]);
        const LAS unsigned char* vp = st + vlane;
#define SA_PV(O, PA, CT, KS) do { const s16x4 lo_ = vtr(vp + (CT) * 4 * CS + (KS) * 256), hi_ = vtr(vp + (CT) * 4 * CS + (KS) * 256 + 128); \
        const bf16x8 vf_ = {lo_[0], lo_[1], lo_[2], lo_[3], hi_[0], hi_[1], hi_[2], hi_[3]}; \
        O = __builtin_amdgcn_mfma_f32_32x32x16_bf16(__builtin_bit_cast(bf16x8, PA), vf_, O, 0, 0, 0); } while (0)
        SA_PV(o0, pa0, 0, 0); SA_PV(o1, pa0, 1, 0); SA_PV(o0, pa1, 0, 1); SA_PV(o1, pa1, 1, 1);
#undef SA_PV
}
__device__ __forceinline__ void attn_unit(const Frame& F, int bs, int split) {
    const int tid = F.tid, lane = F.lane, wid = F.wave, r32 = lane & 31, hi = lane >> 5, g = wid >> 2, w4 = wid & 3, tg = tid & 255;
    LAS unsigned char* base = F.lds + RING_OFF;
    LAS bf16* qfb = (LAS bf16*)(base + QF_OFF);
    LAS float* wsf = (LAS float*)(base + WSF_OFF) + wid * 64;
    __syncthreads();
    { LAS float* tmp = (LAS float*)base;
      for (int e = tid; e < 32 * 64; e += 512) { const int rr = e >> 6, n = e & 63, t = rr >> 3, h = rr & 7; tmp[e] = bf2f(F.QM[(size_t)(R_SAMP + bs * 4 + t) * 768 + h * 64 + n]); }
      for (int e = tid; e < 32 * 32; e += 512) { const int rr = e >> 5, i = e & 31, t = rr >> 3, h = rr & 7; qfb[rr * 288 + 256 + i] = F.QM[(size_t)(R_SAMP + bs * 4 + t) * 768 + 512 + h * 32 + i]; }
      __syncthreads();
      { int tz = tid; asm volatile("" : "+v"(tz)); const int h = tz & 7;
#pragma unroll 1
        for (int j = 0; j < 4; ++j) { const int c = (tz >> 3) + 64 * j; const f32x4* w = (const f32x4*)(F.w_kv_b + (size_t)c * 1024 + h * 128);
            f32x4 wv[16];
#pragma unroll
            for (int k = 0; k < 16; ++k) wv[k] = w[k];
#pragma unroll
            for (int t = 0; t < 4; ++t) { const LAS f32x4* q4 = (const LAS f32x4*)(tmp + (t * 8 + h) * 64); float a = 0.f;
#pragma unroll
                for (int k = 0; k < 16; ++k) { const f32x4 q = q4[k]; a += (wv[k].x * q.x + wv[k].y * q.y) + (wv[k].z * q.z + wv[k].w * q.w); }
                qfb[(t * 8 + h) * 288 + c] = (bf16)f2bf(a); if (split == 0) F.QLAT[((size_t)bs * 32 + t * 8 + h) * 256 + c] = a; } } }
      __syncthreads(); }
    bf16x8 qf[18];
#pragma unroll
    for (int s = 0; s < 18; ++s) qf[s] = *(const LAS bf16x8*)(qfb + r32 * 288 + 16 * s + 8 * hi);
    const int ptv = F.page_table[bs * NPAGES + split * (KEYS_PER / PAGE) + (lane & 15)];
    f32x4 RA[9], RB[9];
#define SA_LOAD(R, t) do { const int key0_ = (t) * 64 + g * 32; const int page_ = __builtin_amdgcn_readlane(ptv, key0_ >> 7); const size_t rb_ = (size_t)page_ * PAGE + (key0_ & 127); \
        _Pragma("unroll") for (int i_ = 0; i_ < 8; ++i_) R[i_] = *((const f32x4*)(F.cache_latent + (rb_ + i_ * 4 + w4) * 256) + lane); \
        R[8] = *((const f32x4*)(F.cache_krope + (rb_ + (tg >> 3)) * 32) + (tg & 7)); } while (0)
#define SA_WRITE(R, buf) do { LAS unsigned char* b_ = base + (g * 2 + (buf)) * TILE; \
        _Pragma("unroll") for (int i_ = 0; i_ < 8; ++i_) { const unsigned long long w_ = (unsigned long long)cvtpk(R[i_].x, R[i_].y) | ((unsigned long long)cvtpk(R[i_].z, R[i_].w) << 32); \
            *(LAS unsigned long long*)(b_ + (lane >> 1) * CS + (i_ * 4 + w4) * 16 + (lane & 1) * 8) = w_; } \
        { const unsigned long long w_ = (unsigned long long)cvtpk(R[8].x, R[8].y) | ((unsigned long long)cvtpk(R[8].z, R[8].w) << 32); \
          *(LAS unsigned long long*)(b_ + (32 + ((tg & 7) >> 1)) * CS + (tg >> 3) * 16 + (tg & 1) * 8) = w_; } } while (0)
    SA_LOAD(RA, 0); SA_WRITE(RA, 0); SA_LOAD(RB, 1); SA_LOAD(RA, 2);
    f32x16 o0, o1;
#pragma unroll
    for (int r = 0; r < 16; ++r) { o0[r] = 0.f; o1[r] = 0.f; }
    float m = -INFINITY, l = 0.f;
    const int vlane = (8 * w4 + 2 * ((lane >> 4) & 1) + ((lane & 3) >> 1)) * CS + (4 * hi + ((lane & 15) >> 2)) * 16 + 8 * (lane & 1);
    for (int t = 0; t < NTC; t += 2) {
        __syncthreads();
        tile_step(base + (g * 2 + 0) * TILE, qf, o0, o1, m, l, wsf, r32, hi, vlane);
        SA_WRITE(RB, 1);
        if (t + 3 < NTC) SA_LOAD(RB, t + 3);
        __syncthreads();
        tile_step(base + (g * 2 + 1) * TILE, qf, o0, o1, m, l, wsf, r32, hi, vlane);
        if (t + 2 < NTC) { SA_WRITE(RA, 0); if (t + 4 < NTC) SA_LOAD(RA, t + 4); }
    }
#undef SA_LOAD
#undef SA_WRITE
    l += __shfl_xor(l, 32);
    { int lz = lane; asm volatile("" : "+v"(lz));
      const int rz = lz & 31, hz = lz >> 5;
      const int sp = split * 2 + g; float* po = F.PART + ((size_t)(bs * NSPL + sp) * 32) * 256 + 64 * w4 + rz;
#pragma unroll
      for (int r = 0; r < 16; ++r) { po[(size_t)crow(r, hz) * 256] = o0[r]; po[(size_t)crow(r, hz) * 256 + 32] = o1[r]; }
      if (w4 == 0 && hz == 0) { float* ps = F.PSTAT + ((size_t)(bs * NSPL + sp) * 32 + rz) * 2; ps[0] = m; ps[1] = l; } }
}
__device__ __forceinline__ void attn_phase(const Frame& F) {
    for (int u = F.vcu; u < NSB * NUNIT; u += F.G) attn_unit(F, u >> 3, u & 7);
    __syncthreads();
}
}

namespace gdn {
using fa::f32x16; using fa::crow;
constexpr int REC = 40960, OFF_W = 0, OFF_QG = 8192, OFF_QK = 16384, OFF_KD = 24576, OFF_U = 32768;
constexpr int NCH = SEQ / 64;
typedef float f32x2_t __attribute__((ext_vector_type(2))); typedef __bf16 bf16x2_t __attribute__((ext_vector_type(2)));
__device__ __forceinline__ unsigned cvt2(float lo, float hi) { f32x2_t v = {lo, hi}; bf16x2_t b = __builtin_convertvector(v, bf16x2_t); return __builtin_bit_cast(unsigned, b); }
__device__ __forceinline__ bf16x8 pack8(float a0, float a1, float a2, float a3, float a4, float a5, float a6, float a7) {
    v4u w; w.x = cvt2(a0, a1); w.y = cvt2(a2, a3); w.z = cvt2(a4, a5); w.w = cvt2(a6, a7); return __builtin_bit_cast(bf16x8, w); }
__device__ __forceinline__ bf16x8 ldfrag_f32(const float* p) { const f32x4 a = *(const f32x4*)p, b = *(const f32x4*)(p + 4); return pack8(a.x, a.y, a.z, a.w, b.x, b.y, b.z, b.w); }
__device__ __forceinline__ int swz16(int c) { return (c & 3) | ((c & 4) << 1) | ((c & 8) >> 1); }

template <int PASS> __device__ __forceinline__ void solve_pass(const Frame& F, const LAS float* Lm, const LAS float* gcs, const LAS float* bts, const bf16* col, unsigned char* rec, int lane) {
    float X[64];
#pragma unroll
    for (int ib = 0; ib < 4; ++ib) {
        float c16[16];
#pragma unroll
        for (int k = 0; k < 16; ++k) c16[k] = bf2f(col[(size_t)(16 * ib + k) * 1536]);
        asm volatile("" ::: "memory");
#pragma unroll
        for (int k = 0; k < 16; ++k) { const int i = 16 * ib + k;
            float x = c16[k] * bts[i]; if (PASS == 1) x *= __expf(gcs[i]);
#pragma unroll
            for (int m = 0; m < (i + 3) / 4; ++m) { const f32x4 l4 = *(const LAS f32x4*)(Lm + i * 64 + ((4 * m) ^ ((i & 7) << 2)));
                if (4 * m + 0 < i) x -= l4.x * X[4 * m + 0];
                if (4 * m + 1 < i) x -= l4.y * X[4 * m + 1];
                if (4 * m + 2 < i) x -= l4.z * X[4 * m + 2];
                if (4 * m + 3 < i) x -= l4.w * X[4 * m + 3]; }
            X[i] = x;
            if ((k & 3) == 3) asm volatile("" ::: "memory");
        }
    }
    if (PASS == 0) { const unsigned lo = (unsigned)((lane >> 5) * 2048 + (lane & 31)); bf16* U = (bf16*)(rec + OFF_U);
#pragma unroll
        for (int i = 0; i < 64; ++i) { const int rt = i >> 5, ip = i & 31, hi_ = (ip >> 2) & 1, r = (ip & 3) + 4 * (ip >> 3);
            U[lo + (unsigned)((rt * 16 + r) * 64 + 32 * hi_)] = (bf16)f2bf(X[i]); } }
    else { const int s = lane >> 4, sw = swz16(lane & 15), hsel = (sw >> 3) & 1, el = sw & 7; bf16* W = (bf16*)(rec + OFF_W); const unsigned lo = (unsigned)((s * 64 + 32 * hsel) * 8 + el);
#pragma unroll
        for (int i = 0; i < 64; ++i) { const int rt = i >> 5, ip = i & 31; W[lo + (unsigned)((rt * 256 + ip) * 8)] = (bf16)f2bf(-X[i]); } }
}
__device__ __forceinline__ void g1_unit(const Frame& F, int b, int n) {
    int lane_ = F.lane; asm volatile("" : "+v"(lane_));
    const int lane = lane_, h = F.wave, r32 = lane & 31, hi = lane >> 5;
    LAS float* Lm = (LAS float*)(F.lds + RING_OFF) + h * 4096;
    LAS float* gcs = (LAS float*)(F.lds + LDSCTL_OFF + 1024) + h * 128;
    LAS float* bts = gcs + 64;
    const size_t row0 = (size_t)b * SEQ + 64 * n;
    unsigned char* rec = F.GCH + ((size_t)(b * NCH + n) * NH + h) * REC;
    const float beta_l = F.GB[(row0 + lane) * 16 + h]; float gc = F.GB[(row0 + lane) * 16 + 8 + h];
#pragma unroll
    for (int off = 1; off < 64; off <<= 1) { const float t = __shfl_up(gc, off); if (lane >= off) gc += t; }
    const float gl = rdlane(gc, 63);
    gcs[lane] = gc; bts[lane] = beta_l;
    if (lane == 0) F.EGL[(size_t)(b * NH + h) * NCH + n] = __expf(gl);
    bf16x8 kf[2][4], qf[2][4];
#pragma unroll
    for (int t = 0; t < 2; ++t)
#pragma unroll
        for (int s = 0; s < 4; ++s) { const bf16* base = F.GQKV + (row0 + 32 * t + r32) * 1536 + h * 64 + 16 * s + 8 * hi; qf[t][s] = *(const bf16x8*)base; kf[t][s] = *(const bf16x8*)(base + 512); }
    LDS_WAIT(); asm volatile("" ::: "memory");
#pragma unroll
    for (int tt = 0; tt < 3; ++tt) { const int it = tt == 0 ? 0 : 1, jt = tt == 2 ? 1 : 0;
        f32x16 acc;
#pragma unroll
        for (int r = 0; r < 16; ++r) acc[r] = 0.f;
#pragma unroll
        for (int s = 0; s < 4; ++s) acc = __builtin_amdgcn_mfma_f32_32x32x16_bf16(kf[jt][s], kf[it][s], acc, 0, 0, 0);
        const int i = 32 * it + r32; const float gci = gcs[i], bi = bts[i];
#pragma unroll
        for (int r = 0; r < 16; ++r) { const int j = 32 * jt + crow(r, hi); const float v = j < i ? bi * acc[r] * __expf(gci - gcs[j]) : 0.f; Lm[i * 64 + (j ^ ((i & 7) << 2))] = v; } }
#pragma unroll
    for (int tt = 0; tt < 4; ++tt) { const int it = tt >> 1, ct = tt & 1;
        if (ct <= it) {
            f32x16 acc;
#pragma unroll
            for (int r = 0; r < 16; ++r) acc[r] = 0.f;
#pragma unroll
            for (int s = 0; s < 4; ++s) acc = __builtin_amdgcn_mfma_f32_32x32x16_bf16(kf[ct][s], qf[it][s], acc, 0, 0, 0);
            const int i = 32 * it + r32; const float gci = gcs[i];
#pragma unroll
            for (int r = 0; r < 16; ++r) { const int c = 32 * ct + crow(r, hi); acc[r] = c <= i ? acc[r] * __expf(gci - gcs[c]) : 0.f; }
#pragma unroll
            for (int hf = 0; hf < 2; ++hf) *(bf16x8*)(rec + (unsigned)(OFF_QK + (it * 4 + 2 * ct + hf) * 1024) + (unsigned)lane * 16u) =
                pack8(acc[8 * hf], acc[8 * hf + 1], acc[8 * hf + 2], acc[8 * hf + 3], acc[8 * hf + 4], acc[8 * hf + 5], acc[8 * hf + 6], acc[8 * hf + 7]);
        } else { unsigned z = 0u; asm volatile("" : "+v"(z));
#pragma unroll
            for (int hf = 0; hf < 2; ++hf) *(v4u*)(rec + (unsigned)(OFF_QK + (it * 4 + 2 * ct + hf) * 1024) + (unsigned)lane * 16u) = (v4u){z, z, z, z}; } }
    LDS_WAIT(); asm volatile("" ::: "memory");
    const bf16* vcol = F.GQKV + row0 * 1536 + 1024 + h * 64 + lane; const bf16* kcol = F.GQKV + row0 * 1536 + 512 + h * 64 + lane; const bf16* qcol = F.GQKV + row0 * 1536 + h * 64 + lane;
    { int l2 = lane; asm volatile("" : "+v"(l2)); solve_pass<0>(F, Lm, gcs, bts, vcol, rec, l2); }
    { int l2 = lane; asm volatile("" : "+v"(l2)); solve_pass<1>(F, Lm, gcs, bts, kcol, rec, l2); }
    { const int s = lane >> 4, sw = swz16(lane & 15), hsel = (sw >> 3) & 1, el = sw & 7; bf16* QG = (bf16*)(rec + OFF_QG); const unsigned lo = (unsigned)((s * 64 + 32 * hsel) * 8 + el);
#pragma unroll 8
      for (int i = 0; i < 64; ++i) { const int rt = i >> 5, ip = i & 31; QG[lo + (unsigned)((rt * 256 + ip) * 8)] = (bf16)f2bf(bf2f(qcol[(size_t)i * 1536]) * __expf(gcs[i])); } }
    { const int rt = lane >> 5;
#pragma unroll
      for (int s = 0; s < 4; ++s)
#pragma unroll
          for (int hh = 0; hh < 2; ++hh) { float v[8];
#pragma unroll
              for (int j = 0; j < 8; ++j) { const int c = 16 * s + 8 * (j >> 2) + 4 * hh + (j & 3); v[j] = bf2f(kcol[(size_t)c * 1536]) * __expf(gl - gcs[c]); }
              *(bf16x8*)(rec + OFF_KD + (unsigned)(rt * 4096 + (lane & 31) * 16) + (unsigned)(s * 1024 + hh * 512)) = pack8(v[0], v[1], v[2], v[3], v[4], v[5], v[6], v[7]); } }
    LDS_WAIT(); asm volatile("" ::: "memory");
}
__device__ __forceinline__ void chain_short(const Frame& F, int mode, int idx) {
    const int lane = F.lane; int h, total, rbase; float S[64];
    if (mode == 0) { h = idx; total = NMETA; rbase = R_META;
#pragma unroll
        for (int d = 0; d < 64; ++d) S[d] = 0.f; }
    else { h = idx & 7; total = NST; rbase = R_SAMP + (idx >> 3) * NST;
#pragma unroll
        for (int d = 0; d < 64; ++d) S[d] = F.state_ssm[((size_t)idx * 64 + d) * 64 + lane]; }
    for (int i = 0; i < total; ++i) { const size_t r = rbase + i;
        const float q = bf2f(F.GQKV[r * 1536 + h * 64 + lane]), k = bf2f(F.GQKV[r * 1536 + 512 + h * 64 + lane]), v = bf2f(F.GQKV[r * 1536 + 1024 + h * 64 + lane]);
        const float beta = F.GB[r * 16 + h], eg = expf(F.GB[r * 16 + 8 + h]);
        float k0 = 0.f, k1 = 0.f;
#pragma unroll
        for (int d = 0; d < 64; d += 2) { k0 += rdlane(k, d) * S[d]; k1 += rdlane(k, d + 1) * S[d + 1]; }
        const float vnew = beta * (v - eg * (k0 + k1));
        float o0 = 0.f, o1 = 0.f;
#pragma unroll
        for (int d = 0; d < 64; d += 2) { S[d] = eg * S[d] + rdlane(k, d) * vnew; o0 += rdlane(q, d) * S[d]; S[d + 1] = eg * S[d + 1] + rdlane(k, d + 1) * vnew; o1 += rdlane(q, d + 1) * S[d + 1]; }
        F.GO[r * 512 + h * 64 + lane] = o0 + o1; }
    float* so = mode == 0 ? F.S1 + (size_t)h * 4096 : F.out + O_SSMS + (size_t)idx * 4096;
#pragma unroll
    for (int d = 0; d < 64; ++d) so[d * 64 + lane] = S[d];
}
__device__ __forceinline__ void g1_phase(const Frame& F) {
    for (int u = F.vcu; u < NB * NCH; u += F.G) g1_unit(F, u / NCH, u % NCH);
    const int gw = F.vcu * NWAVES + F.wave, NGW = F.G * NWAVES;
    for (int t = NGW - 1 - gw; t < NH + NSB * NH; t += NGW) { if (t < NH) chain_short(F, 0, t); else chain_short(F, 1, t - NH); }
}
__device__ __forceinline__ void g2_task(const Frame& F, int b, int h, int cb) {
    int lane_ = F.lane; asm volatile("" : "+v"(lane_));
    const int lane = lane_, r32 = lane & 31, hi = lane >> 5;
    LAS unsigned char* base = F.lds + RING_OFF;
    constexpr int BUF = 36864;
    const unsigned char* recs = F.GCH + ((size_t)(b * NCH) * NH + h) * REC;
    f32x16 S0, S1, V0, V1, O0, O1;
    { const float* s1 = F.S1 + (size_t)h * 4096 + 32 * cb + r32;
#pragma unroll
      for (int r = 0; r < 16; ++r) { S0[r] = s1[(size_t)crow(r, hi) * 64]; S1[r] = s1[(size_t)(32 + crow(r, hi)) * 64]; } }
    const float egl_l = lane < NCH ? F.EGL[(size_t)(b * NH + h) * NCH + lane] : 0.f;
    const unsigned voff16 = (unsigned)lane * 16u;
#define G2_ISSUE(n, buf) do { const unsigned char* rc_ = recs + (size_t)(n) * NH * REC; LAS unsigned char* d_ = base + (buf) * BUF; \
        _Pragma("unroll") for (int f_ = 0; f_ < 32; ++f_) __builtin_amdgcn_global_load_lds((const unsigned*)(rc_ + f_ * 1024 + voff16), (LAS unsigned*)(d_ + f_ * 1024), 16, 0, 0); \
        _Pragma("unroll") for (int f_ = 0; f_ < 4; ++f_) __builtin_amdgcn_global_load_lds((const unsigned*)(rc_ + OFF_U + (cb * 4 + f_) * 1024 + voff16), (LAS unsigned*)(d_ + 32768 + f_ * 1024), 16, 0, 0); } while (0)
    G2_ISSUE(0, 0);
    for (int n = 0; n < NCH; ++n) {
        asm volatile("s_waitcnt vmcnt(0)" ::: "memory");
        if (n + 1 < NCH) G2_ISSUE(n + 1, (n + 1) & 1);
        const LAS unsigned char* bf = base + (n & 1) * BUF;
#define G2_FR(off, f) (*(const LAS bf16x8*)(bf + (off) + (f) * 1024 + lane * 16))
        bf16x8 sb[4];
        sb[0] = pack8(S0[0], S0[1], S0[2], S0[3], S0[4], S0[5], S0[6], S0[7]); sb[1] = pack8(S0[8], S0[9], S0[10], S0[11], S0[12], S0[13], S0[14], S0[15]);
        sb[2] = pack8(S1[0], S1[1], S1[2], S1[3], S1[4], S1[5], S1[6], S1[7]); sb[3] = pack8(S1[8], S1[9], S1[10], S1[11], S1[12], S1[13], S1[14], S1[15]);
        { const LAS unsigned* up = (const LAS unsigned*)(bf + 32768);
#pragma unroll
          for (int r = 0; r < 16; ++r) { V0[r] = bf2f(((const LAS bf16*)up)[(0 * 16 + r) * 64 + lane]); V1[r] = bf2f(((const LAS bf16*)up)[(1 * 16 + r) * 64 + lane]); O0[r] = 0.f; O1[r] = 0.f; } }
#pragma unroll
        for (int s = 0; s < 4; ++s) { V0 = __builtin_amdgcn_mfma_f32_32x32x16_bf16(G2_FR(OFF_W, s), sb[s], V0, 0, 0, 0); V1 = __builtin_amdgcn_mfma_f32_32x32x16_bf16(G2_FR(OFF_W, 4 + s), sb[s], V1, 0, 0, 0);
            O0 = __builtin_amdgcn_mfma_f32_32x32x16_bf16(G2_FR(OFF_QG, s), sb[s], O0, 0, 0, 0); O1 = __builtin_amdgcn_mfma_f32_32x32x16_bf16(G2_FR(OFF_QG, 4 + s), sb[s], O1, 0, 0, 0); }
        bf16x8 vb[4];
        vb[0] = pack8(V0[0], V0[1], V0[2], V0[3], V0[4], V0[5], V0[6], V0[7]); vb[1] = pack8(V0[8], V0[9], V0[10], V0[11], V0[12], V0[13], V0[14], V0[15]);
        vb[2] = pack8(V1[0], V1[1], V1[2], V1[3], V1[4], V1[5], V1[6], V1[7]); vb[3] = pack8(V1[8], V1[9], V1[10], V1[11], V1[12], V1[13], V1[14], V1[15]);
        const float egl = rdlane(egl_l, n);
#pragma unroll
        for (int r = 0; r < 16; ++r) { S0[r] *= egl; S1[r] *= egl; }
#pragma unroll
        for (int s = 0; s < 4; ++s) { O0 = __builtin_amdgcn_mfma_f32_32x32x16_bf16(G2_FR(OFF_QK, s), vb[s], O0, 0, 0, 0); O1 = __builtin_amdgcn_mfma_f32_32x32x16_bf16(G2_FR(OFF_QK, 4 + s), vb[s], O1, 0, 0, 0);
            S0 = __builtin_amdgcn_mfma_f32_32x32x16_bf16(G2_FR(OFF_KD, s), vb[s], S0, 0, 0, 0); S1 = __builtin_amdgcn_mfma_f32_32x32x16_bf16(G2_FR(OFF_KD, 4 + s), vb[s], S1, 0, 0, 0); }
#undef G2_FR
        { unsigned* go = (unsigned*)F.GO + (size_t)((((b * NCH + n) * NH + h) * 2 + cb) * 2) * 512;
          unsigned lo = (unsigned)lane; asm volatile("" : "+v"(lo));
#pragma unroll
          for (int r = 0; r < 16; r += 2) { go[lo + (unsigned)((r >> 1) * 64)] = cvt2(O0[r], O0[r + 1]); go[lo + (unsigned)(512 + (r >> 1) * 64)] = cvt2(O1[r], O1[r + 1]); } }
    }
#undef G2_ISSUE
    { float* so = F.out + O_SSMP + ((size_t)b * NH + h) * 4096 + 32 * cb + r32;
#pragma unroll
      for (int r = 0; r < 16; ++r) { so[(size_t)crow(r, hi) * 64] = S0[r]; so[(size_t)(32 + crow(r, hi)) * 64] = S1[r]; } }
}
__device__ __forceinline__ void g2_phase(const Frame& F) {
    if (F.wave == 0) for (int t = F.vcu; t < NB * NH * 2; t += F.G) g2_task(F, t >> 4, (t >> 1) & 7, t & 1);
}
}
__device__ __forceinline__ void p4_mixers(Frame& F) {
    if (F.G == 256) {
        const int v = F.vcu, first = v < 128, w = v & 127, bh = w >> 1, b = bh >> 3, h = bh & 7;
        const unsigned ql = first ? ((w & 1) ? 0xF04u : 0xFF5u) : ((w & 1) ? 0x126u : 0xF37u);
        if (first && F.wave == 0) gdn::g2_task(F, b, h, v & 1);
        if (!first) sa::attn_unit(F, v >> 3, v & 7);
        for (int i = 0; i < 3; ++i) { const int qb = (int)((ql >> (4 * i)) & 0xFu); if (qb != 0xF) fa::attn_unit(F, b, h, qb); }
        if (first) sa::attn_unit(F, v >> 3, v & 7);
        __syncthreads();
    } else {
        gdn::g2_phase(F);
        fa::attn_phase(F);
        sa::attn_phase(F);
    }
}
__device__ __forceinline__ void p5_post(Frame& F) {
    const int lane = F.lane; const int gw = F.vcu * NWAVES + F.wave, NGW = F.G * NWAVES;
    LAS float* wl = (LAS float*)(F.lds + RING_OFF) + F.wave * 256;
    const bool bal = (F.G == 256);
    const int t0 = bal ? (F.wave < 4 ? F.wave * 256 + F.vcu : NSB * 32) : gw, tstep = bal ? NSB * 32 : NGW;
    for (int t = t0; t < NSB * 32; t += tstep) { const int bs = t >> 5, rr = t & 31, tt = rr >> 3, h = rr & 7;
        float M = -INFINITY;
        for (int s = 0; s < sa::NSPL; ++s) M = fmaxf(M, F.PSTAT[(((size_t)bs * sa::NSPL + s) * 32 + rr) * 2]);
        float L = 0.f, o[4] = {0.f, 0.f, 0.f, 0.f};
        for (int s = 0; s < sa::NSPL; ++s) { const float* ps = F.PSTAT + (((size_t)bs * sa::NSPL + s) * 32 + rr) * 2; const float w = __builtin_amdgcn_exp2f(ps[0] - M); L += w * ps[1];
            const float* po = F.PART + (((size_t)bs * sa::NSPL + s) * 32 + rr) * 256;
#pragma unroll
            for (int k = 0; k < 4; ++k) o[k] += w * po[lane + 64 * k]; }
        {
          float ql[4];
#pragma unroll
          for (int k = 0; k < 4; ++k) ql[k] = F.QLAT[((size_t)bs * 32 + rr) * 256 + lane + 64 * k];
          const float qp = lane < 32 ? bf2f(F.QM[(size_t)(R_SAMP + bs * NST + tt) * 768 + 512 + h * 32 + lane]) : 0.f;
          for (int j = 0; j <= tt; ++j) { const float* lj = F.out + O_LATS + ((size_t)bs * NST + j) * KVLORA; const float* kj = F.KPE + (size_t)(R_SAMP + bs * NST + j) * 32;
              float lv[4]; float part = lane < 32 ? qp * kj[lane] : 0.f;
#pragma unroll
              for (int k = 0; k < 4; ++k) { lv[k] = lj[lane + 64 * k]; part += ql[k] * lv[k]; }
              const float sj = wave_sum(part); const float M2 = fmaxf(M, sj); const float sc = __builtin_amdgcn_exp2f(M - M2), pj = __builtin_amdgcn_exp2f(sj - M2);
              L = L * sc + pj; M = M2;
#pragma unroll
              for (int k = 0; k < 4; ++k) o[k] = o[k] * sc + pj * lv[k]; } }
        const float inv = 1.0f / L;
#pragma unroll
        for (int k = 0; k < 4; ++k) wl[lane + 64 * k] = o[k] * inv;
        LDS_WAIT(); asm volatile("" ::: "memory");
        float a = 0.f; const float* w = F.w_kv_b + h * 128 + 64 + lane;
        for (int c = 0; c < 256; ++c) a += wl[c] * w[(size_t)c * 1024];
        F.MIX[(size_t)(R_SAMP + bs * NST + tt) * 1024 + 512 + h * 64 + lane] = (bf16)f2bf(a);
        LDS_WAIT(); asm volatile("" ::: "memory"); }
    { const int h = lane >> 3, j = lane & 7;
      const f32x4 gn0 = *(const f32x4*)(F.gdn_norm_g + 8 * j), gn1 = *(const f32x4*)(F.gdn_norm_g + 8 * j + 4);
      const int nr = bal ? (F.wave < 4 ? 5 : (F.wave == 7 ? 12 : 11)) : (MT - gw + NGW - 1) / NGW;
      const int rbase = bal ? F.vcu * 65 + (F.wave < 4 ? F.wave * 5 : 20 + (F.wave - 4) * 11) : gw, rstride = bal ? 1 : NGW;
      static_assert(MT == 256 * 65, "balanced row split");
      for (int k0 = 0; k0 < nr; k0 += 4) {
        f32x4 oa[4], ob[4]; v4u zz[4]; int rq[4];
#pragma unroll
        for (int q = 0; q < 4; ++q) { const int r = (k0 + q < nr) ? rbase + (k0 + q) * rstride : MT; rq[q] = r < MT ? r : -1;
            oa[q] = (f32x4){0.f, 0.f, 0.f, 0.f}; ob[q] = oa[q]; zz[q] = (v4u){0u, 0u, 0u, 0u};
            if (r < R_END) {
                if (r < R_META) { const int b_ = r >> 11, n_ = (r >> 6) & 31, tk = r & 63, rt = tk >> 5, ip = tk & 31, hi_ = (ip >> 2) & 1, rr_ = (ip & 3) + 4 * (ip >> 3);
                    const unsigned* op = (const unsigned*)F.GO + (size_t)((((((b_ * 32 + n_) * NH + h) * 2 + (j >> 2)) * 2 + rt) * 8 + (rr_ >> 1)) * 64) + 8 * (j & 3) + 32 * hi_;
                    const v4u w0 = *(const v4u*)op, w1 = *(const v4u*)(op + 4);
                    if (rr_ & 1) { oa[q] = (f32x4){__uint_as_float(w0.x & 0xffff0000u), __uint_as_float(w0.y & 0xffff0000u), __uint_as_float(w0.z & 0xffff0000u), __uint_as_float(w0.w & 0xffff0000u)};
                                   ob[q] = (f32x4){__uint_as_float(w1.x & 0xffff0000u), __uint_as_float(w1.y & 0xffff0000u), __uint_as_float(w1.z & 0xffff0000u), __uint_as_float(w1.w & 0xffff0000u)}; }
                    else { oa[q] = (f32x4){__uint_as_float(w0.x << 16), __uint_as_float(w0.y << 16), __uint_as_float(w0.z << 16), __uint_as_float(w0.w << 16)};
                           ob[q] = (f32x4){__uint_as_float(w1.x << 16), __uint_as_float(w1.y << 16), __uint_as_float(w1.z << 16), __uint_as_float(w1.w << 16)}; } }
                else { const float* op = F.GO + (size_t)r * 512 + h * 64 + 8 * j; oa[q] = *(const f32x4*)op; ob[q] = *(const f32x4*)(op + 4); }
                zz[q] = *(const v4u*)(F.PRJ + (size_t)r * NPRJ + C_Z + h * 64 + 8 * j); } }
#pragma unroll
        for (int q = 0; q < 4; ++q) { const int r = rq[q]; if (r < 0) continue;
            bf16* mrow = F.MIX + (size_t)r * 1024;
            if (r >= R_END) { *(v4u*)(mrow + 8 * lane) = (v4u){0u, 0u, 0u, 0u}; *(v4u*)(mrow + 512 + 8 * lane) = (v4u){0u, 0u, 0u, 0u}; continue; }
            const f32x4 o0 = oa[q], o1 = ob[q]; const v4u zw = zz[q];
            float ss = (o0.x * o0.x + o0.y * o0.y) + (o0.z * o0.z + o0.w * o0.w) + (o1.x * o1.x + o1.y * o1.y) + (o1.z * o1.z + o1.w * o1.w);
            ss += __shfl_xor(ss, 1); ss += __shfl_xor(ss, 2); ss += __shfl_xor(ss, 4);
            const float rs = 1.0f / sqrtf(ss * (1.0f / 64.0f) + EPS);
            v4u w;
            w.x = pk2(o0.x * rs * gn0.x * silu_f(__uint_as_float(zw.x << 16)), o0.y * rs * gn0.y * silu_f(__uint_as_float(zw.x & 0xffff0000u)));
            w.y = pk2(o0.z * rs * gn0.z * silu_f(__uint_as_float(zw.y << 16)), o0.w * rs * gn0.w * silu_f(__uint_as_float(zw.y & 0xffff0000u)));
            w.z = pk2(o1.x * rs * gn1.x * silu_f(__uint_as_float(zw.z << 16)), o1.y * rs * gn1.y * silu_f(__uint_as_float(zw.z & 0xffff0000u)));
            w.w = pk2(o1.z * rs * gn1.z * silu_f(__uint_as_float(zw.w << 16)), o1.w * rs * gn1.w * silu_f(__uint_as_float(zw.w & 0xffff0000u)));
            *(v4u*)(mrow + h * 64 + 8 * j) = w;
            if (r >= R_META && r < R_SAMP) *(v4u*)(mrow + 512 + 8 * lane) = (v4u){0u, 0u, 0u, 0u}; }
      } }
}
__device__ __forceinline__ void p9_final(Frame& F) {
    const int gw = F.vcu * NWAVES + F.wave, NGW = F.G * NWAVES;
    { int lane = F.lane; asm volatile("" : "+v"(lane));
      const f32x4* gv = (const f32x4*)F.final_g; f32x4 g4[4];
      g4[0] = gv[2 * lane]; g4[1] = gv[2 * lane + 1]; g4[2] = gv[128 + 2 * lane]; g4[3] = gv[128 + 2 * lane + 1];
      for (int i0 = gw; i0 < NREAL; i0 += 4 * NGW) {
        v4u hb[4][2]; int rr[4];
#pragma unroll
        for (int q = 0; q < 4; ++q) { const int r = i0 + q * NGW; rr[q] = r < NREAL ? r : -1;
            if (rr[q] >= 0) { const bf16* hp = F.H2B + (size_t)r * D + 8 * lane; hb[q][0] = *(const v4u*)hp; hb[q][1] = *(const v4u*)(hp + 512); }
            else { hb[q][0] = (v4u){0u, 0u, 0u, 0u}; hb[q][1] = hb[q][0]; } }
#pragma unroll
        for (int q = 0; q < 4; ++q) { if (rr[q] < 0) continue;
            f32x4 v[4];
#pragma unroll
            for (int k = 0; k < 2; ++k) { const v4u w = hb[q][k];
                v[2 * k] = (f32x4){__uint_as_float(w.x << 16), __uint_as_float(w.x & 0xffff0000u), __uint_as_float(w.y << 16), __uint_as_float(w.y & 0xffff0000u)};
                v[2 * k + 1] = (f32x4){__uint_as_float(w.z << 16), __uint_as_float(w.z & 0xffff0000u), __uint_as_float(w.w << 16), __uint_as_float(w.w & 0xffff0000u)}; }
            float s = 0.f;
#pragma unroll
            for (int j = 0; j < 4; ++j) s += (v[j].x * v[j].x + v[j].y * v[j].y) + (v[j].z * v[j].z + v[j].w * v[j].w);
            const float rstd = 1.0f / sqrtf(wave_sum(s) * (1.0f / D) + EPS);
            float* o = F.out + O_YP + (size_t)rr[q] * D + 8 * lane;
            *(f32x4*)o = v[0] * rstd * g4[0]; *(f32x4*)(o + 4) = v[1] * rstd * g4[1]; *(f32x4*)(o + 512) = v[2] * rstd * g4[2]; *(f32x4*)(o + 516) = v[3] * rstd * g4[3]; }
      } }
    { const f32x4* gv = (const f32x4*)F.final_g + F.lane; f32x4 g4[4];
#pragma unroll
      for (int j = 0; j < 4; ++j) g4[j] = gv[64 * j];
      for (int i = gw; i < NSAMP; i += NGW) { const int r = R_SAMP + i;
        const f32x4* hv = (const f32x4*)(F.H2 + (size_t)r * D) + F.lane; f32x4 v[4];
#pragma unroll
        for (int j = 0; j < 4; ++j) v[j] = hv[64 * j];
        float s = 0.f;
#pragma unroll
        for (int j = 0; j < 4; ++j) s += (v[j].x * v[j].x + v[j].y * v[j].y) + (v[j].z * v[j].z + v[j].w * v[j].w);
        const float rstd = 1.0f / sqrtf(wave_sum(s) * (1.0f / D) + EPS);
        float* o = F.out + O_YS + (size_t)i * D;
#pragma unroll
        for (int j = 0; j < 4; ++j) *((f32x4*)o + F.lane + 64 * j) = v[j] * rstd * g4[j]; } }
}

struct Args { const void* in[23]; float* out; unsigned char* ws; int ph_lo, ph_hi, li, pad; };
__global__ void __launch_bounds__(NWAVES * 64, 2) mk_fwd(Args args) {
    extern __shared__ __attribute__((aligned(16))) unsigned char lds[];
    Frame F;
    F.lds = (LAS unsigned char*)lds;
    F.MISC = (volatile LAS unsigned*)(F.lds + MISC_OFF);
    F.tid = threadIdx.x; F.lane = F.tid & 63; F.wave = __builtin_amdgcn_readfirstlane(F.tid >> 6);
    F.G = gridDim.x; F.vcu = blockIdx.x;
    unsigned char* ws = args.ws;
    F.ctl = (gu32*)(ws + WS_CTL);
    F.x_prompt = (const float*)args.in[0]; F.x_sample = (const float*)args.in[1]; F.cache_latent = (const float*)args.in[2]; F.cache_krope = (const float*)args.in[3];
    F.state_conv = (const float*)args.in[4]; F.state_ssm = (const float*)args.in[5]; F.page_table = (const int*)args.in[6]; F.meta = (const float*)args.in[7];
    F.norm_mix_g = (const float*)args.in[8]; F.w_in = (const float*)args.in[9]; F.conv_w = (const float*)args.in[10]; F.a_log = (const float*)args.in[11]; F.dt_bias = (const float*)args.in[12];
    F.gdn_norm_g = (const float*)args.in[13]; F.q_norm_g = (const float*)args.in[14]; F.w_q_b = (const float*)args.in[15]; F.kv_norm_g = (const float*)args.in[16]; F.w_kv_b = (const float*)args.in[17];
    F.w_out = (const float*)args.in[18]; F.norm_mlp_g = (const float*)args.in[19]; F.w_up = (const float*)args.in[20]; F.w_down = (const float*)args.in[21]; F.final_g = (const float*)args.in[22];
    F.out = args.out;
    F.WIN = (bf16*)(ws + WS_WIN); F.WQB = (bf16*)(ws + WS_WQB); F.WKVB = (bf16*)(ws + WS_WKVB); F.WOUT = (bf16*)(ws + WS_WOUT); F.WUP = (bf16*)(ws + WS_WUP); F.WDN = (bf16*)(ws + WS_WDN);
    F.XN = (bf16*)(ws + WS_XN); F.PRJ = (bf16*)(ws + WS_PRJ); F.CQN = (bf16*)(ws + WS_CQN); F.LATN = (bf16*)(ws + WS_LATN); F.QM = (bf16*)(ws + WS_QM); F.KV = (bf16*)(ws + WS_KV);
    F.MIX = (bf16*)(ws + WS_MIX); F.H1B = (bf16*)(ws + WS_H1B); F.HFF = (bf16*)(ws + WS_HFF); F.KPEB = (bf16*)(ws + WS_KPEB); F.ROPE = (float*)(ws + WS_ROPE); F.QLAT = (float*)(ws + WS_QLAT); F.EGL = (float*)(ws + WS_EGL); F.S1 = (float*)(ws + WS_S1); F.GCH = ws + WS_GCH;
    F.KPE = (float*)(ws + WS_KPE); F.GQKV = (bf16*)(ws + WS_GQKV); F.GB = (float*)(ws + WS_GB); F.GO = (float*)(ws + WS_GO); F.H2B = (bf16*)(ws + WS_H2B); F.H2 = (float*)(ws + WS_H2);
    F.PART = (float*)(ws + WS_PART); F.PSTAT = (float*)(ws + WS_PSTAT); F.SS1 = (float*)(ws + WS_CTL) + CW_SS1;
    for (int u = F.tid; u < (LDS_BYTES - LDSCTL_OFF) / 4; u += NWAVES * 64) ((LAS unsigned*)(F.lds + LDSCTL_OFF))[u] = 0u;
    __syncthreads();
    XcdBarrier bar; bar.bar = (unsigned*)(F.ctl + CW_BAR); bar.x = 0; bar.st = nullptr;
    if (N_LAUNCHES == 1) bar = xcd_barrier_post((unsigned*)(F.ctl + CW_BAR), F.MISC + 8);
#define GRID_BAR() do { if (N_LAUNCHES == 1) xcd_barrier(bar); } while (0)
    const int lo = args.ph_lo, hi = args.ph_hi;
#define IN(k) (lo <= (k) && (k) < hi)
#define BOTH(k) (IN(k) && IN((k) + 1))

    if (IN(0)) { p0_prologue(F); VM_WAIT(); __syncthreads(); if (BOTH(0)) GRID_BAR(); }
    if (IN(1)) {
        pg8::Gemm g{F.XN, F.WIN, MT, NPRJ, D, D}; pg8::StaticOrder S; S.init(MT, NPRJ, F.G, (int)blockIdx.x);
        pg8::EpiStoreBf16 E{F.PRJ, NPRJ};
        pg8::gemm_phase<pg8::EpiStoreBf16, pg8::StaticOrder, true, true>(F.lds + RING_OFF, g, S, E);
        if (BOTH(1)) GRID_BAR();
    }
    if (IN(2)) {
        const int gw = F.vcu * NWAVES + F.wave, NGW = F.G * NWAVES;
        { int lane_ = F.lane; asm volatile("" : "+v"(lane_)); P2Consts W; p2_consts(F, W, lane_);
          const int rot = (NGW == SEQ) ? 40 : 0;
#pragma clang loop unroll(disable)
          for (int k = 0; ; ++k) { int r = gw + k * NGW; if (r >= MT) break;
              if (r < R_META) r = (r & ~(SEQ - 1)) | ((r + rot * k) & (SEQ - 1));
              const int s2 = r & (SEQ - 1); if (r < R_META && s2 >= 3 && s2 < SEQ - 3) p2_row_fast(F, r, W, lane_); else p2_row(F, r); } }
        VM_WAIT(); __syncthreads();
        if (BOTH(2)) GRID_BAR();
    }
    if (IN(3)) {
        { pg8::Gemm g{F.CQN, F.WQB, MT, 768, QLORA, QLORA}; pg8::StaticOrder S; S.init(MT, 768, F.G, (int)blockIdx.x);
          pg8::EpiQ E{F.QM, F.ROPE, MLA_SCALE * 1.4426950408889634f};
          pg8::gemm_phase<pg8::EpiQ, pg8::StaticOrder, true, true>(F.lds + RING_OFF, g, S, E); }
        { pg8::Gemm g{F.LATN, F.WKVB, MT, 1024, KVLORA, KVLORA}; pg8::StaticOrder S; S.init(MT, 1024, F.G, ((int)blockIdx.x + 8) % (int)gridDim.x);
          pg8::EpiStoreBf16 E{F.KV, 1024};
          pg8::gemm_phase<pg8::EpiStoreBf16, pg8::StaticOrder, true, true>(F.lds + RING_OFF, g, S, E); }
        gdn::g1_phase(F); VM_WAIT(); __syncthreads();
        if (BOTH(3)) GRID_BAR();
    }
    if (IN(4)) { p4_mixers(F); VM_WAIT(); __syncthreads(); if (BOTH(4)) GRID_BAR(); }
    if (IN(5)) { p5_post(F); VM_WAIT(); __syncthreads(); if (BOTH(5)) GRID_BAR(); }
    const bool split_tail = (F.G == 256);
    if (IN(6)) {
        const int Mrows = split_tail ? NREAL : MT;
        pg8::Gemm g{F.MIX, F.WOUT, Mrows, D, 1024, 1024}; pg8::StaticOrder S; S.init(Mrows, D, F.G, (int)blockIdx.x);
        pg8::EpiResid1 E{F.x_prompt, F.meta, F.x_sample, F.H1B, F.SS1, F.H2};
        pg8::gemm_phase<pg8::EpiResid1, pg8::StaticOrder, true, true>(F.lds + RING_OFF, g, S, E);
        if (BOTH(6)) GRID_BAR();
    }
    if (IN(7)) {
        gu32* cnt6 = F.ctl + CW_CNT6;
        if (split_tail && blockIdx.x < 4) {
            pg8::Gemm g{F.MIX, F.WOUT, MT, D, 1024, 1024}; pg8::OneUnit S{64, (int)blockIdx.x};
            pg8::EpiResid1 E{F.x_prompt, F.meta, F.x_sample, F.H1B, F.SS1, F.H2};
            pg8::gemm_phase<pg8::EpiResid1, pg8::OneUnit, true, true>(F.lds + RING_OFF, g, S, E);
            VM_WAIT(); __syncthreads();
            if (F.tid == 0) { __builtin_amdgcn_fence(__ATOMIC_RELEASE, "agent"); asm volatile("s_waitcnt vmcnt(0)" ::: "memory"); __hip_atomic_fetch_add(cnt6, 1u, RLX_AGENT); }
        }
        { const int Mrows = split_tail ? NREAL : MT;
          pg8::Gemm g{F.H1B, F.WUP, Mrows, FF, D, D}; pg8::StaticOrder S; S.init(Mrows, FF, F.G, (int)blockIdx.x);
          pg8::EpiUp E{F.HFF, FF, F.SS1};
          pg8::gemm_phase<pg8::EpiUp, pg8::StaticOrder, true, true>(F.lds + RING_OFF, g, S, E); }
        if (split_tail && blockIdx.x >= 240) {
            if (F.tid == 0) { unsigned sp = 0; while (__hip_atomic_load(cnt6, RLX_AGENT) < 4u) { __builtin_amdgcn_s_sleep(2); if (++sp > (1u << 22)) break; }
                __builtin_amdgcn_fence(__ATOMIC_ACQUIRE, "agent"); asm volatile("s_waitcnt vmcnt(0)" ::: "memory"); }
            __syncthreads();
            pg8::Gemm g{F.H1B + (size_t)NREAL * D, F.WUP, 256, FF, D, D}; pg8::OneUnit S{0, (int)blockIdx.x - 240};
            pg8::EpiUp E{F.HFF + (size_t)NREAL * FF, FF, F.SS1 + NREAL};
            pg8::gemm_phase<pg8::EpiUp, pg8::OneUnit, true, true>(F.lds + RING_OFF, g, S, E);
        }
        if (BOTH(7)) GRID_BAR();
    }
    if (IN(8)) {
        { pg8::Gemm g{F.HFF, F.WDN, NREAL, D, FF, FF}; pg8::StaticOrder S; S.init(NREAL, D, F.G, (int)blockIdx.x);
          pg8::EpiResid2 E{F.H1B, F.H2B};
          pg8::gemm_phase<pg8::EpiResid2, pg8::StaticOrder, true, true>(F.lds + RING_OFF, g, S, E); }
        { pg8::Gemm g{F.HFF + (size_t)NREAL * FF, F.WDN, 256, D, 256, FF}; pg8::SplitKOrder S; S.init(D, 16, 256, F.G, (int)blockIdx.x);
          pg8::EpiAtomicAdd E{F.H2 + (size_t)NREAL * D};
          pg8::gemm_phase<pg8::EpiAtomicAdd, pg8::SplitKOrder, true, true>(F.lds + RING_OFF, g, S, E); }
        if (BOTH(8)) GRID_BAR();
    }
    if (IN(9)) { p9_final(F); }
#undef IN
#undef BOTH
}

extern "C" void kernel_launch(void* const* d_in, const int* in_sizes, int n_in, void* d_out, int out_size, void* d_ws, size_t ws_size, hipStream_t stream) {
    static int grid = 0;
    if (grid == 0) {
        if (n_in != 23 || out_size != (int)O_END || ws_size < WS_END) { fprintf(stderr, "kernel_launch: unexpected shapes: n_in %d out %d ws %zu (need %zu); nothing launched\n", n_in, out_size, ws_size, (size_t)WS_END); grid = -1; return; }
        int dev = 0, cus = 0, per_cu = 0;
        if (hipGetDevice(&dev) != hipSuccess || hipDeviceGetAttribute(&cus, hipDeviceAttributeMultiprocessorCount, dev) != hipSuccess) { fprintf(stderr, "kernel_launch: device query failed\n"); grid = -1; return; }
        if (hipFuncSetAttribute((const void*)mk_fwd, hipFuncAttributeMaxDynamicSharedMemorySize, LDS_BYTES) != hipSuccess) { fprintf(stderr, "kernel_launch: hipFuncSetAttribute failed\n"); grid = -1; return; }
        if (hipOccupancyMaxActiveBlocksPerMultiprocessor(&per_cu, (const void*)mk_fwd, NWAVES * 64, LDS_BYTES) != hipSuccess || per_cu < 1) { fprintf(stderr, "kernel_launch: occupancy query says %d blocks per CU\n", per_cu); per_cu = 1; }
        (void)hipGetLastError();
        grid = cus;
        fprintf(stderr, "kernel_launch: grid %d (cus %d, per_cu %d)\n", grid, cus, per_cu);
    }
    if (grid < 0) return;
    if (hipMemsetAsync((char*)d_ws + WS_CTL, 0, CTL_ZERO_BYTES, stream) != hipSuccess) { fprintf(stderr, "kernel_launch: memset failed\n"); return; }
    Args a{};
    for (int i = 0; i < 23; ++i) a.in[i] = d_in[i];
    a.out = (float*)d_out; a.ws = (unsigned char*)d_ws;
    for (int li = 0; li < N_LAUNCHES; ++li) {
        if (N_LAUNCHES == 1) { a.ph_lo = 0; a.ph_hi = NPHASES; } else { a.ph_lo = li * NPHASES / N_LAUNCHES; a.ph_hi = (li + 1) * NPHASES / N_LAUNCHES; }
        a.li = li;
        hipLaunchKernelGGL(mk_fwd, dim3(grid), dim3(NWAVES * 64), LDS_BYTES, stream, a);
        if (N_LAUNCHES == NPHASES && li == DUP_PHASE) hipLaunchKernelGGL(mk_fwd, dim3(grid), dim3(NWAVES * 64), LDS_BYTES, stream, a);
        const hipError_t le = hipPeekAtLastError();
        if (le != hipSuccess) { fprintf(stderr, "kernel_launch: launch %d failed: %s\n", li, hipGetErrorName(le)); break; }
    }
}
```

```cpp
#include <hip/hip_runtime.h>
#include <cstdio>
#include <cstdint>
#include <cmath>
namespace pg8 {
#define PG8_LAS __attribute__((address_space(3)))
typedef unsigned short bf16_t;
typedef short bf16x8 __attribute__((ext_vector_type(8)));
typedef float f32x4 __attribute__((ext_vector_type(4)));
typedef unsigned u32x4 __attribute__((ext_vector_type(4)));
constexpr int BM = 256, BK = 64, HALF = 128, HTB = HALF * BK * 2  , STAGE_BYTES = 8 * HTB, NXCD = 8, WGM = 8;

__host__ __device__ __forceinline__ int lds_byte(int r, int c) { const int st = (r >> 4) * 2 + (c >> 5), rr = r & 15, cc = c & 31, ob = rr * 64 + cc * 2; return st * 1024 + (ob ^ (((ob >> 9) & 1) << 5)); }
__host__ __device__ __forceinline__ void stage_rc(int b, int& R, int& C) { const int st = b / 1024, sb = b % 1024, swz = sb ^ (((sb >> 9) & 1) << 5); R = (st >> 1) * 16 + swz / 64; C = (st & 1) * 32 + (swz % 64) / 2; }
__host__ __device__ __forceinline__ int perm32(int rho) { const int n = rho >> 4, i = rho & 15; return 8 * (i >> 2) + 4 * n + (i & 3); }

struct Unit { int pm, pn, ko; };
struct Gemm { const bf16_t* A; const bf16_t* Bt; int M, N, K, ld; };

struct StaticOrder {
    int nM, nN, nwg, G, c;
    __host__ __device__ void init(int M, int N, int G_, int c_) { nM = M / BM; nN = N / BM; nwg = nM * nN; G = G_; c = c_; }
    __host__ __device__ bool next(int i, Unit& u) const {
        const long L = (long)i * G + c; if (L >= nwg) return false;
        int wgid = (int)L; { const int q = nwg / NXCD, r = nwg % NXCD, xcd = wgid % NXCD, off = wgid / NXCD; wgid = (xcd < r ? xcd * (q + 1) : r * (q + 1) + (xcd - r) * q) + off; }
        const int nig = WGM * nN, gid = wgid / nig, fm = gid * WGM, gsz = (nM - fm) < WGM ? (nM - fm) : WGM;
        u.pm = fm + ((wgid % nig) % gsz); u.pn = (wgid % nig) / gsz; u.ko = 0; return true;
    }
    __device__ __forceinline__ void a_ready(const Unit&) const {}
    __device__ __forceinline__ void done(const Unit&) const {}
};

struct OneUnit {
    int pm, pn;
    __host__ __device__ bool next(int i, Unit& u) const { if (i != 0) return false; u.pm = pm; u.pn = pn; u.ko = 0; return true; }
    __device__ __forceinline__ void a_ready(const Unit&) const {}
    __device__ __forceinline__ void done(const Unit&) const {}
};
struct SplitKOrder {
    int nN, nS, ks, G, c;
    __host__ __device__ void init(int N, int nslices, int kslice, int G_, int c_) { nN = N / BM; nS = nslices; ks = kslice; G = G_; c = c_; }
    __host__ __device__ bool next(int i, Unit& u) const { const long L = (long)i * G + c; if (L >= nN * nS) return false; u.pm = 0; u.pn = (int)(L % nN); u.ko = (int)(L / nN) * ks; return true; }
    __device__ __forceinline__ void a_ready(const Unit&) const {}
    __device__ __forceinline__ void done(const Unit&) const {}
};
__device__ __forceinline__ unsigned cvt_pk_bf16(float lo, float hi) { unsigned r; asm volatile("v_cvt_pk_bf16_f32 %0, %1, %2" : "=v"(r) : "v"(lo), "v"(hi)); return r; }
constexpr int ROWS_REAL = 16384, ROW_META = 16384, ROW_SAMP = 16400, ROW_END = 16528;
__device__ __forceinline__ const float* x_row_ptr(const float* xp, const float* xm, const float* xs, int row) {
    if (row < ROW_META) return xp + (size_t)row * 1024;
    if (row < ROW_SAMP) return xm + (size_t)(row - ROW_META) * 1024;
    if (row < ROW_END) return xs + (size_t)(row - ROW_SAMP) * 1024;
    return nullptr;
}
struct EpiStoreBf16 {
    static constexpr bool PERM = true, AFTER_DRAIN = false;
    bf16_t* O; int ldc;
    __device__ __forceinline__ void operator()(const f32x4 (&acc)[2][2][4][2], const Unit& u, int wr, int wc, int fr, int fq) const {
        asm volatile("" : "+v"(fr), "+v"(fq));
        const int row0 = u.pm * BM + wr * 64 + fr, col0 = u.pn * BM + wc * 32 + 8 * fq;
#pragma unroll
        for (int ai = 0; ai < 2; ++ai)
#pragma unroll
            for (int m = 0; m < 4; ++m) { bf16_t* rowp = O + (size_t)(row0 + ai * HALF + m * 16) * ldc + col0;
#pragma unroll
                for (int bj = 0; bj < 2; ++bj) { const f32x4 v0 = acc[ai][bj][m][0], v1 = acc[ai][bj][m][1];
                    u32x4 w; w.x = cvt_pk_bf16(v0[0], v0[1]); w.y = cvt_pk_bf16(v0[2], v0[3]); w.z = cvt_pk_bf16(v1[0], v1[1]); w.w = cvt_pk_bf16(v1[2], v1[3]);
                    *(u32x4*)(rowp + bj * HALF) = w; } }
    }
};
struct EpiResid1 {
    static constexpr bool PERM = true, AFTER_DRAIN = false;
    const float* xp; const float* xm; const float* xs; bf16_t* H1B; float* ss; float* H2;
    __device__ __forceinline__ void operator()(const f32x4 (&acc)[2][2][4][2], const Unit& u, int wr, int wc, int fr, int fq) const {
        asm volatile("" : "+v"(fr), "+v"(fq));
        const int row0 = u.pm * BM + wr * 64 + fr, col0 = u.pn * BM + wc * 32 + 8 * fq;
#pragma unroll
        for (int ai = 0; ai < 2; ++ai)
#pragma unroll
          for (int mh = 0; mh < 2; ++mh) {
            f32x4 xv[2][2][2]; float fl[2];
#pragma unroll
            for (int mm = 0; mm < 2; ++mm) { const int row = row0 + ai * HALF + (2 * mh + mm) * 16;
                const float* xb = row < ROW_META ? xp : (row < ROW_SAMP ? xm : (row < ROW_END ? xs : xp));
                const int rel = row < ROW_META ? row : (row < ROW_SAMP ? row - ROW_META : (row < ROW_END ? row - ROW_SAMP : 0));
                fl[mm] = row < ROW_END ? 1.f : 0.f; const float* xq = xb + (size_t)rel * 1024;
#pragma unroll
                for (int bj = 0; bj < 2; ++bj) { const int col = col0 + bj * HALF; xv[mm][bj][0] = *(const f32x4*)(xq + col); xv[mm][bj][1] = *(const f32x4*)(xq + col + 4); } }
#pragma unroll
            for (int mm = 0; mm < 2; ++mm) { const int m = 2 * mh + mm; const int row = row0 + ai * HALF + m * 16; float part = 0.f;
#pragma unroll
                for (int bj = 0; bj < 2; ++bj) { const int col = col0 + bj * HALF;
                    const f32x4 v0 = acc[ai][bj][m][0] + xv[mm][bj][0] * fl[mm], v1 = acc[ai][bj][m][1] + xv[mm][bj][1] * fl[mm];
                    u32x4 w; w.x = cvt_pk_bf16(v0[0], v0[1]); w.y = cvt_pk_bf16(v0[2], v0[3]); w.z = cvt_pk_bf16(v1[0], v1[1]); w.w = cvt_pk_bf16(v1[2], v1[3]);
                    *(u32x4*)(H1B + (size_t)row * 1024 + col) = w;
                    if (u.pm == 64) { *(f32x4*)(H2 + (size_t)row * 1024 + col) = v0; *(f32x4*)(H2 + (size_t)row * 1024 + col + 4) = v1; }
                    part += (v0[0] * v0[0] + v0[1] * v0[1]) + (v0[2] * v0[2] + v0[3] * v0[3]) + (v1[0] * v1[0] + v1[1] * v1[1]) + (v1[2] * v1[2] + v1[3] * v1[3]); }
                part += __shfl_xor(part, 16); part += __shfl_xor(part, 32);
                if (fq == 0 && ss) __hip_atomic_fetch_add(ss + row, part, __ATOMIC_RELAXED, __HIP_MEMORY_SCOPE_AGENT); } }
    }
};
struct EpiUp {
    static constexpr bool PERM = true, AFTER_DRAIN = false;
    bf16_t* O; int ldc; const float* ss;
    __device__ __forceinline__ void operator()(const f32x4 (&acc)[2][2][4][2], const Unit& u, int wr, int wc, int fr, int fq) const {
        asm volatile("" : "+v"(fr), "+v"(fq));
        const int row0 = u.pm * BM + wr * 64 + fr, col0 = u.pn * BM + wc * 32 + 8 * fq;
        float ssv[2][4];
#pragma unroll
        for (int ai = 0; ai < 2; ++ai)
#pragma unroll
            for (int m = 0; m < 4; ++m) ssv[ai][m] = ss[row0 + ai * HALF + m * 16];
#pragma unroll
        for (int ai = 0; ai < 2; ++ai)
#pragma unroll
            for (int m = 0; m < 4; ++m) { const int row = row0 + ai * HALF + m * 16; bf16_t* rowp = O + (size_t)row * ldc + col0;
                const float rs = 1.0f / sqrtf(ssv[ai][m] * (1.0f / 1024.0f) + 1e-6f);
#pragma unroll
                for (int bj = 0; bj < 2; ++bj) { f32x4 v0 = acc[ai][bj][m][0] * rs, v1 = acc[ai][bj][m][1] * rs;
#pragma unroll
                    for (int e = 0; e < 4; ++e) { const float a = fmaxf(v0[e], 0.f), b = fmaxf(v1[e], 0.f); v0[e] = a * a; v1[e] = b * b; }
                    u32x4 w; w.x = cvt_pk_bf16(v0[0], v0[1]); w.y = cvt_pk_bf16(v0[2], v0[3]); w.z = cvt_pk_bf16(v1[0], v1[1]); w.w = cvt_pk_bf16(v1[2], v1[3]);
                    *(u32x4*)(rowp + bj * HALF) = w; } }
    }
};
struct EpiResid2 {
    static constexpr bool PERM = true, AFTER_DRAIN = false;
    const bf16_t* H1B; bf16_t* H2B;
    __device__ __forceinline__ void operator()(const f32x4 (&acc)[2][2][4][2], const Unit& u, int wr, int wc, int fr, int fq) const {
        asm volatile("" : "+v"(fr), "+v"(fq));
        const int row0 = u.pm * BM + wr * 64 + fr, col0 = u.pn * BM + wc * 32 + 8 * fq;
#pragma unroll
        for (int ai = 0; ai < 2; ++ai) {
            u32x4 hv[4][2];
#pragma unroll
            for (int m = 0; m < 4; ++m)
#pragma unroll
                for (int bj = 0; bj < 2; ++bj) hv[m][bj] = *(const u32x4*)(H1B + (size_t)(row0 + ai * HALF + m * 16) * 1024 + col0 + bj * HALF);
#pragma unroll
            for (int m = 0; m < 4; ++m) { const int row = row0 + ai * HALF + m * 16;
#pragma unroll
                for (int bj = 0; bj < 2; ++bj) { const size_t off = (size_t)row * 1024 + col0 + bj * HALF;
                    const u32x4 hb = hv[m][bj];
                    const f32x4 h0 = (f32x4){__uint_as_float(hb.x << 16), __uint_as_float(hb.x & 0xffff0000u), __uint_as_float(hb.y << 16), __uint_as_float(hb.y & 0xffff0000u)};
                    const f32x4 h1 = (f32x4){__uint_as_float(hb.z << 16), __uint_as_float(hb.z & 0xffff0000u), __uint_as_float(hb.w << 16), __uint_as_float(hb.w & 0xffff0000u)};
                    const f32x4 v0 = acc[ai][bj][m][0] + h0, v1 = acc[ai][bj][m][1] + h1;
                    u32x4 w; w.x = cvt_pk_bf16(v0[0], v0[1]); w.y = cvt_pk_bf16(v0[2], v0[3]); w.z = cvt_pk_bf16(v1[0], v1[1]); w.w = cvt_pk_bf16(v1[2], v1[3]);
                    *(u32x4*)(H2B + off) = w; } } }
    }
};
struct EpiAtomicAdd {
    static constexpr bool PERM = true, AFTER_DRAIN = false;
    float* H2;
    __device__ __forceinline__ void operator()(const f32x4 (&acc)[2][2][4][2], const Unit& u, int wr, int wc, int fr, int fq) const {
        asm volatile("" : "+v"(fr), "+v"(fq));
        const int row0 = wr * 64 + fr, col0 = u.pn * BM + wc * 32 + 8 * fq;
#pragma unroll
        for (int ai = 0; ai < 2; ++ai)
#pragma unroll
            for (int m = 0; m < 4; ++m) { const int row = row0 + ai * HALF + m * 16;
                if (row >= 16 && row < 144) {
#pragma unroll
                    for (int bj = 0; bj < 2; ++bj) { float* p = H2 + (size_t)row * 1024 + col0 + bj * HALF;
#pragma unroll
                        for (int e = 0; e < 4; ++e) { __hip_atomic_fetch_add(p + e, acc[ai][bj][m][0][e], __ATOMIC_RELAXED, __HIP_MEMORY_SCOPE_AGENT); __hip_atomic_fetch_add(p + 4 + e, acc[ai][bj][m][1][e], __ATOMIC_RELAXED, __HIP_MEMORY_SCOPE_AGENT); } } } }
    }
};
struct EpiQ {
    static constexpr bool PERM = true, AFTER_DRAIN = false;
    bf16_t* O; const float* rope; float c2;
    __device__ __forceinline__ void operator()(const f32x4 (&acc)[2][2][4][2], const Unit& u, int wr, int wc, int fr, int fq) const {
        asm volatile("" : "+v"(fr), "+v"(fq));
        const int row0 = u.pm * BM + wr * 64 + fr, col0 = u.pn * BM + wc * 32 + 8 * fq;
        const bool dorope = (u.pn == 2);
#pragma unroll
        for (int ai = 0; ai < 2; ++ai) {
            f32x4 cs[4][4];
            if (dorope) {
#pragma unroll
                for (int m = 0; m < 4; ++m) { const int row = row0 + ai * HALF + m * 16;
                    const int pi = row < ROW_META ? 16 + (row & 2047) : (row < ROW_SAMP ? row - ROW_META : (row < ROW_END ? 2064 + ((row - ROW_SAMP) & 3) : 0));
                    const float* tb = rope + (size_t)pi * 32 + ((8 * fq) & 15);
                    cs[m][0] = *(const f32x4*)(tb); cs[m][1] = *(const f32x4*)(tb + 16); cs[m][2] = *(const f32x4*)(tb + 4); cs[m][3] = *(const f32x4*)(tb + 20); } }
#pragma unroll
            for (int m = 0; m < 4; ++m) { const int row = row0 + ai * HALF + m * 16; bf16_t* rowp = O + (size_t)row * 768 + col0;
#pragma unroll
                for (int bj = 0; bj < 2; ++bj) { f32x4 v0 = acc[ai][bj][m][0] * c2, v1 = acc[ai][bj][m][1] * c2;
                    if (dorope) { const f32x4 c0 = cs[m][0], s0 = cs[m][1], c1 = cs[m][2], s1 = cs[m][3];
                        f32x4 p0, p1;
#pragma unroll
                        for (int e = 0; e < 4; ++e) { p0[e] = __shfl_xor(v0[e], 32); p1[e] = __shfl_xor(v1[e], 32); }
                        if (fq < 2) { v0 = v0 * c0 - p0 * s0; v1 = v1 * c1 - p1 * s1; } else { v0 = v0 * c0 + p0 * s0; v1 = v1 * c1 + p1 * s1; } }
                    u32x4 w; w.x = cvt_pk_bf16(v0[0], v0[1]); w.y = cvt_pk_bf16(v0[2], v0[3]); w.z = cvt_pk_bf16(v1[0], v1[1]); w.w = cvt_pk_bf16(v1[2], v1[3]);
                    *(u32x4*)(rowp + bj * HALF) = w; } } }
    }
};
template <class Epi, class Sched, bool ALIGN_EPI = false, bool SP2 = false>
__device__ __forceinline__ void gemm_phase(PG8_LAS unsigned char* lds, const Gemm g, const Sched& S, const Epi& E) {
    int tid_ = threadIdx.x; asm volatile("" : "+v"(tid_));
    const int tid = tid_, wid = __builtin_amdgcn_readfirstlane(tid >> 6), lane = tid & 63, wr = wid >> 2, wc = wid & 3, fr = lane & 15, fq = lane >> 4;
    const int K = g.ld, nt = g.K / BK;
    unsigned voffA[2], voffB[2];
#pragma unroll
    for (int i = 0; i < 2; ++i) { int R, C; stage_rc(tid * 16 + i * 8192, R, C); const int Rb = Epi::PERM ? ((R & ~31) + perm32(R & 31)) : R;
        voffA[i] = (unsigned)(R * K + C) * 2u; voffB[i] = (unsigned)(Rb * K + C) * 2u; }
    const size_t kstep = (size_t)(BK * 2);
    const size_t hstep = (size_t)HALF * K * 2;
    const size_t tstep = 2 * hstep;
    const unsigned ldsw = (unsigned)wid * 1024u;
    const int aoff = lds_byte(wr * 64 + fr, fq * 8), boff = lds_byte(wc * 32 + fr, fq * 8);
#define PG8_SA(b, h) (((b) * 2 + (h)) * HTB)
#define PG8_SB(b, h) ((4 + (b) * 2 + (h)) * HTB)
#define PG8_STAGE(bufoff, gbase, voff) do { _Pragma("unroll") for (int _i = 0; _i < 2; ++_i) \
        __builtin_amdgcn_global_load_lds((const unsigned*)((const char*)(gbase) + (voff)[_i]), (PG8_LAS unsigned*)(lds + (bufoff) + ldsw + _i * 8192), 16, 0, 0); } while (0)
#define PG8_LDA(dst, b, h) do { _Pragma("unroll") for (int m = 0; m < 4; ++m) _Pragma("unroll") for (int k = 0; k < 2; ++k) dst[m][k] = *(const PG8_LAS bf16x8*)(lds + PG8_SA(b, h) + aoff + m * 2048 + k * 1024); } while (0)
#define PG8_LDB(dst, b, h) do { _Pragma("unroll") for (int n = 0; n < 2; ++n) _Pragma("unroll") for (int k = 0; k < 2; ++k) dst[n][k] = *(const PG8_LAS bf16x8*)(lds + PG8_SB(b, h) + boff + n * 2048 + k * 1024); } while (0)
#define PG8_MMA(ai, bj, At, Bt) do { __builtin_amdgcn_s_setprio(1); _Pragma("unroll") for (int m = 0; m < 4; ++m) _Pragma("unroll") for (int n = 0; n < 2; ++n) _Pragma("unroll") for (int k = 0; k < 2; ++k) \
        acc[ai][bj][m][n] = __builtin_amdgcn_mfma_f32_16x16x32_bf16(Bt[n][k], At[m][k], acc[ai][bj][m][n], 0, 0, 0); __builtin_amdgcn_s_setprio(0); } while (0)
#define PG8_WAIT_V(n) asm volatile("s_waitcnt vmcnt(" #n ")" ::: "memory")
#define PG8_WAIT_L(n) asm volatile("s_waitcnt lgkmcnt(" #n ")" ::: "memory")
#define PG8_BAR __builtin_amdgcn_s_barrier()
#define PG8_SCHED __builtin_amdgcn_sched_barrier(0)
    Unit cur, nxt; int ui = 0;
    if (!S.next(0, cur)) return;
    f32x4 acc[2][2][4][2];
#pragma unroll
    for (int a = 0; a < 2; ++a)
#pragma unroll
        for (int b = 0; b < 2; ++b)
#pragma unroll
            for (int m = 0; m < 4; ++m)
#pragma unroll
                for (int n = 0; n < 2; ++n) acc[a][b][m][n] = (f32x4){0.f, 0.f, 0.f, 0.f};
    bf16x8 At[4][2], B0[2][2], B1[2][2];
    const char* cA = (const char*)g.A + (size_t)cur.pm * tstep + (size_t)cur.ko * 2; const char* cB = (const char*)g.Bt + (size_t)cur.pn * tstep + (size_t)cur.ko * 2;
    S.a_ready(cur);
    if constexpr (SP2) {
        PG8_STAGE(PG8_SB(0, 0), cB, voffB); PG8_STAGE(PG8_SB(0, 1), cB + hstep, voffB); PG8_STAGE(PG8_SA(0, 0), cA, voffA); PG8_STAGE(PG8_SA(0, 1), cA + hstep, voffA);
        if (wr == 1) PG8_BAR;
        PG8_WAIT_V(2); PG8_BAR;
        PG8_STAGE(PG8_SB(1, 0), cB + kstep, voffB); PG8_STAGE(PG8_SA(1, 0), cA + kstep, voffA); PG8_STAGE(PG8_SB(1, 1), cB + hstep + kstep, voffB);
        PG8_WAIT_V(6); PG8_BAR;
    } else {
        PG8_STAGE(PG8_SB(0, 0), cB, voffB); PG8_STAGE(PG8_SA(0, 0), cA, voffA); PG8_STAGE(PG8_SB(0, 1), cB + hstep, voffB); PG8_STAGE(PG8_SA(0, 1), cA + hstep, voffA);
        if (wr == 1) PG8_BAR;
        PG8_WAIT_V(4); PG8_BAR;
        PG8_STAGE(PG8_SB(1, 0), cB + kstep, voffB); PG8_STAGE(PG8_SA(1, 0), cA + kstep, voffA); PG8_STAGE(PG8_SB(1, 1), cB + hstep + kstep, voffB);
        PG8_WAIT_V(6); PG8_BAR;
    }
    for (;;) {
        const bool has_next = S.next(ui + 1, nxt);
        const char* nA = has_next ? (const char*)g.A + (size_t)nxt.pm * tstep + (size_t)nxt.ko * 2 : cA; const char* nB = has_next ? (const char*)g.Bt + (size_t)nxt.pn * tstep + (size_t)nxt.ko * 2 : cB;
        asm volatile(".p2align 8" ::: "memory");
#pragma clang loop unroll(disable)
        for (int t = 0; t < nt; t += 2) {
            const bool last = (t == nt - 2);
            const char* a1 = cA + (size_t)(t + 1) * kstep;
            const char* a2 = last ? nA : cA + (size_t)(t + 2) * kstep; const char* b2 = last ? nB : cB + (size_t)(t + 2) * kstep;
            const char* a3 = a2 + kstep; const char* b3 = b2 + kstep;
            if (last && has_next) S.a_ready(nxt);
            if constexpr (SP2) {
            PG8_LDB(B0, 0, 0); PG8_LDB(B1, 0, 1); PG8_SCHED; PG8_LDA(At, 0, 0); PG8_STAGE(PG8_SA(1, 1), a1 + hstep, voffA);
            PG8_WAIT_V(8); PG8_WAIT_L(0); PG8_BAR; PG8_MMA(0, 0, At, B0); PG8_MMA(0, 1, At, B1); PG8_BAR; PG8_SCHED;
            PG8_LDA(At, 0, 1); PG8_STAGE(PG8_SB(0, 0), b2, voffB); PG8_STAGE(PG8_SB(0, 1), b2 + hstep, voffB); PG8_STAGE(PG8_SA(0, 0), a2, voffA);
            PG8_WAIT_V(8); PG8_WAIT_L(0); PG8_BAR; PG8_MMA(1, 0, At, B0); PG8_MMA(1, 1, At, B1); PG8_BAR; PG8_SCHED;
            PG8_LDB(B0, 1, 0); PG8_LDB(B1, 1, 1); PG8_SCHED; PG8_LDA(At, 1, 0); PG8_STAGE(PG8_SA(0, 1), a2 + hstep, voffA);
            PG8_WAIT_V(8); PG8_WAIT_L(0); PG8_BAR; PG8_MMA(0, 0, At, B0); PG8_MMA(0, 1, At, B1); PG8_BAR; PG8_SCHED;
            PG8_LDA(At, 1, 1); PG8_STAGE(PG8_SB(1, 0), b3, voffB); PG8_STAGE(PG8_SB(1, 1), b3 + hstep, voffB); PG8_STAGE(PG8_SA(1, 0), a3, voffA);
            PG8_WAIT_V(8); PG8_WAIT_L(0); PG8_BAR; PG8_MMA(1, 0, At, B0); PG8_MMA(1, 1, At, B1); PG8_BAR; PG8_SCHED;
            } else {
            PG8_LDB(B0, 0, 0); PG8_SCHED; PG8_LDA(At, 0, 0); PG8_STAGE(PG8_SA(1, 1), a1 + hstep, voffA);
            PG8_WAIT_L(8); PG8_BAR; PG8_WAIT_L(0); PG8_MMA(0, 0, At, B0); PG8_BAR; PG8_SCHED;
            PG8_LDB(B1, 0, 1); PG8_STAGE(PG8_SB(0, 0), b2, voffB);
            PG8_BAR; PG8_WAIT_L(0); PG8_MMA(0, 1, At, B1); PG8_BAR;
            PG8_LDA(At, 0, 1); PG8_STAGE(PG8_SA(0, 0), a2, voffA);
            PG8_BAR; PG8_WAIT_L(0); PG8_MMA(1, 0, At, B0); PG8_BAR; PG8_SCHED;
            PG8_STAGE(PG8_SB(0, 1), b2 + hstep, voffB);
            PG8_WAIT_V(6); PG8_BAR; PG8_MMA(1, 1, At, B1); PG8_BAR;
            PG8_LDB(B0, 1, 0); PG8_SCHED; PG8_LDA(At, 1, 0); PG8_STAGE(PG8_SA(0, 1), a2 + hstep, voffA);
            PG8_WAIT_L(8); PG8_BAR; PG8_WAIT_L(0); PG8_MMA(0, 0, At, B0); PG8_BAR; PG8_SCHED;
            PG8_LDB(B1, 1, 1); PG8_STAGE(PG8_SB(1, 0), b3, voffB);
            PG8_BAR; PG8_WAIT_L(0); PG8_MMA(0, 1, At, B1); PG8_BAR;
            PG8_LDA(At, 1, 1); PG8_STAGE(PG8_SA(1, 0), a3, voffA);
            PG8_BAR; PG8_WAIT_L(0); PG8_MMA(1, 0, At, B0); PG8_BAR; PG8_SCHED;
            PG8_STAGE(PG8_SB(1, 1), b3 + hstep, voffB);
            PG8_WAIT_V(6); PG8_BAR; PG8_MMA(1, 1, At, B1); PG8_BAR;
            }
        }
        if constexpr (ALIGN_EPI) { if (wr == 0) PG8_BAR; }
        if constexpr (!Epi::AFTER_DRAIN) { E(acc, cur, wr, wc, fr, fq); S.done(cur); }
        if (!has_next) break;
#pragma unroll
        for (int a = 0; a < 2; ++a)
#pragma unroll
            for (int b = 0; b < 2; ++b)
#pragma unroll
                for (int m = 0; m < 4; ++m)
#pragma unroll
                    for (int n = 0; n < 2; ++n) acc[a][b][m][n] = (f32x4){0.f, 0.f, 0.f, 0.f};
        cur = nxt; cA = nA; cB = nB; ++ui;
        if constexpr (ALIGN_EPI) { if (wr == 1) PG8_BAR; }
    }
    PG8_WAIT_V(0);
    if constexpr (!ALIGN_EPI) { if (wr == 0) PG8_BAR; }
    PG8_BAR;
    if constexpr (Epi::AFTER_DRAIN) { E.fused(acc, cur, wr, wc, fr, fq, lds, wid, lane); S.done(cur); }
#undef PG8_SA
#undef PG8_SB
#undef PG8_STAGE
#undef PG8_LDA
#undef PG8_LDB
#undef PG8_MMA
#undef PG8_WAIT_V
#undef PG8_WAIT_L
#undef PG8_BAR
#undef PG8_SCHED
}
}
constexpr int NWAVES = 8;
constexpr int NPHASES = 10;
#ifndef MK_N_LAUNCHES
#define MK_N_LAUNCHES 1
#endif
#ifndef DUP_PHASE
#define DUP_PHASE -1
#endif
#ifndef DUP_SUB
#define DUP_SUB 0
#endif
constexpr int N_LAUNCHES = MK_N_LAUNCHES;

constexpr int D = 1024, NB = 8, SEQ = 2048, NREAL = NB * SEQ, NMETA = 16, NSB = 32, NST = 4, NSAMP = NSB * NST;
constexpr int R_META = NREAL, R_SAMP = NREAL + NMETA, R_END = R_SAMP + NSAMP, MT = 16640;
constexpr int TP = NMETA + SEQ;
constexpr int NPRJ = 2816;
constexpr int C_QKV = 0, C_Z = 1536, C_CQ = 2048, C_CKV = 2432, C_KPE = 2688, C_B = 2720, C_A = 2728, C_PAD = 2736;
constexpr int IN_COLS = 2736, FF = 4096, QLORA = 384, KVLORA = 256, NH = 8;
constexpr int PAST = 16384, PAGE = 128, NPAGES = 128;
constexpr float EPS = 1e-6f;
constexpr float MLA_SCALE = 0.10206207261596577f;
constexpr size_t O_YP = 0, O_YS = 16777216, O_LATP = 16908288, O_KRP = 21135360, O_CONVP = 21663744, O_SSMP = 21700608,
                 O_LATS = 21962752, O_KRS = 21995520, O_CONVS = 21999616, O_SSMS = 22147072, O_END = 23195648;
constexpr int NSPLIT = 32, SPLIT_KEYS = PAST / NSPLIT  , NSPLITX = NSPLIT + 1;

constexpr size_t MiB = 1u << 20;
constexpr size_t al(size_t x) { return (x + MiB - 1) / MiB * MiB; }
constexpr size_t WS_CTL = 0, CTL_ZERO_BYTES = 100 * 1024;
constexpr size_t WS_WIN = 1 * MiB;
constexpr size_t WS_WQB = WS_WIN + al((size_t)NPRJ * D * 2);
constexpr size_t WS_WKVB = WS_WQB + al((size_t)768 * 384 * 2);
constexpr size_t WS_WOUT = WS_WKVB + al((size_t)1024 * 256 * 2);
constexpr size_t WS_WUP = WS_WOUT + al((size_t)1024 * 1024 * 2);
constexpr size_t WS_WDN = WS_WUP + al((size_t)4096 * 1024 * 2);
constexpr size_t WS_XN = WS_WDN + al((size_t)4096 * 1024 * 2);
constexpr size_t WS_PRJ = WS_XN + al((size_t)MT * D * 2);
constexpr size_t WS_CQN = WS_PRJ + al((size_t)MT * NPRJ * 2);
constexpr size_t WS_LATN = WS_CQN + al((size_t)MT * QLORA * 2);
constexpr size_t WS_KPE = WS_LATN + al((size_t)MT * KVLORA * 2);
constexpr size_t WS_GQKV = WS_KPE + al((size_t)MT * 32 * 4);
constexpr size_t WS_GB = WS_GQKV + al((size_t)MT * 1536 * 4);
constexpr size_t WS_QM = WS_GB + al((size_t)MT * 16 * 4);
constexpr size_t WS_KV = WS_QM + al((size_t)MT * 768 * 2);
constexpr size_t WS_GO = WS_KV + al((size_t)MT * 1024 * 2);
constexpr size_t WS_MIX = WS_GO + al((size_t)MT * 512 * 4);
constexpr size_t WS_H2B = WS_MIX + al((size_t)MT * D * 2);
constexpr size_t WS_H1B = WS_H2B + al((size_t)MT * D * 2);
constexpr size_t WS_HFF = WS_H1B + al((size_t)MT * D * 2);
constexpr size_t WS_H2 = WS_HFF + al((size_t)MT * FF * 2);
constexpr size_t WS_PART = WS_H2 + al((size_t)MT * D * 4);
constexpr size_t WS_PSTAT = WS_PART + al((size_t)NSB * NSPLITX * 32 * 256 * 4);
constexpr int NROPE = TP + NST;
constexpr size_t WS_KPEB = WS_PSTAT + al((size_t)NSB * NSPLITX * 32 * 2 * 4);
constexpr size_t WS_ROPE = WS_KPEB + al((size_t)MT * 32 * 2);
constexpr size_t WS_QLAT = WS_ROPE + al((size_t)NROPE * 32 * 4);
constexpr size_t WS_EGL = WS_QLAT + al((size_t)NSB * 32 * 256 * 4);
constexpr size_t WS_S1 = WS_EGL + MiB;
constexpr size_t WS_GCH = WS_S1 + MiB;
constexpr size_t WS_END = WS_GCH + al((size_t)NB * 32 * NH * 40960);
constexpr int CW_TMO = 0, CW_CODE = 1, CW_CNT6 = 64;
constexpr int CW_BAR = 4096;
constexpr int CW_SS1 = 8192;
static_assert((size_t)(CW_SS1 + MT) * 4 <= CTL_ZERO_BYTES && CW_BAR + 3456 <= CW_SS1, "CTL words inside the memset region");

constexpr int RING_OFF = 0, RING_BYTES = 131072;
constexpr int LDSCTL_OFF = RING_BYTES, MISC_OFF = LDSCTL_OFF + 320;
constexpr int LDS_BYTES = 147456;
static_assert(MISC_OFF + 128 <= LDS_BYTES, "LDS map");
#define GAS __attribute__((address_space(1)))
#define LAS __attribute__((address_space(3)))
typedef unsigned short bf16;
typedef unsigned v4u __attribute__((ext_vector_type(4)));
typedef float f32x4 __attribute__((ext_vector_type(4)));
typedef short bf16x8 __attribute__((ext_vector_type(8)));
typedef GAS unsigned gu32;
typedef GAS unsigned long long gu64;
#define RLX_AGENT __ATOMIC_RELAXED, __HIP_MEMORY_SCOPE_AGENT
#define LDS_WAIT() asm volatile("s_waitcnt lgkmcnt(0)" ::: "memory")
#define VM_WAIT() asm volatile("s_waitcnt vmcnt(0)" ::: "memory")
__device__ __forceinline__ unsigned long long rt() { return __builtin_amdgcn_s_memrealtime(); }
__device__ __forceinline__ unsigned f2bf(float f) { unsigned u = __builtin_bit_cast(unsigned, f); return (u + 0x7fffu + ((u >> 16) & 1u)) >> 16; }
__device__ __forceinline__ unsigned pk2(float lo, float hi) { return f2bf(lo) | (f2bf(hi) << 16); }

#define XB_TMO      128
#define XB_XCNT(j)  (256  + 64 * (j))
#define XB_XSUB(j)  (1280 + 64 * (j))
#define XB_XGEN(j)  (2304 + 64 * (j))
#define XB_TOP      3328
#define XB_TOPGEN   3392
#define XCD_BAR_WORDS 3456
#define XB_SPIN_CAP (1u << 18)

__device__ __forceinline__ unsigned xb_ld(unsigned* p)              { return __hip_atomic_load(p, __ATOMIC_RELAXED, __HIP_MEMORY_SCOPE_AGENT); }
__device__ __forceinline__ unsigned xb_add(unsigned* p, unsigned v) { return __hip_atomic_fetch_add(p, v, __ATOMIC_RELAXED, __HIP_MEMORY_SCOPE_AGENT); }
__device__ __forceinline__ unsigned xb_xcc_id() { return (unsigned)__builtin_amdgcn_s_getreg((3 << 11) | 20) & 0xFu; }
#define XB_SPIN(cond, bar) do { unsigned _sp = 0; while (cond) { __builtin_amdgcn_s_sleep(1); \
    if ((++_sp & 255u) == 0u) { if (xb_ld(&(bar)[XB_TMO])) break; if (_sp > XB_SPIN_CAP) { atomicAdd(&(bar)[XB_TMO], 1u); break; } } } } while (0)

struct XcdBarrier {
    unsigned* bar; unsigned x;
    volatile LAS unsigned* st;
};

__device__ __forceinline__ XcdBarrier xcd_barrier_post(unsigned* bar, volatile LAS unsigned* st) {
    XcdBarrier b; b.bar = bar; b.x = xb_xcc_id(); b.st = st;
    if (threadIdx.x == 0) (void)xb_add(&bar[XB_XCNT(b.x)], 1u);
    return b;
}
__device__ __forceinline__ void xcd_barrier_complete(unsigned* bar, unsigned x, unsigned& nloc, unsigned& nx) {
    const unsigned G = gridDim.x * gridDim.y * gridDim.z;
    unsigned sum, cnt, mine, sp = 0u;
    for (;;) {
        sum = 0u; cnt = 0u; mine = 0u;
#pragma unroll
        for (unsigned j = 0; j < 16; ++j) { const unsigned c = xb_ld(&bar[XB_XCNT(j)]); sum += c; cnt += (c > 0u) ? 1u : 0u; mine = (j == x) ? c : mine; }
        if (sum == G) break;
        __builtin_amdgcn_s_sleep(1);
        if ((++sp & 255u) == 0u) { if (xb_ld(&bar[XB_TMO])) break; if (sp > XB_SPIN_CAP) { atomicAdd(&bar[XB_TMO], 1u); break; } }
    }
    nloc = mine > 0u ? mine : 1u; nx = cnt > 0u ? cnt : 1u;
}

__device__ __forceinline__ void xcd_barrier(const XcdBarrier& b) {
    asm volatile("s_waitcnt vmcnt(0)" ::: "memory");
    __syncthreads();
    if (threadIdx.x == 0) {
        unsigned* bar = b.bar;
        __builtin_amdgcn_s_waitcnt(0);
        unsigned nloc = b.st[0], nx = b.st[1];
        if (nloc == 0u) { xcd_barrier_complete(bar, b.x, nloc, nx); b.st[0] = nloc; b.st[1] = nx; }
        const unsigned old = xb_add(&bar[XB_XSUB(b.x)], 1u);
        const unsigned gen = old / nloc;
        if (old + 1u == (gen + 1u) * nloc) {
            __builtin_amdgcn_fence(__ATOMIC_RELEASE, "agent");
            asm volatile("s_waitcnt vmcnt(0)" ::: "memory");
            const unsigned og = xb_add(&bar[XB_TOP], 1u);
            const unsigned tg = og / nx;
            if (og + 1u == (tg + 1u) * nx) xb_add(&bar[XB_TOPGEN], 1u);
            else XB_SPIN(xb_ld(&bar[XB_TOPGEN]) == tg, bar);
            __builtin_amdgcn_fence(__ATOMIC_ACQUIRE, "agent");
            xb_add(&bar[XB_XGEN(b.x)], 1u);
            asm volatile("s_waitcnt vmcnt(0)" ::: "memory");
        } else {
            XB_SPIN(xb_ld(&bar[XB_XGEN(b.x)]) == gen, bar);
            __builtin_amdgcn_fence(__ATOMIC_ACQUIRE, "agent");
            asm volatile("s_waitcnt vmcnt(0)" ::: "memory");
        }
    }
    __syncthreads();
}
struct Frame {
    LAS unsigned char* lds;
    volatile LAS unsigned* MISC;
    gu32* ctl;
    int tid, lane, wave, vcu, G;
    const float *x_prompt, *x_sample, *cache_latent, *cache_krope, *state_conv, *state_ssm; const int* page_table;
    const float *meta, *norm_mix_g, *w_in, *conv_w, *a_log, *dt_bias, *gdn_norm_g, *q_norm_g, *w_q_b, *kv_norm_g, *w_kv_b, *w_out, *norm_mlp_g, *w_up, *w_down, *final_g;
    float* out;
    bf16 *WIN, *WQB, *WKVB, *WOUT, *WUP, *WDN, *XN, *PRJ, *CQN, *LATN, *QM, *KV, *MIX, *H1B, *HFF, *KPEB, *GQKV;
    bf16* H2B;
    float *KPE, *GB, *GO, *H2, *PART, *PSTAT, *SS1, *ROPE, *QLAT, *EGL, *S1; unsigned char* GCH;
};
__device__ __forceinline__ float bf2f(bf16 v) { return __uint_as_float((unsigned)v << 16); }
__device__ __forceinline__ float wave_sum(float v) {
#pragma unroll
    for (int o = 1; o < 64; o <<= 1) v += __shfl_xor(v, o);
    return v;
}
__device__ __forceinline__ float wave_max(float v) {
#pragma unroll
    for (int o = 1; o < 64; o <<= 1) v = fmaxf(v, __shfl_xor(v, o));
    return v;
}
__device__ __forceinline__ float silu_f(float y) { return y / (1.0f + __expf(-y)); }
__device__ __forceinline__ float rdlane(float v, int l) { return __int_as_float(__builtin_amdgcn_readlane(__float_as_int(v), l)); }
__device__ __forceinline__ int row_pos(int r) { return r < R_META ? NMETA + (r & (SEQ - 1)) : (r < R_SAMP ? r - R_META : PAST + ((r - R_SAMP) & (NST - 1))); }

__device__ __forceinline__ float wsrc(const Frame& F, int mat, int k, int n) {
    switch (mat) {
    case 0: { int c;
        if (n < C_CQ) c = n; else if (n < C_CKV) c = 2064 + (n - C_CQ); else if (n < C_KPE) c = 2448 + (n - C_CKV); else if (n < C_B) c = 2704 + (n - C_KPE);
        else if (n < C_A) c = 2048 + (n - C_B); else if (n < C_PAD) c = 2056 + (n - C_A); else return 0.f;
        return F.w_in[(size_t)k * IN_COLS + c]; }
    case 1: { const int c = n < 512 ? (n >> 6) * 96 + (n & 63) : ((n - 512) >> 5) * 96 + 64 + ((n - 512) & 31); return F.w_q_b[(size_t)k * 768 + c]; }
    case 2: { const int c = n < 512 ? (n >> 6) * 128 + (n & 63) : ((n - 512) >> 6) * 128 + 64 + ((n - 512) & 63); return F.w_kv_b[(size_t)k * 1024 + c]; }
    case 3: return F.w_out[(size_t)k * 1024 + n];
    case 4: return F.norm_mlp_g[k] * F.w_up[(size_t)k * 4096 + n];
    default: return F.w_down[(size_t)k * 1024 + n];
    }
}
__device__ __forceinline__ void p0_transpose_item(const Frame& F, int mat, int K, int N, bf16* WT, LAS float* scr, int item, int lane) {
    const int nblk = N / 32, kb = item / nblk, nb = item % nblk, k0 = 64 * kb, n0 = 32 * nb;
#pragma unroll 4
    for (int i = 0; i < 32; ++i) { const int kk = 2 * i + (lane >> 5); scr[kk * 33 + (lane & 31)] = wsrc(F, mat, k0 + kk, n0 + (lane & 31)); }
    LDS_WAIT(); asm volatile("" ::: "memory");
    const int c = lane & 7;
#pragma unroll
    for (int j = 0; j < 4; ++j) { const int n = (lane >> 3) + 8 * j; const LAS float* s = scr + (8 * c) * 33 + n;
        v4u o; o.x = pk2(s[0 * 33], s[1 * 33]); o.y = pk2(s[2 * 33], s[3 * 33]); o.z = pk2(s[4 * 33], s[5 * 33]); o.w = pk2(s[6 * 33], s[7 * 33]);
        *(GAS v4u*)(WT + (size_t)(n0 + n) * K + k0 + 8 * c) = o; }
    LDS_WAIT(); asm volatile("" ::: "memory");
}
__device__ __forceinline__ const float* x_row(const Frame& F, int r) {
    if (r < R_META) return F.x_prompt + (size_t)r * D;
    if (r < R_SAMP) return F.meta + (size_t)(r - R_META) * D;
    if (r < R_END) return F.x_sample + (size_t)(r - R_SAMP) * D;
    return nullptr;
}
__device__ __forceinline__ void p0_prologue(Frame& F) {
    LAS float* scr = (LAS float*)(F.lds + RING_OFF + F.wave * 16384);
    const int gw = F.vcu * NWAVES + F.wave, NGW = F.G * NWAVES;
    constexpr int I0 = (D / 64) * (NPRJ / 32), I1 = (QLORA / 64) * (768 / 32), I2 = (KVLORA / 64) * (1024 / 32), I3 = (1024 / 64) * (1024 / 32), I4 = (D / 64) * (FF / 32), I5 = (FF / 64) * (D / 32);
    constexpr int NITEMS = I0 + I1 + I2 + I3 + I4 + I5;
    for (int it = gw; it < NITEMS; it += NGW) {
        int r = it;
        if (r < I0) { p0_transpose_item(F, 0, D, NPRJ, F.WIN, scr, r, F.lane); continue; } r -= I0;
        if (r < I1) { p0_transpose_item(F, 1, QLORA, 768, F.WQB, scr, r, F.lane); continue; } r -= I1;
        if (r < I2) { p0_transpose_item(F, 2, KVLORA, 1024, F.WKVB, scr, r, F.lane); continue; } r -= I2;
        if (r < I3) { p0_transpose_item(F, 3, 1024, 1024, F.WOUT, scr, r, F.lane); continue; } r -= I3;
        if (r < I4) { p0_transpose_item(F, 4, D, FF, F.WUP, scr, r, F.lane); continue; } r -= I4;
        p0_transpose_item(F, 5, FF, D, F.WDN, scr, r, F.lane);
    }
    for (int e = (F.vcu * NWAVES * 64 + F.tid); e < NROPE * 16; e += F.G * NWAVES * 64) { const int pi = e >> 4, i = e & 15; const int pos = pi < TP ? pi : PAST + (pi - TP);
        const double ang = (double)pos * exp2(-(double)i * 0.83048202372184059); const double n = rint(ang * 0.15915494309189535); const float rr = (float)fma(-n, 6.2831853071795862, ang);
        F.ROPE[pi * 32 + i] = cosf(rr); F.ROPE[pi * 32 + 16 + i] = sinf(rr); }
    { const f32x4* gv = (const f32x4*)F.norm_mix_g + F.lane; f32x4 g4[4];
#pragma unroll
      for (int j = 0; j < 4; ++j) g4[j] = gv[64 * j];
      for (int m0 = gw; m0 < MT; m0 += 2 * NGW) { const int m1 = m0 + NGW;
        const float* x0 = x_row(F, m0); const float* x1 = m1 < MT ? x_row(F, m1) : nullptr;
        f32x4 v0[4], v1[4];
#pragma unroll
        for (int j = 0; j < 4; ++j) { v0[j] = x0 ? ((const f32x4*)x0 + F.lane)[64 * j] : (f32x4){0.f, 0.f, 0.f, 0.f}; v1[j] = x1 ? ((const f32x4*)x1 + F.lane)[64 * j] : (f32x4){0.f, 0.f, 0.f, 0.f}; }
        float s0 = 0.f, s1 = 0.f;
#pragma unroll
        for (int j = 0; j < 4; ++j) { s0 += (v0[j].x * v0[j].x + v0[j].y * v0[j].y) + (v0[j].z * v0[j].z + v0[j].w * v0[j].w); s1 += (v1[j].x * v1[j].x + v1[j].y * v1[j].y) + (v1[j].z * v1[j].z + v1[j].w * v1[j].w); }
        const float r0 = 1.0f / sqrtf(wave_sum(s0) * (1.0f / D) + EPS), r1 = 1.0f / sqrtf(wave_sum(s1) * (1.0f / D) + EPS);
        GAS unsigned long long* o0 = (GAS unsigned long long*)(F.XN + (size_t)m0 * D) + F.lane;
#pragma unroll
        for (int j = 0; j < 4; ++j) { const f32x4 y = v0[j] * r0 * g4[j]; o0[64 * j] = (unsigned long long)pk2(y.x, y.y) | ((unsigned long long)pk2(y.z, y.w) << 32); }
        if (m1 < MT) { GAS unsigned long long* o1 = (GAS unsigned long long*)(F.XN + (size_t)m1 * D) + F.lane;
#pragma unroll
            for (int j = 0; j < 4; ++j) { const f32x4 y = v1[j] * r1 * g4[j]; o1[64 * j] = (unsigned long long)pk2(y.x, y.y) | ((unsigned long long)pk2(y.z, y.w) << 32); } }
      } }
}

struct TapSrc { const bf16* pb; const float* pf; };
__device__ __forceinline__ TapSrc tap_src(const Frame& F, int r, int d) {
    TapSrc t; t.pb = nullptr; t.pf = nullptr;
    if (r < R_META) { const int s = r & (SEQ - 1); if (s - d >= 0) t.pb = F.PRJ + (size_t)(r - d) * NPRJ; else t.pb = F.PRJ + (size_t)(R_META + NMETA + (s - d)) * NPRJ; }
    else if (r < R_SAMP) { const int m = r - R_META; if (m - d >= 0) t.pb = F.PRJ + (size_t)(r - d) * NPRJ; }
    else if (r < R_END) { const int i = r - R_SAMP, bs = i >> 2, tt = i & 3; if (tt - d >= 0) t.pb = F.PRJ + (size_t)(r - d) * NPRJ; else t.pf = F.state_conv + ((size_t)bs * 3 + (3 + tt - d)) * 1536; }
    return t;
}
struct P2Consts { f32x4 cw[4][3][2]; float qg[6]; f32x4 kvg; float dtb, nal; };
__device__ __forceinline__ void p2_consts(const Frame& F, P2Consts& W, int lane) {
#pragma unroll
    for (int j = 0; j < 4; ++j)
#pragma unroll
        for (int sg = 0; sg < 3; ++sg) { W.cw[j][sg][0] = *(const f32x4*)(F.conv_w + j * 1536 + sg * 512 + 8 * lane); W.cw[j][sg][1] = *(const f32x4*)(F.conv_w + j * 1536 + sg * 512 + 8 * lane + 4); }
#pragma unroll
    for (int j = 0; j < 3; ++j) { W.qg[2 * j] = F.q_norm_g[128 * j + 2 * lane]; W.qg[2 * j + 1] = F.q_norm_g[128 * j + 2 * lane + 1]; }
    W.kvg = *((const f32x4*)F.kv_norm_g + lane); W.dtb = F.dt_bias[lane & 7]; W.nal = -expf(F.a_log[lane & 7]);
}
__device__ __forceinline__ void p2_row_fast(Frame& F, int r, const P2Consts& W, int lane) {
    const bf16* p = F.PRJ + (size_t)r * NPRJ; const int b = r >> 11, s2 = r & (SEQ - 1);
    unsigned cq[3];
#pragma unroll
    for (int j = 0; j < 3; ++j) cq[j] = *(const unsigned*)(p + C_CQ + 128 * j + 2 * lane);
    const unsigned long long ckv = *(const unsigned long long*)(p + C_CKV + 4 * lane);
    const bf16 kp1 = p[C_KPE + (lane & 15)], kp2 = p[C_KPE + 16 + (lane & 15)], bbr = p[C_B + (lane & 7)], aar = p[C_A + (lane & 7)];
    const float rc = F.ROPE[(NMETA + s2) * 32 + (lane & 15)], rs = F.ROPE[(NMETA + s2) * 32 + 16 + (lane & 15)];
    v4u xt[4][3];
#pragma unroll
    for (int j = 0; j < 4; ++j)
#pragma unroll
        for (int sg = 0; sg < 3; ++sg) xt[j][sg] = *(const v4u*)(p - (size_t)(3 - j) * NPRJ + sg * 512 + 8 * lane);
    { float v[6]; float s = 0.f;
#pragma unroll
      for (int j = 0; j < 3; ++j) { v[2 * j] = __uint_as_float(cq[j] << 16); v[2 * j + 1] = __uint_as_float(cq[j] & 0xffff0000u); s += v[2 * j] * v[2 * j] + v[2 * j + 1] * v[2 * j + 1]; }
      const float rstd = 1.0f / sqrtf(wave_sum(s) * (1.0f / QLORA) + EPS);
#pragma unroll
      for (int j = 0; j < 3; ++j) *(unsigned*)(F.CQN + (size_t)r * QLORA + 128 * j + 2 * lane) = pk2(v[2 * j] * rstd * W.qg[2 * j], v[2 * j + 1] * rstd * W.qg[2 * j + 1]); }
    { float v[4]; v[0] = __uint_as_float((unsigned)(ckv << 16) & 0xffff0000u); v[1] = __uint_as_float((unsigned)ckv & 0xffff0000u); v[2] = __uint_as_float((unsigned)(ckv >> 16) & 0xffff0000u); v[3] = __uint_as_float((unsigned)(ckv >> 32) & 0xffff0000u);
      const float s = (v[0] * v[0] + v[1] * v[1]) + (v[2] * v[2] + v[3] * v[3]);
      const float rstd = 1.0f / sqrtf(wave_sum(s) * (1.0f / KVLORA) + EPS);
      const f32x4 y = {v[0] * rstd * W.kvg.x, v[1] * rstd * W.kvg.y, v[2] * rstd * W.kvg.z, v[3] * rstd * W.kvg.w};
      *(unsigned long long*)(F.LATN + (size_t)r * KVLORA + 4 * lane) = (unsigned long long)pk2(y.x, y.y) | ((unsigned long long)pk2(y.z, y.w) << 32);
      *((f32x4*)(F.out + O_LATP + ((size_t)b * TP + NMETA + s2) * KVLORA) + lane) = y; }
    if (lane < 16) { const float x1 = bf2f(kp1), x2 = bf2f(kp2), o1 = x1 * rc - x2 * rs, o2 = x2 * rc + x1 * rs;
      F.KPE[(size_t)r * 32 + lane] = o1; F.KPE[(size_t)r * 32 + 16 + lane] = o2; F.KPEB[(size_t)r * 32 + lane] = (bf16)f2bf(o1); F.KPEB[(size_t)r * 32 + 16 + lane] = (bf16)f2bf(o2);
      float* o = F.out + O_KRP + ((size_t)b * TP + NMETA + s2) * 32; o[lane] = o1; o[16 + lane] = o2; }
    if (lane < 8) { const float beta = 1.0f / (1.0f + expf(-bf2f(bbr))); const float xx = bf2f(aar) + W.dtb; const float sp = xx > 20.f ? xx : log1pf(expf(xx));
      F.GB[(size_t)r * 16 + lane] = beta; F.GB[(size_t)r * 16 + 8 + lane] = W.nal * sp; }
#pragma unroll
    for (int sg = 0; sg < 3; ++sg) { float y[8];
#pragma unroll
        for (int e = 0; e < 8; ++e) y[e] = 0.f;
#pragma unroll
        for (int j = 0; j < 4; ++j) { const v4u w = xt[j][sg]; const f32x4 w0 = W.cw[j][sg][0], w1 = W.cw[j][sg][1];
            y[0] += __uint_as_float(w.x << 16) * w0.x; y[1] += __uint_as_float(w.x & 0xffff0000u) * w0.y; y[2] += __uint_as_float(w.y << 16) * w0.z; y[3] += __uint_as_float(w.y & 0xffff0000u) * w0.w;
            y[4] += __uint_as_float(w.z << 16) * w1.x; y[5] += __uint_as_float(w.z & 0xffff0000u) * w1.y; y[6] += __uint_as_float(w.w << 16) * w1.z; y[7] += __uint_as_float(w.w & 0xffff0000u) * w1.w; }
        float ss = 0.f;
#pragma unroll
        for (int e = 0; e < 8; ++e) { y[e] = silu_f(y[e]); ss += y[e] * y[e]; }
        if (sg < 2) { ss += __shfl_xor(ss, 1); ss += __shfl_xor(ss, 2); ss += __shfl_xor(ss, 4); const float sc = (sg == 0 ? 0.125f : 1.0f) / sqrtf(ss + EPS);
#pragma unroll
            for (int e = 0; e < 8; ++e) y[e] *= sc; }
        v4u o; o.x = pk2(y[0], y[1]); o.y = pk2(y[2], y[3]); o.z = pk2(y[4], y[5]); o.w = pk2(y[6], y[7]);
        *(v4u*)(F.GQKV + (size_t)r * 1536 + sg * 512 + 8 * lane) = o; }
}
__device__ __forceinline__ void p2_row(Frame& F, int r) {
    int lane_ = F.lane; asm volatile("" : "+v"(lane_)); const int lane = lane_;
    const bf16* p = F.PRJ + (size_t)r * NPRJ;
    if (r >= R_END) {
        for (int c = lane; c < QLORA; c += 64) F.CQN[(size_t)r * QLORA + c] = 0;
        for (int c = lane; c < KVLORA; c += 64) F.LATN[(size_t)r * KVLORA + c] = 0;
        return; }
    { float v[6]; float s = 0.f;
#pragma unroll
      for (int j = 0; j < 3; ++j) { const unsigned w = *(const unsigned*)(p + C_CQ + 128 * j + 2 * lane); v[2 * j] = __uint_as_float(w << 16); v[2 * j + 1] = __uint_as_float(w & 0xffff0000u); s += v[2 * j] * v[2 * j] + v[2 * j + 1] * v[2 * j + 1]; }
      const float rstd = 1.0f / sqrtf(wave_sum(s) * (1.0f / QLORA) + EPS);
#pragma unroll
      for (int j = 0; j < 3; ++j) { const int c = 128 * j + 2 * lane; *(unsigned*)(F.CQN + (size_t)r * QLORA + c) = pk2(v[2 * j] * rstd * F.q_norm_g[c], v[2 * j + 1] * rstd * F.q_norm_g[c + 1]); } }
    { const unsigned long long w = *(const unsigned long long*)(p + C_CKV + 4 * lane); float v[4];
      v[0] = __uint_as_float((unsigned)(w << 16) & 0xffff0000u); v[1] = __uint_as_float((unsigned)w & 0xffff0000u); v[2] = __uint_as_float((unsigned)(w >> 16) & 0xffff0000u); v[3] = __uint_as_float((unsigned)(w >> 32) & 0xffff0000u);
      const float s = (v[0] * v[0] + v[1] * v[1]) + (v[2] * v[2] + v[3] * v[3]);
      const float rstd = 1.0f / sqrtf(wave_sum(s) * (1.0f / KVLORA) + EPS);
      const f32x4 g = *((const f32x4*)F.kv_norm_g + lane);
      const f32x4 y = {v[0] * rstd * g.x, v[1] * rstd * g.y, v[2] * rstd * g.z, v[3] * rstd * g.w};
      *(unsigned long long*)(F.LATN + (size_t)r * KVLORA + 4 * lane) = (unsigned long long)pk2(y.x, y.y) | ((unsigned long long)pk2(y.z, y.w) << 32);
      if (r < R_META) { const int b = r >> 11, s2 = r & (SEQ - 1); *((f32x4*)(F.out + O_LATP + ((size_t)b * TP + NMETA + s2) * KVLORA) + lane) = y; }
      else if (r < R_SAMP) { const int m = r - R_META;
#pragma unroll
          for (int b = 0; b < NB; ++b) *((f32x4*)(F.out + O_LATP + ((size_t)b * TP + m) * KVLORA) + lane) = y; }
      else *((f32x4*)(F.out + O_LATS + (size_t)(r - R_SAMP) * KVLORA) + lane) = y; }
    if (lane < 16) { const float x1 = bf2f(p[C_KPE + lane]), x2 = bf2f(p[C_KPE + 16 + lane]);
      const int pi = r < R_META ? NMETA + (r & (SEQ - 1)) : (r < R_SAMP ? r - R_META : TP + ((r - R_SAMP) & (NST - 1)));
      const float c = F.ROPE[pi * 32 + lane], s = F.ROPE[pi * 32 + 16 + lane], o1 = x1 * c - x2 * s, o2 = x2 * c + x1 * s;
      F.KPE[(size_t)r * 32 + lane] = o1; F.KPE[(size_t)r * 32 + 16 + lane] = o2; F.KPEB[(size_t)r * 32 + lane] = (bf16)f2bf(o1); F.KPEB[(size_t)r * 32 + 16 + lane] = (bf16)f2bf(o2);
      if (r < R_META) { const int b = r >> 11, s2 = r & (SEQ - 1); float* o = F.out + O_KRP + ((size_t)b * TP + NMETA + s2) * 32; o[lane] = o1; o[16 + lane] = o2; }
      else if (r < R_SAMP) { const int m = r - R_META; for (int b = 0; b < NB; ++b) { float* o = F.out + O_KRP + ((size_t)b * TP + m) * 32; o[lane] = o1; o[16 + lane] = o2; } }
      else { float* o = F.out + O_KRS + (size_t)(r - R_SAMP) * 32; o[lane] = o1; o[16 + lane] = o2; } }
    if (lane < 8) { const float bb = bf2f(p[C_B + lane]), aa = bf2f(p[C_A + lane]);
      const float beta = 1.0f / (1.0f + expf(-bb)); const float xx = aa + F.dt_bias[lane];
      const float sp = xx > 20.f ? xx : log1pf(expf(xx));
      F.GB[(size_t)r * 16 + lane] = beta; F.GB[(size_t)r * 16 + 8 + lane] = -expf(F.a_log[lane]) * sp; }
    { TapSrc ts[4];
#pragma unroll
      for (int j = 0; j < 4; ++j) ts[j] = tap_src(F, r, 3 - j);
      float y[3][8];
#pragma unroll
      for (int sg = 0; sg < 3; ++sg)
#pragma unroll
          for (int e = 0; e < 8; ++e) y[sg][e] = 0.f;
#pragma unroll
      for (int j = 0; j < 4; ++j) {
          if (!ts[j].pb && !ts[j].pf) continue;
#pragma unroll
          for (int sg = 0; sg < 3; ++sg) { const int ch = sg * 512 + 8 * lane; float x[8];
              if (ts[j].pb) { const v4u w = *(const v4u*)(ts[j].pb + ch);
                  x[0] = __uint_as_float(w.x << 16); x[1] = __uint_as_float(w.x & 0xffff0000u); x[2] = __uint_as_float(w.y << 16); x[3] = __uint_as_float(w.y & 0xffff0000u);
                  x[4] = __uint_as_float(w.z << 16); x[5] = __uint_as_float(w.z & 0xffff0000u); x[6] = __uint_as_float(w.w << 16); x[7] = __uint_as_float(w.w & 0xffff0000u); }
              else { const f32x4 a = *(const f32x4*)(ts[j].pf + ch), b2 = *(const f32x4*)(ts[j].pf + ch + 4); x[0] = a.x; x[1] = a.y; x[2] = a.z; x[3] = a.w; x[4] = b2.x; x[5] = b2.y; x[6] = b2.z; x[7] = b2.w; }
              const f32x4 w0 = *(const f32x4*)(F.conv_w + j * 1536 + ch), w1 = *(const f32x4*)(F.conv_w + j * 1536 + ch + 4);
              y[sg][0] += x[0] * w0.x; y[sg][1] += x[1] * w0.y; y[sg][2] += x[2] * w0.z; y[sg][3] += x[3] * w0.w;
              y[sg][4] += x[4] * w1.x; y[sg][5] += x[5] * w1.y; y[sg][6] += x[6] * w1.z; y[sg][7] += x[7] * w1.w; } }
#pragma unroll
      for (int sg = 0; sg < 3; ++sg) { float ss = 0.f;
#pragma unroll
          for (int e = 0; e < 8; ++e) { y[sg][e] = silu_f(y[sg][e]); ss += y[sg][e] * y[sg][e]; }
          if (sg < 2) { ss += __shfl_xor(ss, 1); ss += __shfl_xor(ss, 2); ss += __shfl_xor(ss, 4); const float sc = (sg == 0 ? 0.125f : 1.0f) / sqrtf(ss + EPS);
#pragma unroll
              for (int e = 0; e < 8; ++e) y[sg][e] *= sc; }
          v4u o; o.x = pk2(y[sg][0], y[sg][1]); o.y = pk2(y[sg][2], y[sg][3]); o.z = pk2(y[sg][4], y[sg][5]); o.w = pk2(y[sg][6], y[sg][7]);
          *(v4u*)(F.GQKV + (size_t)r * 1536 + sg * 512 + 8 * lane) = o; } }
    { float* o = nullptr;
      if (r < R_META) { const int b = r >> 11, s2 = r & (SEQ - 1); if (s2 >= SEQ - 3) o = F.out + O_CONVP + ((size_t)b * 3 + (s2 - (SEQ - 3))) * 1536; }
      else if (r >= R_SAMP) { const int i = r - R_SAMP, bs = i >> 2, tt = i & 3; if (tt >= 1) o = F.out + O_CONVS + ((size_t)bs * 3 + (tt - 1)) * 1536; }
      if (o) {
          v4u w[3];
#pragma unroll
          for (int k = 0; k < 3; ++k) w[k] = *(const v4u*)(p + 512 * k + 8 * lane);
#pragma unroll
          for (int k = 0; k < 3; ++k) { float* ok = o + 512 * k + 8 * lane;
              *(f32x4*)ok = (f32x4){__uint_as_float(w[k].x << 16), __uint_as_float(w[k].x & 0xffff0000u), __uint_as_float(w[k].y << 16), __uint_as_float(w[k].y & 0xffff0000u)};
              *(f32x4*)(ok + 4) = (f32x4){__uint_as_float(w[k].z << 16), __uint_as_float(w[k].z & 0xffff0000u), __uint_as_float(w[k].w << 16), __uint_as_float(w[k].w & 0xffff0000u)}; } } }
}

namespace fa {
typedef float f32x16 __attribute__((ext_vector_type(16)));
typedef short s16x4 __attribute__((ext_vector_type(4)));
typedef short v4i16_t __attribute__((ext_vector_type(4)));
constexpr int KOFF = 0, VOFF = 12288, STAGE = 20480;
constexpr int LDS_WSF = 2 * STAGE, LDS_OST = LDS_WSF + 8 * 256, LDS_TOTAL = LDS_OST + 8 * 4096;
static_assert(LDS_TOTAL <= RING_BYTES, "attention LDS");
__device__ __forceinline__ int crow(int r, int hi) { return (r & 3) + 8 * (r >> 2) + 4 * hi; }
typedef float f32x2_t __attribute__((ext_vector_type(2))); typedef __bf16 bf16x2_t __attribute__((ext_vector_type(2)));
__device__ __forceinline__ unsigned cvtpk(float lo, float hi) { f32x2_t v = {lo, hi}; bf16x2_t b = __builtin_convertvector(v, bf16x2_t); return __builtin_bit_cast(unsigned, b); }
__device__ __forceinline__ s16x4 vtr(const LAS unsigned char* p) { return __builtin_bit_cast(s16x4, __builtin_amdgcn_ds_read_tr16_b64_v4i16((LAS v4i16_t*)p)); }
__device__ __forceinline__ void issue_tile(const Frame& F, LAS unsigned char* st, int b, int h, int t, bool meta, int wid, int lane) {
    { const int key = lane; const int krow = meta ? R_META + (key < NMETA ? key : NMETA - 1) : b * SEQ + 64 * t + key;
      __builtin_amdgcn_global_load_lds((const unsigned*)(F.KV + (size_t)krow * 1024 + h * 64 + wid * 8), (LAS unsigned*)(st + KOFF + wid * 1024), 16, 0, 0);
      if (wid < 4) __builtin_amdgcn_global_load_lds((const unsigned*)(F.KPEB + (size_t)krow * 32 + wid * 8), (LAS unsigned*)(st + KOFF + (8 + wid) * 1024), 16, 0, 0); }
    { const int key = 16 * (wid & 3) + (lane >> 2); const int vrow = meta ? R_META + (key < NMETA ? key : NMETA - 1) : b * SEQ + 64 * t + key;
      __builtin_amdgcn_global_load_lds((const unsigned*)(F.KV + (size_t)vrow * 1024 + 512 + h * 64 + (wid >> 2) * 32 + (lane & 3) * 8), (LAS unsigned*)(st + VOFF + wid * 1024), 16, 0, 0); }
}
__device__ __forceinline__ void attn_unit(const Frame& F, int b, int h, int qb) {
    const int lane = F.lane, wid = F.wave, r32 = lane & 31, hi = lane >> 5;
    LAS unsigned char* base = F.lds + RING_OFF;
    LAS float* wsf = (LAS float*)(base + LDS_WSF) + wid * 64;
    const int s0 = 256 * qb + 32 * wid; const size_t row0 = (size_t)b * SEQ + s0;
    const int NTR = 4 * (qb + 1), NT = NTR + 1;
    const int td = 4 * qb + (wid >> 1);
    __syncthreads();
    issue_tile(F, base, b, h, 0, false, wid, lane);
    bf16x8 qr[6];
    { const bf16* q = F.QM + (row0 + r32) * 768;
#pragma unroll
      for (int d0 = 0; d0 < 4; ++d0) qr[d0] = *(const bf16x8*)(q + h * 64 + d0 * 16 + hi * 8);
#pragma unroll
      for (int d0 = 0; d0 < 2; ++d0) qr[4 + d0] = *(const bf16x8*)(q + 512 + h * 32 + d0 * 16 + hi * 8); }
    f32x16 o0, o1;
#pragma unroll
    for (int r = 0; r < 16; ++r) { o0[r] = 0.f; o1[r] = 0.f; }
    float m = -INFINITY, l = 0.f;
    const int qrel = 32 * (wid & 1) + r32;
    const int vlane = ((lane >> 4) & 1) * 32 + (lane & 3) * 8 + (4 * hi + ((lane & 15) >> 2)) * 64;
    for (int t = 0; t < NT; ++t) {
        const bool meta = (t == NTR);
        asm volatile("s_waitcnt vmcnt(0)" ::: "memory");
        __syncthreads();
        if (t + 1 < NT) issue_tile(F, base + ((t + 1) & 1) * STAGE, b, h, t + 1, t + 1 == NTR, wid, lane);
        if (!meta && t > td) continue;
        const LAS unsigned char* st = base + (t & 1) * STAGE;
        const LAS unsigned char* kb = st + KOFF + hi * 1024 + r32 * 16;
        f32x16 p0, p1;
#pragma unroll
        for (int r = 0; r < 16; ++r) { p0[r] = 0.f; p1[r] = 0.f; }
#pragma unroll
        for (int d0 = 0; d0 < 6; ++d0) {
            const bf16x8 k0 = *(const LAS bf16x8*)(kb + d0 * 2048);
            p0 = __builtin_amdgcn_mfma_f32_32x32x16_bf16(k0, qr[d0], p0, 0, 0, 0);
            if (!meta) { const bf16x8 k1 = *(const LAS bf16x8*)(kb + d0 * 2048 + 512); p1 = __builtin_amdgcn_mfma_f32_32x32x16_bf16(k1, qr[d0], p1, 0, 0, 0); }
        }
        if (meta) {
#pragma unroll
            for (int r = 8; r < 16; ++r) p0[r] = -INFINITY;
#pragma unroll
            for (int r = 0; r < 16; ++r) p1[r] = -INFINITY;
        } else if (t == td) {
#pragma unroll
            for (int r = 0; r < 16; ++r) { const int kk = crow(r, hi); if (kk > qrel) p0[r] = -INFINITY; if (kk + 32 > qrel) p1[r] = -INFINITY; }
        }
        float mx = fmaxf(p0[0], p1[0]);
#pragma unroll
        for (int r = 1; r < 16; ++r) mx = fmaxf(mx, fmaxf(p0[r], p1[r]));
        mx = fmaxf(mx, __shfl_xor(mx, 32));
        const float mn = fmaxf(m, mx);
        if (__any(mn > m)) {
            const float f = __builtin_amdgcn_exp2f(m - mn);
            l *= f; wsf[r32] = f;
#pragma unroll
            for (int r = 0; r < 16; ++r) { const float fr_ = wsf[crow(r, hi)]; o0[r] *= fr_; o1[r] *= fr_; }
            m = mn;
        }
        float sum = 0.f;
#pragma unroll
        for (int r = 0; r < 16; ++r) { p0[r] = __builtin_amdgcn_exp2f(p0[r] - m); p1[r] = __builtin_amdgcn_exp2f(p1[r] - m); sum += p0[r] + p1[r]; }
        l += sum;
        v4u pa0, pa1, pa2, pa3;
        pa0.x = cvtpk(p0[0], p0[1]); pa0.y = cvtpk(p0[2], p0[3]); pa0.z = cvtpk(p0[4], p0[5]); pa0.w = cvtpk(p0[6], p0[7]);
        pa1.x = cvtpk(p0[8], p0[9]); pa1.y = cvtpk(p0[10], p0[11]); pa1.z = cvtpk(p0[12], p0[13]); pa1.w = cvtpk(p0[14], p0[15]);
        pa2.x = cvtpk(p1[0], p1[1]); pa2.y = cvtpk(p1[2], p1[3]); pa2.z = cvtpk(p1[4], p1[5]); pa2.w = cvtpk(p1[6], p1[7]);
        pa3.x = cvtpk(p1[8], p1[9]); pa3.y = cvtpk(p1[10], p1[11]); pa3.z = cvtpk(p1[12], p1[13]); pa3.w = cvtpk(p1[14], p1[15]);
        const LAS unsigned char* vp = st + VOFF + vlane;
#define FA_PV(O, PA, DB, KS) do { const s16x4 lo_ = vtr(vp + (DB) * 4096 + (KS) * 1024), hi_ = vtr(vp + (DB) * 4096 + (KS) * 1024 + 512); \
        const bf16x8 vf_ = {lo_[0], lo_[1], lo_[2], lo_[3], hi_[0], hi_[1], hi_[2], hi_[3]}; \
        O = __builtin_amdgcn_mfma_f32_32x32x16_bf16(__builtin_bit_cast(bf16x8, PA), vf_, O, 0, 0, 0); } while (0)
        FA_PV(o0, pa0, 0, 0); FA_PV(o1, pa0, 1, 0);
        if (!meta) { FA_PV(o0, pa1, 0, 1); FA_PV(o1, pa1, 1, 1); FA_PV(o0, pa2, 0, 2); FA_PV(o1, pa2, 1, 2); FA_PV(o0, pa3, 0, 3); FA_PV(o1, pa3, 1, 3); }
#undef FA_PV
    }
    l += __shfl_xor(l, 32);
    wsf[32 + r32] = l;
    float rli[16];
#pragma unroll
    for (int r = 0; r < 16; ++r) rli[r] = 1.0f / wsf[32 + crow(r, hi)];
    LAS bf16* stg = (LAS bf16*)(base + LDS_OST) + wid * 2048;
#pragma unroll
    for (int r = 0; r < 16; ++r) { const int orow = crow(r, hi); stg[orow * 64 + r32] = (bf16)f2bf(o0[r] * rli[r]); stg[orow * 64 + 32 + r32] = (bf16)f2bf(o1[r] * rli[r]); }
#pragma unroll
    for (int i = 0; i < 4; ++i) { const int row = i * 8 + (lane >> 3), ch = lane & 7; const v4u v = *(const LAS v4u*)(stg + row * 64 + ch * 8);
        *(v4u*)(F.MIX + (row0 + row) * 1024 + 512 + h * 64 + ch * 8) = v; }
}
__device__ __forceinline__ void attn_phase(const Frame& F) {
    for (int u = F.vcu; u < 256; u += F.G) { const int bh = u >> 2, pr = u & 3;
        attn_unit(F, bh >> 3, bh & 7, pr); attn_unit(F, bh >> 3, bh & 7, 7 - pr); }
    __syncthreads();
}
}

namespace sa {
using fa::f32x16; using fa::s16x4; using fa::crow; using fa::cvtpk; using fa::vtr;
constexpr int CS = 528, TILE = 36 * CS  , QF_OFF = 4 * TILE  , WSF_OFF = QF_OFF + 32 * 288 * 2  , LDS_TOTAL = WSF_OFF + 8 * 256;
static_assert(LDS_TOTAL <= RING_BYTES && QF_OFF % 16 == 0 && WSF_OFF % 16 == 0, "sample attention LDS");
constexpr int NUNIT = 8, KEYS_PER = PAST / NUNIT  , NTC = KEYS_PER / 64  , NSPL = 2 * NUNIT  ;
__device__ __forceinline__ void tile_step(const LAS unsigned char* st, const bf16x8 (&qf)[18], f32x16& o0, f32x16& o1, float& m, float& l, LAS float* wsf, int r32, int hi, int vlane) {
        const LAS unsigned char* kb = st + hi * CS + r32 * 16;
        f32x16 p0;
#pragma unroll
        for (int r = 0; r < 16; ++r) p0[r] = 0.f;
#pragma unroll
        for (int s = 0; s < 18; ++s) { const bf16x8 k0 = *(const LAS bf16x8*)(kb + 2 * s * CS); p0 = __builtin_amdgcn_mfma_f32_32x32x16_bf16(k0, qf[s], p0, 0, 0, 0); }
        float mx = p0[0];
#pragma unroll
        for (int r = 1; r < 16; ++r) mx = fmaxf(mx, p0[r]);
        mx = fmaxf(mx, __shfl_xor(mx, 32));
        const float mn = fmaxf(m, mx);
        if (__any(mn > m)) {
            const float f = __builtin_amdgcn_exp2f(m - mn);
            l *= f; wsf[r32] = f;
#pragma unroll
            for (int r = 0; r < 16; ++r) { const float fr_ = wsf[crow(r, hi)]; o0[r] *= fr_; o1[r] *= fr_; }
            m = mn;
        }
        float sum = 0.f;
#pragma unroll
        for (int r = 0; r < 16; ++r) { p0[r] = __builtin_amdgcn_exp2f(p0[r] - m); sum += p0[r]; }
        l += sum;
        v4u pa0, pa1;
        pa0.x = cvtpk(p0[0], p0[1]); pa0.y = cvtpk(p0[2], p0[3]); pa0.z = cvtpk(p0[4], p0[5]); pa0.w = cvtpk(p0[6], p0[7]);
        pa1.x = cvtpk(p0[8], p0[9]); pa1.y = cvtpk(p0[10], p0[11]); pa1.z = cvtpk(p0[12], p0[13]); pa1.w = cvtpk(p0[14], p0[15]);
        const LAS unsigned char* vp = st + vlane;
#define SA_PV(O, PA, CT, KS) do { const s16x4 lo_ = vtr(vp + (CT) * 4 * CS + (KS) * 256), hi_ = vtr(vp + (CT) * 4 * CS + (KS) * 256 + 128); \
        const bf16x8 vf_ = {lo_[0], lo_[1], lo_[2], lo_[3], hi_[0], hi_[1], hi_[2], hi_[3]}; \
        O = __builtin_amdgcn_mfma_f32_32x32x16_bf16(__builtin_bit_cast(bf16x8, PA), vf_, O, 0, 0, 0); } while (0)
        SA_PV(o0, pa0, 0, 0); SA_PV(o1, pa0, 1, 0); SA_PV(o0, pa1, 0, 1); SA_PV(o1, pa1, 1, 1);
#undef SA_PV
}
__device__ __forceinline__ void attn_unit(const Frame& F, int bs, int split) {
    const int tid = F.tid, lane = F.lane, wid = F.wave, r32 = lane & 31, hi = lane >> 5, g = wid >> 2, w4 = wid & 3, tg = tid & 255;
    LAS unsigned char* base = F.lds + RING_OFF;
    LAS bf16* qfb = (LAS bf16*)(base + QF_OFF);
    LAS float* wsf = (LAS float*)(base + WSF_OFF) + wid * 64;
    __syncthreads();
    { LAS float* tmp = (LAS float*)base;
      for (int e = tid; e < 32 * 64; e += 512) { const int rr = e >> 6, n = e & 63, t = rr >> 3, h = rr & 7; tmp[e] = bf2f(F.QM[(size_t)(R_SAMP + bs * 4 + t) * 768 + h * 64 + n]); }
      for (int e = tid; e < 32 * 32; e += 512) { const int rr = e >> 5, i = e & 31, t = rr >> 3, h = rr & 7; qfb[rr * 288 + 256 + i] = F.QM[(size_t)(R_SAMP + bs * 4 + t) * 768 + 512 + h * 32 + i]; }
      __syncthreads();
      { int tz = tid; asm volatile("" : "+v"(tz)); const int h = tz & 7;
#pragma unroll 1
        for (int j = 0; j < 4; ++j) { const int c = (tz >> 3) + 64 * j; const f32x4* w = (const f32x4*)(F.w_kv_b + (size_t)c * 1024 + h * 128);
            f32x4 wv[16];
#pragma unroll
            for (int k = 0; k < 16; ++k) wv[k] = w[k];
#pragma unroll
            for (int t = 0; t < 4; ++t) { const LAS f32x4* q4 = (const LAS f32x4*)(tmp + (t * 8 + h) * 64); float a = 0.f;
#pragma unroll
                for (int k = 0; k < 16; ++k) { const f32x4 q = q4[k]; a += (wv[k].x * q.x + wv[k].y * q.y) + (wv[k].z * q.z + wv[k].w * q.w); }
                qfb[(t * 8 + h) * 288 + c] = (bf16)f2bf(a); if (split == 0) F.QLAT[((size_t)bs * 32 + t * 8 + h) * 256 + c] = a; } } }
      __syncthreads(); }
    bf16x8 qf[18];
#pragma unroll
    for (int s = 0; s < 18; ++s) qf[s] = *(const LAS bf16x8*)(qfb + r32 * 288 + 16 * s + 8 * hi);
    const int ptv = F.page_table[bs * NPAGES + split * (KEYS_PER / PAGE) + (lane & 15)];
    f32x4 RA[9], RB[9];
#define SA_LOAD(R, t) do { const int key0_ = (t) * 64 + g * 32; const int page_ = __builtin_amdgcn_readlane(ptv, key0_ >> 7); const size_t rb_ = (size_t)page_ * PAGE + (key0_ & 127); \
        _Pragma("unroll") for (int i_ = 0; i_ < 8; ++i_) R[i_] = *((const f32x4*)(F.cache_latent + (rb_ + i_ * 4 + w4) * 256) + lane); \
        R[8] = *((const f32x4*)(F.cache_krope + (rb_ + (tg >> 3)) * 32) + (tg & 7)); } while (0)
#define SA_WRITE(R, buf) do { LAS unsigned char* b_ = base + (g * 2 + (buf)) * TILE; \
        _Pragma("unroll") for (int i_ = 0; i_ < 8; ++i_) { const unsigned long long w_ = (unsigned long long)cvtpk(R[i_].x, R[i_].y) | ((unsigned long long)cvtpk(R[i_].z, R[i_].w) << 32); \
            *(LAS unsigned long long*)(b_ + (lane >> 1) * CS + (i_ * 4 + w4) * 16 + (lane & 1) * 8) = w_; } \
        { const unsigned long long w_ = (unsigned long long)cvtpk(R[8].x, R[8].y) | ((unsigned long long)cvtpk(R[8].z, R[8].w) << 32); \
          *(LAS unsigned long long*)(b_ + (32 + ((tg & 7) >> 1)) * CS + (tg >> 3) * 16 + (tg & 1) * 8) = w_; } } while (0)
    SA_LOAD(RA, 0); SA_WRITE(RA, 0); SA_LOAD(RB, 1); SA_LOAD(RA, 2);
    f32x16 o0, o1;
#pragma unroll
    for (int r = 0; r < 16; ++r) { o0[r] = 0.f; o1[r] = 0.f; }
    float m = -INFINITY, l = 0.f;
    const int vlane = (8 * w4 + 2 * ((lane >> 4) & 1) + ((lane & 3) >> 1)) * CS + (4 * hi + ((lane & 15) >> 2)) * 16 + 8 * (lane & 1);
    for (int t = 0; t < NTC; t += 2) {
        __syncthreads();
        tile_step(base + (g * 2 + 0) * TILE, qf, o0, o1, m, l, wsf, r32, hi, vlane);
        SA_WRITE(RB, 1);
        if (t + 3 < NTC) SA_LOAD(RB, t + 3);
        __syncthreads();
        tile_step(base + (g * 2 + 1) * TILE, qf, o0, o1, m, l, wsf, r32, hi, vlane);
        if (t + 2 < NTC) { SA_WRITE(RA, 0); if (t + 4 < NTC) SA_LOAD(RA, t + 4); }
    }
#undef SA_LOAD
#undef SA_WRITE
    l += __shfl_xor(l, 32);
    { int lz = lane; asm volatile("" : "+v"(lz));
      const int rz = lz & 31, hz = lz >> 5;
      const int sp = split * 2 + g; float* po = F.PART + ((size_t)(bs * NSPL + sp) * 32) * 256 + 64 * w4 + rz;
#pragma unroll
      for (int r = 0; r < 16; ++r) { po[(size_t)crow(r, hz) * 256] = o0[r]; po[(size_t)crow(r, hz) * 256 + 32] = o1[r]; }
      if (w4 == 0 && hz == 0) { float* ps = F.PSTAT + ((size_t)(bs * NSPL + sp) * 32 + rz) * 2; ps[0] = m; ps[1] = l; } }
}
__device__ __forceinline__ void attn_phase(const Frame& F) {
    for (int u = F.vcu; u < NSB * NUNIT; u += F.G) attn_unit(F, u >> 3, u & 7);
    __syncthreads();
}
}

namespace gdn {
using fa::f32x16; using fa::crow;
constexpr int REC = 40960, OFF_W = 0, OFF_QG = 8192, OFF_QK = 16384, OFF_KD = 24576, OFF_U = 32768;
constexpr int NCH = SEQ / 64;
typedef float f32x2_t __attribute__((ext_vector_type(2))); typedef __bf16 bf16x2_t __attribute__((ext_vector_type(2)));
__device__ __forceinline__ unsigned cvt2(float lo, float hi) { f32x2_t v = {lo, hi}; bf16x2_t b = __builtin_convertvector(v, bf16x2_t); return __builtin_bit_cast(unsigned, b); }
__device__ __forceinline__ bf16x8 pack8(float a0, float a1, float a2, float a3, float a4, float a5, float a6, float a7) {
    v4u w; w.x = cvt2(a0, a1); w.y = cvt2(a2, a3); w.z = cvt2(a4, a5); w.w = cvt2(a6, a7); return __builtin_bit_cast(bf16x8, w); }
__device__ __forceinline__ bf16x8 ldfrag_f32(const float* p) { const f32x4 a = *(const f32x4*)p, b = *(const f32x4*)(p + 4); return pack8(a.x, a.y, a.z, a.w, b.x, b.y, b.z, b.w); }
__device__ __forceinline__ int swz16(int c) { return (c & 3) | ((c & 4) << 1) | ((c & 8) >> 1); }

template <int PASS> __device__ __forceinline__ void solve_pass(const Frame& F, const LAS float* Lm, const LAS float* gcs, const LAS float* bts, const bf16* col, unsigned char* rec, int lane) {
    float X[64];
#pragma unroll
    for (int ib = 0; ib < 4; ++ib) {
        float c16[16];
#pragma unroll
        for (int k = 0; k < 16; ++k) c16[k] = bf2f(col[(size_t)(16 * ib + k) * 1536]);
        asm volatile("" ::: "memory");
#pragma unroll
        for (int k = 0; k < 16; ++k) { const int i = 16 * ib + k;
            float x = c16[k] * bts[i]; if (PASS == 1) x *= __expf(gcs[i]);
#pragma unroll
            for (int m = 0; m < (i + 3) / 4; ++m) { const f32x4 l4 = *(const LAS f32x4*)(Lm + i * 64 + ((4 * m) ^ ((i & 7) << 2)));
                if (4 * m + 0 < i) x -= l4.x * X[4 * m + 0];
                if (4 * m + 1 < i) x -= l4.y * X[4 * m + 1];
                if (4 * m + 2 < i) x -= l4.z * X[4 * m + 2];
                if (4 * m + 3 < i) x -= l4.w * X[4 * m + 3]; }
            X[i] = x;
            if ((k & 3) == 3) asm volatile("" ::: "memory");
        }
    }
    if (PASS == 0) { const unsigned lo = (unsigned)((lane >> 5) * 2048 + (lane & 31)); bf16* U = (bf16*)(rec + OFF_U);
#pragma unroll
        for (int i = 0; i < 64; ++i) { const int rt = i >> 5, ip = i & 31, hi_ = (ip >> 2) & 1, r = (ip & 3) + 4 * (ip >> 3);
            U[lo + (unsigned)((rt * 16 + r) * 64 + 32 * hi_)] = (bf16)f2bf(X[i]); } }
    else { const int s = lane >> 4, sw = swz16(lane & 15), hsel = (sw >> 3) & 1, el = sw & 7; bf16* W = (bf16*)(rec + OFF_W); const unsigned lo = (unsigned)((s * 64 + 32 * hsel) * 8 + el);
#pragma unroll
        for (int i = 0; i < 64; ++i) { const int rt = i >> 5, ip = i & 31; W[lo + (unsigned)((rt * 256 + ip) * 8)] = (bf16)f2bf(-X[i]); } }
}
__device__ __forceinline__ void solve_both(const Frame& F, const LAS float* Lm, const LAS float* gcs, const LAS float* bts, const bf16* vcol, const bf16* kcol, unsigned char* rec, int lane) {
    float XU[64], XW[64];
#pragma unroll
    for (int ib = 0; ib < 8; ++ib) {
        float cu[8], cw[8];
        { const bf16* vc = vcol + (size_t)(8 * ib) * 1536; const bf16* kc = kcol + (size_t)(8 * ib) * 1536; asm volatile("" : "+v"(vc), "+v"(kc));
#pragma unroll
          for (int k = 0; k < 8; ++k) { cu[k] = bf2f(vc[(size_t)k * 1536]); cw[k] = bf2f(kc[(size_t)k * 1536]); } }
        asm volatile("" ::: "memory");
#pragma unroll
        for (int k = 0; k < 8; ++k) { const int i = 8 * ib + k;
            const float bi = bts[i]; float xu = cu[k] * bi, xw = cw[k] * bi * __expf(gcs[i]);
#pragma unroll
            for (int m = 0; m < (i + 3) / 4; ++m) { const f32x4 l4 = *(const LAS f32x4*)(Lm + i * 64 + ((4 * m) ^ ((i & 7) << 2)));
                if (4 * m + 0 < i) { xu -= l4.x * XU[4 * m + 0]; xw -= l4.x * XW[4 * m + 0]; }
                if (4 * m + 1 < i) { xu -= l4.y * XU[4 * m + 1]; xw -= l4.y * XW[4 * m + 1]; }
                if (4 * m + 2 < i) { xu -= l4.z * XU[4 * m + 2]; xw -= l4.z * XW[4 * m + 2]; }
                if (4 * m + 3 < i) { xu -= l4.w * XU[4 * m + 3]; xw -= l4.w * XW[4 * m + 3]; } }
            XU[i] = xu; XW[i] = xw;
            asm volatile("" ::: "memory");
        }
    }
    { int lz = lane; asm volatile("" : "+v"(lz));
      const unsigned lo = (unsigned)((lz >> 5) * 2048 + (lz & 31)); bf16* U = (bf16*)(rec + OFF_U);
#pragma unroll
      for (int i = 0; i < 64; ++i) { const int rt = i >> 5, ip = i & 31, hi_ = (ip >> 2) & 1, r = (ip & 3) + 4 * (ip >> 3);
          U[lo + (unsigned)((rt * 16 + r) * 64 + 32 * hi_)] = (bf16)f2bf(XU[i]); } }
    asm volatile("" ::: "memory");
    { int lz = lane; asm volatile("" : "+v"(lz)); lane = lz; }
    { const int s = lane >> 4, sw = swz16(lane & 15), hsel = (sw >> 3) & 1, el = sw & 7; bf16* W = (bf16*)(rec + OFF_W); const unsigned lo = (unsigned)((s * 64 + 32 * hsel) * 8 + el);
#pragma unroll
      for (int i = 0; i < 64; ++i) { const int rt = i >> 5, ip = i & 31; W[lo + (unsigned)((rt * 256 + ip) * 8)] = (bf16)f2bf(-XW[i]); } }
}
__device__ __forceinline__ void g1_unit(const Frame& F, int b, int n) {
    int lane_ = F.lane; asm volatile("" : "+v"(lane_));
    const int lane = lane_, h = F.wave, r32 = lane & 31, hi = lane >> 5;
    LAS float* Lm = (LAS float*)(F.lds + RING_OFF) + h * 4096;
    LAS float* gcs = (LAS float*)(F.lds + LDSCTL_OFF + 1024) + h * 128;
    LAS float* bts = gcs + 64;
    const size_t row0 = (size_t)b * SEQ + 64 * n;
    unsigned char* rec = F.GCH + ((size_t)(b * NCH + n) * NH + h) * REC;
    const float beta_l = F.GB[(row0 + lane) * 16 + h]; float gc = F.GB[(row0 + lane) * 16 + 8 + h];
#pragma unroll
    for (int off = 1; off < 64; off <<= 1) { const float t = __int_as_float(__builtin_amdgcn_ds_bpermute((lane - off) << 2, __float_as_int(gc))); if (lane >= off) gc += t; }
    const float gl = rdlane(gc, 63);
    gcs[lane] = gc; bts[lane] = beta_l;
    if (lane == 0) F.EGL[(size_t)(b * NH + h) * NCH + n] = __expf(gl);
    bf16x8 kf[2][4], qf[2][4];
#pragma unroll
    for (int t = 0; t < 2; ++t)
#pragma unroll
        for (int s = 0; s < 4; ++s) { const bf16* base = F.GQKV + (row0 + 32 * t + r32) * 1536 + h * 64 + 16 * s + 8 * hi; qf[t][s] = *(const bf16x8*)base; kf[t][s] = *(const bf16x8*)(base + 512); }
    LDS_WAIT(); asm volatile("" ::: "memory");
#pragma unroll
    for (int tt = 0; tt < 3; ++tt) { const int it = tt == 0 ? 0 : 1, jt = tt == 2 ? 1 : 0;
        f32x16 acc;
#pragma unroll
        for (int r = 0; r < 16; ++r) acc[r] = 0.f;
#pragma unroll
        for (int s = 0; s < 4; ++s) acc = __builtin_amdgcn_mfma_f32_32x32x16_bf16(kf[jt][s], kf[it][s], acc, 0, 0, 0);
        const int i = 32 * it + r32; const float gci = gcs[i], bi = bts[i];
#pragma unroll
        for (int r = 0; r < 16; ++r) { const int j = 32 * jt + crow(r, hi); const float v = j < i ? bi * acc[r] * __expf(gci - gcs[j]) : 0.f; Lm[i * 64 + (j ^ ((i & 7) << 2))] = v; } }
#pragma unroll
    for (int tt = 0; tt < 4; ++tt) { const int it = tt >> 1, ct = tt & 1;
        if (ct <= it) {
            f32x16 acc;
#pragma unroll
            for (int r = 0; r < 16; ++r) acc[r] = 0.f;
#pragma unroll
            for (int s = 0; s < 4; ++s) acc = __builtin_amdgcn_mfma_f32_32x32x16_bf16(kf[ct][s], qf[it][s], acc, 0, 0, 0);
            const int i = 32 * it + r32; const float gci = gcs[i];
#pragma unroll
            for (int r = 0; r < 16; ++r) { const int c = 32 * ct + crow(r, hi); acc[r] = c <= i ? acc[r] * __expf(gci - gcs[c]) : 0.f; }
#pragma unroll
            for (int hf = 0; hf < 2; ++hf) *(bf16x8*)(rec + (unsigned)(OFF_QK + (it * 4 + 2 * ct + hf) * 1024) + (unsigned)lane * 16u) =
                pack8(acc[8 * hf], acc[8 * hf + 1], acc[8 * hf + 2], acc[8 * hf + 3], acc[8 * hf + 4], acc[8 * hf + 5], acc[8 * hf + 6], acc[8 * hf + 7]);
        } else { unsigned z = 0u; asm volatile("" : "+v"(z));
#pragma unroll
            for (int hf = 0; hf < 2; ++hf) *(v4u*)(rec + (unsigned)(OFF_QK + (it * 4 + 2 * ct + hf) * 1024) + (unsigned)lane * 16u) = (v4u){z, z, z, z}; } }
    LDS_WAIT(); asm volatile("" ::: "memory");
    const bf16* vcol = F.GQKV + row0 * 1536 + 1024 + h * 64 + lane; const bf16* kcol = F.GQKV + row0 * 1536 + 512 + h * 64 + lane; const bf16* qcol = F.GQKV + row0 * 1536 + h * 64 + lane;
    { int l2 = lane; asm volatile("" : "+v"(l2)); solve_both(F, Lm, gcs, bts, vcol, kcol, rec, l2); }
    { const int s = lane >> 4, sw = swz16(lane & 15), hsel = (sw >> 3) & 1, el = sw & 7; bf16* QG = (bf16*)(rec + OFF_QG); const unsigned lo = (unsigned)((s * 64 + 32 * hsel) * 8 + el);
#pragma unroll 8
      for (int i = 0; i < 64; ++i) { const int rt = i >> 5, ip = i & 31; QG[lo + (unsigned)((rt * 256 + ip) * 8)] = (bf16)f2bf(bf2f(qcol[(size_t)i * 1536]) * __expf(gcs[i])); } }
    { const int rt = lane >> 5;
#pragma unroll
      for (int s = 0; s < 4; ++s)
#pragma unroll
          for (int hh = 0; hh < 2; ++hh) { float v[8];
#pragma unroll
              for (int j = 0; j < 8; ++j) { const int c = 16 * s + 8 * (j >> 2) + 4 * hh + (j & 3); v[j] = bf2f(kcol[(size_t)c * 1536]) * __expf(gl - gcs[c]); }
              *(bf16x8*)(rec + OFF_KD + (unsigned)(rt * 4096 + (lane & 31) * 16) + (unsigned)(s * 1024 + hh * 512)) = pack8(v[0], v[1], v[2], v[3], v[4], v[5], v[6], v[7]); } }
    LDS_WAIT(); asm volatile("" ::: "memory");
}
__device__ __forceinline__ void chain_short(const Frame& F, int mode, int idx) {
    const int lane = F.lane; int h, total, rbase; float S[64];
    if (mode == 0) { h = idx; total = NMETA; rbase = R_META;
#pragma unroll
        for (int d = 0; d < 64; ++d) S[d] = 0.f; }
    else { h = idx & 7; total = NST; rbase = R_SAMP + (idx >> 3) * NST;
#pragma unroll
        for (int d = 0; d < 64; ++d) S[d] = F.state_ssm[((size_t)idx * 64 + d) * 64 + lane]; }
    for (int i = 0; i < total; ++i) { const size_t r = rbase + i;
        const float q = bf2f(F.GQKV[r * 1536 + h * 64 + lane]), k = bf2f(F.GQKV[r * 1536 + 512 + h * 64 + lane]), v = bf2f(F.GQKV[r * 1536 + 1024 + h * 64 + lane]);
        const float beta = F.GB[r * 16 + h], eg = expf(F.GB[r * 16 + 8 + h]);
        float k0 = 0.f, k1 = 0.f;
#pragma unroll
        for (int d = 0; d < 64; d += 2) { k0 += rdlane(k, d) * S[d]; k1 += rdlane(k, d + 1) * S[d + 1]; }
        const float vnew = beta * (v - eg * (k0 + k1));
        float o0 = 0.f, o1 = 0.f;
#pragma unroll
        for (int d = 0; d < 64; d += 2) { S[d] = eg * S[d] + rdlane(k, d) * vnew; o0 += rdlane(q, d) * S[d]; S[d + 1] = eg * S[d + 1] + rdlane(k, d + 1) * vnew; o1 += rdlane(q, d + 1) * S[d + 1]; }
        F.GO[r * 512 + h * 64 + lane] = o0 + o1; }
    float* so = mode == 0 ? F.S1 + (size_t)h * 4096 : F.out + O_SSMS + (size_t)idx * 4096;
#pragma unroll
    for (int d = 0; d < 64; ++d) so[d * 64 + lane] = S[d];
}
__device__ __forceinline__ void g1_phase(const Frame& F) {
    for (int u = F.vcu; u < NB * NCH; u += F.G) g1_unit(F, u / NCH, u % NCH);
    const int gw = F.vcu * NWAVES + F.wave, NGW = F.G * NWAVES;
    for (int t = NGW - 1 - gw; t < NH + NSB * NH; t += NGW) { if (t < NH) chain_short(F, 0, t); else chain_short(F, 1, t - NH); }
}
__device__ __forceinline__ void g2_task(const Frame& F, int b, int h, int cb) {
    int lane_ = F.lane; asm volatile("" : "+v"(lane_));
    const int lane = lane_, r32 = lane & 31, hi = lane >> 5;
    LAS unsigned char* base = F.lds + RING_OFF;
    constexpr int BUF = 36864;
    const unsigned char* recs = F.GCH + ((size_t)(b * NCH) * NH + h) * REC;
    f32x16 S0, S1, V0, V1, O0, O1;
    { const float* s1 = F.S1 + (size_t)h * 4096 + 32 * cb + r32;
#pragma unroll
      for (int r = 0; r < 16; ++r) { S0[r] = s1[(size_t)crow(r, hi) * 64]; S1[r] = s1[(size_t)(32 + crow(r, hi)) * 64]; } }
    const float egl_l = lane < NCH ? F.EGL[(size_t)(b * NH + h) * NCH + lane] : 0.f;
    const unsigned voff16 = (unsigned)lane * 16u;
#define G2_ISSUE(n, buf) do { const unsigned char* rc_ = recs + (size_t)(n) * NH * REC; LAS unsigned char* d_ = base + (buf) * BUF; \
        _Pragma("unroll") for (int f_ = 0; f_ < 32; ++f_) __builtin_amdgcn_global_load_lds((const unsigned*)(rc_ + f_ * 1024 + voff16), (LAS unsigned*)(d_ + f_ * 1024), 16, 0, 0); \
        _Pragma("unroll") for (int f_ = 0; f_ < 4; ++f_) __builtin_amdgcn_global_load_lds((const unsigned*)(rc_ + OFF_U + (cb * 4 + f_) * 1024 + voff16), (LAS unsigned*)(d_ + 32768 + f_ * 1024), 16, 0, 0); } while (0)
    G2_ISSUE(0, 0);
    for (int n = 0; n < NCH; ++n) {
        asm volatile("s_waitcnt vmcnt(0)" ::: "memory");
        if (n + 1 < NCH) G2_ISSUE(n + 1, (n + 1) & 1);
        const LAS unsigned char* bf = base + (n & 1) * BUF;
#define G2_FR(off, f) (*(const LAS bf16x8*)(bf + (off) + (f) * 1024 + lane * 16))
        bf16x8 sb[4];
        sb[0] = pack8(S0[0], S0[1], S0[2], S0[3], S0[4], S0[5], S0[6], S0[7]); sb[1] = pack8(S0[8], S0[9], S0[10], S0[11], S0[12], S0[13], S0[14], S0[15]);
        sb[2] = pack8(S1[0], S1[1], S1[2], S1[3], S1[4], S1[5], S1[6], S1[7]); sb[3] = pack8(S1[8], S1[9], S1[10], S1[11], S1[12], S1[13], S1[14], S1[15]);
        { const LAS unsigned* up = (const LAS unsigned*)(bf + 32768);
#pragma unroll
          for (int r = 0; r < 16; ++r) { V0[r] = bf2f(((const LAS bf16*)up)[(0 * 16 + r) * 64 + lane]); V1[r] = bf2f(((const LAS bf16*)up)[(1 * 16 + r) * 64 + lane]); O0[r] = 0.f; O1[r] = 0.f; } }
#pragma unroll
        for (int s = 0; s < 4; ++s) { V0 = __builtin_amdgcn_mfma_f32_32x32x16_bf16(G2_FR(OFF_W, s), sb[s], V0, 0, 0, 0); V1 = __builtin_amdgcn_mfma_f32_32x32x16_bf16(G2_FR(OFF_W, 4 + s), sb[s], V1, 0, 0, 0);
            O0 = __builtin_amdgcn_mfma_f32_32x32x16_bf16(G2_FR(OFF_QG, s), sb[s], O0, 0, 0, 0); O1 = __builtin_amdgcn_mfma_f32_32x32x16_bf16(G2_FR(OFF_QG, 4 + s), sb[s], O1, 0, 0, 0); }
        bf16x8 vb[4];
        vb[0] = pack8(V0[0], V0[1], V0[2], V0[3], V0[4], V0[5], V0[6], V0[7]); vb[1] = pack8(V0[8], V0[9], V0[10], V0[11], V0[12], V0[13], V0[14], V0[15]);
        vb[2] = pack8(V1[0], V1[1], V1[2], V1[3], V1[4], V1[5], V1[6], V1[7]); vb[3] = pack8(V1[8], V1[9], V1[10], V1[11], V1[12], V1[13], V1[14], V1[15]);
        const float egl = rdlane(egl_l, n);
#pragma unroll
        for (int r = 0; r < 16; ++r) { S0[r] *= egl; S1[r] *= egl; }
#pragma unroll
        for (int s = 0; s < 4; ++s) { O0 = __builtin_amdgcn_mfma_f32_32x32x16_bf16(G2_FR(OFF_QK, s), vb[s], O0, 0, 0, 0); O1 = __builtin_amdgcn_mfma_f32_32x32x16_bf16(G2_FR(OFF_QK, 4 + s), vb[s], O1, 0, 0, 0);
            S0 = __builtin_amdgcn_mfma_f32_32x32x16_bf16(G2_FR(OFF_KD, s), vb[s], S0, 0, 0, 0); S1 = __builtin_amdgcn_mfma_f32_32x32x16_bf16(G2_FR(OFF_KD, 4 + s), vb[s], S1, 0, 0, 0); }
#undef G2_FR
        { unsigned* go = (unsigned*)F.GO + (size_t)((((b * NCH + n) * NH + h) * 2 + cb) * 2) * 512;
          unsigned lo = (unsigned)lane; asm volatile("" : "+v"(lo));
#pragma unroll
          for (int r = 0; r < 16; r += 2) { go[lo + (unsigned)((r >> 1) * 64)] = cvt2(O0[r], O0[r + 1]); go[lo + (unsigned)(512 + (r >> 1) * 64)] = cvt2(O1[r], O1[r + 1]); } }
    }
#undef G2_ISSUE
    { float* so = F.out + O_SSMP + ((size_t)b * NH + h) * 4096 + 32 * cb + r32;
#pragma unroll
      for (int r = 0; r < 16; ++r) { so[(size_t)crow(r, hi) * 64] = S0[r]; so[(size_t)(32 + crow(r, hi)) * 64] = S1[r]; } }
}
__device__ __forceinline__ void g2_phase(const Frame& F) {
    if (F.wave == 0) for (int t = F.vcu; t < NB * NH * 2; t += F.G) g2_task(F, t >> 4, (t >> 1) & 7, t & 1);
}
}
__device__ __forceinline__ void p4_mixers(Frame& F) {
    if (F.G == 256) {
        const int v = F.vcu, first = v < 128, w = v & 127, bh = w >> 1, b = bh >> 3, h = bh & 7;
        const unsigned ql = first ? ((w & 1) ? 0xF04u : 0xFF5u) : ((w & 1) ? 0x126u : 0xF37u);
        if (first && F.wave == 0) gdn::g2_task(F, b, h, v & 1);
        if (!first) sa::attn_unit(F, v >> 3, v & 7);
        for (int i = 0; i < 3; ++i) { const int qb = (int)((ql >> (4 * i)) & 0xFu); if (qb != 0xF) fa::attn_unit(F, b, h, qb); }
        if (first) sa::attn_unit(F, v >> 3, v & 7);
        __syncthreads();
    } else {
        gdn::g2_phase(F);
        fa::attn_phase(F);
        sa::attn_phase(F);
    }
}
__device__ __forceinline__ void p5_post(Frame& F) {
    const int lane = F.lane; const int gw = F.vcu * NWAVES + F.wave, NGW = F.G * NWAVES;
    LAS float* wl = (LAS float*)(F.lds + RING_OFF) + F.wave * 256;
    const bool bal = (F.G == 256);
    const int t0 = bal ? (F.wave < 4 ? F.wave * 256 + F.vcu : NSB * 32) : gw, tstep = bal ? NSB * 32 : NGW;
    for (int t = t0; t < NSB * 32; t += tstep) { const int bs = t >> 5, rr = t & 31, tt = rr >> 3, h = rr & 7;
        float M = -INFINITY;
        for (int s = 0; s < sa::NSPL; ++s) M = fmaxf(M, F.PSTAT[(((size_t)bs * sa::NSPL + s) * 32 + rr) * 2]);
        float L = 0.f, o[4] = {0.f, 0.f, 0.f, 0.f};
        for (int s = 0; s < sa::NSPL; ++s) { const float* ps = F.PSTAT + (((size_t)bs * sa::NSPL + s) * 32 + rr) * 2; const float w = __builtin_amdgcn_exp2f(ps[0] - M); L += w * ps[1];
            const float* po = F.PART + (((size_t)bs * sa::NSPL + s) * 32 + rr) * 256;
#pragma unroll
            for (int k = 0; k < 4; ++k) o[k] += w * po[lane + 64 * k]; }
        {
          float ql[4];
#pragma unroll
          for (int k = 0; k < 4; ++k) ql[k] = F.QLAT[((size_t)bs * 32 + rr) * 256 + lane + 64 * k];
          const float qp = lane < 32 ? bf2f(F.QM[(size_t)(R_SAMP + bs * NST + tt) * 768 + 512 + h * 32 + lane]) : 0.f;
          for (int j = 0; j <= tt; ++j) { const float* lj = F.out + O_LATS + ((size_t)bs * NST + j) * KVLORA; const float* kj = F.KPE + (size_t)(R_SAMP + bs * NST + j) * 32;
              float lv[4]; float part = lane < 32 ? qp * kj[lane] : 0.f;
#pragma unroll
              for (int k = 0; k < 4; ++k) { lv[k] = lj[lane + 64 * k]; part += ql[k] * lv[k]; }
              const float sj = wave_sum(part); const float M2 = fmaxf(M, sj); const float sc = __builtin_amdgcn_exp2f(M - M2), pj = __builtin_amdgcn_exp2f(sj - M2);
              L = L * sc + pj; M = M2;
#pragma unroll
              for (int k = 0; k < 4; ++k) o[k] = o[k] * sc + pj * lv[k]; } }
        const float inv = 1.0f / L;
#pragma unroll
        for (int k = 0; k < 4; ++k) wl[lane + 64 * k] = o[k] * inv;
        LDS_WAIT(); asm volatile("" ::: "memory");
        float a = 0.f; const float* w = F.w_kv_b + h * 128 + 64 + lane;
        for (int c = 0; c < 256; ++c) a += wl[c] * w[(size_t)c * 1024];
        F.MIX[(size_t)(R_SAMP + bs * NST + tt) * 1024 + 512 + h * 64 + lane] = (bf16)f2bf(a);
        LDS_WAIT(); asm volatile("" ::: "memory"); }
    { const int h = lane >> 3, j = lane & 7;
      const f32x4 gn0 = *(const f32x4*)(F.gdn_norm_g + 8 * j), gn1 = *(const f32x4*)(F.gdn_norm_g + 8 * j + 4);
      const int nr = bal ? (F.wave < 4 ? 5 : (F.wave == 7 ? 12 : 11)) : (MT - gw + NGW - 1) / NGW;
      const int rbase = bal ? F.vcu * 65 + (F.wave < 4 ? F.wave * 5 : 20 + (F.wave - 4) * 11) : gw, rstride = bal ? 1 : NGW;
      static_assert(MT == 256 * 65, "balanced row split");
      for (int k0 = 0; k0 < nr; k0 += 4) {
        f32x4 oa[4], ob[4]; v4u zz[4]; int rq[4];
#pragma unroll
        for (int q = 0; q < 4; ++q) { const int r = (k0 + q < nr) ? rbase + (k0 + q) * rstride : MT; rq[q] = r < MT ? r : -1;
            oa[q] = (f32x4){0.f, 0.f, 0.f, 0.f}; ob[q] = oa[q]; zz[q] = (v4u){0u, 0u, 0u, 0u};
            if (r < R_END) {
                if (r < R_META) { const int b_ = r >> 11, n_ = (r >> 6) & 31, tk = r & 63, rt = tk >> 5, ip = tk & 31, hi_ = (ip >> 2) & 1, rr_ = (ip & 3) + 4 * (ip >> 3);
                    const unsigned* op = (const unsigned*)F.GO + (size_t)((((((b_ * 32 + n_) * NH + h) * 2 + (j >> 2)) * 2 + rt) * 8 + (rr_ >> 1)) * 64) + 8 * (j & 3) + 32 * hi_;
                    const v4u w0 = *(const v4u*)op, w1 = *(const v4u*)(op + 4);
                    if (rr_ & 1) { oa[q] = (f32x4){__uint_as_float(w0.x & 0xffff0000u), __uint_as_float(w0.y & 0xffff0000u), __uint_as_float(w0.z & 0xffff0000u), __uint_as_float(w0.w & 0xffff0000u)};
                                   ob[q] = (f32x4){__uint_as_float(w1.x & 0xffff0000u), __uint_as_float(w1.y & 0xffff0000u), __uint_as_float(w1.z & 0xffff0000u), __uint_as_float(w1.w & 0xffff0000u)}; }
                    else { oa[q] = (f32x4){__uint_as_float(w0.x << 16), __uint_as_float(w0.y << 16), __uint_as_float(w0.z << 16), __uint_as_float(w0.w << 16)};
                           ob[q] = (f32x4){__uint_as_float(w1.x << 16), __uint_as_float(w1.y << 16), __uint_as_float(w1.z << 16), __uint_as_float(w1.w << 16)}; } }
                else { const float* op = F.GO + (size_t)r * 512 + h * 64 + 8 * j; oa[q] = *(const f32x4*)op; ob[q] = *(const f32x4*)(op + 4); }
                zz[q] = *(const v4u*)(F.PRJ + (size_t)r * NPRJ + C_Z + h * 64 + 8 * j); } }
#pragma unroll
        for (int q = 0; q < 4; ++q) { const int r = rq[q]; if (r < 0) continue;
            bf16* mrow = F.MIX + (size_t)r * 1024;
            if (r >= R_END) { *(v4u*)(mrow + 8 * lane) = (v4u){0u, 0u, 0u, 0u}; *(v4u*)(mrow + 512 + 8 * lane) = (v4u){0u, 0u, 0u, 0u}; continue; }
            const f32x4 o0 = oa[q], o1 = ob[q]; const v4u zw = zz[q];
            float ss = (o0.x * o0.x + o0.y * o0.y) + (o0.z * o0.z + o0.w * o0.w) + (o1.x * o1.x + o1.y * o1.y) + (o1.z * o1.z + o1.w * o1.w);
            ss += __shfl_xor(ss, 1); ss += __shfl_xor(ss, 2); ss += __shfl_xor(ss, 4);
            const float rs = 1.0f / sqrtf(ss * (1.0f / 64.0f) + EPS);
            v4u w;
            w.x = pk2(o0.x * rs * gn0.x * silu_f(__uint_as_float(zw.x << 16)), o0.y * rs * gn0.y * silu_f(__uint_as_float(zw.x & 0xffff0000u)));
            w.y = pk2(o0.z * rs * gn0.z * silu_f(__uint_as_float(zw.y << 16)), o0.w * rs * gn0.w * silu_f(__uint_as_float(zw.y & 0xffff0000u)));
            w.z = pk2(o1.x * rs * gn1.x * silu_f(__uint_as_float(zw.z << 16)), o1.y * rs * gn1.y * silu_f(__uint_as_float(zw.z & 0xffff0000u)));
            w.w = pk2(o1.z * rs * gn1.z * silu_f(__uint_as_float(zw.w << 16)), o1.w * rs * gn1.w * silu_f(__uint_as_float(zw.w & 0xffff0000u)));
            *(v4u*)(mrow + h * 64 + 8 * j) = w;
            if (r >= R_META && r < R_SAMP) *(v4u*)(mrow + 512 + 8 * lane) = (v4u){0u, 0u, 0u, 0u}; }
      } }
}
__device__ __forceinline__ void p9_final(Frame& F) {
    const int gw = F.vcu * NWAVES + F.wave, NGW = F.G * NWAVES;
    { int lane = F.lane; asm volatile("" : "+v"(lane));
      const f32x4* gv = (const f32x4*)F.final_g; f32x4 g4[4];
      g4[0] = gv[2 * lane]; g4[1] = gv[2 * lane + 1]; g4[2] = gv[128 + 2 * lane]; g4[3] = gv[128 + 2 * lane + 1];
      for (int i0 = gw; i0 < NREAL; i0 += 4 * NGW) {
        v4u hb[4][2]; int rr[4];
#pragma unroll
        for (int q = 0; q < 4; ++q) { const int r = i0 + q * NGW; rr[q] = r < NREAL ? r : -1;
            if (rr[q] >= 0) { const bf16* hp = F.H2B + (size_t)r * D + 8 * lane; hb[q][0] = *(const v4u*)hp; hb[q][1] = *(const v4u*)(hp + 512); }
            else { hb[q][0] = (v4u){0u, 0u, 0u, 0u}; hb[q][1] = hb[q][0]; } }
#pragma unroll
        for (int q = 0; q < 4; ++q) { if (rr[q] < 0) continue;
            f32x4 v[4];
#pragma unroll
            for (int k = 0; k < 2; ++k) { const v4u w = hb[q][k];
                v[2 * k] = (f32x4){__uint_as_float(w.x << 16), __uint_as_float(w.x & 0xffff0000u), __uint_as_float(w.y << 16), __uint_as_float(w.y & 0xffff0000u)};
                v[2 * k + 1] = (f32x4){__uint_as_float(w.z << 16), __uint_as_float(w.z & 0xffff0000u), __uint_as_float(w.w << 16), __uint_as_float(w.w & 0xffff0000u)}; }
            float s = 0.f;
#pragma unroll
            for (int j = 0; j < 4; ++j) s += (v[j].x * v[j].x + v[j].y * v[j].y) + (v[j].z * v[j].z + v[j].w * v[j].w);
            const float rstd = 1.0f / sqrtf(wave_sum(s) * (1.0f / D) + EPS);
            float* o = F.out + O_YP + (size_t)rr[q] * D + 8 * lane;
            *(f32x4*)o = v[0] * rstd * g4[0]; *(f32x4*)(o + 4) = v[1] * rstd * g4[1]; *(f32x4*)(o + 512) = v[2] * rstd * g4[2]; *(f32x4*)(o + 516) = v[3] * rstd * g4[3]; }
      } }
    { const f32x4* gv = (const f32x4*)F.final_g + F.lane; f32x4 g4[4];
#pragma unroll
      for (int j = 0; j < 4; ++j) g4[j] = gv[64 * j];
      for (int i = gw; i < NSAMP; i += NGW) { const int r = R_SAMP + i;
        const f32x4* hv = (const f32x4*)(F.H2 + (size_t)r * D) + F.lane; f32x4 v[4];
#pragma unroll
        for (int j = 0; j < 4; ++j) v[j] = hv[64 * j];
        float s = 0.f;
#pragma unroll
        for (int j = 0; j < 4; ++j) s += (v[j].x * v[j].x + v[j].y * v[j].y) + (v[j].z * v[j].z + v[j].w * v[j].w);
        const float rstd = 1.0f / sqrtf(wave_sum(s) * (1.0f / D) + EPS);
        float* o = F.out + O_YS + (size_t)i * D;
#pragma unroll
        for (int j = 0; j < 4; ++j) *((f32x4*)o + F.lane + 64 * j) = v[j] * rstd * g4[j]; } }
}

struct Args { const void* in[23]; float* out; unsigned char* ws; int ph_lo, ph_hi, li, pad; };
__global__ void __launch_bounds__(NWAVES * 64, 2) mk_fwd(Args args) {
    extern __shared__ __attribute__((aligned(16))) unsigned char lds[];
    Frame F;
    F.lds = (LAS unsigned char*)lds;
    F.MISC = (volatile LAS unsigned*)(F.lds + MISC_OFF);
    F.tid = threadIdx.x; F.lane = F.tid & 63; F.wave = __builtin_amdgcn_readfirstlane(F.tid >> 6);
    F.G = gridDim.x; F.vcu = blockIdx.x;
    unsigned char* ws = args.ws;
    F.ctl = (gu32*)(ws + WS_CTL);
    F.x_prompt = (const float*)args.in[0]; F.x_sample = (const float*)args.in[1]; F.cache_latent = (const float*)args.in[2]; F.cache_krope = (const float*)args.in[3];
    F.state_conv = (const float*)args.in[4]; F.state_ssm = (const float*)args.in[5]; F.page_table = (const int*)args.in[6]; F.meta = (const float*)args.in[7];
    F.norm_mix_g = (const float*)args.in[8]; F.w_in = (const float*)args.in[9]; F.conv_w = (const float*)args.in[10]; F.a_log = (const float*)args.in[11]; F.dt_bias = (const float*)args.in[12];
    F.gdn_norm_g = (const float*)args.in[13]; F.q_norm_g = (const float*)args.in[14]; F.w_q_b = (const float*)args.in[15]; F.kv_norm_g = (const float*)args.in[16]; F.w_kv_b = (const float*)args.in[17];
    F.w_out = (const float*)args.in[18]; F.norm_mlp_g = (const float*)args.in[19]; F.w_up = (const float*)args.in[20]; F.w_down = (const float*)args.in[21]; F.final_g = (const float*)args.in[22];
    F.out = args.out;
    F.WIN = (bf16*)(ws + WS_WIN); F.WQB = (bf16*)(ws + WS_WQB); F.WKVB = (bf16*)(ws + WS_WKVB); F.WOUT = (bf16*)(ws + WS_WOUT); F.WUP = (bf16*)(ws + WS_WUP); F.WDN = (bf16*)(ws + WS_WDN);
    F.XN = (bf16*)(ws + WS_XN); F.PRJ = (bf16*)(ws + WS_PRJ); F.CQN = (bf16*)(ws + WS_CQN); F.LATN = (bf16*)(ws + WS_LATN); F.QM = (bf16*)(ws + WS_QM); F.KV = (bf16*)(ws + WS_KV);
    F.MIX = (bf16*)(ws + WS_MIX); F.H1B = (bf16*)(ws + WS_H1B); F.HFF = (bf16*)(ws + WS_HFF); F.KPEB = (bf16*)(ws + WS_KPEB); F.ROPE = (float*)(ws + WS_ROPE); F.QLAT = (float*)(ws + WS_QLAT); F.EGL = (float*)(ws + WS_EGL); F.S1 = (float*)(ws + WS_S1); F.GCH = ws + WS_GCH;
    F.KPE = (float*)(ws + WS_KPE); F.GQKV = (bf16*)(ws + WS_GQKV); F.GB = (float*)(ws + WS_GB); F.GO = (float*)(ws + WS_GO); F.H2B = (bf16*)(ws + WS_H2B); F.H2 = (float*)(ws + WS_H2);
    F.PART = (float*)(ws + WS_PART); F.PSTAT = (float*)(ws + WS_PSTAT); F.SS1 = (float*)(ws + WS_CTL) + CW_SS1;
    for (int u = F.tid; u < (LDS_BYTES - LDSCTL_OFF) / 4; u += NWAVES * 64) ((LAS unsigned*)(F.lds + LDSCTL_OFF))[u] = 0u;
    __syncthreads();
    XcdBarrier bar; bar.bar = (unsigned*)(F.ctl + CW_BAR); bar.x = 0; bar.st = nullptr;
    if (N_LAUNCHES == 1) bar = xcd_barrier_post((unsigned*)(F.ctl + CW_BAR), F.MISC + 8);
#define GRID_BAR() do { if (N_LAUNCHES == 1) xcd_barrier(bar); } while (0)
    const int lo = args.ph_lo, hi = args.ph_hi;
#define IN(k) (lo <= (k) && (k) < hi)
#define BOTH(k) (IN(k) && IN((k) + 1))

    if (IN(0)) { p0_prologue(F); VM_WAIT(); __syncthreads(); if (BOTH(0)) GRID_BAR(); }
    if (IN(1)) {
        pg8::Gemm g{F.XN, F.WIN, MT, NPRJ, D, D}; pg8::StaticOrder S; S.init(MT, NPRJ, F.G, (int)blockIdx.x);
        pg8::EpiStoreBf16 E{F.PRJ, NPRJ};
        pg8::gemm_phase<pg8::EpiStoreBf16, pg8::StaticOrder, true, true>(F.lds + RING_OFF, g, S, E);
        if (BOTH(1)) GRID_BAR();
    }
    if (IN(2)) {
        const int gw = F.vcu * NWAVES + F.wave, NGW = F.G * NWAVES;
        { int lane_ = F.lane; asm volatile("" : "+v"(lane_)); P2Consts W; p2_consts(F, W, lane_);
          const int rot = (NGW == SEQ) ? 40 : 0;
#pragma clang loop unroll(disable)
          for (int k = 0; ; ++k) { int r = gw + k * NGW; if (r >= MT) break;
              if (r < R_META) r = (r & ~(SEQ - 1)) | ((r + rot * k) & (SEQ - 1));
              const int s2 = r & (SEQ - 1); if (r < R_META && s2 >= 3 && s2 < SEQ - 3) p2_row_fast(F, r, W, lane_); else p2_row(F, r); } }
        VM_WAIT(); __syncthreads();
        if (BOTH(2)) GRID_BAR();
    }
    if (IN(3)) {
        { pg8::Gemm g{F.CQN, F.WQB, MT, 768, QLORA, QLORA}; pg8::StaticOrder S; S.init(MT, 768, F.G, (int)blockIdx.x);
          pg8::EpiQ E{F.QM, F.ROPE, MLA_SCALE * 1.4426950408889634f};
          pg8::gemm_phase<pg8::EpiQ, pg8::StaticOrder, true, true>(F.lds + RING_OFF, g, S, E); }
        { pg8::Gemm g{F.LATN, F.WKVB, MT, 1024, KVLORA, KVLORA}; pg8::StaticOrder S; S.init(MT, 1024, F.G, ((int)blockIdx.x + 8) % (int)gridDim.x);
          pg8::EpiStoreBf16 E{F.KV, 1024};
          pg8::gemm_phase<pg8::EpiStoreBf16, pg8::StaticOrder, true, true>(F.lds + RING_OFF, g, S, E); }
        gdn::g1_phase(F); VM_WAIT(); __syncthreads();
        if (BOTH(3)) GRID_BAR();
    }
    if (IN(4)) { p4_mixers(F); VM_WAIT(); __syncthreads(); if (BOTH(4)) GRID_BAR(); }
    if (IN(5)) { p5_post(F); VM_WAIT(); __syncthreads(); if (BOTH(5)) GRID_BAR(); }
    const bool split_tail = (F.G == 256);
    if (IN(6)) {
        const int Mrows = split_tail ? NREAL : MT;
        pg8::Gemm g{F.MIX, F.WOUT, Mrows, D, 1024, 1024}; pg8::StaticOrder S; S.init(Mrows, D, F.G, (int)blockIdx.x);
        pg8::EpiResid1 E{F.x_prompt, F.meta, F.x_sample, F.H1B, F.SS1, F.H2};
        pg8::gemm_phase<pg8::EpiResid1, pg8::StaticOrder, true, true>(F.lds + RING_OFF, g, S, E);
        if (BOTH(6)) GRID_BAR();
    }
    if (IN(7)) {
        gu32* cnt6 = F.ctl + CW_CNT6;
        if (split_tail && blockIdx.x < 4) {
            pg8::Gemm g{F.MIX, F.WOUT, MT, D, 1024, 1024}; pg8::OneUnit S{64, (int)blockIdx.x};
            pg8::EpiResid1 E{F.x_prompt, F.meta, F.x_sample, F.H1B, F.SS1, F.H2};
            pg8::gemm_phase<pg8::EpiResid1, pg8::OneUnit, true, true>(F.lds + RING_OFF, g, S, E);
            VM_WAIT(); __syncthreads();
            if (F.tid == 0) { __builtin_amdgcn_fence(__ATOMIC_RELEASE, "agent"); asm volatile("s_waitcnt vmcnt(0)" ::: "memory"); __hip_atomic_fetch_add(cnt6, 1u, RLX_AGENT); }
        }
        { const int Mrows = split_tail ? NREAL : MT;
          pg8::Gemm g{F.H1B, F.WUP, Mrows, FF, D, D}; pg8::StaticOrder S; S.init(Mrows, FF, F.G, (int)blockIdx.x);
          pg8::EpiUp E{F.HFF, FF, F.SS1};
          pg8::gemm_phase<pg8::EpiUp, pg8::StaticOrder, true, true>(F.lds + RING_OFF, g, S, E); }
        if (split_tail && blockIdx.x >= 240) {
            if (F.tid == 0) { unsigned sp = 0; while (__hip_atomic_load(cnt6, RLX_AGENT) < 4u) { __builtin_amdgcn_s_sleep(2); if (++sp > (1u << 22)) break; }
                __builtin_amdgcn_fence(__ATOMIC_ACQUIRE, "agent"); asm volatile("s_waitcnt vmcnt(0)" ::: "memory"); }
            __syncthreads();
            pg8::Gemm g{F.H1B + (size_t)NREAL * D, F.WUP, 256, FF, D, D}; pg8::OneUnit S{0, (int)blockIdx.x - 240};
            pg8::EpiUp E{F.HFF + (size_t)NREAL * FF, FF, F.SS1 + NREAL};
            pg8::gemm_phase<pg8::EpiUp, pg8::OneUnit, true, true>(F.lds + RING_OFF, g, S, E);
        }
        if (BOTH(7)) GRID_BAR();
    }
    if (IN(8)) {
        { pg8::Gemm g{F.HFF, F.WDN, NREAL, D, FF, FF}; pg8::StaticOrder S; S.init(NREAL, D, F.G, (int)blockIdx.x);
          pg8::EpiResid2 E{F.H1B, F.H2B};
          pg8::gemm_phase<pg8::EpiResid2, pg8::StaticOrder, true, true>(F.lds + RING_OFF, g, S, E); }
        { pg8::Gemm g{F.HFF + (size_t)NREAL * FF, F.WDN, 256, D, 256, FF}; pg8::SplitKOrder S; S.init(D, 16, 256, F.G, (int)blockIdx.x);
          pg8::EpiAtomicAdd E{F.H2 + (size_t)NREAL * D};
          pg8::gemm_phase<pg8::EpiAtomicAdd, pg8::SplitKOrder, true, true>(F.lds + RING_OFF, g, S, E); }
        if (BOTH(8)) GRID_BAR();
    }
    if (IN(9)) { p9_final(F); }
#undef IN
#undef BOTH
}

extern "C" void kernel_launch(void* const* d_in, const int* in_sizes, int n_in, void* d_out, int out_size, void* d_ws, size_t ws_size, hipStream_t stream) {
    static int grid = 0;
    if (grid == 0) {
        if (n_in != 23 || out_size != (int)O_END || ws_size < WS_END) { fprintf(stderr, "kernel_launch: unexpected shapes: n_in %d out %d ws %zu (need %zu); nothing launched\n", n_in, out_size, ws_size, (size_t)WS_END); grid = -1; return; }
        int dev = 0, cus = 0, per_cu = 0;
        if (hipGetDevice(&dev) != hipSuccess || hipDeviceGetAttribute(&cus, hipDeviceAttributeMultiprocessorCount, dev) != hipSuccess) { fprintf(stderr, "kernel_launch: device query failed\n"); grid = -1; return; }
        if (hipFuncSetAttribute((const void*)mk_fwd, hipFuncAttributeMaxDynamicSharedMemorySize, LDS_BYTES) != hipSuccess) { fprintf(stderr, "kernel_launch: hipFuncSetAttribute failed\n"); grid = -1; return; }
        if (hipOccupancyMaxActiveBlocksPerMultiprocessor(&per_cu, (const void*)mk_fwd, NWAVES * 64, LDS_BYTES) != hipSuccess || per_cu < 1) { fprintf(stderr, "kernel_launch: occupancy query says %d blocks per CU\n", per_cu); per_cu = 1; }
        (void)hipGetLastError();
        grid = cus;
        fprintf(stderr, "kernel_launch: grid %d (cus %d, per_cu %d)\n", grid, cus, per_cu);
    }
    if (grid < 0) return;
    if (hipMemsetAsync((char*)d_ws + WS_CTL, 0, CTL_ZERO_BYTES, stream) != hipSuccess) { fprintf(stderr, "kernel_launch: memset failed\n"); return; }
    Args a{};
    for (int i = 0; i < 23; ++i) a.in[i] = d_in[i];
    a.out = (float*)d_out; a.ws = (unsigned char*)d_ws;
    for (int li = 0; li < N_LAUNCHES; ++li) {
        if (N_LAUNCHES == 1) { a.ph_lo = 0; a.ph_hi = NPHASES; } else { a.ph_lo = li * NPHASES / N_LAUNCHES; a.ph_hi = (li + 1) * NPHASES / N_LAUNCHES; }
        a.li = li;
        hipLaunchKernelGGL(mk_fwd, dim3(grid), dim3(NWAVES * 64), LDS_BYTES, stream, a);
        if (N_LAUNCHES == NPHASES && li == DUP_PHASE) hipLaunchKernelGGL(mk_fwd, dim3(grid), dim3(NWAVES * 64), LDS_BYTES, stream, a);
        const hipError_t le = hipPeekAtLastError();
        if (le != hipSuccess) { fprintf(stderr, "kernel_launch: launch %d failed: %s\n", li, hipGetErrorName(le)); break; }
    }
}
```

```cpp
#include <hip/hip_runtime.h>
#include <cstdio>
#include <cstdint>
#include <cmath>
namespace pg8 {
#define PG8_LAS __attribute__((address_space(3)))
typedef unsigned short bf16_t;
typedef short bf16x8 __attribute__((ext_vector_type(8)));
typedef float f32x4 __attribute__((ext_vector_type(4)));
typedef unsigned u32x4 __attribute__((ext_vector_type(4)));
constexpr int BM = 256, BK = 64, HALF = 128, HTB = HALF * BK * 2  , STAGE_BYTES = 8 * HTB, NXCD = 8, WGM = 8;

__host__ __device__ __forceinline__ int lds_byte(int r, int c) { const int st = (r >> 4) * 2 + (c >> 5), rr = r & 15, cc = c & 31, ob = rr * 64 + cc * 2; return st * 1024 + (ob ^ (((ob >> 9) & 1) << 5)); }
__host__ __device__ __forceinline__ void stage_rc(int b, int& R, int& C) { const int st = b / 1024, sb = b % 1024, swz = sb ^ (((sb >> 9) & 1) << 5); R = (st >> 1) * 16 + swz / 64; C = (st & 1) * 32 + (swz % 64) / 2; }
__host__ __device__ __forceinline__ int perm32(int rho) { const int n = rho >> 4, i = rho & 15; return 8 * (i >> 2) + 4 * n + (i & 3); }

struct Unit { int pm, pn, ko; };
struct Gemm { const bf16_t* A; const bf16_t* Bt; int M, N, K, ld; };

struct StaticOrder {
    int nM, nN, nwg, G, c;
    __host__ __device__ void init(int M, int N, int G_, int c_) { nM = M / BM; nN = N / BM; nwg = nM * nN; G = G_; c = c_; }
    __host__ __device__ bool next(int i, Unit& u) const {
        const long L = (long)i * G + c; if (L >= nwg) return false;
        int wgid = (int)L; { const int q = nwg / NXCD, r = nwg % NXCD, xcd = wgid % NXCD, off = wgid / NXCD; wgid = (xcd < r ? xcd * (q + 1) : r * (q + 1) + (xcd - r) * q) + off; }
        const int nig = WGM * nN, gid = wgid / nig, fm = gid * WGM, gsz = (nM - fm) < WGM ? (nM - fm) : WGM;
        u.pm = fm + ((wgid % nig) % gsz); u.pn = (wgid % nig) / gsz; u.ko = 0; return true;
    }
    __device__ __forceinline__ void a_ready(const Unit&) const {}
    __device__ __forceinline__ void done(const Unit&) const {}
};

struct OneUnit {
    int pm, pn;
    __host__ __device__ bool next(int i, Unit& u) const { if (i != 0) return false; u.pm = pm; u.pn = pn; u.ko = 0; return true; }
    __device__ __forceinline__ void a_ready(const Unit&) const {}
    __device__ __forceinline__ void done(const Unit&) const {}
};
struct SplitKOrder {
    int nN, nS, ks, G, c;
    __host__ __device__ void init(int N, int nslices, int kslice, int G_, int c_) { nN = N / BM; nS = nslices; ks = kslice; G = G_; c = c_; }
    __host__ __device__ bool next(int i, Unit& u) const { const long L = (long)i * G + c; if (L >= nN * nS) return false; u.pm = 0; u.pn = (int)(L % nN); u.ko = (int)(L / nN) * ks; return true; }
    __device__ __forceinline__ void a_ready(const Unit&) const {}
    __device__ __forceinline__ void done(const Unit&) const {}
};
__device__ __forceinline__ unsigned cvt_pk_bf16(float lo, float hi) { unsigned r; asm volatile("v_cvt_pk_bf16_f32 %0, %1, %2" : "=v"(r) : "v"(lo), "v"(hi)); return r; }
constexpr int ROWS_REAL = 16384, ROW_META = 16384, ROW_SAMP = 16400, ROW_END = 16528;
__device__ __forceinline__ const float* x_row_ptr(const float* xp, const float* xm, const float* xs, int row) {
    if (row < ROW_META) return xp + (size_t)row * 1024;
    if (row < ROW_SAMP) return xm + (size_t)(row - ROW_META) * 1024;
    if (row < ROW_END) return xs + (size_t)(row - ROW_SAMP) * 1024;
    return nullptr;
}
struct EpiStoreBf16 {
    static constexpr bool PERM = true, AFTER_DRAIN = false;
    bf16_t* O; int ldc;
    __device__ __forceinline__ void operator()(const f32x4 (&acc)[2][2][4][2], const Unit& u, int wr, int wc, int fr, int fq) const {
        asm volatile("" : "+v"(fr), "+v"(fq));
        const int row0 = u.pm * BM + wr * 64 + fr, col0 = u.pn * BM + wc * 32 + 8 * fq;
#pragma unroll
        for (int ai = 0; ai < 2; ++ai)
#pragma unroll
            for (int m = 0; m < 4; ++m) { bf16_t* rowp = O + (size_t)(row0 + ai * HALF + m * 16) * ldc + col0;
#pragma unroll
                for (int bj = 0; bj < 2; ++bj) { const f32x4 v0 = acc[ai][bj][m][0], v1 = acc[ai][bj][m][1];
                    u32x4 w; w.x = cvt_pk_bf16(v0[0], v0[1]); w.y = cvt_pk_bf16(v0[2], v0[3]); w.z = cvt_pk_bf16(v1[0], v1[1]); w.w = cvt_pk_bf16(v1[2], v1[3]);
                    *(u32x4*)(rowp + bj * HALF) = w; } }
    }
};
struct EpiResid1 {
    static constexpr bool PERM = true, AFTER_DRAIN = false;
    const float* xp; const float* xm; const float* xs; bf16_t* H1B; float* ss; float* H2;
    __device__ __forceinline__ void operator()(const f32x4 (&acc)[2][2][4][2], const Unit& u, int wr, int wc, int fr, int fq) const {
        asm volatile("" : "+v"(fr), "+v"(fq));
        const int row0 = u.pm * BM + wr * 64 + fr, col0 = u.pn * BM + wc * 32 + 8 * fq;
#pragma unroll
        for (int ai = 0; ai < 2; ++ai)
#pragma unroll
          for (int mh = 0; mh < 2; ++mh) {
            f32x4 xv[2][2][2]; float fl[2];
#pragma unroll
            for (int mm = 0; mm < 2; ++mm) { const int row = row0 + ai * HALF + (2 * mh + mm) * 16;
                const float* xb = row < ROW_META ? xp : (row < ROW_SAMP ? xm : (row < ROW_END ? xs : xp));
                const int rel = row < ROW_META ? row : (row < ROW_SAMP ? row - ROW_META : (row < ROW_END ? row - ROW_SAMP : 0));
                fl[mm] = row < ROW_END ? 1.f : 0.f; const float* xq = xb + (size_t)rel * 1024;
#pragma unroll
                for (int bj = 0; bj < 2; ++bj) { const int col = col0 + bj * HALF; xv[mm][bj][0] = *(const f32x4*)(xq + col); xv[mm][bj][1] = *(const f32x4*)(xq + col + 4); } }
#pragma unroll
            for (int mm = 0; mm < 2; ++mm) { const int m = 2 * mh + mm; const int row = row0 + ai * HALF + m * 16; float part = 0.f;
#pragma unroll
                for (int bj = 0; bj < 2; ++bj) { const int col = col0 + bj * HALF;
                    const f32x4 v0 = acc[ai][bj][m][0] + xv[mm][bj][0] * fl[mm], v1 = acc[ai][bj][m][1] + xv[mm][bj][1] * fl[mm];
                    u32x4 w; w.x = cvt_pk_bf16(v0[0], v0[1]); w.y = cvt_pk_bf16(v0[2], v0[3]); w.z = cvt_pk_bf16(v1[0], v1[1]); w.w = cvt_pk_bf16(v1[2], v1[3]);
                    *(u32x4*)(H1B + (size_t)row * 1024 + col) = w;
                    if (u.pm == 64) { *(f32x4*)(H2 + (size_t)row * 1024 + col) = v0; *(f32x4*)(H2 + (size_t)row * 1024 + col + 4) = v1; }
                    part += (v0[0] * v0[0] + v0[1] * v0[1]) + (v0[2] * v0[2] + v0[3] * v0[3]) + (v1[0] * v1[0] + v1[1] * v1[1]) + (v1[2] * v1[2] + v1[3] * v1[3]); }
                part += __shfl_xor(part, 16); part += __shfl_xor(part, 32);
                if (fq == 0 && ss) __hip_atomic_fetch_add(ss + row, part, __ATOMIC_RELAXED, __HIP_MEMORY_SCOPE_AGENT); } }
    }
};
struct EpiUp {
    static constexpr bool PERM = true, AFTER_DRAIN = false;
    bf16_t* O; int ldc; const float* ss;
    __device__ __forceinline__ void operator()(const f32x4 (&acc)[2][2][4][2], const Unit& u, int wr, int wc, int fr, int fq) const {
        asm volatile("" : "+v"(fr), "+v"(fq));
        const int row0 = u.pm * BM + wr * 64 + fr, col0 = u.pn * BM + wc * 32 + 8 * fq;
        float ssv[2][4];
#pragma unroll
        for (int ai = 0; ai < 2; ++ai)
#pragma unroll
            for (int m = 0; m < 4; ++m) ssv[ai][m] = ss[row0 + ai * HALF + m * 16];
#pragma unroll
        for (int ai = 0; ai < 2; ++ai)
#pragma unroll
            for (int m = 0; m < 4; ++m) { const int row = row0 + ai * HALF + m * 16; bf16_t* rowp = O + (size_t)row * ldc + col0;
                const float rs = 1.0f / sqrtf(ssv[ai][m] * (1.0f / 1024.0f) + 1e-6f);
#pragma unroll
                for (int bj = 0; bj < 2; ++bj) { f32x4 v0 = acc[ai][bj][m][0] * rs, v1 = acc[ai][bj][m][1] * rs;
#pragma unroll
                    for (int e = 0; e < 4; ++e) { const float a = fmaxf(v0[e], 0.f), b = fmaxf(v1[e], 0.f); v0[e] = a * a; v1[e] = b * b; }
                    u32x4 w; w.x = cvt_pk_bf16(v0[0], v0[1]); w.y = cvt_pk_bf16(v0[2], v0[3]); w.z = cvt_pk_bf16(v1[0], v1[1]); w.w = cvt_pk_bf16(v1[2], v1[3]);
                    *(u32x4*)(rowp + bj * HALF) = w; } }
    }
};
struct EpiResid2 {
    static constexpr bool PERM = true, AFTER_DRAIN = false;
    const bf16_t* H1B; bf16_t* H2B;
    __device__ __forceinline__ void operator()(const f32x4 (&acc)[2][2][4][2], const Unit& u, int wr, int wc, int fr, int fq) const {
        asm volatile("" : "+v"(fr), "+v"(fq));
        const int row0 = u.pm * BM + wr * 64 + fr, col0 = u.pn * BM + wc * 32 + 8 * fq;
#pragma unroll
        for (int ai = 0; ai < 2; ++ai) {
            u32x4 hv[4][2];
#pragma unroll
            for (int m = 0; m < 4; ++m)
#pragma unroll
                for (int bj = 0; bj < 2; ++bj) hv[m][bj] = *(const u32x4*)(H1B + (size_t)(row0 + ai * HALF + m * 16) * 1024 + col0 + bj * HALF);
#pragma unroll
            for (int m = 0; m < 4; ++m) { const int row = row0 + ai * HALF + m * 16;
#pragma unroll
                for (int bj = 0; bj < 2; ++bj) { const size_t off = (size_t)row * 1024 + col0 + bj * HALF;
                    const u32x4 hb = hv[m][bj];
                    const f32x4 h0 = (f32x4){__uint_as_float(hb.x << 16), __uint_as_float(hb.x & 0xffff0000u), __uint_as_float(hb.y << 16), __uint_as_float(hb.y & 0xffff0000u)};
                    const f32x4 h1 = (f32x4){__uint_as_float(hb.z << 16), __uint_as_float(hb.z & 0xffff0000u), __uint_as_float(hb.w << 16), __uint_as_float(hb.w & 0xffff0000u)};
                    const f32x4 v0 = acc[ai][bj][m][0] + h0, v1 = acc[ai][bj][m][1] + h1;
                    u32x4 w; w.x = cvt_pk_bf16(v0[0], v0[1]); w.y = cvt_pk_bf16(v0[2], v0[3]); w.z = cvt_pk_bf16(v1[0], v1[1]); w.w = cvt_pk_bf16(v1[2], v1[3]);
                    *(u32x4*)(H2B + off) = w; } } }
    }
};
struct EpiAtomicAdd {
    static constexpr bool PERM = true, AFTER_DRAIN = false;
    float* H2;
    __device__ __forceinline__ void operator()(const f32x4 (&acc)[2][2][4][2], const Unit& u, int wr, int wc, int fr, int fq) const {
        asm volatile("" : "+v"(fr), "+v"(fq));
        const int row0 = wr * 64 + fr, col0 = u.pn * BM + wc * 32 + 8 * fq;
#pragma unroll
        for (int ai = 0; ai < 2; ++ai)
#pragma unroll
            for (int m = 0; m < 4; ++m) { const int row = row0 + ai * HALF + m * 16;
                if (row >= 16 && row < 144) {
#pragma unroll
                    for (int bj = 0; bj < 2; ++bj) { float* p = H2 + (size_t)row * 1024 + col0 + bj * HALF;
#pragma unroll
                        for (int e = 0; e < 4; ++e) { __hip_atomic_fetch_add(p + e, acc[ai][bj][m][0][e], __ATOMIC_RELAXED, __HIP_MEMORY_SCOPE_AGENT); __hip_atomic_fetch_add(p + 4 + e, acc[ai][bj][m][1][e], __ATOMIC_RELAXED, __HIP_MEMORY_SCOPE_AGENT); } } } }
    }
};
struct EpiQ {
    static constexpr bool PERM = true, AFTER_DRAIN = false;
    bf16_t* O; const float* rope; float c2;
    __device__ __forceinline__ void operator()(const f32x4 (&acc)[2][2][4][2], const Unit& u, int wr, int wc, int fr, int fq) const {
        asm volatile("" : "+v"(fr), "+v"(fq));
        const int row0 = u.pm * BM + wr * 64 + fr, col0 = u.pn * BM + wc * 32 + 8 * fq;
        const bool dorope = (u.pn == 2);
#pragma unroll
        for (int ai = 0; ai < 2; ++ai) {
            f32x4 cs[4][4];
            if (dorope) {
#pragma unroll
                for (int m = 0; m < 4; ++m) { const int row = row0 + ai * HALF + m * 16;
                    const int pi = row < ROW_META ? 16 + (row & 2047) : (row < ROW_SAMP ? row - ROW_META : (row < ROW_END ? 2064 + ((row - ROW_SAMP) & 3) : 0));
                    const float* tb = rope + (size_t)pi * 32 + ((8 * fq) & 15);
                    cs[m][0] = *(const f32x4*)(tb); cs[m][1] = *(const f32x4*)(tb + 16); cs[m][2] = *(const f32x4*)(tb + 4); cs[m][3] = *(const f32x4*)(tb + 20); } }
#pragma unroll
            for (int m = 0; m < 4; ++m) { const int row = row0 + ai * HALF + m * 16; bf16_t* rowp = O + (size_t)row * 768 + col0;
#pragma unroll
                for (int bj = 0; bj < 2; ++bj) { f32x4 v0 = acc[ai][bj][m][0] * c2, v1 = acc[ai][bj][m][1] * c2;
                    if (dorope) { const f32x4 c0 = cs[m][0], s0 = cs[m][1], c1 = cs[m][2], s1 = cs[m][3];
                        f32x4 p0, p1;
#pragma unroll
                        for (int e = 0; e < 4; ++e) { p0[e] = __shfl_xor(v0[e], 32); p1[e] = __shfl_xor(v1[e], 32); }
                        if (fq < 2) { v0 = v0 * c0 - p0 * s0; v1 = v1 * c1 - p1 * s1; } else { v0 = v0 * c0 + p0 * s0; v1 = v1 * c1 + p1 * s1; } }
                    u32x4 w; w.x = cvt_pk_bf16(v0[0], v0[1]); w.y = cvt_pk_bf16(v0[2], v0[3]); w.z = cvt_pk_bf16(v1[0], v1[1]); w.w = cvt_pk_bf16(v1[2], v1[3]);
                    *(u32x4*)(rowp + bj * HALF) = w; } } }
    }
};
template <class Epi, class Sched, bool ALIGN_EPI = false, bool SP2 = false>
__device__ __forceinline__ void gemm_phase(PG8_LAS unsigned char* lds, const Gemm g, const Sched& S, const Epi& E) {
    int tid_ = threadIdx.x; asm volatile("" : "+v"(tid_));
    const int tid = tid_, wid = __builtin_amdgcn_readfirstlane(tid >> 6), lane = tid & 63, wr = wid >> 2, wc = wid & 3, fr = lane & 15, fq = lane >> 4;
    const int K = g.ld, nt = g.K / BK;
    unsigned voffA[2], voffB[2];
#pragma unroll
    for (int i = 0; i < 2; ++i) { int R, C; stage_rc(tid * 16 + i * 8192, R, C); const int Rb = Epi::PERM ? ((R & ~31) + perm32(R & 31)) : R;
        voffA[i] = (unsigned)(R * K + C) * 2u; voffB[i] = (unsigned)(Rb * K + C) * 2u; }
    const size_t kstep = (size_t)(BK * 2);
    const size_t hstep = (size_t)HALF * K * 2;
    const size_t tstep = 2 * hstep;
    const unsigned ldsw = (unsigned)wid * 1024u;
    const int aoff = lds_byte(wr * 64 + fr, fq * 8), boff = lds_byte(wc * 32 + fr, fq * 8);
#define PG8_SA(b, h) (((b) * 2 + (h)) * HTB)
#define PG8_SB(b, h) ((4 + (b) * 2 + (h)) * HTB)
#define PG8_STAGE(bufoff, gbase, voff) do { _Pragma("unroll") for (int _i = 0; _i < 2; ++_i) \
        __builtin_amdgcn_global_load_lds((const unsigned*)((const char*)(gbase) + (voff)[_i]), (PG8_LAS unsigned*)(lds + (bufoff) + ldsw + _i * 8192), 16, 0, 0); } while (0)
#define PG8_LDA(dst, b, h) do { _Pragma("unroll") for (int m = 0; m < 4; ++m) _Pragma("unroll") for (int k = 0; k < 2; ++k) dst[m][k] = *(const PG8_LAS bf16x8*)(lds + PG8_SA(b, h) + aoff + m * 2048 + k * 1024); } while (0)
#define PG8_LDB(dst, b, h) do { _Pragma("unroll") for (int n = 0; n < 2; ++n) _Pragma("unroll") for (int k = 0; k < 2; ++k) dst[n][k] = *(const PG8_LAS bf16x8*)(lds + PG8_SB(b, h) + boff + n * 2048 + k * 1024); } while (0)
#define PG8_MMA(ai, bj, At, Bt) do { __builtin_amdgcn_s_setprio(1); _Pragma("unroll") for (int m = 0; m < 4; ++m) _Pragma("unroll") for (int n = 0; n < 2; ++n) _Pragma("unroll") for (int k = 0; k < 2; ++k) \
        acc[ai][bj][m][n] = __builtin_amdgcn_mfma_f32_16x16x32_bf16(Bt[n][k], At[m][k], acc[ai][bj][m][n], 0, 0, 0); __builtin_amdgcn_s_setprio(0); } while (0)
#define PG8_WAIT_V(n) asm volatile("s_waitcnt vmcnt(" #n ")" ::: "memory")
#define PG8_WAIT_L(n) asm volatile("s_waitcnt lgkmcnt(" #n ")" ::: "memory")
#define PG8_BAR __builtin_amdgcn_s_barrier()
#define PG8_SCHED __builtin_amdgcn_sched_barrier(0)
    Unit cur, nxt; int ui = 0;
    if (!S.next(0, cur)) return;
    f32x4 acc[2][2][4][2];
#pragma unroll
    for (int a = 0; a < 2; ++a)
#pragma unroll
        for (int b = 0; b < 2; ++b)
#pragma unroll
            for (int m = 0; m < 4; ++m)
#pragma unroll
                for (int n = 0; n < 2; ++n) acc[a][b][m][n] = (f32x4){0.f, 0.f, 0.f, 0.f};
    bf16x8 At[4][2], B0[2][2], B1[2][2];
    const char* cA = (const char*)g.A + (size_t)cur.pm * tstep + (size_t)cur.ko * 2; const char* cB = (const char*)g.Bt + (size_t)cur.pn * tstep + (size_t)cur.ko * 2;
    S.a_ready(cur);
    if constexpr (SP2) {
        PG8_STAGE(PG8_SB(0, 0), cB, voffB); PG8_STAGE(PG8_SB(0, 1), cB + hstep, voffB); PG8_STAGE(PG8_SA(0, 0), cA, voffA); PG8_STAGE(PG8_SA(0, 1), cA + hstep, voffA);
        if (wr == 1) PG8_BAR;
        PG8_WAIT_V(2); PG8_BAR;
        PG8_STAGE(PG8_SB(1, 0), cB + kstep, voffB); PG8_STAGE(PG8_SA(1, 0), cA + kstep, voffA); PG8_STAGE(PG8_SB(1, 1), cB + hstep + kstep, voffB);
        PG8_WAIT_V(6); PG8_BAR;
    } else {
        PG8_STAGE(PG8_SB(0, 0), cB, voffB); PG8_STAGE(PG8_SA(0, 0), cA, voffA); PG8_STAGE(PG8_SB(0, 1), cB + hstep, voffB); PG8_STAGE(PG8_SA(0, 1), cA + hstep, voffA);
        if (wr == 1) PG8_BAR;
        PG8_WAIT_V(4); PG8_BAR;
        PG8_STAGE(PG8_SB(1, 0), cB + kstep, voffB); PG8_STAGE(PG8_SA(1, 0), cA + kstep, voffA); PG8_STAGE(PG8_SB(1, 1), cB + hstep + kstep, voffB);
        PG8_WAIT_V(6); PG8_BAR;
    }
    for (;;) {
        const bool has_next = S.next(ui + 1, nxt);
        const char* nA = has_next ? (const char*)g.A + (size_t)nxt.pm * tstep + (size_t)nxt.ko * 2 : cA; const char* nB = has_next ? (const char*)g.Bt + (size_t)nxt.pn * tstep + (size_t)nxt.ko * 2 : cB;
        asm volatile(".p2align 8" ::: "memory");
#pragma clang loop unroll(disable)
        for (int t = 0; t < nt; t += 2) {
            const bool last = (t == nt - 2);
            const char* a1 = cA + (size_t)(t + 1) * kstep;
            const char* a2 = last ? nA : cA + (size_t)(t + 2) * kstep; const char* b2 = last ? nB : cB + (size_t)(t + 2) * kstep;
            const char* a3 = a2 + kstep; const char* b3 = b2 + kstep;
            if (last && has_next) S.a_ready(nxt);
            if constexpr (SP2) {
            PG8_LDB(B0, 0, 0); PG8_LDB(B1, 0, 1); PG8_SCHED; PG8_LDA(At, 0, 0); PG8_STAGE(PG8_SA(1, 1), a1 + hstep, voffA);
            PG8_WAIT_V(8); PG8_WAIT_L(0); PG8_BAR; PG8_MMA(0, 0, At, B0); PG8_MMA(0, 1, At, B1); PG8_BAR; PG8_SCHED;
            PG8_LDA(At, 0, 1); PG8_STAGE(PG8_SB(0, 0), b2, voffB); PG8_STAGE(PG8_SB(0, 1), b2 + hstep, voffB); PG8_STAGE(PG8_SA(0, 0), a2, voffA);
            PG8_WAIT_V(8); PG8_WAIT_L(0); PG8_BAR; PG8_MMA(1, 0, At, B0); PG8_MMA(1, 1, At, B1); PG8_BAR; PG8_SCHED;
            PG8_LDB(B0, 1, 0); PG8_LDB(B1, 1, 1); PG8_SCHED; PG8_LDA(At, 1, 0); PG8_STAGE(PG8_SA(0, 1), a2 + hstep, voffA);
            PG8_WAIT_V(8); PG8_WAIT_L(0); PG8_BAR; PG8_MMA(0, 0, At, B0); PG8_MMA(0, 1, At, B1); PG8_BAR; PG8_SCHED;
            PG8_LDA(At, 1, 1); PG8_STAGE(PG8_SB(1, 0), b3, voffB); PG8_STAGE(PG8_SB(1, 1), b3 + hstep, voffB); PG8_STAGE(PG8_SA(1, 0), a3, voffA);
            PG8_WAIT_V(8); PG8_WAIT_L(0); PG8_BAR; PG8_MMA(1, 0, At, B0); PG8_MMA(1, 1, At, B1); PG8_BAR; PG8_SCHED;
            } else {
            PG8_LDB(B0, 0, 0); PG8_SCHED; PG8_LDA(At, 0, 0); PG8_STAGE(PG8_SA(1, 1), a1 + hstep, voffA);
            PG8_WAIT_L(8); PG8_BAR; PG8_WAIT_L(0); PG8_MMA(0, 0, At, B0); PG8_BAR; PG8_SCHED;
            PG8_LDB(B1, 0, 1); PG8_STAGE(PG8_SB(0, 0), b2, voffB);
            PG8_BAR; PG8_WAIT_L(0); PG8_MMA(0, 1, At, B1); PG8_BAR;
            PG8_LDA(At, 0, 1); PG8_STAGE(PG8_SA(0, 0), a2, voffA);
            PG8_BAR; PG8_WAIT_L(0); PG8_MMA(1, 0, At, B0); PG8_BAR; PG8_SCHED;
            PG8_STAGE(PG8_SB(0, 1), b2 + hstep, voffB);
            PG8_WAIT_V(6); PG8_BAR; PG8_MMA(1, 1, At, B1); PG8_BAR;
            PG8_LDB(B0, 1, 0); PG8_SCHED; PG8_LDA(At, 1, 0); PG8_STAGE(PG8_SA(0, 1), a2 + hstep, voffA);
            PG8_WAIT_L(8); PG8_BAR; PG8_WAIT_L(0); PG8_MMA(0, 0, At, B0); PG8_BAR; PG8_SCHED;
            PG8_LDB(B1, 1, 1); PG8_STAGE(PG8_SB(1, 0), b3, voffB);
            PG8_BAR; PG8_WAIT_L(0); PG8_MMA(0, 1, At, B1); PG8_BAR;
            PG8_LDA(At, 1, 1); PG8_STAGE(PG8_SA(1, 0), a3, voffA);
            PG8_BAR; PG8_WAIT_L(0); PG8_MMA(1, 0, At, B0); PG8_BAR; PG8_SCHED;
            PG8_STAGE(PG8_SB(1, 1), b3 + hstep, voffB);
            PG8_WAIT_V(6); PG8_BAR; PG8_MMA(1, 1, At, B1); PG8_BAR;
            }
        }
        if constexpr (ALIGN_EPI) { if (wr == 0) PG8_BAR; }
        if constexpr (!Epi::AFTER_DRAIN) { E(acc, cur, wr, wc, fr, fq); S.done(cur); }
        if (!has_next) break;
#pragma unroll
        for (int a = 0; a < 2; ++a)
#pragma unroll
            for (int b = 0; b < 2; ++b)
#pragma unroll
                for (int m = 0; m < 4; ++m)
#pragma unroll
                    for (int n = 0; n < 2; ++n) acc[a][b][m][n] = (f32x4){0.f, 0.f, 0.f, 0.f};
        cur = nxt; cA = nA; cB = nB; ++ui;
        if constexpr (ALIGN_EPI) { if (wr == 1) PG8_BAR; }
    }
    PG8_WAIT_V(0);
    if constexpr (!ALIGN_EPI) { if (wr == 0) PG8_BAR; }
    PG8_BAR;
    if constexpr (Epi::AFTER_DRAIN) { E.fused(acc, cur, wr, wc, fr, fq, lds, wid, lane); S.done(cur); }
#undef PG8_SA
#undef PG8_SB
#undef PG8_STAGE
#undef PG8_LDA
#undef PG8_LDB
#undef PG8_MMA
#undef PG8_WAIT_V
#undef PG8_WAIT_L
#undef PG8_BAR
#undef PG8_SCHED
}
}
constexpr int NWAVES = 8;
constexpr int NPHASES = 10;
#ifndef MK_N_LAUNCHES
#define MK_N_LAUNCHES 1
#endif
#ifndef DUP_PHASE
#define DUP_PHASE -1
#endif
#ifndef DUP_SUB
#define DUP_SUB 0
#endif
constexpr int N_LAUNCHES = MK_N_LAUNCHES;

constexpr int D = 1024, NB = 8, SEQ = 2048, NREAL = NB * SEQ, NMETA = 16, NSB = 32, NST = 4, NSAMP = NSB * NST;
constexpr int R_META = NREAL, R_SAMP = NREAL + NMETA, R_END = R_SAMP + NSAMP, MT = 16640;
constexpr int TP = NMETA + SEQ;
constexpr int NPRJ = 2816;
constexpr int C_QKV = 0, C_Z = 1536, C_CQ = 2048, C_CKV = 2432, C_KPE = 2688, C_B = 2720, C_A = 2728, C_PAD = 2736;
constexpr int IN_COLS = 2736, FF = 4096, QLORA = 384, KVLORA = 256, NH = 8;
constexpr int PAST = 16384, PAGE = 128, NPAGES = 128;
constexpr float EPS = 1e-6f;
constexpr float MLA_SCALE = 0.10206207261596577f;
constexpr size_t O_YP = 0, O_YS = 16777216, O_LATP = 16908288, O_KRP = 21135360, O_CONVP = 21663744, O_SSMP = 21700608,
                 O_LATS = 21962752, O_KRS = 21995520, O_CONVS = 21999616, O_SSMS = 22147072, O_END = 23195648;
constexpr int NSPLIT = 32, SPLIT_KEYS = PAST / NSPLIT  , NSPLITX = NSPLIT + 1;

constexpr size_t MiB = 1u << 20;
constexpr size_t al(size_t x) { return (x + MiB - 1) / MiB * MiB; }
constexpr size_t WS_CTL = 0, CTL_ZERO_BYTES = 100 * 1024;
constexpr size_t WS_WIN = 1 * MiB;
constexpr size_t WS_WQB = WS_WIN + al((size_t)NPRJ * D * 2);
constexpr size_t WS_WKVB = WS_WQB + al((size_t)768 * 384 * 2);
constexpr size_t WS_WOUT = WS_WKVB + al((size_t)1024 * 256 * 2);
constexpr size_t WS_WUP = WS_WOUT + al((size_t)1024 * 1024 * 2);
constexpr size_t WS_WDN = WS_WUP + al((size_t)4096 * 1024 * 2);
constexpr size_t WS_XN = WS_WDN + al((size_t)4096 * 1024 * 2);
constexpr size_t WS_PRJ = WS_XN + al((size_t)MT * D * 2);
constexpr size_t WS_CQN = WS_PRJ + al((size_t)MT * NPRJ * 2);
constexpr size_t WS_LATN = WS_CQN + al((size_t)MT * QLORA * 2);
constexpr size_t WS_KPE = WS_LATN + al((size_t)MT * KVLORA * 2);
constexpr size_t WS_GQKV = WS_KPE + al((size_t)MT * 32 * 4);
constexpr size_t WS_GB = WS_GQKV + al((size_t)MT * 1536 * 4);
constexpr size_t WS_QM = WS_GB + al((size_t)MT * 16 * 4);
constexpr size_t WS_KV = WS_QM + al((size_t)MT * 768 * 2);
constexpr size_t WS_GO = WS_KV + al((size_t)MT * 1024 * 2);
constexpr size_t WS_MIX = WS_GO + al((size_t)MT * 512 * 4);
constexpr size_t WS_H2B = WS_MIX + al((size_t)MT * D * 2);
constexpr size_t WS_H1B = WS_H2B + al((size_t)MT * D * 2);
constexpr size_t WS_HFF = WS_H1B + al((size_t)MT * D * 2);
constexpr size_t WS_H2 = WS_HFF + al((size_t)MT * FF * 2);
constexpr size_t WS_PART = WS_H2 + al((size_t)MT * D * 4);
constexpr size_t WS_PSTAT = WS_PART + al((size_t)NSB * NSPLITX * 32 * 256 * 4);
constexpr int NROPE = TP + NST;
constexpr size_t WS_KPEB = WS_PSTAT + al((size_t)NSB * NSPLITX * 32 * 2 * 4);
constexpr size_t WS_ROPE = WS_KPEB + al((size_t)MT * 32 * 2);
constexpr size_t WS_QLAT = WS_ROPE + al((size_t)NROPE * 32 * 4);
constexpr size_t WS_EGL = WS_QLAT + al((size_t)NSB * 32 * 256 * 4);
constexpr size_t WS_S1 = WS_EGL + MiB;
constexpr size_t WS_GCH = WS_S1 + MiB;
constexpr size_t WS_END = WS_GCH + al((size_t)NB * 32 * NH * 40960);
constexpr int CW_TMO = 0, CW_CODE = 1, CW_CNT6 = 64;
constexpr int CW_BAR = 4096;
constexpr int CW_SS1 = 8192;
static_assert((size_t)(CW_SS1 + MT) * 4 <= CTL_ZERO_BYTES && CW_BAR + 3456 <= CW_SS1, "CTL words inside the memset region");

constexpr int RING_OFF = 0, RING_BYTES = 131072;
constexpr int LDSCTL_OFF = RING_BYTES, MISC_OFF = LDSCTL_OFF + 320;
constexpr int LDS_BYTES = 147456;
static_assert(MISC_OFF + 128 <= LDS_BYTES, "LDS map");
#define GAS __attribute__((address_space(1)))
#define LAS __attribute__((address_space(3)))
typedef unsigned short bf16;
typedef unsigned v4u __attribute__((ext_vector_type(4)));
typedef float f32x4 __attribute__((ext_vector_type(4)));
typedef short bf16x8 __attribute__((ext_vector_type(8)));
typedef GAS unsigned gu32;
typedef GAS unsigned long long gu64;
#define RLX_AGENT __ATOMIC_RELAXED, __HIP_MEMORY_SCOPE_AGENT
#define LDS_WAIT() asm volatile("s_waitcnt lgkmcnt(0)" ::: "memory")
#define VM_WAIT() asm volatile("s_waitcnt vmcnt(0)" ::: "memory")
__device__ __forceinline__ unsigned long long rt() { return __builtin_amdgcn_s_memrealtime(); }
__device__ __forceinline__ unsigned f2bf(float f) { unsigned u = __builtin_bit_cast(unsigned, f); return (u + 0x7fffu + ((u >> 16) & 1u)) >> 16; }
__device__ __forceinline__ unsigned pk2(float lo, float hi) { return f2bf(lo) | (f2bf(hi) << 16); }

#define XB_TMO      128
#define XB_XCNT(j)  (256  + 64 * (j))
#define XB_XSUB(j)  (1280 + 64 * (j))
#define XB_XGEN(j)  (2304 + 64 * (j))
#define XB_TOP      3328
#define XB_TOPGEN   3392
#define XCD_BAR_WORDS 3456
#define XB_SPIN_CAP (1u << 18)

__device__ __forceinline__ unsigned xb_ld(unsigned* p)              { return __hip_atomic_load(p, __ATOMIC_RELAXED, __HIP_MEMORY_SCOPE_AGENT); }
__device__ __forceinline__ unsigned xb_add(unsigned* p, unsigned v) { return __hip_atomic_fetch_add(p, v, __ATOMIC_RELAXED, __HIP_MEMORY_SCOPE_AGENT); }
__device__ __forceinline__ unsigned xb_xcc_id() { return (unsigned)__builtin_amdgcn_s_getreg((3 << 11) | 20) & 0xFu; }
#define XB_SPIN(cond, bar) do { unsigned _sp = 0; while (cond) { __builtin_amdgcn_s_sleep(1); \
    if ((++_sp & 255u) == 0u) { if (xb_ld(&(bar)[XB_TMO])) break; if (_sp > XB_SPIN_CAP) { atomicAdd(&(bar)[XB_TMO], 1u); break; } } } } while (0)

struct XcdBarrier {
    unsigned* bar; unsigned x;
    volatile LAS unsigned* st;
};

__device__ __forceinline__ XcdBarrier xcd_barrier_post(unsigned* bar, volatile LAS unsigned* st) {
    XcdBarrier b; b.bar = bar; b.x = xb_xcc_id(); b.st = st;
    if (threadIdx.x == 0) (void)xb_add(&bar[XB_XCNT(b.x)], 1u);
    return b;
}
__device__ __forceinline__ void xcd_barrier_complete(unsigned* bar, unsigned x, unsigned& nloc, unsigned& nx) {
    const unsigned G = gridDim.x * gridDim.y * gridDim.z;
    unsigned sum, cnt, mine, sp = 0u;
    for (;;) {
        sum = 0u; cnt = 0u; mine = 0u;
#pragma unroll
        for (unsigned j = 0; j < 16; ++j) { const unsigned c = xb_ld(&bar[XB_XCNT(j)]); sum += c; cnt += (c > 0u) ? 1u : 0u; mine = (j == x) ? c : mine; }
        if (sum == G) break;
        __builtin_amdgcn_s_sleep(1);
        if ((++sp & 255u) == 0u) { if (xb_ld(&bar[XB_TMO])) break; if (sp > XB_SPIN_CAP) { atomicAdd(&bar[XB_TMO], 1u); break; } }
    }
    nloc = mine > 0u ? mine : 1u; nx = cnt > 0u ? cnt : 1u;
}

__device__ __forceinline__ void xcd_barrier(const XcdBarrier& b) {
    asm volatile("s_waitcnt vmcnt(0)" ::: "memory");
    __syncthreads();
    if (threadIdx.x == 0) {
        unsigned* bar = b.bar;
        __builtin_amdgcn_s_waitcnt(0);
        unsigned nloc = b.st[0], nx = b.st[1];
        if (nloc == 0u) { xcd_barrier_complete(bar, b.x, nloc, nx); b.st[0] = nloc; b.st[1] = nx; }
        const unsigned old = xb_add(&bar[XB_XSUB(b.x)], 1u);
        const unsigned gen = old / nloc;
        if (old + 1u == (gen + 1u) * nloc) {
            __builtin_amdgcn_fence(__ATOMIC_RELEASE, "agent");
            asm volatile("s_waitcnt vmcnt(0)" ::: "memory");
            const unsigned og = xb_add(&bar[XB_TOP], 1u);
            const unsigned tg = og / nx;
            if (og + 1u == (tg + 1u) * nx) xb_add(&bar[XB_TOPGEN], 1u);
            else XB_SPIN(xb_ld(&bar[XB_TOPGEN]) == tg, bar);
            __builtin_amdgcn_fence(__ATOMIC_ACQUIRE, "agent");
            xb_add(&bar[XB_XGEN(b.x)], 1u);
            asm volatile("s_waitcnt vmcnt(0)" ::: "memory");
        } else {
            XB_SPIN(xb_ld(&bar[XB_XGEN(b.x)]) == gen, bar);
            __builtin_amdgcn_fence(__ATOMIC_ACQUIRE, "agent");
            asm volatile("s_waitcnt vmcnt(0)" ::: "memory");
        }
    }
    __syncthreads();
}
struct Frame {
    LAS unsigned char* lds;
    volatile LAS unsigned* MISC;
    gu32* ctl;
    int tid, lane, wave, vcu, G;
    const float *x_prompt, *x_sample, *cache_latent, *cache_krope, *state_conv, *state_ssm; const int* page_table;
    const float *meta, *norm_mix_g, *w_in, *conv_w, *a_log, *dt_bias, *gdn_norm_g, *q_norm_g, *w_q_b, *kv_norm_g, *w_kv_b, *w_out, *norm_mlp_g, *w_up, *w_down, *final_g;
    float* out;
    bf16 *WIN, *WQB, *WKVB, *WOUT, *WUP, *WDN, *XN, *PRJ, *CQN, *LATN, *QM, *KV, *MIX, *H1B, *HFF, *KPEB, *GQKV;
    bf16* H2B;
    float *KPE, *GB, *GO, *H2, *PART, *PSTAT, *SS1, *ROPE, *QLAT, *EGL, *S1; unsigned char* GCH;
};
__device__ __forceinline__ float bf2f(bf16 v) { return __uint_as_float((unsigned)v << 16); }
__device__ __forceinline__ float wave_sum(float v) {
#pragma unroll
    for (int o = 1; o < 64; o <<= 1) v += __shfl_xor(v, o);
    return v;
}
__device__ __forceinline__ float wave_max(float v) {
#pragma unroll
    for (int o = 1; o < 64; o <<= 1) v = fmaxf(v, __shfl_xor(v, o));
    return v;
}
__device__ __forceinline__ float silu_f(float y) { return y / (1.0f + __expf(-y)); }
__device__ __forceinline__ float rdlane(float v, int l) { return __int_as_float(__builtin_amdgcn_readlane(__float_as_int(v), l)); }
__device__ __forceinline__ int row_pos(int r) { return r < R_META ? NMETA + (r & (SEQ - 1)) : (r < R_SAMP ? r - R_META : PAST + ((r - R_SAMP) & (NST - 1))); }

__device__ __forceinline__ float wsrc(const Frame& F, int mat, int k, int n) {
    switch (mat) {
    case 0: { int c;
        if (n < C_CQ) c = n; else if (n < C_CKV) c = 2064 + (n - C_CQ); else if (n < C_KPE) c = 2448 + (n - C_CKV); else if (n < C_B) c = 2704 + (n - C_KPE);
        else if (n < C_A) c = 2048 + (n - C_B); else if (n < C_PAD) c = 2056 + (n - C_A); else return 0.f;
        return F.w_in[(size_t)k * IN_COLS + c]; }
    case 1: { const int c = n < 512 ? (n >> 6) * 96 + (n & 63) : ((n - 512) >> 5) * 96 + 64 + ((n - 512) & 31); return F.w_q_b[(size_t)k * 768 + c]; }
    case 2: { const int c = n < 512 ? (n >> 6) * 128 + (n & 63) : ((n - 512) >> 6) * 128 + 64 + ((n - 512) & 63); return F.w_kv_b[(size_t)k * 1024 + c]; }
    case 3: return F.w_out[(size_t)k * 1024 + n];
    case 4: return F.norm_mlp_g[k] * F.w_up[(size_t)k * 4096 + n];
    default: return F.w_down[(size_t)k * 1024 + n];
    }
}
__device__ __forceinline__ void p0_transpose_item(const Frame& F, int mat, int K, int N, bf16* WT, LAS float* scr, int item, int lane) {
    const int nblk = N / 32, kb = item / nblk, nb = item % nblk, k0 = 64 * kb, n0 = 32 * nb;
#pragma unroll 4
    for (int i = 0; i < 32; ++i) { const int kk = 2 * i + (lane >> 5); scr[kk * 33 + (lane & 31)] = wsrc(F, mat, k0 + kk, n0 + (lane & 31)); }
    LDS_WAIT(); asm volatile("" ::: "memory");
    const int c = lane & 7;
#pragma unroll
    for (int j = 0; j < 4; ++j) { const int n = (lane >> 3) + 8 * j; const LAS float* s = scr + (8 * c) * 33 + n;
        v4u o; o.x = pk2(s[0 * 33], s[1 * 33]); o.y = pk2(s[2 * 33], s[3 * 33]); o.z = pk2(s[4 * 33], s[5 * 33]); o.w = pk2(s[6 * 33], s[7 * 33]);
        *(GAS v4u*)(WT + (size_t)(n0 + n) * K + k0 + 8 * c) = o; }
    LDS_WAIT(); asm volatile("" ::: "memory");
}
__device__ __forceinline__ const float* x_row(const Frame& F, int r) {
    if (r < R_META) return F.x_prompt + (size_t)r * D;
    if (r < R_SAMP) return F.meta + (size_t)(r - R_META) * D;
    if (r < R_END) return F.x_sample + (size_t)(r - R_SAMP) * D;
    return nullptr;
}
__device__ __forceinline__ void p0_prologue(Frame& F) {
    LAS float* scr = (LAS float*)(F.lds + RING_OFF + F.wave * 16384);
    const int gw = F.vcu * NWAVES + F.wave, NGW = F.G * NWAVES;
    constexpr int I0 = (D / 64) * (NPRJ / 32), I1 = (QLORA / 64) * (768 / 32), I2 = (KVLORA / 64) * (1024 / 32), I3 = (1024 / 64) * (1024 / 32), I4 = (D / 64) * (FF / 32), I5 = (FF / 64) * (D / 32);
    constexpr int NITEMS = I0 + I1 + I2 + I3 + I4 + I5;
    for (int it = gw; it < NITEMS; it += NGW) {
        int r = it;
        if (r < I0) { p0_transpose_item(F, 0, D, NPRJ, F.WIN, scr, r, F.lane); continue; } r -= I0;
        if (r < I1) { p0_transpose_item(F, 1, QLORA, 768, F.WQB, scr, r, F.lane); continue; } r -= I1;
        if (r < I2) { p0_transpose_item(F, 2, KVLORA, 1024, F.WKVB, scr, r, F.lane); continue; } r -= I2;
        if (r < I3) { p0_transpose_item(F, 3, 1024, 1024, F.WOUT, scr, r, F.lane); continue; } r -= I3;
        if (r < I4) { p0_transpose_item(F, 4, D, FF, F.WUP, scr, r, F.lane); continue; } r -= I4;
        p0_transpose_item(F, 5, FF, D, F.WDN, scr, r, F.lane);
    }
    for (int e = (F.vcu * NWAVES * 64 + F.tid); e < NROPE * 16; e += F.G * NWAVES * 64) { const int pi = e >> 4, i = e & 15; const int pos = pi < TP ? pi : PAST + (pi - TP);
        const double ang = (double)pos * exp2(-(double)i * 0.83048202372184059); const double n = rint(ang * 0.15915494309189535); const float rr = (float)fma(-n, 6.2831853071795862, ang);
        F.ROPE[pi * 32 + i] = cosf(rr); F.ROPE[pi * 32 + 16 + i] = sinf(rr); }
    { const f32x4* gv = (const f32x4*)F.norm_mix_g + F.lane; f32x4 g4[4];
#pragma unroll
      for (int j = 0; j < 4; ++j) g4[j] = gv[64 * j];
      for (int m0 = gw; m0 < MT; m0 += 2 * NGW) { const int m1 = m0 + NGW;
        const float* x0 = x_row(F, m0); const float* x1 = m1 < MT ? x_row(F, m1) : nullptr;
        f32x4 v0[4], v1[4];
#pragma unroll
        for (int j = 0; j < 4; ++j) { v0[j] = x0 ? ((const f32x4*)x0 + F.lane)[64 * j] : (f32x4){0.f, 0.f, 0.f, 0.f}; v1[j] = x1 ? ((const f32x4*)x1 + F.lane)[64 * j] : (f32x4){0.f, 0.f, 0.f, 0.f}; }
        float s0 = 0.f, s1 = 0.f;
#pragma unroll
        for (int j = 0; j < 4; ++j) { s0 += (v0[j].x * v0[j].x + v0[j].y * v0[j].y) + (v0[j].z * v0[j].z + v0[j].w * v0[j].w); s1 += (v1[j].x * v1[j].x + v1[j].y * v1[j].y) + (v1[j].z * v1[j].z + v1[j].w * v1[j].w); }
        const float r0 = 1.0f / sqrtf(wave_sum(s0) * (1.0f / D) + EPS), r1 = 1.0f / sqrtf(wave_sum(s1) * (1.0f / D) + EPS);
        GAS unsigned long long* o0 = (GAS unsigned long long*)(F.XN + (size_t)m0 * D) + F.lane;
#pragma unroll
        for (int j = 0; j < 4; ++j) { const f32x4 y = v0[j] * r0 * g4[j]; o0[64 * j] = (unsigned long long)pk2(y.x, y.y) | ((unsigned long long)pk2(y.z, y.w) << 32); }
        if (m1 < MT) { GAS unsigned long long* o1 = (GAS unsigned long long*)(F.XN + (size_t)m1 * D) + F.lane;
#pragma unroll
            for (int j = 0; j < 4; ++j) { const f32x4 y = v1[j] * r1 * g4[j]; o1[64 * j] = (unsigned long long)pk2(y.x, y.y) | ((unsigned long long)pk2(y.z, y.w) << 32); } }
      } }
}

struct TapSrc { const bf16* pb; const float* pf; };
__device__ __forceinline__ TapSrc tap_src(const Frame& F, int r, int d) {
    TapSrc t; t.pb = nullptr; t.pf = nullptr;
    if (r < R_META) { const int s = r & (SEQ - 1); if (s - d >= 0) t.pb = F.PRJ + (size_t)(r - d) * NPRJ; else t.pb = F.PRJ + (size_t)(R_META + NMETA + (s - d)) * NPRJ; }
    else if (r < R_SAMP) { const int m = r - R_META; if (m - d >= 0) t.pb = F.PRJ + (size_t)(r - d) * NPRJ; }
    else if (r < R_END) { const int i = r - R_SAMP, bs = i >> 2, tt = i & 3; if (tt - d >= 0) t.pb = F.PRJ + (size_t)(r - d) * NPRJ; else t.pf = F.state_conv + ((size_t)bs * 3 + (3 + tt - d)) * 1536; }
    return t;
}
struct P2Consts { f32x4 cw[4][3][2]; float qg[6]; f32x4 kvg; float dtb, nal; };
__device__ __forceinline__ void p2_consts(const Frame& F, P2Consts& W, int lane) {
#pragma unroll
    for (int j = 0; j < 4; ++j)
#pragma unroll
        for (int sg = 0; sg < 3; ++sg) { W.cw[j][sg][0] = *(const f32x4*)(F.conv_w + j * 1536 + sg * 512 + 8 * lane); W.cw[j][sg][1] = *(const f32x4*)(F.conv_w + j * 1536 + sg * 512 + 8 * lane + 4); }
#pragma unroll
    for (int j = 0; j < 3; ++j) { W.qg[2 * j] = F.q_norm_g[128 * j + 2 * lane]; W.qg[2 * j + 1] = F.q_norm_g[128 * j + 2 * lane + 1]; }
    W.kvg = *((const f32x4*)F.kv_norm_g + lane); W.dtb = F.dt_bias[lane & 7]; W.nal = -expf(F.a_log[lane & 7]);
}
__device__ __forceinline__ void p2_row_fast(Frame& F, int r, const P2Consts& W, int lane) {
    const bf16* p = F.PRJ + (size_t)r * NPRJ; const int b = r >> 11, s2 = r & (SEQ - 1);
    unsigned cq[3];
#pragma unroll
    for (int j = 0; j < 3; ++j) cq[j] = *(const unsigned*)(p + C_CQ + 128 * j + 2 * lane);
    const unsigned long long ckv = *(const unsigned long long*)(p + C_CKV + 4 * lane);
    const bf16 kp1 = p[C_KPE + (lane & 15)], kp2 = p[C_KPE + 16 + (lane & 15)], bbr = p[C_B + (lane & 7)], aar = p[C_A + (lane & 7)];
    const float rc = F.ROPE[(NMETA + s2) * 32 + (lane & 15)], rs = F.ROPE[(NMETA + s2) * 32 + 16 + (lane & 15)];
    v4u xt[4][3];
#pragma unroll
    for (int j = 0; j < 4; ++j)
#pragma unroll
        for (int sg = 0; sg < 3; ++sg) xt[j][sg] = *(const v4u*)(p - (size_t)(3 - j) * NPRJ + sg * 512 + 8 * lane);
    { float v[6]; float s = 0.f;
#pragma unroll
      for (int j = 0; j < 3; ++j) { v[2 * j] = __uint_as_float(cq[j] << 16); v[2 * j + 1] = __uint_as_float(cq[j] & 0xffff0000u); s += v[2 * j] * v[2 * j] + v[2 * j + 1] * v[2 * j + 1]; }
      const float rstd = 1.0f / sqrtf(wave_sum(s) * (1.0f / QLORA) + EPS);
#pragma unroll
      for (int j = 0; j < 3; ++j) *(unsigned*)(F.CQN + (size_t)r * QLORA + 128 * j + 2 * lane) = pk2(v[2 * j] * rstd * W.qg[2 * j], v[2 * j + 1] * rstd * W.qg[2 * j + 1]); }
    { float v[4]; v[0] = __uint_as_float((unsigned)(ckv << 16) & 0xffff0000u); v[1] = __uint_as_float((unsigned)ckv & 0xffff0000u); v[2] = __uint_as_float((unsigned)(ckv >> 16) & 0xffff0000u); v[3] = __uint_as_float((unsigned)(ckv >> 32) & 0xffff0000u);
      const float s = (v[0] * v[0] + v[1] * v[1]) + (v[2] * v[2] + v[3] * v[3]);
      const float rstd = 1.0f / sqrtf(wave_sum(s) * (1.0f / KVLORA) + EPS);
      const f32x4 y = {v[0] * rstd * W.kvg.x, v[1] * rstd * W.kvg.y, v[2] * rstd * W.kvg.z, v[3] * rstd * W.kvg.w};
      *(unsigned long long*)(F.LATN + (size_t)r * KVLORA + 4 * lane) = (unsigned long long)pk2(y.x, y.y) | ((unsigned long long)pk2(y.z, y.w) << 32);
      *((f32x4*)(F.out + O_LATP + ((size_t)b * TP + NMETA + s2) * KVLORA) + lane) = y; }
    if (lane < 16) { const float x1 = bf2f(kp1), x2 = bf2f(kp2), o1 = x1 * rc - x2 * rs, o2 = x2 * rc + x1 * rs;
      F.KPE[(size_t)r * 32 + lane] = o1; F.KPE[(size_t)r * 32 + 16 + lane] = o2; F.KPEB[(size_t)r * 32 + lane] = (bf16)f2bf(o1); F.KPEB[(size_t)r * 32 + 16 + lane] = (bf16)f2bf(o2);
      float* o = F.out + O_KRP + ((size_t)b * TP + NMETA + s2) * 32; o[lane] = o1; o[16 + lane] = o2; }
    if (lane < 8) { const float beta = 1.0f / (1.0f + expf(-bf2f(bbr))); const float xx = bf2f(aar) + W.dtb; const float sp = xx > 20.f ? xx : log1pf(expf(xx));
      F.GB[(size_t)r * 16 + lane] = beta; F.GB[(size_t)r * 16 + 8 + lane] = W.nal * sp; }
#pragma unroll
    for (int sg = 0; sg < 3; ++sg) { float y[8];
#pragma unroll
        for (int e = 0; e < 8; ++e) y[e] = 0.f;
#pragma unroll
        for (int j = 0; j < 4; ++j) { const v4u w = xt[j][sg]; const f32x4 w0 = W.cw[j][sg][0], w1 = W.cw[j][sg][1];
            y[0] += __uint_as_float(w.x << 16) * w0.x; y[1] += __uint_as_float(w.x & 0xffff0000u) * w0.y; y[2] += __uint_as_float(w.y << 16) * w0.z; y[3] += __uint_as_float(w.y & 0xffff0000u) * w0.w;
            y[4] += __uint_as_float(w.z << 16) * w1.x; y[5] += __uint_as_float(w.z & 0xffff0000u) * w1.y; y[6] += __uint_as_float(w.w << 16) * w1.z; y[7] += __uint_as_float(w.w & 0xffff0000u) * w1.w; }
        float ss = 0.f;
#pragma unroll
        for (int e = 0; e < 8; ++e) { y[e] = silu_f(y[e]); ss += y[e] * y[e]; }
        if (sg < 2) { ss += __shfl_xor(ss, 1); ss += __shfl_xor(ss, 2); ss += __shfl_xor(ss, 4); const float sc = (sg == 0 ? 0.125f : 1.0f) / sqrtf(ss + EPS);
#pragma unroll
            for (int e = 0; e < 8; ++e) y[e] *= sc; }
        v4u o; o.x = pk2(y[0], y[1]); o.y = pk2(y[2], y[3]); o.z = pk2(y[4], y[5]); o.w = pk2(y[6], y[7]);
        *(v4u*)(F.GQKV + (size_t)r * 1536 + sg * 512 + 8 * lane) = o; }
}
__device__ __forceinline__ void p2_row(Frame& F, int r) {
    int lane_ = F.lane; asm volatile("" : "+v"(lane_)); const int lane = lane_;
    const bf16* p = F.PRJ + (size_t)r * NPRJ;
    if (r >= R_END) {
        for (int c = lane; c < QLORA; c += 64) F.CQN[(size_t)r * QLORA + c] = 0;
        for (int c = lane; c < KVLORA; c += 64) F.LATN[(size_t)r * KVLORA + c] = 0;
        return; }
    { float v[6]; float s = 0.f;
#pragma unroll
      for (int j = 0; j < 3; ++j) { const unsigned w = *(const unsigned*)(p + C_CQ + 128 * j + 2 * lane); v[2 * j] = __uint_as_float(w << 16); v[2 * j + 1] = __uint_as_float(w & 0xffff0000u); s += v[2 * j] * v[2 * j] + v[2 * j + 1] * v[2 * j + 1]; }
      const float rstd = 1.0f / sqrtf(wave_sum(s) * (1.0f / QLORA) + EPS);
#pragma unroll
      for (int j = 0; j < 3; ++j) { const int c = 128 * j + 2 * lane; *(unsigned*)(F.CQN + (size_t)r * QLORA + c) = pk2(v[2 * j] * rstd * F.q_norm_g[c], v[2 * j + 1] * rstd * F.q_norm_g[c + 1]); } }
    { const unsigned long long w = *(const unsigned long long*)(p + C_CKV + 4 * lane); float v[4];
      v[0] = __uint_as_float((unsigned)(w << 16) & 0xffff0000u); v[1] = __uint_as_float((unsigned)w & 0xffff0000u); v[2] = __uint_as_float((unsigned)(w >> 16) & 0xffff0000u); v[3] = __uint_as_float((unsigned)(w >> 32) & 0xffff0000u);
      const float s = (v[0] * v[0] + v[1] * v[1]) + (v[2] * v[2] + v[3] * v[3]);
      const float rstd = 1.0f / sqrtf(wave_sum(s) * (1.0f / KVLORA) + EPS);
      const f32x4 g = *((const f32x4*)F.kv_norm_g + lane);
      const f32x4 y = {v[0] * rstd * g.x, v[1] * rstd * g.y, v[2] * rstd * g.z, v[3] * rstd * g.w};
      *(unsigned long long*)(F.LATN + (size_t)r * KVLORA + 4 * lane) = (unsigned long long)pk2(y.x, y.y) | ((unsigned long long)pk2(y.z, y.w) << 32);
      if (r < R_META) { const int b = r >> 11, s2 = r & (SEQ - 1); *((f32x4*)(F.out + O_LATP + ((size_t)b * TP + NMETA + s2) * KVLORA) + lane) = y; }
      else if (r < R_SAMP) { const int m = r - R_META;
#pragma unroll
          for (int b = 0; b < NB; ++b) *((f32x4*)(F.out + O_LATP + ((size_t)b * TP + m) * KVLORA) + lane) = y; }
      else *((f32x4*)(F.out + O_LATS + (size_t)(r - R_SAMP) * KVLORA) + lane) = y; }
    if (lane < 16) { const float x1 = bf2f(p[C_KPE + lane]), x2 = bf2f(p[C_KPE + 16 + lane]);
      const int pi = r < R_META ? NMETA + (r & (SEQ - 1)) : (r < R_SAMP ? r - R_META : TP + ((r - R_SAMP) & (NST - 1)));
      const float c = F.ROPE[pi * 32 + lane], s = F.ROPE[pi * 32 + 16 + lane], o1 = x1 * c - x2 * s, o2 = x2 * c + x1 * s;
      F.KPE[(size_t)r * 32 + lane] = o1; F.KPE[(size_t)r * 32 + 16 + lane] = o2; F.KPEB[(size_t)r * 32 + lane] = (bf16)f2bf(o1); F.KPEB[(size_t)r * 32 + 16 + lane] = (bf16)f2bf(o2);
      if (r < R_META) { const int b = r >> 11, s2 = r & (SEQ - 1); float* o = F.out + O_KRP + ((size_t)b * TP + NMETA + s2) * 32; o[lane] = o1; o[16 + lane] = o2; }
      else if (r < R_SAMP) { const int m = r - R_META; for (int b = 0; b < NB; ++b) { float* o = F.out + O_KRP + ((size_t)b * TP + m) * 32; o[lane] = o1; o[16 + lane] = o2; } }
      else { float* o = F.out + O_KRS + (size_t)(r - R_SAMP) * 32; o[lane] = o1; o[16 + lane] = o2; } }
    if (lane < 8) { const float bb = bf2f(p[C_B + lane]), aa = bf2f(p[C_A + lane]);
      const float beta = 1.0f / (1.0f + expf(-bb)); const float xx = aa + F.dt_bias[lane];
      const float sp = xx > 20.f ? xx : log1pf(expf(xx));
      F.GB[(size_t)r * 16 + lane] = beta; F.GB[(size_t)r * 16 + 8 + lane] = -expf(F.a_log[lane]) * sp; }
    { TapSrc ts[4];
#pragma unroll
      for (int j = 0; j < 4; ++j) ts[j] = tap_src(F, r, 3 - j);
      float y[3][8];
#pragma unroll
      for (int sg = 0; sg < 3; ++sg)
#pragma unroll
          for (int e = 0; e < 8; ++e) y[sg][e] = 0.f;
#pragma unroll
      for (int j = 0; j < 4; ++j) {
          if (!ts[j].pb && !ts[j].pf) continue;
#pragma unroll
          for (int sg = 0; sg < 3; ++sg) { const int ch = sg * 512 + 8 * lane; float x[8];
              if (ts[j].pb) { const v4u w = *(const v4u*)(ts[j].pb + ch);
                  x[0] = __uint_as_float(w.x << 16); x[1] = __uint_as_float(w.x & 0xffff0000u); x[2] = __uint_as_float(w.y << 16); x[3] = __uint_as_float(w.y & 0xffff0000u);
                  x[4] = __uint_as_float(w.z << 16); x[5] = __uint_as_float(w.z & 0xffff0000u); x[6] = __uint_as_float(w.w << 16); x[7] = __uint_as_float(w.w & 0xffff0000u); }
              else { const f32x4 a = *(const f32x4*)(ts[j].pf + ch), b2 = *(const f32x4*)(ts[j].pf + ch + 4); x[0] = a.x; x[1] = a.y; x[2] = a.z; x[3] = a.w; x[4] = b2.x; x[5] = b2.y; x[6] = b2.z; x[7] = b2.w; }
              const f32x4 w0 = *(const f32x4*)(F.conv_w + j * 1536 + ch), w1 = *(const f32x4*)(F.conv_w + j * 1536 + ch + 4);
              y[sg][0] += x[0] * w0.x; y[sg][1] += x[1] * w0.y; y[sg][2] += x[2] * w0.z; y[sg][3] += x[3] * w0.w;
              y[sg][4] += x[4] * w1.x; y[sg][5] += x[5] * w1.y; y[sg][6] += x[6] * w1.z; y[sg][7] += x[7] * w1.w; } }
#pragma unroll
      for (int sg = 0; sg < 3; ++sg) { float ss = 0.f;
#pragma unroll
          for (int e = 0; e < 8; ++e) { y[sg][e] = silu_f(y[sg][e]); ss += y[sg][e] * y[sg][e]; }
          if (sg < 2) { ss += __shfl_xor(ss, 1); ss += __shfl_xor(ss, 2); ss += __shfl_xor(ss, 4); const float sc = (sg == 0 ? 0.125f : 1.0f) / sqrtf(ss + EPS);
#pragma unroll
              for (int e = 0; e < 8; ++e) y[sg][e] *= sc; }
          v4u o; o.x = pk2(y[sg][0], y[sg][1]); o.y = pk2(y[sg][2], y[sg][3]); o.z = pk2(y[sg][4], y[sg][5]); o.w = pk2(y[sg][6], y[sg][7]);
          *(v4u*)(F.GQKV + (size_t)r * 1536 + sg * 512 + 8 * lane) = o; } }
    { float* o = nullptr;
      if (r < R_META) { const int b = r >> 11, s2 = r & (SEQ - 1); if (s2 >= SEQ - 3) o = F.out + O_CONVP + ((size_t)b * 3 + (s2 - (SEQ - 3))) * 1536; }
      else if (r >= R_SAMP) { const int i = r - R_SAMP, bs = i >> 2, tt = i & 3; if (tt >= 1) o = F.out + O_CONVS + ((size_t)bs * 3 + (tt - 1)) * 1536; }
      if (o) {
          v4u w[3];
#pragma unroll
          for (int k = 0; k < 3; ++k) w[k] = *(const v4u*)(p + 512 * k + 8 * lane);
#pragma unroll
          for (int k = 0; k < 3; ++k) { float* ok = o + 512 * k + 8 * lane;
              *(f32x4*)ok = (f32x4){__uint_as_float(w[k].x << 16), __uint_as_float(w[k].x & 0xffff0000u), __uint_as_float(w[k].y << 16), __uint_as_float(w[k].y & 0xffff0000u)};
              *(f32x4*)(ok + 4) = (f32x4){__uint_as_float(w[k].z << 16), __uint_as_float(w[k].z & 0xffff0000u), __uint_as_float(w[k].w << 16), __uint_as_float(w[k].w & 0xffff0000u)}; } } }
}

namespace fa {
typedef float f32x16 __attribute__((ext_vector_type(16)));
typedef short s16x4 __attribute__((ext_vector_type(4)));
typedef short v4i16_t __attribute__((ext_vector_type(4)));
constexpr int KOFF = 0, VOFF = 12288, STAGE = 20480;
constexpr int LDS_WSF = 2 * STAGE, LDS_OST = LDS_WSF + 8 * 256, LDS_TOTAL = LDS_OST + 8 * 4096;
static_assert(LDS_TOTAL <= RING_BYTES, "attention LDS");
__device__ __forceinline__ int crow(int r, int hi) { return (r & 3) + 8 * (r >> 2) + 4 * hi; }
typedef float f32x2_t __attribute__((ext_vector_type(2))); typedef __bf16 bf16x2_t __attribute__((ext_vector_type(2)));
__device__ __forceinline__ unsigned cvtpk(float lo, float hi) { f32x2_t v = {lo, hi}; bf16x2_t b = __builtin_convertvector(v, bf16x2_t); return __builtin_bit_cast(unsigned, b); }
__device__ __forceinline__ s16x4 vtr(const LAS unsigned char* p) { return __builtin_bit_cast(s16x4, __builtin_amdgcn_ds_read_tr16_b64_v4i16((LAS v4i16_t*)p)); }
__device__ __forceinline__ void issue_tile(const Frame& F, LAS unsigned char* st, int b, int h, int t, bool meta, int wid, int lane) {
    { const int key = lane; const int krow = meta ? R_META + (key < NMETA ? key : NMETA - 1) : b * SEQ + 64 * t + key;
      __builtin_amdgcn_global_load_lds((const unsigned*)(F.KV + (size_t)krow * 1024 + h * 64 + wid * 8), (LAS unsigned*)(st + KOFF + wid * 1024), 16, 0, 0);
      if (wid < 4) __builtin_amdgcn_global_load_lds((const unsigned*)(F.KPEB + (size_t)krow * 32 + wid * 8), (LAS unsigned*)(st + KOFF + (8 + wid) * 1024), 16, 0, 0); }
    { const int key = 16 * (wid & 3) + (lane >> 2); const int vrow = meta ? R_META + (key < NMETA ? key : NMETA - 1) : b * SEQ + 64 * t + key;
      __builtin_amdgcn_global_load_lds((const unsigned*)(F.KV + (size_t)vrow * 1024 + 512 + h * 64 + (wid >> 2) * 32 + (lane & 3) * 8), (LAS unsigned*)(st + VOFF + wid * 1024), 16, 0, 0); }
}
__device__ __forceinline__ void attn_unit(const Frame& F, int b, int h, int qb) {
    const int lane = F.lane, wid = F.wave, r32 = lane & 31, hi = lane >> 5;
    LAS unsigned char* base = F.lds + RING_OFF;
    LAS float* wsf = (LAS float*)(base + LDS_WSF) + wid * 64;
    const int s0 = 256 * qb + 32 * wid; const size_t row0 = (size_t)b * SEQ + s0;
    const int NTR = 4 * (qb + 1), NT = NTR + 1;
    const int td = 4 * qb + (wid >> 1);
    __syncthreads();
    issue_tile(F, base, b, h, 0, false, wid, lane);
    bf16x8 qr[6];
    { const bf16* q = F.QM + (row0 + r32) * 768;
#pragma unroll
      for (int d0 = 0; d0 < 4; ++d0) qr[d0] = *(const bf16x8*)(q + h * 64 + d0 * 16 + hi * 8);
#pragma unroll
      for (int d0 = 0; d0 < 2; ++d0) qr[4 + d0] = *(const bf16x8*)(q + 512 + h * 32 + d0 * 16 + hi * 8); }
    f32x16 o0, o1;
#pragma unroll
    for (int r = 0; r < 16; ++r) { o0[r] = 0.f; o1[r] = 0.f; }
    float m = -INFINITY, l = 0.f;
    const int qrel = 32 * (wid & 1) + r32;
    const int vlane = ((lane >> 4) & 1) * 32 + (lane & 3) * 8 + (4 * hi + ((lane & 15) >> 2)) * 64;
    for (int t = 0; t < NT; ++t) {
        const bool meta = (t == NTR);
        asm volatile("s_waitcnt vmcnt(0)" ::: "memory");
        __syncthreads();
        if (t + 1 < NT) issue_tile(F, base + ((t + 1) & 1) * STAGE, b, h, t + 1, t + 1 == NTR, wid, lane);
        if (!meta && t > td) continue;
        const LAS unsigned char* st = base + (t & 1) * STAGE;
        const LAS unsigned char* kb = st + KOFF + hi * 1024 + r32 * 16;
        f32x16 p0, p1;
#pragma unroll
        for (int r = 0; r < 16; ++r) { p0[r] = 0.f; p1[r] = 0.f; }
#pragma unroll
        for (int d0 = 0; d0 < 6; ++d0) {
            const bf16x8 k0 = *(const LAS bf16x8*)(kb + d0 * 2048);
            p0 = __builtin_amdgcn_mfma_f32_32x32x16_bf16(k0, qr[d0], p0, 0, 0, 0);
            if (!meta) { const bf16x8 k1 = *(const LAS bf16x8*)(kb + d0 * 2048 + 512); p1 = __builtin_amdgcn_mfma_f32_32x32x16_bf16(k1, qr[d0], p1, 0, 0, 0); }
        }
        if (meta) {
#pragma unroll
            for (int r = 8; r < 16; ++r) p0[r] = -INFINITY;
#pragma unroll
            for (int r = 0; r < 16; ++r) p1[r] = -INFINITY;
        } else if (t == td) {
#pragma unroll
            for (int r = 0; r < 16; ++r) { const int kk = crow(r, hi); if (kk > qrel) p0[r] = -INFINITY; if (kk + 32 > qrel) p1[r] = -INFINITY; }
        }
        float mx = fmaxf(p0[0], p1[0]);
#pragma unroll
        for (int r = 1; r < 16; ++r) mx = fmaxf(mx, fmaxf(p0[r], p1[r]));
        mx = fmaxf(mx, __shfl_xor(mx, 32));
        const float mn = fmaxf(m, mx);
        if (__any(mn > m)) {
            const float f = __builtin_amdgcn_exp2f(m - mn);
            l *= f; wsf[r32] = f;
#pragma unroll
            for (int r = 0; r < 16; ++r) { const float fr_ = wsf[crow(r, hi)]; o0[r] *= fr_; o1[r] *= fr_; }
            m = mn;
        }
        float sum = 0.f;
#pragma unroll
        for (int r = 0; r < 16; ++r) { p0[r] = __builtin_amdgcn_exp2f(p0[r] - m); p1[r] = __builtin_amdgcn_exp2f(p1[r] - m); sum += p0[r] + p1[r]; }
        l += sum;
        v4u pa0, pa1, pa2, pa3;
        pa0.x = cvtpk(p0[0], p0[1]); pa0.y = cvtpk(p0[2], p0[3]); pa0.z = cvtpk(p0[4], p0[5]); pa0.w = cvtpk(p0[6], p0[7]);
        pa1.x = cvtpk(p0[8], p0[9]); pa1.y = cvtpk(p0[10], p0[11]); pa1.z = cvtpk(p0[12], p0[13]); pa1.w = cvtpk(p0[14], p0[15]);
        pa2.x = cvtpk(p1[0], p1[1]); pa2.y = cvtpk(p1[2], p1[3]); pa2.z = cvtpk(p1[4], p1[5]); pa2.w = cvtpk(p1[6], p1[7]);
        pa3.x = cvtpk(p1[8], p1[9]); pa3.y = cvtpk(p1[10], p1[11]); pa3.z = cvtpk(p1[12], p1[13]); pa3.w = cvtpk(p1[14], p1[15]);
        const LAS unsigned char* vp = st + VOFF + vlane;
#define FA_PV(O, PA, DB, KS) do { const s16x4 lo_ = vtr(vp + (DB) * 4096 + (KS) * 1024), hi_ = vtr(vp + (DB) * 4096 + (KS) * 1024 + 512); \
        const bf16x8 vf_ = {lo_[0], lo_[1], lo_[2], lo_[3], hi_[0], hi_[1], hi_[2], hi_[3]}; \
        O = __builtin_amdgcn_mfma_f32_32x32x16_bf16(__builtin_bit_cast(bf16x8, PA), vf_, O, 0, 0, 0); } while (0)
        FA_PV(o0, pa0, 0, 0); FA_PV(o1, pa0, 1, 0);
        if (!meta) { FA_PV(o0, pa1, 0, 1); FA_PV(o1, pa1, 1, 1); FA_PV(o0, pa2, 0, 2); FA_PV(o1, pa2, 1, 2); FA_PV(o0, pa3, 0, 3); FA_PV(o1, pa3, 1, 3); }
#undef FA_PV
    }
    l += __shfl_xor(l, 32);
    wsf[32 + r32] = l;
    float rli[16];
#pragma unroll
    for (int r = 0; r < 16; ++r) rli[r] = 1.0f / wsf[32 + crow(r, hi)];
    LAS bf16* stg = (LAS bf16*)(base + LDS_OST) + wid * 2048;
#pragma unroll
    for (int r = 0; r < 16; ++r) { const int orow = crow(r, hi); stg[orow * 64 + r32] = (bf16)f2bf(o0[r] * rli[r]); stg[orow * 64 + 32 + r32] = (bf16)f2bf(o1[r] * rli[r]); }
#pragma unroll
    for (int i = 0; i < 4; ++i) { const int row = i * 8 + (lane >> 3), ch = lane & 7; const v4u v = *(const LAS v4u*)(stg + row * 64 + ch * 8);
        *(v4u*)(F.MIX + (row0 + row) * 1024 + 512 + h * 64 + ch * 8) = v; }
}
__device__ __forceinline__ void attn_phase(const Frame& F) {
    for (int u = F.vcu; u < 256; u += F.G) { const int bh = u >> 2, pr = u & 3;
        attn_unit(F, bh >> 3, bh & 7, pr); attn_unit(F, bh >> 3, bh & 7, 7 - pr); }
    __syncthreads();
}
}

namespace sa {
using fa::f32x16; using fa::s16x4; using fa::crow; using fa::cvtpk; using fa::vtr;
constexpr int CS = 528, TILE = 36 * CS  , QF_OFF = 4 * TILE  , WSF_OFF = QF_OFF + 32 * 288 * 2  , LDS_TOTAL = WSF_OFF + 8 * 256;
static_assert(LDS_TOTAL <= RING_BYTES && QF_OFF % 16 == 0 && WSF_OFF % 16 == 0, "sample attention LDS");
constexpr int NUNIT = 8, KEYS_PER = PAST / NUNIT  , NTC = KEYS_PER / 64  , NSPL = 2 * NUNIT  ;
__device__ __forceinline__ void tile_step(const LAS unsigned char* st, const bf16x8 (&qf)[18], f32x16& o0, f32x16& o1, float& m, float& l, LAS float* wsf, int r32, int hi, int vlane) {
        const LAS unsigned char* kb = st + hi * CS + r32 * 16;
        f32x16 p0;
#pragma unroll
        for (int r = 0; r < 16; ++r) p0[r] = 0.f;
#pragma unroll
        for (int s = 0; s < 18; ++s) { const bf16x8 k0 = *(const LAS bf16x8*)(kb + 2 * s * CS); p0 = __builtin_amdgcn_mfma_f32_32x32x16_bf16(k0, qf[s], p0, 0, 0, 0); }
        float mx = p0[0];
#pragma unroll
        for (int r = 1; r < 16; ++r) mx = fmaxf(mx, p0[r]);
        mx = fmaxf(mx, __shfl_xor(mx, 32));
        const float mn = fmaxf(m, mx);
        if (__any(mn > m)) {
            const float f = __builtin_amdgcn_exp2f(m - mn);
            l *= f; wsf[r32] = f;
#pragma unroll
            for (int r = 0; r < 16; ++r) { const float fr_ = wsf[crow(r, hi)]; o0[r] *= fr_; o1[r] *= fr_; }
            m = mn;
        }
        float sum = 0.f;
#pragma unroll
        for (int r = 0; r < 16; ++r) { p0[r] = __builtin_amdgcn_exp2f(p0[r] - m); sum += p0[r]; }
        l += sum;
        v4u pa0, pa1;
        pa0.x = cvtpk(p0[0], p0[1]); pa0.y = cvtpk(p0[2], p0[3]); pa0.z = cvtpk(p0[4], p0[5]); pa0.w = cvtpk(p0[6], p0[7]);
        pa1.x = cvtpk(p0[8], p0[9]); pa1.y = cvtpk(p0[10], p0[11]); pa1.z = cvtpk(p0[12], p0[13]); pa1.w = cvtpk(p0[14], p0[15]);
        const LAS unsigned char* vp = st + vlane;
#define SA_PV(O, PA, CT, KS) do { const s16x4 lo_ = vtr(vp + (CT) * 4 * CS + (KS) * 256), hi_ = vtr(vp + (CT) * 4 * CS + (KS) * 256 + 128); \
        const bf16x8 vf_ = {lo_[0], lo_[1], lo_[2], lo_[3], hi_[0], hi_[1], hi_[2], hi_[3]}; \
        O = __builtin_amdgcn_mfma_f32_32x32x16_bf16(__builtin_bit_cast(bf16x8, PA), vf_, O, 0, 0, 0); } while (0)
        SA_PV(o0, pa0, 0, 0); SA_PV(o1, pa0, 1, 0); SA_PV(o0, pa1, 0, 1); SA_PV(o1, pa1, 1, 1);
#undef SA_PV
}
__device__ __forceinline__ void attn_unit(const Frame& F, int bs, int split) {
    const int tid = F.tid, lane = F.lane, wid = F.wave, r32 = lane & 31, hi = lane >> 5, g = wid >> 2, w4 = wid & 3, tg = tid & 255;
    LAS unsigned char* base = F.lds + RING_OFF;
    LAS bf16* qfb = (LAS bf16*)(base + QF_OFF);
    LAS float* wsf = (LAS float*)(base + WSF_OFF) + wid * 64;
    __syncthreads();
    { LAS float* tmp = (LAS float*)base;
      for (int e = tid; e < 32 * 64; e += 512) { const int rr = e >> 6, n = e & 63, t = rr >> 3, h = rr & 7; tmp[e] = bf2f(F.QM[(size_t)(R_SAMP + bs * 4 + t) * 768 + h * 64 + n]); }
      for (int e = tid; e < 32 * 32; e += 512) { const int rr = e >> 5, i = e & 31, t = rr >> 3, h = rr & 7; qfb[rr * 288 + 256 + i] = F.QM[(size_t)(R_SAMP + bs * 4 + t) * 768 + 512 + h * 32 + i]; }
      __syncthreads();
      { int tz = tid; asm volatile("" : "+v"(tz)); const int h = tz & 7;
#pragma unroll 1
        for (int j = 0; j < 4; ++j) { const int c = (tz >> 3) + 64 * j; const f32x4* w = (const f32x4*)(F.w_kv_b + (size_t)c * 1024 + h * 128);
            f32x4 wv[16];
#pragma unroll
            for (int k = 0; k < 16; ++k) wv[k] = w[k];
#pragma unroll
            for (int t = 0; t < 4; ++t) { const LAS f32x4* q4 = (const LAS f32x4*)(tmp + (t * 8 + h) * 64); float a = 0.f;
#pragma unroll
                for (int k = 0; k < 16; ++k) { const f32x4 q = q4[k]; a += (wv[k].x * q.x + wv[k].y * q.y) + (wv[k].z * q.z + wv[k].w * q.w); }
                qfb[(t * 8 + h) * 288 + c] = (bf16)f2bf(a); if (split == 0) F.QLAT[((size_t)bs * 32 + t * 8 + h) * 256 + c] = a; } } }
      __syncthreads(); }
    bf16x8 qf[18];
#pragma unroll
    for (int s = 0; s < 18; ++s) qf[s] = *(const LAS bf16x8*)(qfb + r32 * 288 + 16 * s + 8 * hi);
    const int ptv = F.page_table[bs * NPAGES + split * (KEYS_PER / PAGE) + (lane & 15)];
    f32x4 RA[9], RB[9];
#define SA_LOAD(R, t) do { const int key0_ = (t) * 64 + g * 32; const int page_ = __builtin_amdgcn_readlane(ptv, key0_ >> 7); const size_t rb_ = (size_t)page_ * PAGE + (key0_ & 127); \
        _Pragma("unroll") for (int i_ = 0; i_ < 8; ++i_) R[i_] = *((const f32x4*)(F.cache_latent + (rb_ + i_ * 4 + w4) * 256) + lane); \
        R[8] = *((const f32x4*)(F.cache_krope + (rb_ + (tg >> 3)) * 32) + (tg & 7)); } while (0)
#define SA_WRITE(R, buf) do { LAS unsigned char* b_ = base + (g * 2 + (buf)) * TILE; \
        _Pragma("unroll") for (int i_ = 0; i_ < 8; ++i_) { const unsigned long long w_ = (unsigned long long)cvtpk(R[i_].x, R[i_].y) | ((unsigned long long)cvtpk(R[i_].z, R[i_].w) << 32); \
            *(LAS unsigned long long*)(b_ + (lane >> 1) * CS + (i_ * 4 + w4) * 16 + (lane & 1) * 8) = w_; } \
        { const unsigned long long w_ = (unsigned long long)cvtpk(R[8].x, R[8].y) | ((unsigned long long)cvtpk(R[8].z, R[8].w) << 32); \
          *(LAS unsigned long long*)(b_ + (32 + ((tg & 7) >> 1)) * CS + (tg >> 3) * 16 + (tg & 1) * 8) = w_; } } while (0)
    SA_LOAD(RA, 0); SA_WRITE(RA, 0); SA_LOAD(RB, 1); SA_LOAD(RA, 2);
    f32x16 o0, o1;
#pragma unroll
    for (int r = 0; r < 16; ++r) { o0[r] = 0.f; o1[r] = 0.f; }
    float m = -INFINITY, l = 0.f;
    const int vlane = (8 * w4 + 2 * ((lane >> 4) & 1) + ((lane & 3) >> 1)) * CS + (4 * hi + ((lane & 15) >> 2)) * 16 + 8 * (lane & 1);
    for (int t = 0; t < NTC; t += 2) {
        __syncthreads();
        tile_step(base + (g * 2 + 0) * TILE, qf, o0, o1, m, l, wsf, r32, hi, vlane);
        SA_WRITE(RB, 1);
        if (t + 3 < NTC) SA_LOAD(RB, t + 3);
        __syncthreads();
        tile_step(base + (g * 2 + 1) * TILE, qf, o0, o1, m, l, wsf, r32, hi, vlane);
        if (t + 2 < NTC) { SA_WRITE(RA, 0); if (t + 4 < NTC) SA_LOAD(RA, t + 4); }
    }
#undef SA_LOAD
#undef SA_WRITE
    l += __shfl_xor(l, 32);
    { int lz = lane; asm volatile("" : "+v"(lz));
      const int rz = lz & 31, hz = lz >> 5;
      const int sp = split * 2 + g; float* po = F.PART + ((size_t)(bs * NSPL + sp) * 32) * 256 + 64 * w4 + rz;
#pragma unroll
      for (int r = 0; r < 16; ++r) { po[(size_t)crow(r, hz) * 256] = o0[r]; po[(size_t)crow(r, hz) * 256 + 32] = o1[r]; }
      if (w4 == 0 && hz == 0) { float* ps = F.PSTAT + ((size_t)(bs * NSPL + sp) * 32 + rz) * 2; ps[0] = m; ps[1] = l; } }
}
__device__ __forceinline__ void attn_phase(const Frame& F) {
    for (int u = F.vcu; u < NSB * NUNIT; u += F.G) attn_unit(F, u >> 3, u & 7);
    __syncthreads();
}
}

namespace gdn {
using fa::f32x16; using fa::crow;
constexpr int REC = 40960, OFF_W = 0, OFF_QG = 8192, OFF_QK = 16384, OFF_KD = 24576, OFF_U = 32768;
constexpr int NCH = SEQ / 64;
typedef float f32x2_t __attribute__((ext_vector_type(2))); typedef __bf16 bf16x2_t __attribute__((ext_vector_type(2)));
__device__ __forceinline__ unsigned cvt2(float lo, float hi) { f32x2_t v = {lo, hi}; bf16x2_t b = __builtin_convertvector(v, bf16x2_t); return __builtin_bit_cast(unsigned, b); }
__device__ __forceinline__ bf16x8 pack8(float a0, float a1, float a2, float a3, float a4, float a5, float a6, float a7) {
    v4u w; w.x = cvt2(a0, a1); w.y = cvt2(a2, a3); w.z = cvt2(a4, a5); w.w = cvt2(a6, a7); return __builtin_bit_cast(bf16x8, w); }
__device__ __forceinline__ bf16x8 ldfrag_f32(const float* p) { const f32x4 a = *(const f32x4*)p, b = *(const f32x4*)(p + 4); return pack8(a.x, a.y, a.z, a.w, b.x, b.y, b.z, b.w); }
__device__ __forceinline__ int swz16(int c) { return (c & 3) | ((c & 4) << 1) | ((c & 8) >> 1); }

template <int PASS> __device__ __forceinline__ void solve_pass(const Frame& F, const LAS float* Lm, const LAS float* gcs, const LAS float* bts, const bf16* col, unsigned char* rec, int lane) {
    float X[64];
#pragma unroll
    for (int ib = 0; ib < 4; ++ib) {
        float c16[16];
#pragma unroll
        for (int k = 0; k < 16; ++k) c16[k] = bf2f(col[(size_t)(16 * ib + k) * 1536]);
        asm volatile("" ::: "memory");
#pragma unroll
        for (int k = 0; k < 16; ++k) { const int i = 16 * ib + k;
            float x = c16[k] * bts[i]; if (PASS == 1) x *= __expf(gcs[i]);
#pragma unroll
            for (int m = 0; m < (i + 3) / 4; ++m) { const f32x4 l4 = *(const LAS f32x4*)(Lm + i * 64 + ((4 * m) ^ ((i & 7) << 2)));
                if (4 * m + 0 < i) x -= l4.x * X[4 * m + 0];
                if (4 * m + 1 < i) x -= l4.y * X[4 * m + 1];
                if (4 * m + 2 < i) x -= l4.z * X[4 * m + 2];
                if (4 * m + 3 < i) x -= l4.w * X[4 * m + 3]; }
            X[i] = x;
            if ((k & 3) == 3) asm volatile("" ::: "memory");
        }
    }
    if (PASS == 0) { const unsigned lo = (unsigned)((lane >> 5) * 2048 + (lane & 31)); bf16* U = (bf16*)(rec + OFF_U);
#pragma unroll
        for (int i = 0; i < 64; ++i) { const int rt = i >> 5, ip = i & 31, hi_ = (ip >> 2) & 1, r = (ip & 3) + 4 * (ip >> 3);
            U[lo + (unsigned)((rt * 16 + r) * 64 + 32 * hi_)] = (bf16)f2bf(X[i]); } }
    else { const int s = lane >> 4, sw = swz16(lane & 15), hsel = (sw >> 3) & 1, el = sw & 7; bf16* W = (bf16*)(rec + OFF_W); const unsigned lo = (unsigned)((s * 64 + 32 * hsel) * 8 + el);
#pragma unroll
        for (int i = 0; i < 64; ++i) { const int rt = i >> 5, ip = i & 31; W[lo + (unsigned)((rt * 256 + ip) * 8)] = (bf16)f2bf(-X[i]); } }
}
__device__ __forceinline__ void solve_both(const Frame& F, const LAS float* Lm, const LAS float* gcs, const LAS float* bts, const bf16* vcol, const bf16* kcol, unsigned char* rec, int lane) {
    float XU[64], XW[64];
#pragma unroll
    for (int ib = 0; ib < 8; ++ib) {
        float cu[8], cw[8];
        { unsigned lo2 = (unsigned)lane * 2u; asm volatile("" : "+v"(lo2));
          const char* vb = (const char*)vcol + (size_t)(8 * ib) * 3072; const char* kb = (const char*)kcol + (size_t)(8 * ib) * 3072;
#pragma unroll
          for (int k = 0; k < 8; ++k) { cu[k] = bf2f(*(const bf16*)(vb + (size_t)k * 3072 + lo2)); cw[k] = bf2f(*(const bf16*)(kb + (size_t)k * 3072 + lo2)); } }
        asm volatile("" ::: "memory");
#pragma unroll
        for (int k = 0; k < 8; ++k) { const int i = 8 * ib + k;
            const float bi = bts[i]; float xu = cu[k] * bi, xw = cw[k] * bi * __expf(gcs[i]);
#pragma unroll
            for (int m = 0; m < (i + 3) / 4; ++m) { const f32x4 l4 = *(const LAS f32x4*)(Lm + i * 64 + ((4 * m) ^ ((i & 7) << 2)));
                if (4 * m + 0 < i) { xu -= l4.x * XU[4 * m + 0]; xw -= l4.x * XW[4 * m + 0]; }
                if (4 * m + 1 < i) { xu -= l4.y * XU[4 * m + 1]; xw -= l4.y * XW[4 * m + 1]; }
                if (4 * m + 2 < i) { xu -= l4.z * XU[4 * m + 2]; xw -= l4.z * XW[4 * m + 2]; }
                if (4 * m + 3 < i) { xu -= l4.w * XU[4 * m + 3]; xw -= l4.w * XW[4 * m + 3]; } }
            XU[i] = xu; XW[i] = xw;
            asm volatile("" ::: "memory");
        }
    }
    { int lz = lane; asm volatile("" : "+v"(lz));
      const unsigned lo = (unsigned)((lz >> 5) * 2048 + (lz & 31)); bf16* U = (bf16*)(rec + OFF_U);
#pragma unroll
      for (int i = 0; i < 64; ++i) { const int rt = i >> 5, ip = i & 31, hi_ = (ip >> 2) & 1, r = (ip & 3) + 4 * (ip >> 3);
          U[lo + (unsigned)((rt * 16 + r) * 64 + 32 * hi_)] = (bf16)f2bf(XU[i]); } }
    asm volatile("" ::: "memory");
    { int lz = lane; asm volatile("" : "+v"(lz)); lane = lz; }
    { const int s = lane >> 4, sw = swz16(lane & 15), hsel = (sw >> 3) & 1, el = sw & 7; bf16* W = (bf16*)(rec + OFF_W); const unsigned lo = (unsigned)((s * 64 + 32 * hsel) * 8 + el);
#pragma unroll
      for (int i = 0; i < 64; ++i) { const int rt = i >> 5, ip = i & 31; W[lo + (unsigned)((rt * 256 + ip) * 8)] = (bf16)f2bf(-XW[i]); } }
}
__device__ __forceinline__ void g1_unit(const Frame& F, int b, int n) {
    int lane_ = F.lane; asm volatile("" : "+v"(lane_));
    const int lane = lane_, h = F.wave, r32 = lane & 31, hi = lane >> 5;
    LAS float* Lm = (LAS float*)(F.lds + RING_OFF) + h * 4096;
    LAS float* gcs = (LAS float*)(F.lds + LDSCTL_OFF + 1024) + h * 128;
    LAS float* bts = gcs + 64;
    const size_t row0 = (size_t)b * SEQ + 64 * n;
    unsigned char* rec = F.GCH + ((size_t)(b * NCH + n) * NH + h) * REC;
    const float beta_l = F.GB[(row0 + lane) * 16 + h]; float gc = F.GB[(row0 + lane) * 16 + 8 + h];
#pragma unroll
    for (int off = 1; off < 64; off <<= 1) { const float t = __int_as_float(__builtin_amdgcn_ds_bpermute((lane - off) << 2, __float_as_int(gc))); if (lane >= off) gc += t; }
    const float gl = rdlane(gc, 63);
    gcs[lane] = gc; bts[lane] = beta_l;
    if (lane == 0) F.EGL[(size_t)(b * NH + h) * NCH + n] = __expf(gl);
    bf16x8 kf[2][4], qf[2][4];
#pragma unroll
    for (int t = 0; t < 2; ++t)
#pragma unroll
        for (int s = 0; s < 4; ++s) { const bf16* base = F.GQKV + (row0 + 32 * t + r32) * 1536 + h * 64 + 16 * s + 8 * hi; qf[t][s] = *(const bf16x8*)base; kf[t][s] = *(const bf16x8*)(base + 512); }
    LDS_WAIT(); asm volatile("" ::: "memory");
#pragma unroll
    for (int tt = 0; tt < 3; ++tt) { const int it = tt == 0 ? 0 : 1, jt = tt == 2 ? 1 : 0;
        f32x16 acc;
#pragma unroll
        for (int r = 0; r < 16; ++r) acc[r] = 0.f;
#pragma unroll
        for (int s = 0; s < 4; ++s) acc = __builtin_amdgcn_mfma_f32_32x32x16_bf16(kf[jt][s], kf[it][s], acc, 0, 0, 0);
        const int i = 32 * it + r32; const float gci = gcs[i], bi = bts[i];
#pragma unroll
        for (int r = 0; r < 16; ++r) { const int j = 32 * jt + crow(r, hi); const float v = j < i ? bi * acc[r] * __expf(gci - gcs[j]) : 0.f; Lm[i * 64 + (j ^ ((i & 7) << 2))] = v; } }
#pragma unroll
    for (int tt = 0; tt < 4; ++tt) { const int it = tt >> 1, ct = tt & 1;
        if (ct <= it) {
            f32x16 acc;
#pragma unroll
            for (int r = 0; r < 16; ++r) acc[r] = 0.f;
#pragma unroll
            for (int s = 0; s < 4; ++s) acc = __builtin_amdgcn_mfma_f32_32x32x16_bf16(kf[ct][s], qf[it][s], acc, 0, 0, 0);
            const int i = 32 * it + r32; const float gci = gcs[i];
#pragma unroll
            for (int r = 0; r < 16; ++r) { const int c = 32 * ct + crow(r, hi); acc[r] = c <= i ? acc[r] * __expf(gci - gcs[c]) : 0.f; }
#pragma unroll
            for (int hf = 0; hf < 2; ++hf) *(bf16x8*)(rec + (unsigned)(OFF_QK + (it * 4 + 2 * ct + hf) * 1024) + (unsigned)lane * 16u) =
                pack8(acc[8 * hf], acc[8 * hf + 1], acc[8 * hf + 2], acc[8 * hf + 3], acc[8 * hf + 4], acc[8 * hf + 5], acc[8 * hf + 6], acc[8 * hf + 7]);
        } else { unsigned z = 0u; asm volatile("" : "+v"(z));
#pragma unroll
            for (int hf = 0; hf < 2; ++hf) *(v4u*)(rec + (unsigned)(OFF_QK + (it * 4 + 2 * ct + hf) * 1024) + (unsigned)lane * 16u) = (v4u){z, z, z, z}; } }
    LDS_WAIT(); asm volatile("" ::: "memory");
#pragma unroll
    for (int t = 0; t < 2; ++t) { const float eg = __expf(gcs[32 * t + r32]);
#pragma unroll
        for (int s = 0; s < 4; ++s) { const v4u own = __builtin_bit_cast(v4u, qf[t][s]);
            const unsigned s0 = hi ? own.x : own.z, s1 = hi ? own.y : own.w;
            const unsigned p0 = (unsigned)__builtin_amdgcn_ds_bpermute((lane ^ 32) << 2, (int)s0), p1 = (unsigned)__builtin_amdgcn_ds_bpermute((lane ^ 32) << 2, (int)s1);
            const unsigned d0 = hi ? p0 : own.x, d1 = hi ? p1 : own.y, d2 = hi ? own.z : p0, d3 = hi ? own.w : p1;
            v4u o; o.x = cvt2(__uint_as_float(d0 << 16) * eg, __uint_as_float(d0 & 0xffff0000u) * eg); o.y = cvt2(__uint_as_float(d1 << 16) * eg, __uint_as_float(d1 & 0xffff0000u) * eg);
            o.z = cvt2(__uint_as_float(d2 << 16) * eg, __uint_as_float(d2 & 0xffff0000u) * eg); o.w = cvt2(__uint_as_float(d3 << 16) * eg, __uint_as_float(d3 & 0xffff0000u) * eg);
            *(v4u*)(rec + (unsigned)(OFF_QG + (t * 4 + s) * 1024) + (unsigned)lane * 16u) = o; } }
    const bf16* vcol0 = F.GQKV + row0 * 1536 + 1024 + h * 64; const bf16* kcol0 = F.GQKV + row0 * 1536 + 512 + h * 64;
    const bf16* kcol = kcol0 + lane;
    { const int rt = lane >> 5;
#pragma unroll
      for (int s = 0; s < 4; ++s)
#pragma unroll
          for (int hh = 0; hh < 2; ++hh) { float v[8];
#pragma unroll
              for (int j = 0; j < 8; ++j) { const int c = 16 * s + 8 * (j >> 2) + 4 * hh + (j & 3); v[j] = bf2f(kcol[(size_t)c * 1536]) * __expf(gl - gcs[c]); }
              *(bf16x8*)(rec + OFF_KD + (unsigned)(rt * 4096 + (lane & 31) * 16) + (unsigned)(s * 1024 + hh * 512)) = pack8(v[0], v[1], v[2], v[3], v[4], v[5], v[6], v[7]); } }
    asm volatile("" ::: "memory");
    { int l2 = lane; asm volatile("" : "+v"(l2)); solve_both(F, Lm, gcs, bts, vcol0, kcol0, rec, l2); }
    LDS_WAIT(); asm volatile("" ::: "memory");
}
__device__ __forceinline__ void chain_short(const Frame& F, int mode, int idx) {
    const int lane = F.lane; int h, total, rbase; float S[64];
    if (mode == 0) { h = idx; total = NMETA; rbase = R_META;
#pragma unroll
        for (int d = 0; d < 64; ++d) S[d] = 0.f; }
    else { h = idx & 7; total = NST; rbase = R_SAMP + (idx >> 3) * NST;
#pragma unroll
        for (int d = 0; d < 64; ++d) S[d] = F.state_ssm[((size_t)idx * 64 + d) * 64 + lane]; }
    for (int i = 0; i < total; ++i) { const size_t r = rbase + i;
        const float q = bf2f(F.GQKV[r * 1536 + h * 64 + lane]), k = bf2f(F.GQKV[r * 1536 + 512 + h * 64 + lane]), v = bf2f(F.GQKV[r * 1536 + 1024 + h * 64 + lane]);
        const float beta = F.GB[r * 16 + h], eg = expf(F.GB[r * 16 + 8 + h]);
        float k0 = 0.f, k1 = 0.f;
#pragma unroll
        for (int d = 0; d < 64; d += 2) { k0 += rdlane(k, d) * S[d]; k1 += rdlane(k, d + 1) * S[d + 1]; }
        const float vnew = beta * (v - eg * (k0 + k1));
        float o0 = 0.f, o1 = 0.f;
#pragma unroll
        for (int d = 0; d < 64; d += 2) { S[d] = eg * S[d] + rdlane(k, d) * vnew; o0 += rdlane(q, d) * S[d]; S[d + 1] = eg * S[d + 1] + rdlane(k, d + 1) * vnew; o1 += rdlane(q, d + 1) * S[d + 1]; }
        F.GO[r * 512 + h * 64 + lane] = o0 + o1; }
    float* so = mode == 0 ? F.S1 + (size_t)h * 4096 : F.out + O_SSMS + (size_t)idx * 4096;
#pragma unroll
    for (int d = 0; d < 64; ++d) so[d * 64 + lane] = S[d];
}
__device__ __forceinline__ void g1_phase(const Frame& F) {
    for (int u = F.vcu; u < NB * NCH; u += F.G) g1_unit(F, u / NCH, u % NCH);
    const int gw = F.vcu * NWAVES + F.wave, NGW = F.G * NWAVES;
    for (int t = NGW - 1 - gw; t < NH + NSB * NH; t += NGW) { if (t < NH) chain_short(F, 0, t); else chain_short(F, 1, t - NH); }
}
__device__ __forceinline__ void g2_task(const Frame& F, int b, int h, int cb) {
    int lane_ = F.lane; asm volatile("" : "+v"(lane_));
    const int lane = lane_, r32 = lane & 31, hi = lane >> 5;
    LAS unsigned char* base = F.lds + RING_OFF;
    constexpr int BUF = 36864;
    const unsigned char* recs = F.GCH + ((size_t)(b * NCH) * NH + h) * REC;
    f32x16 S0, S1, V0, V1, O0, O1;
    { const float* s1 = F.S1 + (size_t)h * 4096 + 32 * cb + r32;
#pragma unroll
      for (int r = 0; r < 16; ++r) { S0[r] = s1[(size_t)crow(r, hi) * 64]; S1[r] = s1[(size_t)(32 + crow(r, hi)) * 64]; } }
    const float egl_l = lane < NCH ? F.EGL[(size_t)(b * NH + h) * NCH + lane] : 0.f;
    const unsigned voff16 = (unsigned)lane * 16u;
#define G2_ISSUE(n, buf) do { const unsigned char* rc_ = recs + (size_t)(n) * NH * REC; LAS unsigned char* d_ = base + (buf) * BUF; \
        _Pragma("unroll") for (int f_ = 0; f_ < 32; ++f_) __builtin_amdgcn_global_load_lds((const unsigned*)(rc_ + f_ * 1024 + voff16), (LAS unsigned*)(d_ + f_ * 1024), 16, 0, 0); \
        _Pragma("unroll") for (int f_ = 0; f_ < 4; ++f_) __builtin_amdgcn_global_load_lds((const unsigned*)(rc_ + OFF_U + (cb * 4 + f_) * 1024 + voff16), (LAS unsigned*)(d_ + 32768 + f_ * 1024), 16, 0, 0); } while (0)
    G2_ISSUE(0, 0);
    for (int n = 0; n < NCH; ++n) {
        asm volatile("s_waitcnt vmcnt(0)" ::: "memory");
        if (n + 1 < NCH) G2_ISSUE(n + 1, (n + 1) & 1);
        const LAS unsigned char* bf = base + (n & 1) * BUF;
#define G2_FR(off, f) (*(const LAS bf16x8*)(bf + (off) + (f) * 1024 + lane * 16))
        bf16x8 sb[4];
        sb[0] = pack8(S0[0], S0[1], S0[2], S0[3], S0[4], S0[5], S0[6], S0[7]); sb[1] = pack8(S0[8], S0[9], S0[10], S0[11], S0[12], S0[13], S0[14], S0[15]);
        sb[2] = pack8(S1[0], S1[1], S1[2], S1[3], S1[4], S1[5], S1[6], S1[7]); sb[3] = pack8(S1[8], S1[9], S1[10], S1[11], S1[12], S1[13], S1[14], S1[15]);
        { const LAS unsigned* up = (const LAS unsigned*)(bf + 32768);
#pragma unroll
          for (int r = 0; r < 16; ++r) { V0[r] = bf2f(((const LAS bf16*)up)[(0 * 16 + r) * 64 + lane]); V1[r] = bf2f(((const LAS bf16*)up)[(1 * 16 + r) * 64 + lane]); O0[r] = 0.f; O1[r] = 0.f; } }
#pragma unroll
        for (int s = 0; s < 4; ++s) { V0 = __builtin_amdgcn_mfma_f32_32x32x16_bf16(G2_FR(OFF_W, s), sb[s], V0, 0, 0, 0); V1 = __builtin_amdgcn_mfma_f32_32x32x16_bf16(G2_FR(OFF_W, 4 + s), sb[s], V1, 0, 0, 0);
            O0 = __builtin_amdgcn_mfma_f32_32x32x16_bf16(G2_FR(OFF_QG, s), sb[s], O0, 0, 0, 0); O1 = __builtin_amdgcn_mfma_f32_32x32x16_bf16(G2_FR(OFF_QG, 4 + s), sb[s], O1, 0, 0, 0); }
        bf16x8 vb[4];
        vb[0] = pack8(V0[0], V0[1], V0[2], V0[3], V0[4], V0[5], V0[6], V0[7]); vb[1] = pack8(V0[8], V0[9], V0[10], V0[11], V0[12], V0[13], V0[14], V0[15]);
        vb[2] = pack8(V1[0], V1[1], V1[2], V1[3], V1[4], V1[5], V1[6], V1[7]); vb[3] = pack8(V1[8], V1[9], V1[10], V1[11], V1[12], V1[13], V1[14], V1[15]);
        const float egl = rdlane(egl_l, n);
#pragma unroll
        for (int r = 0; r < 16; ++r) { S0[r] *= egl; S1[r] *= egl; }
#pragma unroll
        for (int s = 0; s < 4; ++s) { O0 = __builtin_amdgcn_mfma_f32_32x32x16_bf16(G2_FR(OFF_QK, s), vb[s], O0, 0, 0, 0); O1 = __builtin_amdgcn_mfma_f32_32x32x16_bf16(G2_FR(OFF_QK, 4 + s), vb[s], O1, 0, 0, 0);
            S0 = __builtin_amdgcn_mfma_f32_32x32x16_bf16(G2_FR(OFF_KD, s), vb[s], S0, 0, 0, 0); S1 = __builtin_amdgcn_mfma_f32_32x32x16_bf16(G2_FR(OFF_KD, 4 + s), vb[s], S1, 0, 0, 0); }
#undef G2_FR
        { unsigned* go = (unsigned*)F.GO + (size_t)((((b * NCH + n) * NH + h) * 2 + cb) * 2) * 512;
          unsigned lo = (unsigned)lane; asm volatile("" : "+v"(lo));
#pragma unroll
          for (int r = 0; r < 16; r += 2) { go[lo + (unsigned)((r >> 1) * 64)] = cvt2(O0[r], O0[r + 1]); go[lo + (unsigned)(512 + (r >> 1) * 64)] = cvt2(O1[r], O1[r + 1]); } }
    }
#undef G2_ISSUE
    { float* so = F.out + O_SSMP + ((size_t)b * NH + h) * 4096 + 32 * cb + r32;
#pragma unroll
      for (int r = 0; r < 16; ++r) { so[(size_t)crow(r, hi) * 64] = S0[r]; so[(size_t)(32 + crow(r, hi)) * 64] = S1[r]; } }
}
__device__ __forceinline__ void g2_phase(const Frame& F) {
    if (F.wave == 0) for (int t = F.vcu; t < NB * NH * 2; t += F.G) g2_task(F, t >> 4, (t >> 1) & 7, t & 1);
}
}
__device__ __forceinline__ void p4_mixers(Frame& F) {
    if (F.G == 256) {
        const int v = F.vcu, first = v < 128, w = v & 127, bh = w >> 1, b = bh >> 3, h = bh & 7;
        const unsigned ql = first ? ((w & 1) ? 0xF04u : 0xFF5u) : ((w & 1) ? 0x126u : 0xF37u);
        if (first && F.wave == 0) gdn::g2_task(F, b, h, v & 1);
        if (!first) sa::attn_unit(F, v >> 3, v & 7);
        for (int i = 0; i < 3; ++i) { const int qb = (int)((ql >> (4 * i)) & 0xFu); if (qb != 0xF) fa::attn_unit(F, b, h, qb); }
        if (first) sa::attn_unit(F, v >> 3, v & 7);
        __syncthreads();
    } else {
        gdn::g2_phase(F);
        fa::attn_phase(F);
        sa::attn_phase(F);
    }
}
__device__ __forceinline__ void p5_post(Frame& F) {
    const int lane = F.lane; const int gw = F.vcu * NWAVES + F.wave, NGW = F.G * NWAVES;
    LAS float* wl = (LAS float*)(F.lds + RING_OFF) + F.wave * 256;
    const bool bal = (F.G == 256);
    const int t0 = bal ? (F.wave < 4 ? F.wave * 256 + F.vcu : NSB * 32) : gw, tstep = bal ? NSB * 32 : NGW;
    for (int t = t0; t < NSB * 32; t += tstep) { const int bs = t >> 5, rr = t & 31, tt = rr >> 3, h = rr & 7;
        float M = -INFINITY;
        for (int s = 0; s < sa::NSPL; ++s) M = fmaxf(M, F.PSTAT[(((size_t)bs * sa::NSPL + s) * 32 + rr) * 2]);
        float L = 0.f, o[4] = {0.f, 0.f, 0.f, 0.f};
        for (int s = 0; s < sa::NSPL; ++s) { const float* ps = F.PSTAT + (((size_t)bs * sa::NSPL + s) * 32 + rr) * 2; const float w = __builtin_amdgcn_exp2f(ps[0] - M); L += w * ps[1];
            const float* po = F.PART + (((size_t)bs * sa::NSPL + s) * 32 + rr) * 256;
#pragma unroll
            for (int k = 0; k < 4; ++k) o[k] += w * po[lane + 64 * k]; }
        {
          float ql[4];
#pragma unroll
          for (int k = 0; k < 4; ++k) ql[k] = F.QLAT[((size_t)bs * 32 + rr) * 256 + lane + 64 * k];
          const float qp = lane < 32 ? bf2f(F.QM[(size_t)(R_SAMP + bs * NST + tt) * 768 + 512 + h * 32 + lane]) : 0.f;
          for (int j = 0; j <= tt; ++j) { const float* lj = F.out + O_LATS + ((size_t)bs * NST + j) * KVLORA; const float* kj = F.KPE + (size_t)(R_SAMP + bs * NST + j) * 32;
              float lv[4]; float part = lane < 32 ? qp * kj[lane] : 0.f;
#pragma unroll
              for (int k = 0; k < 4; ++k) { lv[k] = lj[lane + 64 * k]; part += ql[k] * lv[k]; }
              const float sj = wave_sum(part); const float M2 = fmaxf(M, sj); const float sc = __builtin_amdgcn_exp2f(M - M2), pj = __builtin_amdgcn_exp2f(sj - M2);
              L = L * sc + pj; M = M2;
#pragma unroll
              for (int k = 0; k < 4; ++k) o[k] = o[k] * sc + pj * lv[k]; } }
        const float inv = 1.0f / L;
#pragma unroll
        for (int k = 0; k < 4; ++k) wl[lane + 64 * k] = o[k] * inv;
        LDS_WAIT(); asm volatile("" ::: "memory");
        float a = 0.f; const float* w = F.w_kv_b + h * 128 + 64 + lane;
        for (int c = 0; c < 256; ++c) a += wl[c] * w[(size_t)c * 1024];
        F.MIX[(size_t)(R_SAMP + bs * NST + tt) * 1024 + 512 + h * 64 + lane] = (bf16)f2bf(a);
        LDS_WAIT(); asm volatile("" ::: "memory"); }
    { const int h = lane >> 3, j = lane & 7;
      const f32x4 gn0 = *(const f32x4*)(F.gdn_norm_g + 8 * j), gn1 = *(const f32x4*)(F.gdn_norm_g + 8 * j + 4);
      const int nr = bal ? (F.wave < 4 ? 5 : (F.wave == 7 ? 12 : 11)) : (MT - gw + NGW - 1) / NGW;
      const int rbase = bal ? F.vcu * 65 + (F.wave < 4 ? F.wave * 5 : 20 + (F.wave - 4) * 11) : gw, rstride = bal ? 1 : NGW;
      static_assert(MT == 256 * 65, "balanced row split");
      for (int k0 = 0; k0 < nr; k0 += 4) {
        f32x4 oa[4], ob[4]; v4u zz[4]; int rq[4];
#pragma unroll
        for (int q = 0; q < 4; ++q) { const int r = (k0 + q < nr) ? rbase + (k0 + q) * rstride : MT; rq[q] = r < MT ? r : -1;
            oa[q] = (f32x4){0.f, 0.f, 0.f, 0.f}; ob[q] = oa[q]; zz[q] = (v4u){0u, 0u, 0u, 0u};
            if (r < R_END) {
                if (r < R_META) { const int b_ = r >> 11, n_ = (r >> 6) & 31, tk = r & 63, rt = tk >> 5, ip = tk & 31, hi_ = (ip >> 2) & 1, rr_ = (ip & 3) + 4 * (ip >> 3);
                    const unsigned* op = (const unsigned*)F.GO + (size_t)((((((b_ * 32 + n_) * NH + h) * 2 + (j >> 2)) * 2 + rt) * 8 + (rr_ >> 1)) * 64) + 8 * (j & 3) + 32 * hi_;
                    const v4u w0 = *(const v4u*)op, w1 = *(const v4u*)(op + 4);
                    if (rr_ & 1) { oa[q] = (f32x4){__uint_as_float(w0.x & 0xffff0000u), __uint_as_float(w0.y & 0xffff0000u), __uint_as_float(w0.z & 0xffff0000u), __uint_as_float(w0.w & 0xffff0000u)};
                                   ob[q] = (f32x4){__uint_as_float(w1.x & 0xffff0000u), __uint_as_float(w1.y & 0xffff0000u), __uint_as_float(w1.z & 0xffff0000u), __uint_as_float(w1.w & 0xffff0000u)}; }
                    else { oa[q] = (f32x4){__uint_as_float(w0.x << 16), __uint_as_float(w0.y << 16), __uint_as_float(w0.z << 16), __uint_as_float(w0.w << 16)};
                           ob[q] = (f32x4){__uint_as_float(w1.x << 16), __uint_as_float(w1.y << 16), __uint_as_float(w1.z << 16), __uint_as_float(w1.w << 16)}; } }
                else { const float* op = F.GO + (size_t)r * 512 + h * 64 + 8 * j; oa[q] = *(const f32x4*)op; ob[q] = *(const f32x4*)(op + 4); }
                zz[q] = *(const v4u*)(F.PRJ + (size_t)r * NPRJ + C_Z + h * 64 + 8 * j); } }
#pragma unroll
        for (int q = 0; q < 4; ++q) { const int r = rq[q]; if (r < 0) continue;
            bf16* mrow = F.MIX + (size_t)r * 1024;
            if (r >= R_END) { *(v4u*)(mrow + 8 * lane) = (v4u){0u, 0u, 0u, 0u}; *(v4u*)(mrow + 512 + 8 * lane) = (v4u){0u, 0u, 0u, 0u}; continue; }
            const f32x4 o0 = oa[q], o1 = ob[q]; const v4u zw = zz[q];
            float ss = (o0.x * o0.x + o0.y * o0.y) + (o0.z * o0.z + o0.w * o0.w) + (o1.x * o1.x + o1.y * o1.y) + (o1.z * o1.z + o1.w * o1.w);
            ss += __shfl_xor(ss, 1); ss += __shfl_xor(ss, 2); ss += __shfl_xor(ss, 4);
            const float rs = 1.0f / sqrtf(ss * (1.0f / 64.0f) + EPS);
            v4u w;
            w.x = pk2(o0.x * rs * gn0.x * silu_f(__uint_as_float(zw.x << 16)), o0.y * rs * gn0.y * silu_f(__uint_as_float(zw.x & 0xffff0000u)));
            w.y = pk2(o0.z * rs * gn0.z * silu_f(__uint_as_float(zw.y << 16)), o0.w * rs * gn0.w * silu_f(__uint_as_float(zw.y & 0xffff0000u)));
            w.z = pk2(o1.x * rs * gn1.x * silu_f(__uint_as_float(zw.z << 16)), o1.y * rs * gn1.y * silu_f(__uint_as_float(zw.z & 0xffff0000u)));
            w.w = pk2(o1.z * rs * gn1.z * silu_f(__uint_as_float(zw.w << 16)), o1.w * rs * gn1.w * silu_f(__uint_as_float(zw.w & 0xffff0000u)));
            *(v4u*)(mrow + h * 64 + 8 * j) = w;
            if (r >= R_META && r < R_SAMP) *(v4u*)(mrow + 512 + 8 * lane) = (v4u){0u, 0u, 0u, 0u}; }
      } }
}
__device__ __forceinline__ void p9_final(Frame& F) {
    const int gw = F.vcu * NWAVES + F.wave, NGW = F.G * NWAVES;
    { int lane = F.lane; asm volatile("" : "+v"(lane));
      const f32x4* gv = (const f32x4*)F.final_g; f32x4 g4[4];
      g4[0] = gv[2 * lane]; g4[1] = gv[2 * lane + 1]; g4[2] = gv[128 + 2 * lane]; g4[3] = gv[128 + 2 * lane + 1];
      for (int i0 = gw; i0 < NREAL; i0 += 4 * NGW) {
        v4u hb[4][2]; int rr[4];
#pragma unroll
        for (int q = 0; q < 4; ++q) { const int r = i0 + q * NGW; rr[q] = r < NREAL ? r : -1;
            if (rr[q] >= 0) { const bf16* hp = F.H2B + (size_t)r * D + 8 * lane; hb[q][0] = *(const v4u*)hp; hb[q][1] = *(const v4u*)(hp + 512); }
            else { hb[q][0] = (v4u){0u, 0u, 0u, 0u}; hb[q][1] = hb[q][0]; } }
#pragma unroll
        for (int q = 0; q < 4; ++q) { if (rr[q] < 0) continue;
            f32x4 v[4];
#pragma unroll
            for (int k = 0; k < 2; ++k) { const v4u w = hb[q][k];
                v[2 * k] = (f32x4){__uint_as_float(w.x << 16), __uint_as_float(w.x & 0xffff0000u), __uint_as_float(w.y << 16), __uint_as_float(w.y & 0xffff0000u)};
                v[2 * k + 1] = (f32x4){__uint_as_float(w.z << 16), __uint_as_float(w.z & 0xffff0000u), __uint_as_float(w.w << 16), __uint_as_float(w.w & 0xffff0000u)}; }
            float s = 0.f;
#pragma unroll
            for (int j = 0; j < 4; ++j) s += (v[j].x * v[j].x + v[j].y * v[j].y) + (v[j].z * v[j].z + v[j].w * v[j].w);
            const float rstd = 1.0f / sqrtf(wave_sum(s) * (1.0f / D) + EPS);
            float* o = F.out + O_YP + (size_t)rr[q] * D + 8 * lane;
            *(f32x4*)o = v[0] * rstd * g4[0]; *(f32x4*)(o + 4) = v[1] * rstd * g4[1]; *(f32x4*)(o + 512) = v[2] * rstd * g4[2]; *(f32x4*)(o + 516) = v[3] * rstd * g4[3]; }
      } }
    { const f32x4* gv = (const f32x4*)F.final_g + F.lane; f32x4 g4[4];
#pragma unroll
      for (int j = 0; j < 4; ++j) g4[j] = gv[64 * j];
      for (int i = gw; i < NSAMP; i += NGW) { const int r = R_SAMP + i;
        const f32x4* hv = (const f32x4*)(F.H2 + (size_t)r * D) + F.lane; f32x4 v[4];
#pragma unroll
        for (int j = 0; j < 4; ++j) v[j] = hv[64 * j];
        float s = 0.f;
#pragma unroll
        for (int j = 0; j < 4; ++j) s += (v[j].x * v[j].x + v[j].y * v[j].y) + (v[j].z * v[j].z + v[j].w * v[j].w);
        const float rstd = 1.0f / sqrtf(wave_sum(s) * (1.0f / D) + EPS);
        float* o = F.out + O_YS + (size_t)i * D;
#pragma unroll
        for (int j = 0; j < 4; ++j) *((f32x4*)o + F.lane + 64 * j) = v[j] * rstd * g4[j]; } }
}

struct Args { const void* in[23]; float* out; unsigned char* ws; int ph_lo, ph_hi, li, pad; };
__global__ void __launch_bounds__(NWAVES * 64, 2) mk_fwd(Args args) {
    extern __shared__ __attribute__((aligned(16))) unsigned char lds[];
    Frame F;
    F.lds = (LAS unsigned char*)lds;
    F.MISC = (volatile LAS unsigned*)(F.lds + MISC_OFF);
    F.tid = threadIdx.x; F.lane = F.tid & 63; F.wave = __builtin_amdgcn_readfirstlane(F.tid >> 6);
    F.G = gridDim.x; F.vcu = blockIdx.x;
    unsigned char* ws = args.ws;
    F.ctl = (gu32*)(ws + WS_CTL);
    F.x_prompt = (const float*)args.in[0]; F.x_sample = (const float*)args.in[1]; F.cache_latent = (const float*)args.in[2]; F.cache_krope = (const float*)args.in[3];
    F.state_conv = (const float*)args.in[4]; F.state_ssm = (const float*)args.in[5]; F.page_table = (const int*)args.in[6]; F.meta = (const float*)args.in[7];
    F.norm_mix_g = (const float*)args.in[8]; F.w_in = (const float*)args.in[9]; F.conv_w = (const float*)args.in[10]; F.a_log = (const float*)args.in[11]; F.dt_bias = (const float*)args.in[12];
    F.gdn_norm_g = (const float*)args.in[13]; F.q_norm_g = (const float*)args.in[14]; F.w_q_b = (const float*)args.in[15]; F.kv_norm_g = (const float*)args.in[16]; F.w_kv_b = (const float*)args.in[17];
    F.w_out = (const float*)args.in[18]; F.norm_mlp_g = (const float*)args.in[19]; F.w_up = (const float*)args.in[20]; F.w_down = (const float*)args.in[21]; F.final_g = (const float*)args.in[22];
    F.out = args.out;
    F.WIN = (bf16*)(ws + WS_WIN); F.WQB = (bf16*)(ws + WS_WQB); F.WKVB = (bf16*)(ws + WS_WKVB); F.WOUT = (bf16*)(ws + WS_WOUT); F.WUP = (bf16*)(ws + WS_WUP); F.WDN = (bf16*)(ws + WS_WDN);
    F.XN = (bf16*)(ws + WS_XN); F.PRJ = (bf16*)(ws + WS_PRJ); F.CQN = (bf16*)(ws + WS_CQN); F.LATN = (bf16*)(ws + WS_LATN); F.QM = (bf16*)(ws + WS_QM); F.KV = (bf16*)(ws + WS_KV);
    F.MIX = (bf16*)(ws + WS_MIX); F.H1B = (bf16*)(ws + WS_H1B); F.HFF = (bf16*)(ws + WS_HFF); F.KPEB = (bf16*)(ws + WS_KPEB); F.ROPE = (float*)(ws + WS_ROPE); F.QLAT = (float*)(ws + WS_QLAT); F.EGL = (float*)(ws + WS_EGL); F.S1 = (float*)(ws + WS_S1); F.GCH = ws + WS_GCH;
    F.KPE = (float*)(ws + WS_KPE); F.GQKV = (bf16*)(ws + WS_GQKV); F.GB = (float*)(ws + WS_GB); F.GO = (float*)(ws + WS_GO); F.H2B = (bf16*)(ws + WS_H2B); F.H2 = (float*)(ws + WS_H2);
    F.PART = (float*)(ws + WS_PART); F.PSTAT = (float*)(ws + WS_PSTAT); F.SS1 = (float*)(ws + WS_CTL) + CW_SS1;
    for (int u = F.tid; u < (LDS_BYTES - LDSCTL_OFF) / 4; u += NWAVES * 64) ((LAS unsigned*)(F.lds + LDSCTL_OFF))[u] = 0u;
    __syncthreads();
    XcdBarrier bar; bar.bar = (unsigned*)(F.ctl + CW_BAR); bar.x = 0; bar.st = nullptr;
    if (N_LAUNCHES == 1) bar = xcd_barrier_post((unsigned*)(F.ctl + CW_BAR), F.MISC + 8);
#define GRID_BAR() do { if (N_LAUNCHES == 1) xcd_barrier(bar); } while (0)
    const int lo = args.ph_lo, hi = args.ph_hi;
#define IN(k) (lo <= (k) && (k) < hi)
#define BOTH(k) (IN(k) && IN((k) + 1))

    if (IN(0)) { p0_prologue(F); VM_WAIT(); __syncthreads(); if (BOTH(0)) GRID_BAR(); }
    if (IN(1)) {
        pg8::Gemm g{F.XN, F.WIN, MT, NPRJ, D, D}; pg8::StaticOrder S; S.init(MT, NPRJ, F.G, (int)blockIdx.x);
        pg8::EpiStoreBf16 E{F.PRJ, NPRJ};
        pg8::gemm_phase<pg8::EpiStoreBf16, pg8::StaticOrder, true, true>(F.lds + RING_OFF, g, S, E);
        if (BOTH(1)) GRID_BAR();
    }
    if (IN(2)) {
        const int gw = F.vcu * NWAVES + F.wave, NGW = F.G * NWAVES;
        { int lane_ = F.lane; asm volatile("" : "+v"(lane_)); P2Consts W; p2_consts(F, W, lane_);
          const int rot = (NGW == SEQ) ? 40 : 0;
#pragma clang loop unroll(disable)
          for (int k = 0; ; ++k) { int r = gw + k * NGW; if (r >= MT) break;
              if (r < R_META) r = (r & ~(SEQ - 1)) | ((r + rot * k) & (SEQ - 1));
              const int s2 = r & (SEQ - 1); if (r < R_META && s2 >= 3 && s2 < SEQ - 3) p2_row_fast(F, r, W, lane_); else p2_row(F, r); } }
        VM_WAIT(); __syncthreads();
        if (BOTH(2)) GRID_BAR();
    }
    if (IN(3)) {
        { pg8::Gemm g{F.CQN, F.WQB, MT, 768, QLORA, QLORA}; pg8::StaticOrder S; S.init(MT, 768, F.G, (int)blockIdx.x);
          pg8::EpiQ E{F.QM, F.ROPE, MLA_SCALE * 1.4426950408889634f};
          pg8::gemm_phase<pg8::EpiQ, pg8::StaticOrder, true, true>(F.lds + RING_OFF, g, S, E); }
        { pg8::Gemm g{F.LATN, F.WKVB, MT, 1024, KVLORA, KVLORA}; pg8::StaticOrder S; S.init(MT, 1024, F.G, ((int)blockIdx.x + 8) % (int)gridDim.x);
          pg8::EpiStoreBf16 E{F.KV, 1024};
          pg8::gemm_phase<pg8::EpiStoreBf16, pg8::StaticOrder, true, true>(F.lds + RING_OFF, g, S, E); }
        gdn::g1_phase(F); VM_WAIT(); __syncthreads();
        if (BOTH(3)) GRID_BAR();
    }
    if (IN(4)) { p4_mixers(F); VM_WAIT(); __syncthreads(); if (BOTH(4)) GRID_BAR(); }
    if (IN(5)) { p5_post(F); VM_WAIT(); __syncthreads(); if (BOTH(5)) GRID_BAR(); }
    const bool split_tail = (F.G == 256);
    if (IN(6)) {
        const int Mrows = split_tail ? NREAL : MT;
        pg8::Gemm g{F.MIX, F.WOUT, Mrows, D, 1024, 1024}; pg8::StaticOrder S; S.init(Mrows, D, F.G, (int)blockIdx.x);
        pg8::EpiResid1 E{F.x_prompt, F.meta, F.x_sample, F.H1B, F.SS1, F.H2};
        pg8::gemm_phase<pg8::EpiResid1, pg8::StaticOrder, true, true>(F.lds + RING_OFF, g, S, E);
        if (BOTH(6)) GRID_BAR();
    }
    if (IN(7)) {
        gu32* cnt6 = F.ctl + CW_CNT6;
        if (split_tail && blockIdx.x < 4) {
            pg8::Gemm g{F.MIX, F.WOUT, MT, D, 1024, 1024}; pg8::OneUnit S{64, (int)blockIdx.x};
            pg8::EpiResid1 E{F.x_prompt, F.meta, F.x_sample, F.H1B, F.SS1, F.H2};
            pg8::gemm_phase<pg8::EpiResid1, pg8::OneUnit, true, true>(F.lds + RING_OFF, g, S, E);
            VM_WAIT(); __syncthreads();
            if (F.tid == 0) { __builtin_amdgcn_fence(__ATOMIC_RELEASE, "agent"); asm volatile("s_waitcnt vmcnt(0)" ::: "memory"); __hip_atomic_fetch_add(cnt6, 1u, RLX_AGENT); }
        }
        { const int Mrows = split_tail ? NREAL : MT;
          pg8::Gemm g{F.H1B, F.WUP, Mrows, FF, D, D}; pg8::StaticOrder S; S.init(Mrows, FF, F.G, (int)blockIdx.x);
          pg8::EpiUp E{F.HFF, FF, F.SS1};
          pg8::gemm_phase<pg8::EpiUp, pg8::StaticOrder, true, true>(F.lds + RING_OFF, g, S, E); }
        if (split_tail && blockIdx.x >= 240) {
            if (F.tid == 0) { unsigned sp = 0; while (__hip_atomic_load(cnt6, RLX_AGENT) < 4u) { __builtin_amdgcn_s_sleep(2); if (++sp > (1u << 22)) break; }
                __builtin_amdgcn_fence(__ATOMIC_ACQUIRE, "agent"); asm volatile("s_waitcnt vmcnt(0)" ::: "memory"); }
            __syncthreads();
            pg8::Gemm g{F.H1B + (size_t)NREAL * D, F.WUP, 256, FF, D, D}; pg8::OneUnit S{0, (int)blockIdx.x - 240};
            pg8::EpiUp E{F.HFF + (size_t)NREAL * FF, FF, F.SS1 + NREAL};
            pg8::gemm_phase<pg8::EpiUp, pg8::OneUnit, true, true>(F.lds + RING_OFF, g, S, E);
        }
        if (BOTH(7)) GRID_BAR();
    }
    if (IN(8)) {
        { pg8::Gemm g{F.HFF, F.WDN, NREAL, D, FF, FF}; pg8::StaticOrder S; S.init(NREAL, D, F.G, (int)blockIdx.x);
          pg8::EpiResid2 E{F.H1B, F.H2B};
          pg8::gemm_phase<pg8::EpiResid2, pg8::StaticOrder, true, true>(F.lds + RING_OFF, g, S, E); }
        { pg8::Gemm g{F.HFF + (size_t)NREAL * FF, F.WDN, 256, D, 256, FF}; pg8::SplitKOrder S; S.init(D, 16, 256, F.G, (int)blockIdx.x);
          pg8::EpiAtomicAdd E{F.H2 + (size_t)NREAL * D};
          pg8::gemm_phase<pg8::EpiAtomicAdd, pg8::SplitKOrder, true, true>(F.lds + RING_OFF, g, S, E); }
        if (BOTH(8)) GRID_BAR();
    }
    if (IN(9)) { p9_final(F); }
#undef IN
#undef BOTH
}

extern "C" void kernel_launch(void* const* d_in, const int* in_sizes, int n_in, void* d_out, int out_size, void* d_ws, size_t ws_size, hipStream_t stream) {
    static int grid = 0;
    if (grid == 0) {
        if (n_in != 23 || out_size != (int)O_END || ws_size < WS_END) { fprintf(stderr, "kernel_launch: unexpected shapes: n_in %d out %d ws %zu (need %zu); nothing launched\n", n_in, out_size, ws_size, (size_t)WS_END); grid = -1; return; }
        int dev = 0, cus = 0, per_cu = 0;
        if (hipGetDevice(&dev) != hipSuccess || hipDeviceGetAttribute(&cus, hipDeviceAttributeMultiprocessorCount, dev) != hipSuccess) { fprintf(stderr, "kernel_launch: device query failed\n"); grid = -1; return; }
        if (hipFuncSetAttribute((const void*)mk_fwd, hipFuncAttributeMaxDynamicSharedMemorySize, LDS_BYTES) != hipSuccess) { fprintf(stderr, "kernel_launch: hipFuncSetAttribute failed\n"); grid = -1; return; }
        if (hipOccupancyMaxActiveBlocksPerMultiprocessor(&per_cu, (const void*)mk_fwd, NWAVES * 64, LDS_BYTES) != hipSuccess || per_cu < 1) { fprintf(stderr, "kernel_launch: occupancy query says %d blocks per CU\n", per_cu); per_cu = 1; }
        (void)hipGetLastError();
        grid = cus;
        fprintf(stderr, "kernel_launch: grid %d (cus %d, per_cu %d)\n", grid, cus, per_cu);
    }
    if (grid < 0) return;
    if (hipMemsetAsync((char*)d_ws + WS_CTL, 0, CTL_ZERO_BYTES, stream) != hipSuccess) { fprintf(stderr, "kernel_launch: memset failed\n"); return; }
    Args a{};
    for (int i = 0; i < 23; ++i) a.in[i] = d_in[i];
    a.out = (float*)d_out; a.ws = (unsigned char*)d_ws;
    for (int li = 0; li < N_LAUNCHES; ++li) {
        if (N_LAUNCHES == 1) { a.ph_lo = 0; a.ph_hi = NPHASES; } else { a.ph_lo = li * NPHASES / N_LAUNCHES; a.ph_hi = (li + 1) * NPHASES / N_LAUNCHES; }
        a.li = li;
        hipLaunchKernelGGL(mk_fwd, dim3(grid), dim3(NWAVES * 64), LDS_BYTES, stream, a);
        if (N_LAUNCHES == NPHASES && li == DUP_PHASE) hipLaunchKernelGGL(mk_fwd, dim3(grid), dim3(NWAVES * 64), LDS_BYTES, stream, a);
        const hipError_t le = hipPeekAtLastError();
        if (le != hipSuccess) { fprintf(stderr, "kernel_launch: launch %d failed: %s\n", li, hipGetErrorName(le)); break; }
    }
}
```

```cpp
#include <hip/hip_runtime.h>
#include <cstdio>
#include <cstdint>
#include <cmath>
namespace pg8 {
#define PG8_LAS __attribute__((address_space(3)))
typedef unsigned short bf16_t;
typedef short bf16x8 __attribute__((ext_vector_type(8)));
typedef float f32x4 __attribute__((ext_vector_type(4)));
typedef unsigned u32x4 __attribute__((ext_vector_type(4)));
constexpr int BM = 256, BK = 64, HALF = 128, HTB = HALF * BK * 2  , STAGE_BYTES = 8 * HTB, NXCD = 8, WGM = 8;

__host__ __device__ __forceinline__ int lds_byte(int r, int c) { const int st = (r >> 4) * 2 + (c >> 5), rr = r & 15, cc = c & 31, ob = rr * 64 + cc * 2; return st * 1024 + (ob ^ (((ob >> 9) & 1) << 5)); }
__host__ __device__ __forceinline__ void stage_rc(int b, int& R, int& C) { const int st = b / 1024, sb = b % 1024, swz = sb ^ (((sb >> 9) & 1) << 5); R = (st >> 1) * 16 + swz / 64; C = (st & 1) * 32 + (swz % 64) / 2; }
__host__ __device__ __forceinline__ int perm32(int rho) { const int n = rho >> 4, i = rho & 15; return 8 * (i >> 2) + 4 * n + (i & 3); }

struct Unit { int pm, pn, ko; };
struct Gemm { const bf16_t* A; const bf16_t* Bt; int M, N, K, ld; };

struct StaticOrder {
    int nM, nN, nwg, G, c;
    __host__ __device__ void init(int M, int N, int G_, int c_) { nM = M / BM; nN = N / BM; nwg = nM * nN; G = G_; c = c_; }
    __host__ __device__ bool next(int i, Unit& u) const {
        const long L = (long)i * G + c; if (L >= nwg) return false;
        int wgid = (int)L; { const int q = nwg / NXCD, r = nwg % NXCD, xcd = wgid % NXCD, off = wgid / NXCD; wgid = (xcd < r ? xcd * (q + 1) : r * (q + 1) + (xcd - r) * q) + off; }
        const int nig = WGM * nN, gid = wgid / nig, fm = gid * WGM, gsz = (nM - fm) < WGM ? (nM - fm) : WGM;
        u.pm = fm + ((wgid % nig) % gsz); u.pn = (wgid % nig) / gsz; u.ko = 0; return true;
    }
    __device__ __forceinline__ void a_ready(const Unit&) const {}
    __device__ __forceinline__ void done(const Unit&) const {}
};

struct OneUnit {
    int pm, pn;
    __host__ __device__ bool next(int i, Unit& u) const { if (i != 0) return false; u.pm = pm; u.pn = pn; u.ko = 0; return true; }
    __device__ __forceinline__ void a_ready(const Unit&) const {}
    __device__ __forceinline__ void done(const Unit&) const {}
};
struct SplitKOrder {
    int nN, nS, ks, G, c;
    __host__ __device__ void init(int N, int nslices, int kslice, int G_, int c_) { nN = N / BM; nS = nslices; ks = kslice; G = G_; c = c_; }
    __host__ __device__ bool next(int i, Unit& u) const { const long L = (long)i * G + c; if (L >= nN * nS) return false; u.pm = 0; u.pn = (int)(L % nN); u.ko = (int)(L / nN) * ks; return true; }
    __device__ __forceinline__ void a_ready(const Unit&) const {}
    __device__ __forceinline__ void done(const Unit&) const {}
};
__device__ __forceinline__ unsigned cvt_pk_bf16(float lo, float hi) { unsigned r; asm volatile("v_cvt_pk_bf16_f32 %0, %1, %2" : "=v"(r) : "v"(lo), "v"(hi)); return r; }
constexpr int ROWS_REAL = 16384, ROW_META = 16384, ROW_SAMP = 16400, ROW_END = 16528;
__device__ __forceinline__ const float* x_row_ptr(const float* xp, const float* xm, const float* xs, int row) {
    if (row < ROW_META) return xp + (size_t)row * 1024;
    if (row < ROW_SAMP) return xm + (size_t)(row - ROW_META) * 1024;
    if (row < ROW_END) return xs + (size_t)(row - ROW_SAMP) * 1024;
    return nullptr;
}
struct EpiStoreBf16 {
    static constexpr bool PERM = true, AFTER_DRAIN = false;
    bf16_t* O; int ldc;
    __device__ __forceinline__ void operator()(const f32x4 (&acc)[2][2][4][2], const Unit& u, int wr, int wc, int fr, int fq) const {
        asm volatile("" : "+v"(fr), "+v"(fq));
        const int row0 = u.pm * BM + wr * 64 + fr, col0 = u.pn * BM + wc * 32 + 8 * fq;
#pragma unroll
        for (int ai = 0; ai < 2; ++ai)
#pragma unroll
            for (int m = 0; m < 4; ++m) { bf16_t* rowp = O + (size_t)(row0 + ai * HALF + m * 16) * ldc + col0;
#pragma unroll
                for (int bj = 0; bj < 2; ++bj) { const f32x4 v0 = acc[ai][bj][m][0], v1 = acc[ai][bj][m][1];
                    u32x4 w; w.x = cvt_pk_bf16(v0[0], v0[1]); w.y = cvt_pk_bf16(v0[2], v0[3]); w.z = cvt_pk_bf16(v1[0], v1[1]); w.w = cvt_pk_bf16(v1[2], v1[3]);
                    *(u32x4*)(rowp + bj * HALF) = w; } }
    }
};
struct EpiResid1 {
    static constexpr bool PERM = true, AFTER_DRAIN = false;
    const float* xp; const float* xm; const float* xs; bf16_t* H1B; float* ss; float* H2;
    __device__ __forceinline__ void operator()(const f32x4 (&acc)[2][2][4][2], const Unit& u, int wr, int wc, int fr, int fq) const {
        asm volatile("" : "+v"(fr), "+v"(fq));
        const int row0 = u.pm * BM + wr * 64 + fr, col0 = u.pn * BM + wc * 32 + 8 * fq;
#pragma unroll
        for (int ai = 0; ai < 2; ++ai)
#pragma unroll
          for (int mh = 0; mh < 2; ++mh) {
            f32x4 xv[2][2][2]; float fl[2];
#pragma unroll
            for (int mm = 0; mm < 2; ++mm) { const int row = row0 + ai * HALF + (2 * mh + mm) * 16;
                const float* xb = row < ROW_META ? xp : (row < ROW_SAMP ? xm : (row < ROW_END ? xs : xp));
                const int rel = row < ROW_META ? row : (row < ROW_SAMP ? row - ROW_META : (row < ROW_END ? row - ROW_SAMP : 0));
                fl[mm] = row < ROW_END ? 1.f : 0.f; const float* xq = xb + (size_t)rel * 1024;
#pragma unroll
                for (int bj = 0; bj < 2; ++bj) { const int col = col0 + bj * HALF; xv[mm][bj][0] = *(const f32x4*)(xq + col); xv[mm][bj][1] = *(const f32x4*)(xq + col + 4); } }
#pragma unroll
            for (int mm = 0; mm < 2; ++mm) { const int m = 2 * mh + mm; const int row = row0 + ai * HALF + m * 16; float part = 0.f;
#pragma unroll
                for (int bj = 0; bj < 2; ++bj) { const int col = col0 + bj * HALF;
                    const f32x4 v0 = acc[ai][bj][m][0] + xv[mm][bj][0] * fl[mm], v1 = acc[ai][bj][m][1] + xv[mm][bj][1] * fl[mm];
                    u32x4 w; w.x = cvt_pk_bf16(v0[0], v0[1]); w.y = cvt_pk_bf16(v0[2], v0[3]); w.z = cvt_pk_bf16(v1[0], v1[1]); w.w = cvt_pk_bf16(v1[2], v1[3]);
                    *(u32x4*)(H1B + (size_t)row * 1024 + col) = w;
                    if (u.pm == 64) { *(f32x4*)(H2 + (size_t)row * 1024 + col) = v0; *(f32x4*)(H2 + (size_t)row * 1024 + col + 4) = v1; }
                    part += (v0[0] * v0[0] + v0[1] * v0[1]) + (v0[2] * v0[2] + v0[3] * v0[3]) + (v1[0] * v1[0] + v1[1] * v1[1]) + (v1[2] * v1[2] + v1[3] * v1[3]); }
                part += __shfl_xor(part, 16); part += __shfl_xor(part, 32);
                if (fq == 0 && ss) __hip_atomic_fetch_add(ss + row, part, __ATOMIC_RELAXED, __HIP_MEMORY_SCOPE_AGENT); } }
    }
};
struct EpiUp {
    static constexpr bool PERM = true, AFTER_DRAIN = false;
    bf16_t* O; int ldc; const float* ss;
    __device__ __forceinline__ void operator()(const f32x4 (&acc)[2][2][4][2], const Unit& u, int wr, int wc, int fr, int fq) const {
        asm volatile("" : "+v"(fr), "+v"(fq));
        const int row0 = u.pm * BM + wr * 64 + fr, col0 = u.pn * BM + wc * 32 + 8 * fq;
        float ssv[2][4];
#pragma unroll
        for (int ai = 0; ai < 2; ++ai)
#pragma unroll
            for (int m = 0; m < 4; ++m) ssv[ai][m] = ss[row0 + ai * HALF + m * 16];
#pragma unroll
        for (int ai = 0; ai < 2; ++ai)
#pragma unroll
            for (int m = 0; m < 4; ++m) { const int row = row0 + ai * HALF + m * 16; bf16_t* rowp = O + (size_t)row * ldc + col0;
                const float rs = 1.0f / sqrtf(ssv[ai][m] * (1.0f / 1024.0f) + 1e-6f);
#pragma unroll
                for (int bj = 0; bj < 2; ++bj) { f32x4 v0 = acc[ai][bj][m][0] * rs, v1 = acc[ai][bj][m][1] * rs;
#pragma unroll
                    for (int e = 0; e < 4; ++e) { const float a = fmaxf(v0[e], 0.f), b = fmaxf(v1[e], 0.f); v0[e] = a * a; v1[e] = b * b; }
                    u32x4 w; w.x = cvt_pk_bf16(v0[0], v0[1]); w.y = cvt_pk_bf16(v0[2], v0[3]); w.z = cvt_pk_bf16(v1[0], v1[1]); w.w = cvt_pk_bf16(v1[2], v1[3]);
                    *(u32x4*)(rowp + bj * HALF) = w; } }
    }
};
struct EpiResid2 {
    static constexpr bool PERM = true, AFTER_DRAIN = false;
    const bf16_t* H1B; bf16_t* H2B;
    __device__ __forceinline__ void operator()(const f32x4 (&acc)[2][2][4][2], const Unit& u, int wr, int wc, int fr, int fq) const {
        asm volatile("" : "+v"(fr), "+v"(fq));
        const int row0 = u.pm * BM + wr * 64 + fr, col0 = u.pn * BM + wc * 32 + 8 * fq;
#pragma unroll
        for (int ai = 0; ai < 2; ++ai) {
            u32x4 hv[4][2];
#pragma unroll
            for (int m = 0; m < 4; ++m)
#pragma unroll
                for (int bj = 0; bj < 2; ++bj) hv[m][bj] = *(const u32x4*)(H1B + (size_t)(row0 + ai * HALF + m * 16) * 1024 + col0 + bj * HALF);
#pragma unroll
            for (int m = 0; m < 4; ++m) { const int row = row0 + ai * HALF + m * 16;
#pragma unroll
                for (int bj = 0; bj < 2; ++bj) { const size_t off = (size_t)row * 1024 + col0 + bj * HALF;
                    const u32x4 hb = hv[m][bj];
                    const f32x4 h0 = (f32x4){__uint_as_float(hb.x << 16), __uint_as_float(hb.x & 0xffff0000u), __uint_as_float(hb.y << 16), __uint_as_float(hb.y & 0xffff0000u)};
                    const f32x4 h1 = (f32x4){__uint_as_float(hb.z << 16), __uint_as_float(hb.z & 0xffff0000u), __uint_as_float(hb.w << 16), __uint_as_float(hb.w & 0xffff0000u)};
                    const f32x4 v0 = acc[ai][bj][m][0] + h0, v1 = acc[ai][bj][m][1] + h1;
                    u32x4 w; w.x = cvt_pk_bf16(v0[0], v0[1]); w.y = cvt_pk_bf16(v0[2], v0[3]); w.z = cvt_pk_bf16(v1[0], v1[1]); w.w = cvt_pk_bf16(v1[2], v1[3]);
                    *(u32x4*)(H2B + off) = w; } } }
    }
};
struct EpiAtomicAdd {
    static constexpr bool PERM = true, AFTER_DRAIN = false;
    float* H2;
    __device__ __forceinline__ void operator()(const f32x4 (&acc)[2][2][4][2], const Unit& u, int wr, int wc, int fr, int fq) const {
        asm volatile("" : "+v"(fr), "+v"(fq));
        const int row0 = wr * 64 + fr, col0 = u.pn * BM + wc * 32 + 8 * fq;
#pragma unroll
        for (int ai = 0; ai < 2; ++ai)
#pragma unroll
            for (int m = 0; m < 4; ++m) { const int row = row0 + ai * HALF + m * 16;
                if (row >= 16 && row < 144) {
#pragma unroll
                    for (int bj = 0; bj < 2; ++bj) { float* p = H2 + (size_t)row * 1024 + col0 + bj * HALF;
#pragma unroll
                        for (int e = 0; e < 4; ++e) { __hip_atomic_fetch_add(p + e, acc[ai][bj][m][0][e], __ATOMIC_RELAXED, __HIP_MEMORY_SCOPE_AGENT); __hip_atomic_fetch_add(p + 4 + e, acc[ai][bj][m][1][e], __ATOMIC_RELAXED, __HIP_MEMORY_SCOPE_AGENT); } } } }
    }
};
struct EpiQ {
    static constexpr bool PERM = true, AFTER_DRAIN = false;
    bf16_t* O; const float* rope; float c2;
    __device__ __forceinline__ void operator()(const f32x4 (&acc)[2][2][4][2], const Unit& u, int wr, int wc, int fr, int fq) const {
        asm volatile("" : "+v"(fr), "+v"(fq));
        const int row0 = u.pm * BM + wr * 64 + fr, col0 = u.pn * BM + wc * 32 + 8 * fq;
        const bool dorope = (u.pn == 2);
#pragma unroll
        for (int ai = 0; ai < 2; ++ai) {
            f32x4 cs[4][4];
            if (dorope) {
#pragma unroll
                for (int m = 0; m < 4; ++m) { const int row = row0 + ai * HALF + m * 16;
                    const int pi = row < ROW_META ? 16 + (row & 2047) : (row < ROW_SAMP ? row - ROW_META : (row < ROW_END ? 2064 + ((row - ROW_SAMP) & 3) : 0));
                    const float* tb = rope + (size_t)pi * 32 + ((8 * fq) & 15);
                    cs[m][0] = *(const f32x4*)(tb); cs[m][1] = *(const f32x4*)(tb + 16); cs[m][2] = *(const f32x4*)(tb + 4); cs[m][3] = *(const f32x4*)(tb + 20); } }
#pragma unroll
            for (int m = 0; m < 4; ++m) { const int row = row0 + ai * HALF + m * 16; bf16_t* rowp = O + (size_t)row * 768 + col0;
#pragma unroll
                for (int bj = 0; bj < 2; ++bj) { f32x4 v0 = acc[ai][bj][m][0] * c2, v1 = acc[ai][bj][m][1] * c2;
                    if (dorope) { const f32x4 c0 = cs[m][0], s0 = cs[m][1], c1 = cs[m][2], s1 = cs[m][3];
                        f32x4 p0, p1;
#pragma unroll
                        for (int e = 0; e < 4; ++e) { p0[e] = __shfl_xor(v0[e], 32); p1[e] = __shfl_xor(v1[e], 32); }
                        if (fq < 2) { v0 = v0 * c0 - p0 * s0; v1 = v1 * c1 - p1 * s1; } else { v0 = v0 * c0 + p0 * s0; v1 = v1 * c1 + p1 * s1; } }
                    u32x4 w; w.x = cvt_pk_bf16(v0[0], v0[1]); w.y = cvt_pk_bf16(v0[2], v0[3]); w.z = cvt_pk_bf16(v1[0], v1[1]); w.w = cvt_pk_bf16(v1[2], v1[3]);
                    *(u32x4*)(rowp + bj * HALF) = w; } } }
    }
};
template <class Epi, class Sched, bool ALIGN_EPI = false, bool SP2 = false>
__device__ __forceinline__ void gemm_phase(PG8_LAS unsigned char* lds, const Gemm g, const Sched& S, const Epi& E) {
    int tid_ = threadIdx.x; asm volatile("" : "+v"(tid_));
    const int tid = tid_, wid = __builtin_amdgcn_readfirstlane(tid >> 6), lane = tid & 63, wr = wid >> 2, wc = wid & 3, fr = lane & 15, fq = lane >> 4;
    const int K = g.ld, nt = g.K / BK;
    unsigned voffA[2], voffB[2];
#pragma unroll
    for (int i = 0; i < 2; ++i) { int R, C; stage_rc(tid * 16 + i * 8192, R, C); const int Rb = Epi::PERM ? ((R & ~31) + perm32(R & 31)) : R;
        voffA[i] = (unsigned)(R * K + C) * 2u; voffB[i] = (unsigned)(Rb * K + C) * 2u; }
    const size_t kstep = (size_t)(BK * 2);
    const size_t hstep = (size_t)HALF * K * 2;
    const size_t tstep = 2 * hstep;
    const unsigned ldsw = (unsigned)wid * 1024u;
    const int aoff = lds_byte(wr * 64 + fr, fq * 8), boff = lds_byte(wc * 32 + fr, fq * 8);
#define PG8_SA(b, h) (((b) * 2 + (h)) * HTB)
#define PG8_SB(b, h) ((4 + (b) * 2 + (h)) * HTB)
#define PG8_STAGE(bufoff, gbase, voff) do { _Pragma("unroll") for (int _i = 0; _i < 2; ++_i) \
        __builtin_amdgcn_global_load_lds((const unsigned*)((const char*)(gbase) + (voff)[_i]), (PG8_LAS unsigned*)(lds + (bufoff) + ldsw + _i * 8192), 16, 0, 0); } while (0)
#define PG8_LDA(dst, b, h) do { _Pragma("unroll") for (int m = 0; m < 4; ++m) _Pragma("unroll") for (int k = 0; k < 2; ++k) dst[m][k] = *(const PG8_LAS bf16x8*)(lds + PG8_SA(b, h) + aoff + m * 2048 + k * 1024); } while (0)
#define PG8_LDB(dst, b, h) do { _Pragma("unroll") for (int n = 0; n < 2; ++n) _Pragma("unroll") for (int k = 0; k < 2; ++k) dst[n][k] = *(const PG8_LAS bf16x8*)(lds + PG8_SB(b, h) + boff + n * 2048 + k * 1024); } while (0)
#define PG8_MMA(ai, bj, At, Bt) do { __builtin_amdgcn_s_setprio(1); _Pragma("unroll") for (int m = 0; m < 4; ++m) _Pragma("unroll") for (int n = 0; n < 2; ++n) _Pragma("unroll") for (int k = 0; k < 2; ++k) \
        acc[ai][bj][m][n] = __builtin_amdgcn_mfma_f32_16x16x32_bf16(Bt[n][k], At[m][k], acc[ai][bj][m][n], 0, 0, 0); __builtin_amdgcn_s_setprio(0); } while (0)
#define PG8_WAIT_V(n) asm volatile("s_waitcnt vmcnt(" #n ")" ::: "memory")
#define PG8_WAIT_L(n) asm volatile("s_waitcnt lgkmcnt(" #n ")" ::: "memory")
#define PG8_BAR __builtin_amdgcn_s_barrier()
#define PG8_SCHED __builtin_amdgcn_sched_barrier(0)
    Unit cur, nxt; int ui = 0;
    if (!S.next(0, cur)) return;
    f32x4 acc[2][2][4][2];
#pragma unroll
    for (int a = 0; a < 2; ++a)
#pragma unroll
        for (int b = 0; b < 2; ++b)
#pragma unroll
            for (int m = 0; m < 4; ++m)
#pragma unroll
                for (int n = 0; n < 2; ++n) acc[a][b][m][n] = (f32x4){0.f, 0.f, 0.f, 0.f};
    bf16x8 At[4][2], B0[2][2], B1[2][2];
    const char* cA = (const char*)g.A + (size_t)cur.pm * tstep + (size_t)cur.ko * 2; const char* cB = (const char*)g.Bt + (size_t)cur.pn * tstep + (size_t)cur.ko * 2;
    S.a_ready(cur);
    if constexpr (SP2) {
        PG8_STAGE(PG8_SB(0, 0), cB, voffB); PG8_STAGE(PG8_SB(0, 1), cB + hstep, voffB); PG8_STAGE(PG8_SA(0, 0), cA, voffA); PG8_STAGE(PG8_SA(0, 1), cA + hstep, voffA);
        if (wr == 1) PG8_BAR;
        PG8_WAIT_V(2); PG8_BAR;
        PG8_STAGE(PG8_SB(1, 0), cB + kstep, voffB); PG8_STAGE(PG8_SA(1, 0), cA + kstep, voffA); PG8_STAGE(PG8_SB(1, 1), cB + hstep + kstep, voffB);
        PG8_WAIT_V(6); PG8_BAR;
    } else {
        PG8_STAGE(PG8_SB(0, 0), cB, voffB); PG8_STAGE(PG8_SA(0, 0), cA, voffA); PG8_STAGE(PG8_SB(0, 1), cB + hstep, voffB); PG8_STAGE(PG8_SA(0, 1), cA + hstep, voffA);
        if (wr == 1) PG8_BAR;
        PG8_WAIT_V(4); PG8_BAR;
        PG8_STAGE(PG8_SB(1, 0), cB + kstep, voffB); PG8_STAGE(PG8_SA(1, 0), cA + kstep, voffA); PG8_STAGE(PG8_SB(1, 1), cB + hstep + kstep, voffB);
        PG8_WAIT_V(6); PG8_BAR;
    }
    for (;;) {
        const bool has_next = S.next(ui + 1, nxt);
        const char* nA = has_next ? (const char*)g.A + (size_t)nxt.pm * tstep + (size_t)nxt.ko * 2 : cA; const char* nB = has_next ? (const char*)g.Bt + (size_t)nxt.pn * tstep + (size_t)nxt.ko * 2 : cB;
        asm volatile(".p2align 8" ::: "memory");
#pragma clang loop unroll(disable)
        for (int t = 0; t < nt; t += 2) {
            const bool last = (t == nt - 2);
            const char* a1 = cA + (size_t)(t + 1) * kstep;
            const char* a2 = last ? nA : cA + (size_t)(t + 2) * kstep; const char* b2 = last ? nB : cB + (size_t)(t + 2) * kstep;
            const char* a3 = a2 + kstep; const char* b3 = b2 + kstep;
            if (last && has_next) S.a_ready(nxt);
            if constexpr (SP2) {
            PG8_LDB(B0, 0, 0); PG8_LDB(B1, 0, 1); PG8_SCHED; PG8_LDA(At, 0, 0); PG8_STAGE(PG8_SA(1, 1), a1 + hstep, voffA);
            PG8_WAIT_V(8); PG8_WAIT_L(0); PG8_BAR; PG8_MMA(0, 0, At, B0); PG8_MMA(0, 1, At, B1); PG8_BAR; PG8_SCHED;
            PG8_LDA(At, 0, 1); PG8_STAGE(PG8_SB(0, 0), b2, voffB); PG8_STAGE(PG8_SB(0, 1), b2 + hstep, voffB); PG8_STAGE(PG8_SA(0, 0), a2, voffA);
            PG8_WAIT_V(8); PG8_WAIT_L(0); PG8_BAR; PG8_MMA(1, 0, At, B0); PG8_MMA(1, 1, At, B1); PG8_BAR; PG8_SCHED;
            PG8_LDB(B0, 1, 0); PG8_LDB(B1, 1, 1); PG8_SCHED; PG8_LDA(At, 1, 0); PG8_STAGE(PG8_SA(0, 1), a2 + hstep, voffA);
            PG8_WAIT_V(8); PG8_WAIT_L(0); PG8_BAR; PG8_MMA(0, 0, At, B0); PG8_MMA(0, 1, At, B1); PG8_BAR; PG8_SCHED;
            PG8_LDA(At, 1, 1); PG8_STAGE(PG8_SB(1, 0), b3, voffB); PG8_STAGE(PG8_SB(1, 1), b3 + hstep, voffB); PG8_STAGE(PG8_SA(1, 0), a3, voffA);
            PG8_WAIT_V(8); PG8_WAIT_L(0); PG8_BAR; PG8_MMA(1, 0, At, B0); PG8_MMA(1, 1, At, B1); PG8_BAR; PG8_SCHED;
            } else {
            PG8_LDB(B0, 0, 0); PG8_SCHED; PG8_LDA(At, 0, 0); PG8_STAGE(PG8_SA(1, 1), a1 + hstep, voffA);
            PG8_WAIT_L(8); PG8_BAR; PG8_WAIT_L(0); PG8_MMA(0, 0, At, B0); PG8_BAR; PG8_SCHED;
            PG8_LDB(B1, 0, 1); PG8_STAGE(PG8_SB(0, 0), b2, voffB);
            PG8_BAR; PG8_WAIT_L(0); PG8_MMA(0, 1, At, B1); PG8_BAR;
            PG8_LDA(At, 0, 1); PG8_STAGE(PG8_SA(0, 0), a2, voffA);
            PG8_BAR; PG8_WAIT_L(0); PG8_MMA(1, 0, At, B0); PG8_BAR; PG8_SCHED;
            PG8_STAGE(PG8_SB(0, 1), b2 + hstep, voffB);
            PG8_WAIT_V(6); PG8_BAR; PG8_MMA(1, 1, At, B1); PG8_BAR;
            PG8_LDB(B0, 1, 0); PG8_SCHED; PG8_LDA(At, 1, 0); PG8_STAGE(PG8_SA(0, 1), a2 + hstep, voffA);
            PG8_WAIT_L(8); PG8_BAR; PG8_WAIT_L(0); PG8_MMA(0, 0, At, B0); PG8_BAR; PG8_SCHED;
            PG8_LDB(B1, 1, 1); PG8_STAGE(PG8_SB(1, 0), b3, voffB);
            PG8_BAR; PG8_WAIT_L(0); PG8_MMA(0, 1, At, B1); PG8_BAR;
            PG8_LDA(At, 1, 1); PG8_STAGE(PG8_SA(1, 0), a3, voffA);
            PG8_BAR; PG8_WAIT_L(0); PG8_MMA(1, 0, At, B0); PG8_BAR; PG8_SCHED;
            PG8_STAGE(PG8_SB(1, 1), b3 + hstep, voffB);
            PG8_WAIT_V(6); PG8_BAR; PG8_MMA(1, 1, At, B1); PG8_BAR;
            }
        }
        if constexpr (ALIGN_EPI) { if (wr == 0) PG8_BAR; }
        if constexpr (!Epi::AFTER_DRAIN) { E(acc, cur, wr, wc, fr, fq); S.done(cur); }
        if (!has_next) break;
#pragma unroll
        for (int a = 0; a < 2; ++a)
#pragma unroll
            for (int b = 0; b < 2; ++b)
#pragma unroll
                for (int m = 0; m < 4; ++m)
#pragma unroll
                    for (int n = 0; n < 2; ++n) acc[a][b][m][n] = (f32x4){0.f, 0.f, 0.f, 0.f};
        cur = nxt; cA = nA; cB = nB; ++ui;
        if constexpr (ALIGN_EPI) { if (wr == 1) PG8_BAR; }
    }
    PG8_WAIT_V(0);
    if constexpr (!ALIGN_EPI) { if (wr == 0) PG8_BAR; }
    PG8_BAR;
    if constexpr (Epi::AFTER_DRAIN) { E.fused(acc, cur, wr, wc, fr, fq, lds, wid, lane); S.done(cur); }
#undef PG8_SA
#undef PG8_SB
#undef PG8_STAGE
#undef PG8_LDA
#undef PG8_LDB
#undef PG8_MMA
#undef PG8_WAIT_V
#undef PG8_WAIT_L
#undef PG8_BAR
#undef PG8_SCHED
}
}
constexpr int NWAVES = 8;
constexpr int NPHASES = 10;
#ifndef MK_N_LAUNCHES
#define MK_N_LAUNCHES 1
#endif
#ifndef DUP_PHASE
#define DUP_PHASE -1
#endif
#ifndef DUP_SUB
#define DUP_SUB 0
#endif
constexpr int N_LAUNCHES = MK_N_LAUNCHES;

constexpr int D = 1024, NB = 8, SEQ = 2048, NREAL = NB * SEQ, NMETA = 16, NSB = 32, NST = 4, NSAMP = NSB * NST;
constexpr int R_META = NREAL, R_SAMP = NREAL + NMETA, R_END = R_SAMP + NSAMP, MT = 16640;
constexpr int TP = NMETA + SEQ;
constexpr int NPRJ = 2816;
constexpr int C_QKV = 0, C_Z = 1536, C_CQ = 2048, C_CKV = 2432, C_KPE = 2688, C_B = 2720, C_A = 2728, C_PAD = 2736;
constexpr int IN_COLS = 2736, FF = 4096, QLORA = 384, KVLORA = 256, NH = 8;
constexpr int PAST = 16384, PAGE = 128, NPAGES = 128;
constexpr float EPS = 1e-6f;
constexpr float MLA_SCALE = 0.10206207261596577f;
constexpr size_t O_YP = 0, O_YS = 16777216, O_LATP = 16908288, O_KRP = 21135360, O_CONVP = 21663744, O_SSMP = 21700608,
                 O_LATS = 21962752, O_KRS = 21995520, O_CONVS = 21999616, O_SSMS = 22147072, O_END = 23195648;
constexpr int NSPLIT = 32, SPLIT_KEYS = PAST / NSPLIT  , NSPLITX = NSPLIT + 1;

constexpr size_t MiB = 1u << 20;
constexpr size_t al(size_t x) { return (x + MiB - 1) / MiB * MiB; }
constexpr size_t WS_CTL = 0, CTL_ZERO_BYTES = 100 * 1024;
constexpr size_t WS_WIN = 1 * MiB;
constexpr size_t WS_WQB = WS_WIN + al((size_t)NPRJ * D * 2);
constexpr size_t WS_WKVB = WS_WQB + al((size_t)768 * 384 * 2);
constexpr size_t WS_WOUT = WS_WKVB + al((size_t)1024 * 256 * 2);
constexpr size_t WS_WUP = WS_WOUT + al((size_t)1024 * 1024 * 2);
constexpr size_t WS_WDN = WS_WUP + al((size_t)4096 * 1024 * 2);
constexpr size_t WS_XN = WS_WDN + al((size_t)4096 * 1024 * 2);
constexpr size_t WS_PRJ = WS_XN + al((size_t)MT * D * 2);
constexpr size_t WS_CQN = WS_PRJ + al((size_t)MT * NPRJ * 2);
constexpr size_t WS_LATN = WS_CQN + al((size_t)MT * QLORA * 2);
constexpr size_t WS_KPE = WS_LATN + al((size_t)MT * KVLORA * 2);
constexpr size_t WS_GQKV = WS_KPE + al((size_t)MT * 32 * 4);
constexpr size_t WS_GB = WS_GQKV + al((size_t)MT * 1536 * 4);
constexpr size_t WS_QM = WS_GB + al((size_t)MT * 16 * 4);
constexpr size_t WS_KV = WS_QM + al((size_t)MT * 768 * 2);
constexpr size_t WS_GO = WS_KV + al((size_t)MT * 1024 * 2);
constexpr size_t WS_MIX = WS_GO + al((size_t)MT * 512 * 4);
constexpr size_t WS_H2B = WS_MIX + al((size_t)MT * D * 2);
constexpr size_t WS_H1B = WS_H2B + al((size_t)MT * D * 2);
constexpr size_t WS_HFF = WS_H1B + al((size_t)MT * D * 2);
constexpr size_t WS_H2 = WS_HFF + al((size_t)MT * FF * 2);
constexpr size_t WS_PART = WS_H2 + al((size_t)MT * D * 4);
constexpr size_t WS_PSTAT = WS_PART + al((size_t)NSB * NSPLITX * 32 * 256 * 4);
constexpr int NROPE = TP + NST;
constexpr size_t WS_KPEB = WS_PSTAT + al((size_t)NSB * NSPLITX * 32 * 2 * 4);
constexpr size_t WS_ROPE = WS_KPEB + al((size_t)MT * 32 * 2);
constexpr size_t WS_QLAT = WS_ROPE + al((size_t)NROPE * 32 * 4);
constexpr size_t WS_EGL = WS_QLAT + al((size_t)NSB * 32 * 256 * 4);
constexpr size_t WS_S1 = WS_EGL + MiB;
constexpr size_t WS_GCH = WS_S1 + MiB;
constexpr size_t WS_END = WS_GCH + al((size_t)NB * 32 * NH * 40960);
constexpr int CW_TMO = 0, CW_CODE = 1, CW_CNT6 = 64;
constexpr int CW_BAR = 4096;
constexpr int CW_SS1 = 8192;
static_assert((size_t)(CW_SS1 + MT) * 4 <= CTL_ZERO_BYTES && CW_BAR + 3456 <= CW_SS1, "CTL words inside the memset region");

constexpr int RING_OFF = 0, RING_BYTES = 131072;
constexpr int LDSCTL_OFF = RING_BYTES, MISC_OFF = LDSCTL_OFF + 320;
constexpr int LDS_BYTES = 147456;
static_assert(MISC_OFF + 128 <= LDS_BYTES, "LDS map");
#define GAS __attribute__((address_space(1)))
#define LAS __attribute__((address_space(3)))
typedef unsigned short bf16;
typedef unsigned v4u __attribute__((ext_vector_type(4)));
typedef float f32x4 __attribute__((ext_vector_type(4)));
typedef short bf16x8 __attribute__((ext_vector_type(8)));
typedef GAS unsigned gu32;
typedef GAS unsigned long long gu64;
#define RLX_AGENT __ATOMIC_RELAXED, __HIP_MEMORY_SCOPE_AGENT
#define LDS_WAIT() asm volatile("s_waitcnt lgkmcnt(0)" ::: "memory")
#define VM_WAIT() asm volatile("s_waitcnt vmcnt(0)" ::: "memory")
__device__ __forceinline__ unsigned long long rt() { return __builtin_amdgcn_s_memrealtime(); }
__device__ __forceinline__ unsigned f2bf(float f) { unsigned u = __builtin_bit_cast(unsigned, f); return (u + 0x7fffu + ((u >> 16) & 1u)) >> 16; }
__device__ __forceinline__ unsigned pk2(float lo, float hi) { return f2bf(lo) | (f2bf(hi) << 16); }

#define XB_TMO      128
#define XB_XCNT(j)  (256  + 64 * (j))
#define XB_XSUB(j)  (1280 + 64 * (j))
#define XB_XGEN(j)  (2304 + 64 * (j))
#define XB_TOP      3328
#define XB_TOPGEN   3392
#define XCD_BAR_WORDS 3456
#define XB_SPIN_CAP (1u << 18)

__device__ __forceinline__ unsigned xb_ld(unsigned* p)              { return __hip_atomic_load(p, __ATOMIC_RELAXED, __HIP_MEMORY_SCOPE_AGENT); }
__device__ __forceinline__ unsigned xb_add(unsigned* p, unsigned v) { return __hip_atomic_fetch_add(p, v, __ATOMIC_RELAXED, __HIP_MEMORY_SCOPE_AGENT); }
__device__ __forceinline__ unsigned xb_xcc_id() { return (unsigned)__builtin_amdgcn_s_getreg((3 << 11) | 20) & 0xFu; }
#define XB_SPIN(cond, bar) do { unsigned _sp = 0; while (cond) { __builtin_amdgcn_s_sleep(1); \
    if ((++_sp & 255u) == 0u) { if (xb_ld(&(bar)[XB_TMO])) break; if (_sp > XB_SPIN_CAP) { atomicAdd(&(bar)[XB_TMO], 1u); break; } } } } while (0)

struct XcdBarrier {
    unsigned* bar; unsigned x;
    volatile LAS unsigned* st;
};

__device__ __forceinline__ XcdBarrier xcd_barrier_post(unsigned* bar, volatile LAS unsigned* st) {
    XcdBarrier b; b.bar = bar; b.x = xb_xcc_id(); b.st = st;
    if (threadIdx.x == 0) (void)xb_add(&bar[XB_XCNT(b.x)], 1u);
    return b;
}
__device__ __forceinline__ void xcd_barrier_complete(unsigned* bar, unsigned x, unsigned& nloc, unsigned& nx) {
    const unsigned G = gridDim.x * gridDim.y * gridDim.z;
    unsigned sum, cnt, mine, sp = 0u;
    for (;;) {
        sum = 0u; cnt = 0u; mine = 0u;
#pragma unroll
        for (unsigned j = 0; j < 16; ++j) { const unsigned c = xb_ld(&bar[XB_XCNT(j)]); sum += c; cnt += (c > 0u) ? 1u : 0u; mine = (j == x) ? c : mine; }
        if (sum == G) break;
        __builtin_amdgcn_s_sleep(1);
        if ((++sp & 255u) == 0u) { if (xb_ld(&bar[XB_TMO])) break; if (sp > XB_SPIN_CAP) { atomicAdd(&bar[XB_TMO], 1u); break; } }
    }
    nloc = mine > 0u ? mine : 1u; nx = cnt > 0u ? cnt : 1u;
}

__device__ __forceinline__ void xcd_barrier(const XcdBarrier& b) {
    asm volatile("s_waitcnt vmcnt(0)" ::: "memory");
    __syncthreads();
    if (threadIdx.x == 0) {
        unsigned* bar = b.bar;
        __builtin_amdgcn_s_waitcnt(0);
        unsigned nloc = b.st[0], nx = b.st[1];
        if (nloc == 0u) { xcd_barrier_complete(bar, b.x, nloc, nx); b.st[0] = nloc; b.st[1] = nx; }
        const unsigned old = xb_add(&bar[XB_XSUB(b.x)], 1u);
        const unsigned gen = old / nloc;
        if (old + 1u == (gen + 1u) * nloc) {
            __builtin_amdgcn_fence(__ATOMIC_RELEASE, "agent");
            asm volatile("s_waitcnt vmcnt(0)" ::: "memory");
            const unsigned og = xb_add(&bar[XB_TOP], 1u);
            const unsigned tg = og / nx;
            if (og + 1u == (tg + 1u) * nx) xb_add(&bar[XB_TOPGEN], 1u);
            else XB_SPIN(xb_ld(&bar[XB_TOPGEN]) == tg, bar);
            __builtin_amdgcn_fence(__ATOMIC_ACQUIRE, "agent");
            xb_add(&bar[XB_XGEN(b.x)], 1u);
            asm volatile("s_waitcnt vmcnt(0)" ::: "memory");
        } else {
            XB_SPIN(xb_ld(&bar[XB_XGEN(b.x)]) == gen, bar);
            __builtin_amdgcn_fence(__ATOMIC_ACQUIRE, "agent");
            asm volatile("s_waitcnt vmcnt(0)" ::: "memory");
        }
    }
    __syncthreads();
}
struct Frame {
    LAS unsigned char* lds;
    volatile LAS unsigned* MISC;
    gu32* ctl;
    int tid, lane, wave, vcu, G;
    const float *x_prompt, *x_sample, *cache_latent, *cache_krope, *state_conv, *state_ssm; const int* page_table;
    const float *meta, *norm_mix_g, *w_in, *conv_w, *a_log, *dt_bias, *gdn_norm_g, *q_norm_g, *w_q_b, *kv_norm_g, *w_kv_b, *w_out, *norm_mlp_g, *w_up, *w_down, *final_g;
    float* out;
    bf16 *WIN, *WQB, *WKVB, *WOUT, *WUP, *WDN, *XN, *PRJ, *CQN, *LATN, *QM, *KV, *MIX, *H1B, *HFF, *KPEB, *GQKV;
    bf16* H2B;
    float *KPE, *GB, *GO, *H2, *PART, *PSTAT, *SS1, *ROPE, *QLAT, *EGL, *S1; unsigned char* GCH;
};
__device__ __forceinline__ float bf2f(bf16 v) { return __uint_as_float((unsigned)v << 16); }
__device__ __forceinline__ float wave_sum(float v) {
#pragma unroll
    for (int o = 1; o < 64; o <<= 1) v += __shfl_xor(v, o);
    return v;
}
__device__ __forceinline__ float wave_max(float v) {
#pragma unroll
    for (int o = 1; o < 64; o <<= 1) v = fmaxf(v, __shfl_xor(v, o));
    return v;
}
__device__ __forceinline__ float silu_f(float y) { return y / (1.0f + __expf(-y)); }
__device__ __forceinline__ float rdlane(float v, int l) { return __int_as_float(__builtin_amdgcn_readlane(__float_as_int(v), l)); }
__device__ __forceinline__ int row_pos(int r) { return r < R_META ? NMETA + (r & (SEQ - 1)) : (r < R_SAMP ? r - R_META : PAST + ((r - R_SAMP) & (NST - 1))); }

__device__ __forceinline__ float wsrc(const Frame& F, int mat, int k, int n) {
    switch (mat) {
    case 0: { int c;
        if (n < C_CQ) c = n; else if (n < C_CKV) c = 2064 + (n - C_CQ); else if (n < C_KPE) c = 2448 + (n - C_CKV); else if (n < C_B) c = 2704 + (n - C_KPE);
        else if (n < C_A) c = 2048 + (n - C_B); else if (n < C_PAD) c = 2056 + (n - C_A); else return 0.f;
        return F.w_in[(size_t)k * IN_COLS + c]; }
    case 1: { const int c = n < 512 ? (n >> 6) * 96 + (n & 63) : ((n - 512) >> 5) * 96 + 64 + ((n - 512) & 31); return F.w_q_b[(size_t)k * 768 + c]; }
    case 2: { const int c = n < 512 ? (n >> 6) * 128 + (n & 63) : ((n - 512) >> 6) * 128 + 64 + ((n - 512) & 63); return F.w_kv_b[(size_t)k * 1024 + c]; }
    case 3: return F.w_out[(size_t)k * 1024 + n];
    case 4: return F.norm_mlp_g[k] * F.w_up[(size_t)k * 4096 + n];
    default: return F.w_down[(size_t)k * 1024 + n];
    }
}
__device__ __forceinline__ void p0_transpose_item(const Frame& F, int mat, int K, int N, bf16* WT, LAS float* scr, int item, int lane) {
    const int nblk = N / 32, kb = item / nblk, nb = item % nblk, k0 = 64 * kb, n0 = 32 * nb;
#pragma unroll 4
    for (int i = 0; i < 32; ++i) { const int kk = 2 * i + (lane >> 5); scr[kk * 33 + (lane & 31)] = wsrc(F, mat, k0 + kk, n0 + (lane & 31)); }
    LDS_WAIT(); asm volatile("" ::: "memory");
    const int c = lane & 7;
#pragma unroll
    for (int j = 0; j < 4; ++j) { const int n = (lane >> 3) + 8 * j; const LAS float* s = scr + (8 * c) * 33 + n;
        v4u o; o.x = pk2(s[0 * 33], s[1 * 33]); o.y = pk2(s[2 * 33], s[3 * 33]); o.z = pk2(s[4 * 33], s[5 * 33]); o.w = pk2(s[6 * 33], s[7 * 33]);
        *(GAS v4u*)(WT + (size_t)(n0 + n) * K + k0 + 8 * c) = o; }
    LDS_WAIT(); asm volatile("" ::: "memory");
}
__device__ __forceinline__ const float* x_row(const Frame& F, int r) {
    if (r < R_META) return F.x_prompt + (size_t)r * D;
    if (r < R_SAMP) return F.meta + (size_t)(r - R_META) * D;
    if (r < R_END) return F.x_sample + (size_t)(r - R_SAMP) * D;
    return nullptr;
}
__device__ __forceinline__ void p0_prologue(Frame& F) {
    LAS float* scr = (LAS float*)(F.lds + RING_OFF + F.wave * 16384);
    const int gw = F.vcu * NWAVES + F.wave, NGW = F.G * NWAVES;
    constexpr int I0 = (D / 64) * (NPRJ / 32), I1 = (QLORA / 64) * (768 / 32), I2 = (KVLORA / 64) * (1024 / 32), I3 = (1024 / 64) * (1024 / 32), I4 = (D / 64) * (FF / 32), I5 = (FF / 64) * (D / 32);
    constexpr int NITEMS = I0 + I1 + I2 + I3 + I4 + I5;
    for (int it = gw; it < NITEMS; it += NGW) {
        int r = it;
        if (r < I0) { p0_transpose_item(F, 0, D, NPRJ, F.WIN, scr, r, F.lane); continue; } r -= I0;
        if (r < I1) { p0_transpose_item(F, 1, QLORA, 768, F.WQB, scr, r, F.lane); continue; } r -= I1;
        if (r < I2) { p0_transpose_item(F, 2, KVLORA, 1024, F.WKVB, scr, r, F.lane); continue; } r -= I2;
        if (r < I3) { p0_transpose_item(F, 3, 1024, 1024, F.WOUT, scr, r, F.lane); continue; } r -= I3;
        if (r < I4) { p0_transpose_item(F, 4, D, FF, F.WUP, scr, r, F.lane); continue; } r -= I4;
        p0_transpose_item(F, 5, FF, D, F.WDN, scr, r, F.lane);
    }
    for (int e = (F.vcu * NWAVES * 64 + F.tid); e < NROPE * 16; e += F.G * NWAVES * 64) { const int pi = e >> 4, i = e & 15; const int pos = pi < TP ? pi : PAST + (pi - TP);
        const double ang = (double)pos * exp2(-(double)i * 0.83048202372184059); const double n = rint(ang * 0.15915494309189535); const float rr = (float)fma(-n, 6.2831853071795862, ang);
        F.ROPE[pi * 32 + i] = cosf(rr); F.ROPE[pi * 32 + 16 + i] = sinf(rr); }
    { const f32x4* gv = (const f32x4*)F.norm_mix_g + F.lane; f32x4 g4[4];
#pragma unroll
      for (int j = 0; j < 4; ++j) g4[j] = gv[64 * j];
      for (int m0 = gw; m0 < MT; m0 += 2 * NGW) { const int m1 = m0 + NGW;
        const float* x0 = x_row(F, m0); const float* x1 = m1 < MT ? x_row(F, m1) : nullptr;
        f32x4 v0[4], v1[4];
#pragma unroll
        for (int j = 0; j < 4; ++j) { v0[j] = x0 ? ((const f32x4*)x0 + F.lane)[64 * j] : (f32x4){0.f, 0.f, 0.f, 0.f}; v1[j] = x1 ? ((const f32x4*)x1 + F.lane)[64 * j] : (f32x4){0.f, 0.f, 0.f, 0.f}; }
        float s0 = 0.f, s1 = 0.f;
#pragma unroll
        for (int j = 0; j < 4; ++j) { s0 += (v0[j].x * v0[j].x + v0[j].y * v0[j].y) + (v0[j].z * v0[j].z + v0[j].w * v0[j].w); s1 += (v1[j].x * v1[j].x + v1[j].y * v1[j].y) + (v1[j].z * v1[j].z + v1[j].w * v1[j].w); }
        const float r0 = 1.0f / sqrtf(wave_sum(s0) * (1.0f / D) + EPS), r1 = 1.0f / sqrtf(wave_sum(s1) * (1.0f / D) + EPS);
        GAS unsigned long long* o0 = (GAS unsigned long long*)(F.XN + (size_t)m0 * D) + F.lane;
#pragma unroll
        for (int j = 0; j < 4; ++j) { const f32x4 y = v0[j] * r0 * g4[j]; o0[64 * j] = (unsigned long long)pk2(y.x, y.y) | ((unsigned long long)pk2(y.z, y.w) << 32); }
        if (m1 < MT) { GAS unsigned long long* o1 = (GAS unsigned long long*)(F.XN + (size_t)m1 * D) + F.lane;
#pragma unroll
            for (int j = 0; j < 4; ++j) { const f32x4 y = v1[j] * r1 * g4[j]; o1[64 * j] = (unsigned long long)pk2(y.x, y.y) | ((unsigned long long)pk2(y.z, y.w) << 32); } }
      } }
}

struct TapSrc { const bf16* pb; const float* pf; };
__device__ __forceinline__ TapSrc tap_src(const Frame& F, int r, int d) {
    TapSrc t; t.pb = nullptr; t.pf = nullptr;
    if (r < R_META) { const int s = r & (SEQ - 1); if (s - d >= 0) t.pb = F.PRJ + (size_t)(r - d) * NPRJ; else t.pb = F.PRJ + (size_t)(R_META + NMETA + (s - d)) * NPRJ; }
    else if (r < R_SAMP) { const int m = r - R_META; if (m - d >= 0) t.pb = F.PRJ + (size_t)(r - d) * NPRJ; }
    else if (r < R_END) { const int i = r - R_SAMP, bs = i >> 2, tt = i & 3; if (tt - d >= 0) t.pb = F.PRJ + (size_t)(r - d) * NPRJ; else t.pf = F.state_conv + ((size_t)bs * 3 + (3 + tt - d)) * 1536; }
    return t;
}
struct P2Consts { f32x4 cw[4][3][2]; float qg[6]; f32x4 kvg; float dtb, nal; };
__device__ __forceinline__ void p2_consts(const Frame& F, P2Consts& W, int lane) {
#pragma unroll
    for (int j = 0; j < 4; ++j)
#pragma unroll
        for (int sg = 0; sg < 3; ++sg) { W.cw[j][sg][0] = *(const f32x4*)(F.conv_w + j * 1536 + sg * 512 + 8 * lane); W.cw[j][sg][1] = *(const f32x4*)(F.conv_w + j * 1536 + sg * 512 + 8 * lane + 4); }
#pragma unroll
    for (int j = 0; j < 3; ++j) { W.qg[2 * j] = F.q_norm_g[128 * j + 2 * lane]; W.qg[2 * j + 1] = F.q_norm_g[128 * j + 2 * lane + 1]; }
    W.kvg = *((const f32x4*)F.kv_norm_g + lane); W.dtb = F.dt_bias[lane & 7]; W.nal = -expf(F.a_log[lane & 7]);
}
__device__ __forceinline__ void p2_row_fast(Frame& F, int r, const P2Consts& W, int lane) {
    const bf16* p = F.PRJ + (size_t)r * NPRJ; const int b = r >> 11, s2 = r & (SEQ - 1);
    unsigned cq[3];
#pragma unroll
    for (int j = 0; j < 3; ++j) cq[j] = *(const unsigned*)(p + C_CQ + 128 * j + 2 * lane);
    const unsigned long long ckv = *(const unsigned long long*)(p + C_CKV + 4 * lane);
    const bf16 kp1 = p[C_KPE + (lane & 15)], kp2 = p[C_KPE + 16 + (lane & 15)], bbr = p[C_B + (lane & 7)], aar = p[C_A + (lane & 7)];
    const float rc = F.ROPE[(NMETA + s2) * 32 + (lane & 15)], rs = F.ROPE[(NMETA + s2) * 32 + 16 + (lane & 15)];
    v4u xt[4][3];
#pragma unroll
    for (int j = 0; j < 4; ++j)
#pragma unroll
        for (int sg = 0; sg < 3; ++sg) xt[j][sg] = *(const v4u*)(p - (size_t)(3 - j) * NPRJ + sg * 512 + 8 * lane);
    { float v[6]; float s = 0.f;
#pragma unroll
      for (int j = 0; j < 3; ++j) { v[2 * j] = __uint_as_float(cq[j] << 16); v[2 * j + 1] = __uint_as_float(cq[j] & 0xffff0000u); s += v[2 * j] * v[2 * j] + v[2 * j + 1] * v[2 * j + 1]; }
      const float rstd = 1.0f / sqrtf(wave_sum(s) * (1.0f / QLORA) + EPS);
#pragma unroll
      for (int j = 0; j < 3; ++j) *(unsigned*)(F.CQN + (size_t)r * QLORA + 128 * j + 2 * lane) = pk2(v[2 * j] * rstd * W.qg[2 * j], v[2 * j + 1] * rstd * W.qg[2 * j + 1]); }
    { float v[4]; v[0] = __uint_as_float((unsigned)(ckv << 16) & 0xffff0000u); v[1] = __uint_as_float((unsigned)ckv & 0xffff0000u); v[2] = __uint_as_float((unsigned)(ckv >> 16) & 0xffff0000u); v[3] = __uint_as_float((unsigned)(ckv >> 32) & 0xffff0000u);
      const float s = (v[0] * v[0] + v[1] * v[1]) + (v[2] * v[2] + v[3] * v[3]);
      const float rstd = 1.0f / sqrtf(wave_sum(s) * (1.0f / KVLORA) + EPS);
      const f32x4 y = {v[0] * rstd * W.kvg.x, v[1] * rstd * W.kvg.y, v[2] * rstd * W.kvg.z, v[3] * rstd * W.kvg.w};
      *(unsigned long long*)(F.LATN + (size_t)r * KVLORA + 4 * lane) = (unsigned long long)pk2(y.x, y.y) | ((unsigned long long)pk2(y.z, y.w) << 32);
      *((f32x4*)(F.out + O_LATP + ((size_t)b * TP + NMETA + s2) * KVLORA) + lane) = y; }
    if (lane < 16) { const float x1 = bf2f(kp1), x2 = bf2f(kp2), o1 = x1 * rc - x2 * rs, o2 = x2 * rc + x1 * rs;
      F.KPE[(size_t)r * 32 + lane] = o1; F.KPE[(size_t)r * 32 + 16 + lane] = o2; F.KPEB[(size_t)r * 32 + lane] = (bf16)f2bf(o1); F.KPEB[(size_t)r * 32 + 16 + lane] = (bf16)f2bf(o2);
      float* o = F.out + O_KRP + ((size_t)b * TP + NMETA + s2) * 32; o[lane] = o1; o[16 + lane] = o2; }
    if (lane < 8) { const float beta = 1.0f / (1.0f + expf(-bf2f(bbr))); const float xx = bf2f(aar) + W.dtb; const float sp = xx > 20.f ? xx : log1pf(expf(xx));
      F.GB[(size_t)r * 16 + lane] = beta; F.GB[(size_t)r * 16 + 8 + lane] = W.nal * sp; }
#pragma unroll
    for (int sg = 0; sg < 3; ++sg) { float y[8];
#pragma unroll
        for (int e = 0; e < 8; ++e) y[e] = 0.f;
#pragma unroll
        for (int j = 0; j < 4; ++j) { const v4u w = xt[j][sg]; const f32x4 w0 = W.cw[j][sg][0], w1 = W.cw[j][sg][1];
            y[0] += __uint_as_float(w.x << 16) * w0.x; y[1] += __uint_as_float(w.x & 0xffff0000u) * w0.y; y[2] += __uint_as_float(w.y << 16) * w0.z; y[3] += __uint_as_float(w.y & 0xffff0000u) * w0.w;
            y[4] += __uint_as_float(w.z << 16) * w1.x; y[5] += __uint_as_float(w.z & 0xffff0000u) * w1.y; y[6] += __uint_as_float(w.w << 16) * w1.z; y[7] += __uint_as_float(w.w & 0xffff0000u) * w1.w; }
        float ss = 0.f;
#pragma unroll
        for (int e = 0; e < 8; ++e) { y[e] = silu_f(y[e]); ss += y[e] * y[e]; }
        if (sg < 2) { ss += __shfl_xor(ss, 1); ss += __shfl_xor(ss, 2); ss += __shfl_xor(ss, 4); const float sc = (sg == 0 ? 0.125f : 1.0f) / sqrtf(ss + EPS);
#pragma unroll
            for (int e = 0; e < 8; ++e) y[e] *= sc; }
        v4u o; o.x = pk2(y[0], y[1]); o.y = pk2(y[2], y[3]); o.z = pk2(y[4], y[5]); o.w = pk2(y[6], y[7]);
        *(v4u*)(F.GQKV + (size_t)r * 1536 + sg * 512 + 8 * lane) = o; }
}
__device__ __forceinline__ void p2_row(Frame& F, int r) {
    int lane_ = F.lane; asm volatile("" : "+v"(lane_)); const int lane = lane_;
    const bf16* p = F.PRJ + (size_t)r * NPRJ;
    if (r >= R_END) {
        for (int c = lane; c < QLORA; c += 64) F.CQN[(size_t)r * QLORA + c] = 0;
        for (int c = lane; c < KVLORA; c += 64) F.LATN[(size_t)r * KVLORA + c] = 0;
        return; }
    { float v[6]; float s = 0.f;
#pragma unroll
      for (int j = 0; j < 3; ++j) { const unsigned w = *(const unsigned*)(p + C_CQ + 128 * j + 2 * lane); v[2 * j] = __uint_as_float(w << 16); v[2 * j + 1] = __uint_as_float(w & 0xffff0000u); s += v[2 * j] * v[2 * j] + v[2 * j + 1] * v[2 * j + 1]; }
      const float rstd = 1.0f / sqrtf(wave_sum(s) * (1.0f / QLORA) + EPS);
#pragma unroll
      for (int j = 0; j < 3; ++j) { const int c = 128 * j + 2 * lane; *(unsigned*)(F.CQN + (size_t)r * QLORA + c) = pk2(v[2 * j] * rstd * F.q_norm_g[c], v[2 * j + 1] * rstd * F.q_norm_g[c + 1]); } }
    { const unsigned long long w = *(const unsigned long long*)(p + C_CKV + 4 * lane); float v[4];
      v[0] = __uint_as_float((unsigned)(w << 16) & 0xffff0000u); v[1] = __uint_as_float((unsigned)w & 0xffff0000u); v[2] = __uint_as_float((unsigned)(w >> 16) & 0xffff0000u); v[3] = __uint_as_float((unsigned)(w >> 32) & 0xffff0000u);
      const float s = (v[0] * v[0] + v[1] * v[1]) + (v[2] * v[2] + v[3] * v[3]);
      const float rstd = 1.0f / sqrtf(wave_sum(s) * (1.0f / KVLORA) + EPS);
      const f32x4 g = *((const f32x4*)F.kv_norm_g + lane);
      const f32x4 y = {v[0] * rstd * g.x, v[1] * rstd * g.y, v[2] * rstd * g.z, v[3] * rstd * g.w};
      *(unsigned long long*)(F.LATN + (size_t)r * KVLORA + 4 * lane) = (unsigned long long)pk2(y.x, y.y) | ((unsigned long long)pk2(y.z, y.w) << 32);
      if (r < R_META) { const int b = r >> 11, s2 = r & (SEQ - 1); *((f32x4*)(F.out + O_LATP + ((size_t)b * TP + NMETA + s2) * KVLORA) + lane) = y; }
      else if (r < R_SAMP) { const int m = r - R_META;
#pragma unroll
          for (int b = 0; b < NB; ++b) *((f32x4*)(F.out + O_LATP + ((size_t)b * TP + m) * KVLORA) + lane) = y; }
      else *((f32x4*)(F.out + O_LATS + (size_t)(r - R_SAMP) * KVLORA) + lane) = y; }
    if (lane < 16) { const float x1 = bf2f(p[C_KPE + lane]), x2 = bf2f(p[C_KPE + 16 + lane]);
      const int pi = r < R_META ? NMETA + (r & (SEQ - 1)) : (r < R_SAMP ? r - R_META : TP + ((r - R_SAMP) & (NST - 1)));
      const float c = F.ROPE[pi * 32 + lane], s = F.ROPE[pi * 32 + 16 + lane], o1 = x1 * c - x2 * s, o2 = x2 * c + x1 * s;
      F.KPE[(size_t)r * 32 + lane] = o1; F.KPE[(size_t)r * 32 + 16 + lane] = o2; F.KPEB[(size_t)r * 32 + lane] = (bf16)f2bf(o1); F.KPEB[(size_t)r * 32 + 16 + lane] = (bf16)f2bf(o2);
      if (r < R_META) { const int b = r >> 11, s2 = r & (SEQ - 1); float* o = F.out + O_KRP + ((size_t)b * TP + NMETA + s2) * 32; o[lane] = o1; o[16 + lane] = o2; }
      else if (r < R_SAMP) { const int m = r - R_META; for (int b = 0; b < NB; ++b) { float* o = F.out + O_KRP + ((size_t)b * TP + m) * 32; o[lane] = o1; o[16 + lane] = o2; } }
      else { float* o = F.out + O_KRS + (size_t)(r - R_SAMP) * 32; o[lane] = o1; o[16 + lane] = o2; } }
    if (lane < 8) { const float bb = bf2f(p[C_B + lane]), aa = bf2f(p[C_A + lane]);
      const float beta = 1.0f / (1.0f + expf(-bb)); const float xx = aa + F.dt_bias[lane];
      const float sp = xx > 20.f ? xx : log1pf(expf(xx));
      F.GB[(size_t)r * 16 + lane] = beta; F.GB[(size_t)r * 16 + 8 + lane] = -expf(F.a_log[lane]) * sp; }
    { TapSrc ts[4];
#pragma unroll
      for (int j = 0; j < 4; ++j) ts[j] = tap_src(F, r, 3 - j);
      float y[3][8];
#pragma unroll
      for (int sg = 0; sg < 3; ++sg)
#pragma unroll
          for (int e = 0; e < 8; ++e) y[sg][e] = 0.f;
#pragma unroll
      for (int j = 0; j < 4; ++j) {
          if (!ts[j].pb && !ts[j].pf) continue;
#pragma unroll
          for (int sg = 0; sg < 3; ++sg) { const int ch = sg * 512 + 8 * lane; float x[8];
              if (ts[j].pb) { const v4u w = *(const v4u*)(ts[j].pb + ch);
                  x[0] = __uint_as_float(w.x << 16); x[1] = __uint_as_float(w.x & 0xffff0000u); x[2] = __uint_as_float(w.y << 16); x[3] = __uint_as_float(w.y & 0xffff0000u);
                  x[4] = __uint_as_float(w.z << 16); x[5] = __uint_as_float(w.z & 0xffff0000u); x[6] = __uint_as_float(w.w << 16); x[7] = __uint_as_float(w.w & 0xffff0000u); }
              else { const f32x4 a = *(const f32x4*)(ts[j].pf + ch), b2 = *(const f32x4*)(ts[j].pf + ch + 4); x[0] = a.x; x[1] = a.y; x[2] = a.z; x[3] = a.w; x[4] = b2.x; x[5] = b2.y; x[6] = b2.z; x[7] = b2.w; }
              const f32x4 w0 = *(const f32x4*)(F.conv_w + j * 1536 + ch), w1 = *(const f32x4*)(F.conv_w + j * 1536 + ch + 4);
              y[sg][0] += x[0] * w0.x; y[sg][1] += x[1] * w0.y; y[sg][2] += x[2] * w0.z; y[sg][3] += x[3] * w0.w;
              y[sg][4] += x[4] * w1.x; y[sg][5] += x[5] * w1.y; y[sg][6] += x[6] * w1.z; y[sg][7] += x[7] * w1.w; } }
#pragma unroll
      for (int sg = 0; sg < 3; ++sg) { float ss = 0.f;
#pragma unroll
          for (int e = 0; e < 8; ++e) { y[sg][e] = silu_f(y[sg][e]); ss += y[sg][e] * y[sg][e]; }
          if (sg < 2) { ss += __shfl_xor(ss, 1); ss += __shfl_xor(ss, 2); ss += __shfl_xor(ss, 4); const float sc = (sg == 0 ? 0.125f : 1.0f) / sqrtf(ss + EPS);
#pragma unroll
              for (int e = 0; e < 8; ++e) y[sg][e] *= sc; }
          v4u o; o.x = pk2(y[sg][0], y[sg][1]); o.y = pk2(y[sg][2], y[sg][3]); o.z = pk2(y[sg][4], y[sg][5]); o.w = pk2(y[sg][6], y[sg][7]);
          *(v4u*)(F.GQKV + (size_t)r * 1536 + sg * 512 + 8 * lane) = o; } }
    { float* o = nullptr;
      if (r < R_META) { const int b = r >> 11, s2 = r & (SEQ - 1); if (s2 >= SEQ - 3) o = F.out + O_CONVP + ((size_t)b * 3 + (s2 - (SEQ - 3))) * 1536; }
      else if (r >= R_SAMP) { const int i = r - R_SAMP, bs = i >> 2, tt = i & 3; if (tt >= 1) o = F.out + O_CONVS + ((size_t)bs * 3 + (tt - 1)) * 1536; }
      if (o) {
          v4u w[3];
#pragma unroll
          for (int k = 0; k < 3; ++k) w[k] = *(const v4u*)(p + 512 * k + 8 * lane);
#pragma unroll
          for (int k = 0; k < 3; ++k) { float* ok = o + 512 * k + 8 * lane;
              *(f32x4*)ok = (f32x4){__uint_as_float(w[k].x << 16), __uint_as_float(w[k].x & 0xffff0000u), __uint_as_float(w[k].y << 16), __uint_as_float(w[k].y & 0xffff0000u)};
              *(f32x4*)(ok + 4) = (f32x4){__uint_as_float(w[k].z << 16), __uint_as_float(w[k].z & 0xffff0000u), __uint_as_float(w[k].w << 16), __uint_as_float(w[k].w & 0xffff0000u)}; } } }
}

namespace fa {
typedef float f32x16 __attribute__((ext_vector_type(16)));
typedef short s16x4 __attribute__((ext_vector_type(4)));
typedef short v4i16_t __attribute__((ext_vector_type(4)));
constexpr int KOFF = 0, VOFF = 12288, STAGE = 20480;
constexpr int LDS_WSF = 2 * STAGE, LDS_OST = LDS_WSF + 8 * 256, LDS_TOTAL = LDS_OST + 8 * 4096;
static_assert(LDS_TOTAL <= RING_BYTES, "attention LDS");
__device__ __forceinline__ int crow(int r, int hi) { return (r & 3) + 8 * (r >> 2) + 4 * hi; }
typedef float f32x2_t __attribute__((ext_vector_type(2))); typedef __bf16 bf16x2_t __attribute__((ext_vector_type(2)));
__device__ __forceinline__ unsigned cvtpk(float lo, float hi) { f32x2_t v = {lo, hi}; bf16x2_t b = __builtin_convertvector(v, bf16x2_t); return __builtin_bit_cast(unsigned, b); }
__device__ __forceinline__ s16x4 vtr(const LAS unsigned char* p) { return __builtin_bit_cast(s16x4, __builtin_amdgcn_ds_read_tr16_b64_v4i16((LAS v4i16_t*)p)); }
__device__ __forceinline__ void issue_tile(const Frame& F, LAS unsigned char* st, int b, int h, int t, bool meta, int wid, int lane) {
    { const int key = lane; const int krow = meta ? R_META + (key < NMETA ? key : NMETA - 1) : b * SEQ + 64 * t + key;
      __builtin_amdgcn_global_load_lds((const unsigned*)(F.KV + (size_t)krow * 1024 + h * 64 + wid * 8), (LAS unsigned*)(st + KOFF + wid * 1024), 16, 0, 0);
      if (wid < 4) __builtin_amdgcn_global_load_lds((const unsigned*)(F.KPEB + (size_t)krow * 32 + wid * 8), (LAS unsigned*)(st + KOFF + (8 + wid) * 1024), 16, 0, 0); }
    { const int key = 16 * (wid & 3) + (lane >> 2); const int vrow = meta ? R_META + (key < NMETA ? key : NMETA - 1) : b * SEQ + 64 * t + key;
      __builtin_amdgcn_global_load_lds((const unsigned*)(F.KV + (size_t)vrow * 1024 + 512 + h * 64 + (wid >> 2) * 32 + (lane & 3) * 8), (LAS unsigned*)(st + VOFF + wid * 1024), 16, 0, 0); }
}
__device__ __forceinline__ void attn_unit(const Frame& F, int b, int h, int qb) {
    const int lane = F.lane, wid = F.wave, r32 = lane & 31, hi = lane >> 5;
    LAS unsigned char* base = F.lds + RING_OFF;
    LAS float* wsf = (LAS float*)(base + LDS_WSF) + wid * 64;
    const int s0 = 256 * qb + 32 * wid; const size_t row0 = (size_t)b * SEQ + s0;
    const int NTR = 4 * (qb + 1), NT = NTR + 1;
    const int td = 4 * qb + (wid >> 1);
    __syncthreads();
    issue_tile(F, base, b, h, 0, false, wid, lane);
    bf16x8 qr[6];
    { const bf16* q = F.QM + (row0 + r32) * 768;
#pragma unroll
      for (int d0 = 0; d0 < 4; ++d0) qr[d0] = *(const bf16x8*)(q + h * 64 + d0 * 16 + hi * 8);
#pragma unroll
      for (int d0 = 0; d0 < 2; ++d0) qr[4 + d0] = *(const bf16x8*)(q + 512 + h * 32 + d0 * 16 + hi * 8); }
    f32x16 o0, o1;
#pragma unroll
    for (int r = 0; r < 16; ++r) { o0[r] = 0.f; o1[r] = 0.f; }
    float m = -INFINITY, l = 0.f;
    const int qrel = 32 * (wid & 1) + r32;
    const int vlane = ((lane >> 4) & 1) * 32 + (lane & 3) * 8 + (4 * hi + ((lane & 15) >> 2)) * 64;
    for (int t = 0; t < NT; ++t) {
        const bool meta = (t == NTR);
        asm volatile("s_waitcnt vmcnt(0)" ::: "memory");
        __syncthreads();
        if (t + 1 < NT) issue_tile(F, base + ((t + 1) & 1) * STAGE, b, h, t + 1, t + 1 == NTR, wid, lane);
        if (!meta && t > td) continue;
        const LAS unsigned char* st = base + (t & 1) * STAGE;
        const LAS unsigned char* kb = st + KOFF + hi * 1024 + r32 * 16;
        f32x16 p0, p1;
#pragma unroll
        for (int r = 0; r < 16; ++r) { p0[r] = 0.f; p1[r] = 0.f; }
#pragma unroll
        for (int d0 = 0; d0 < 6; ++d0) {
            const bf16x8 k0 = *(const LAS bf16x8*)(kb + d0 * 2048);
            p0 = __builtin_amdgcn_mfma_f32_32x32x16_bf16(k0, qr[d0], p0, 0, 0, 0);
            if (!meta) { const bf16x8 k1 = *(const LAS bf16x8*)(kb + d0 * 2048 + 512); p1 = __builtin_amdgcn_mfma_f32_32x32x16_bf16(k1, qr[d0], p1, 0, 0, 0); }
        }
        if (meta) {
#pragma unroll
            for (int r = 8; r < 16; ++r) p0[r] = -INFINITY;
#pragma unroll
            for (int r = 0; r < 16; ++r) p1[r] = -INFINITY;
        } else if (t == td) {
#pragma unroll
            for (int r = 0; r < 16; ++r) { const int kk = crow(r, hi); if (kk > qrel) p0[r] = -INFINITY; if (kk + 32 > qrel) p1[r] = -INFINITY; }
        }
        float mx = fmaxf(p0[0], p1[0]);
#pragma unroll
        for (int r = 1; r < 16; ++r) mx = fmaxf(mx, fmaxf(p0[r], p1[r]));
        mx = fmaxf(mx, __shfl_xor(mx, 32));
        const float mn = fmaxf(m, mx);
        if (__any(mn > m)) {
            const float f = __builtin_amdgcn_exp2f(m - mn);
            l *= f; wsf[r32] = f;
#pragma unroll
            for (int r = 0; r < 16; ++r) { const float fr_ = wsf[crow(r, hi)]; o0[r] *= fr_; o1[r] *= fr_; }
            m = mn;
        }
        float sum = 0.f;
#pragma unroll
        for (int r = 0; r < 16; ++r) { p0[r] = __builtin_amdgcn_exp2f(p0[r] - m); p1[r] = __builtin_amdgcn_exp2f(p1[r] - m); sum += p0[r] + p1[r]; }
        l += sum;
        v4u pa0, pa1, pa2, pa3;
        pa0.x = cvtpk(p0[0], p0[1]); pa0.y = cvtpk(p0[2], p0[3]); pa0.z = cvtpk(p0[4], p0[5]); pa0.w = cvtpk(p0[6], p0[7]);
        pa1.x = cvtpk(p0[8], p0[9]); pa1.y = cvtpk(p0[10], p0[11]); pa1.z = cvtpk(p0[12], p0[13]); pa1.w = cvtpk(p0[14], p0[15]);
        pa2.x = cvtpk(p1[0], p1[1]); pa2.y = cvtpk(p1[2], p1[3]); pa2.z = cvtpk(p1[4], p1[5]); pa2.w = cvtpk(p1[6], p1[7]);
        pa3.x = cvtpk(p1[8], p1[9]); pa3.y = cvtpk(p1[10], p1[11]); pa3.z = cvtpk(p1[12], p1[13]); pa3.w = cvtpk(p1[14], p1[15]);
        const LAS unsigned char* vp = st + VOFF + vlane;
#define FA_PV(O, PA, DB, KS) do { const s16x4 lo_ = vtr(vp + (DB) * 4096 + (KS) * 1024), hi_ = vtr(vp + (DB) * 4096 + (KS) * 1024 + 512); \
        const bf16x8 vf_ = {lo_[0], lo_[1], lo_[2], lo_[3], hi_[0], hi_[1], hi_[2], hi_[3]}; \
        O = __builtin_amdgcn_mfma_f32_32x32x16_bf16(__builtin_bit_cast(bf16x8, PA), vf_, O, 0, 0, 0); } while (0)
        FA_PV(o0, pa0, 0, 0); FA_PV(o1, pa0, 1, 0);
        if (!meta) { FA_PV(o0, pa1, 0, 1); FA_PV(o1, pa1, 1, 1); FA_PV(o0, pa2, 0, 2); FA_PV(o1, pa2, 1, 2); FA_PV(o0, pa3, 0, 3); FA_PV(o1, pa3, 1, 3); }
#undef FA_PV
    }
    l += __shfl_xor(l, 32);
    wsf[32 + r32] = l;
    float rli[16];
#pragma unroll
    for (int r = 0; r < 16; ++r) rli[r] = 1.0f / wsf[32 + crow(r, hi)];
    LAS bf16* stg = (LAS bf16*)(base + LDS_OST) + wid * 2048;
#pragma unroll
    for (int r = 0; r < 16; ++r) { const int orow = crow(r, hi); stg[orow * 64 + r32] = (bf16)f2bf(o0[r] * rli[r]); stg[orow * 64 + 32 + r32] = (bf16)f2bf(o1[r] * rli[r]); }
#pragma unroll
    for (int i = 0; i < 4; ++i) { const int row = i * 8 + (lane >> 3), ch = lane & 7; const v4u v = *(const LAS v4u*)(stg + row * 64 + ch * 8);
        *(v4u*)(F.MIX + (row0 + row) * 1024 + 512 + h * 64 + ch * 8) = v; }
}
__device__ __forceinline__ void attn_phase(const Frame& F) {
    for (int u = F.vcu; u < 256; u += F.G) { const int bh = u >> 2, pr = u & 3;
        attn_unit(F, bh >> 3, bh & 7, pr); attn_unit(F, bh >> 3, bh & 7, 7 - pr); }
    __syncthreads();
}
}

namespace sa {
using fa::f32x16; using fa::s16x4; using fa::crow; using fa::cvtpk; using fa::vtr;
constexpr int CS = 528, TILE = 36 * CS  , QF_OFF = 4 * TILE  , WSF_OFF = QF_OFF + 32 * 288 * 2  , LDS_TOTAL = WSF_OFF + 8 * 256;
static_assert(LDS_TOTAL <= RING_BYTES && QF_OFF % 16 == 0 && WSF_OFF % 16 == 0, "sample attention LDS");
constexpr int NUNIT = 8, KEYS_PER = PAST / NUNIT  , NTC = KEYS_PER / 64  , NSPL = 2 * NUNIT  ;
__device__ __forceinline__ void tile_step(const LAS unsigned char* st, const bf16x8 (&qf)[18], f32x16& o0, f32x16& o1, float& m, float& l, LAS float* wsf, int r32, int hi, int vlane) {
        const LAS unsigned char* kb = st + hi * CS + r32 * 16;
        f32x16 p0;
#pragma unroll
        for (int r = 0; r < 16; ++r) p0[r] = 0.f;
#pragma unroll
        for (int s = 0; s < 18; ++s) { const bf16x8 k0 = *(const LAS bf16x8*)(kb + 2 * s * CS); p0 = __builtin_amdgcn_mfma_f32_32x32x16_bf16(k0, qf[s], p0, 0, 0, 0); }
        float mx = p0[0];
#pragma unroll
        for (int r = 1; r < 16; ++r) mx = fmaxf(mx, p0[r]);
        mx = fmaxf(mx, __shfl_xor(mx, 32));
        const float mn = fmaxf(m, mx);
        if (__any(mn > m)) {
            const float f = __builtin_amdgcn_exp2f(m - mn);
            l *= f; wsf[r32] = f;
#pragma unroll
            for (int r = 0; r < 16; ++r) { const float fr_ = wsf[crow(r, hi)]; o0[r] *= fr_; o1[r] *= fr_; }
            m = mn;
        }
        float sum = 0.f;
#pragma unroll
        for (int r = 0; r < 16; ++r) { p0[r] = __builtin_amdgcn_exp2f(p0[r] - m); sum += p0[r]; }
        l += sum;
        v4u pa0, pa1;
        pa0.x = cvtpk(p0[0], p0[1]); pa0.y = cvtpk(p0[2], p0[3]); pa0.z = cvtpk(p0[4], p0[5]); pa0.w = cvtpk(p0[6], p0[7]);
        pa1.x = cvtpk(p0[8], p0[9]); pa1.y = cvtpk(p0[10], p0[11]); pa1.z = cvtpk(p0[12], p0[13]); pa1.w = cvtpk(p0[14], p0[15]);
        const LAS unsigned char* vp = st + vlane;
#define SA_PV(O, PA, CT, KS) do { const s16x4 lo_ = vtr(vp + (CT) * 4 * CS + (KS) * 256), hi_ = vtr(vp + (CT) * 4 * CS + (KS) * 256 + 128); \
        const bf16x8 vf_ = {lo_[0], lo_[1], lo_[2], lo_[3], hi_[0], hi_[1], hi_[2], hi_[3]}; \
        O = __builtin_amdgcn_mfma_f32_32x32x16_bf16(__builtin_bit_cast(bf16x8, PA), vf_, O, 0, 0, 0); } while (0)
        SA_PV(o0, pa0, 0, 0); SA_PV(o1, pa0, 1, 0); SA_PV(o0, pa1, 0, 1); SA_PV(o1, pa1, 1, 1);
#undef SA_PV
}
__device__ __forceinline__ void attn_unit(const Frame& F, int bs, int split) {
    const int tid = F.tid, lane = F.lane, wid = F.wave, r32 = lane & 31, hi = lane >> 5, g = wid >> 2, w4 = wid & 3, tg = tid & 255;
    LAS unsigned char* base = F.lds + RING_OFF;
    LAS bf16* qfb = (LAS bf16*)(base + QF_OFF);
    LAS float* wsf = (LAS float*)(base + WSF_OFF) + wid * 64;
    __syncthreads();
    { LAS float* tmp = (LAS float*)base;
      for (int e = tid; e < 32 * 64; e += 512) { const int rr = e >> 6, n = e & 63, t = rr >> 3, h = rr & 7; tmp[e] = bf2f(F.QM[(size_t)(R_SAMP + bs * 4 + t) * 768 + h * 64 + n]); }
      for (int e = tid; e < 32 * 32; e += 512) { const int rr = e >> 5, i = e & 31, t = rr >> 3, h = rr & 7; qfb[rr * 288 + 256 + i] = F.QM[(size_t)(R_SAMP + bs * 4 + t) * 768 + 512 + h * 32 + i]; }
      __syncthreads();
      { int tz = tid; asm volatile("" : "+v"(tz)); const int h = tz & 7;
#pragma unroll 1
        for (int j = 0; j < 4; ++j) { const int c = (tz >> 3) + 64 * j; const f32x4* w = (const f32x4*)(F.w_kv_b + (size_t)c * 1024 + h * 128);
            f32x4 wv[16];
#pragma unroll
            for (int k = 0; k < 16; ++k) wv[k] = w[k];
#pragma unroll
            for (int t = 0; t < 4; ++t) { const LAS f32x4* q4 = (const LAS f32x4*)(tmp + (t * 8 + h) * 64); float a = 0.f;
#pragma unroll
                for (int k = 0; k < 16; ++k) { const f32x4 q = q4[k]; a += (wv[k].x * q.x + wv[k].y * q.y) + (wv[k].z * q.z + wv[k].w * q.w); }
                qfb[(t * 8 + h) * 288 + c] = (bf16)f2bf(a); if (split == 0) F.QLAT[((size_t)bs * 32 + t * 8 + h) * 256 + c] = a; } } }
      __syncthreads(); }
    bf16x8 qf[18];
#pragma unroll
    for (int s = 0; s < 18; ++s) qf[s] = *(const LAS bf16x8*)(qfb + r32 * 288 + 16 * s + 8 * hi);
    const int ptv = F.page_table[bs * NPAGES + split * (KEYS_PER / PAGE) + (lane & 15)];
    f32x4 RA[9], RB[9];
#define SA_LOAD(R, t) do { const int key0_ = (t) * 64 + g * 32; const int page_ = __builtin_amdgcn_readlane(ptv, key0_ >> 7); const size_t rb_ = (size_t)page_ * PAGE + (key0_ & 127); \
        _Pragma("unroll") for (int i_ = 0; i_ < 8; ++i_) R[i_] = *((const f32x4*)(F.cache_latent + (rb_ + i_ * 4 + w4) * 256) + lane); \
        R[8] = *((const f32x4*)(F.cache_krope + (rb_ + (tg >> 3)) * 32) + (tg & 7)); } while (0)
#define SA_WRITE(R, buf) do { LAS unsigned char* b_ = base + (g * 2 + (buf)) * TILE; \
        _Pragma("unroll") for (int i_ = 0; i_ < 8; ++i_) { const unsigned long long w_ = (unsigned long long)cvtpk(R[i_].x, R[i_].y) | ((unsigned long long)cvtpk(R[i_].z, R[i_].w) << 32); \
            *(LAS unsigned long long*)(b_ + (lane >> 1) * CS + (i_ * 4 + w4) * 16 + (lane & 1) * 8) = w_; } \
        { const unsigned long long w_ = (unsigned long long)cvtpk(R[8].x, R[8].y) | ((unsigned long long)cvtpk(R[8].z, R[8].w) << 32); \
          *(LAS unsigned long long*)(b_ + (32 + ((tg & 7) >> 1)) * CS + (tg >> 3) * 16 + (tg & 1) * 8) = w_; } } while (0)
    SA_LOAD(RA, 0); SA_WRITE(RA, 0); SA_LOAD(RB, 1); SA_LOAD(RA, 2);
    f32x16 o0, o1;
#pragma unroll
    for (int r = 0; r < 16; ++r) { o0[r] = 0.f; o1[r] = 0.f; }
    float m = -INFINITY, l = 0.f;
    const int vlane = (8 * w4 + 2 * ((lane >> 4) & 1) + ((lane & 3) >> 1)) * CS + (4 * hi + ((lane & 15) >> 2)) * 16 + 8 * (lane & 1);
    for (int t = 0; t < NTC; t += 2) {
        __syncthreads();
        tile_step(base + (g * 2 + 0) * TILE, qf, o0, o1, m, l, wsf, r32, hi, vlane);
        SA_WRITE(RB, 1);
        if (t + 3 < NTC) SA_LOAD(RB, t + 3);
        __syncthreads();
        tile_step(base + (g * 2 + 1) * TILE, qf, o0, o1, m, l, wsf, r32, hi, vlane);
        if (t + 2 < NTC) { SA_WRITE(RA, 0); if (t + 4 < NTC) SA_LOAD(RA, t + 4); }
    }
#undef SA_LOAD
#undef SA_WRITE
    l += __shfl_xor(l, 32);
    { int lz = lane; asm volatile("" : "+v"(lz));
      const int rz = lz & 31, hz = lz >> 5;
      const int sp = split * 2 + g; float* po = F.PART + ((size_t)(bs * NSPL + sp) * 32) * 256 + 64 * w4 + rz;
#pragma unroll
      for (int r = 0; r < 16; ++r) { po[(size_t)crow(r, hz) * 256] = o0[r]; po[(size_t)crow(r, hz) * 256 + 32] = o1[r]; }
      if (w4 == 0 && hz == 0) { float* ps = F.PSTAT + ((size_t)(bs * NSPL + sp) * 32 + rz) * 2; ps[0] = m; ps[1] = l; } }
}
__device__ __forceinline__ void attn_phase(const Frame& F) {
    for (int u = F.vcu; u < NSB * NUNIT; u += F.G) attn_unit(F, u >> 3, u & 7);
    __syncthreads();
}
}

namespace gdn {
using fa::f32x16; using fa::crow;
constexpr int REC = 40960, OFF_W = 0, OFF_QG = 8192, OFF_QK = 16384, OFF_KD = 24576, OFF_U = 32768;
constexpr int NCH = SEQ / 64;
typedef float f32x2_t __attribute__((ext_vector_type(2))); typedef __bf16 bf16x2_t __attribute__((ext_vector_type(2)));
__device__ __forceinline__ unsigned cvt2(float lo, float hi) { f32x2_t v = {lo, hi}; bf16x2_t b = __builtin_convertvector(v, bf16x2_t); return __builtin_bit_cast(unsigned, b); }
__device__ __forceinline__ bf16x8 pack8(float a0, float a1, float a2, float a3, float a4, float a5, float a6, float a7) {
    v4u w; w.x = cvt2(a0, a1); w.y = cvt2(a2, a3); w.z = cvt2(a4, a5); w.w = cvt2(a6, a7); return __builtin_bit_cast(bf16x8, w); }
__device__ __forceinline__ bf16x8 ldfrag_f32(const float* p) { const f32x4 a = *(const f32x4*)p, b = *(const f32x4*)(p + 4); return pack8(a.x, a.y, a.z, a.w, b.x, b.y, b.z, b.w); }
__device__ __forceinline__ int swz16(int c) { return (c & 3) | ((c & 4) << 1) | ((c & 8) >> 1); }

template <int PASS> __device__ __forceinline__ void solve_pass(const Frame& F, const LAS float* Lm, const LAS float* gcs, const LAS float* bts, const bf16* col, unsigned char* rec, int lane) {
    float X[64];
#pragma unroll
    for (int ib = 0; ib < 4; ++ib) {
        float c16[16];
#pragma unroll
        for (int k = 0; k < 16; ++k) c16[k] = bf2f(col[(size_t)(16 * ib + k) * 1536]);
        asm volatile("" ::: "memory");
#pragma unroll
        for (int k = 0; k < 16; ++k) { const int i = 16 * ib + k;
            float x = c16[k] * bts[i]; if (PASS == 1) x *= __expf(gcs[i]);
#pragma unroll
            for (int m = 0; m < (i + 3) / 4; ++m) { const f32x4 l4 = *(const LAS f32x4*)(Lm + i * 64 + ((4 * m) ^ ((i & 7) << 2)));
                if (4 * m + 0 < i) x -= l4.x * X[4 * m + 0];
                if (4 * m + 1 < i) x -= l4.y * X[4 * m + 1];
                if (4 * m + 2 < i) x -= l4.z * X[4 * m + 2];
                if (4 * m + 3 < i) x -= l4.w * X[4 * m + 3]; }
            X[i] = x;
            if ((k & 3) == 3) asm volatile("" ::: "memory");
        }
    }
    if (PASS == 0) { const unsigned lo = (unsigned)((lane >> 5) * 2048 + (lane & 31)); bf16* U = (bf16*)(rec + OFF_U);
#pragma unroll
        for (int i = 0; i < 64; ++i) { const int rt = i >> 5, ip = i & 31, hi_ = (ip >> 2) & 1, r = (ip & 3) + 4 * (ip >> 3);
            U[lo + (unsigned)((rt * 16 + r) * 64 + 32 * hi_)] = (bf16)f2bf(X[i]); } }
    else { const int s = lane >> 4, sw = swz16(lane & 15), hsel = (sw >> 3) & 1, el = sw & 7; bf16* W = (bf16*)(rec + OFF_W); const unsigned lo = (unsigned)((s * 64 + 32 * hsel) * 8 + el);
#pragma unroll
        for (int i = 0; i < 64; ++i) { const int rt = i >> 5, ip = i & 31; W[lo + (unsigned)((rt * 256 + ip) * 8)] = (bf16)f2bf(-X[i]); } }
}
__device__ __forceinline__ void solve_both(const Frame& F, const LAS float* Lm, const LAS float* gcs, const LAS float* bts, const bf16* vcol, const bf16* kcol, unsigned char* rec, int lane) {
    float XU[64], XW[64];
#pragma unroll
    for (int ib = 0; ib < 8; ++ib) {
        float cu[8], cw[8];
        { unsigned lo2 = (unsigned)lane * 2u; asm volatile("" : "+v"(lo2));
          const char* vb = (const char*)vcol + (size_t)(8 * ib) * 3072; const char* kb = (const char*)kcol + (size_t)(8 * ib) * 3072;
#pragma unroll
          for (int k = 0; k < 8; ++k) { cu[k] = bf2f(*(const bf16*)(vb + (size_t)k * 3072 + lo2)); cw[k] = bf2f(*(const bf16*)(kb + (size_t)k * 3072 + lo2)); } }
        asm volatile("" ::: "memory");
#pragma unroll
        for (int k = 0; k < 8; ++k) { const int i = 8 * ib + k;
            const float bi = bts[i]; float xu = cu[k] * bi, xw = cw[k] * bi * __expf(gcs[i]);
#pragma unroll
            for (int m = 0; m < (i + 3) / 4; ++m) { const f32x4 l4 = *(const LAS f32x4*)(Lm + i * 64 + ((4 * m) ^ ((i & 7) << 2)));
                if (4 * m + 0 < i) { xu -= l4.x * XU[4 * m + 0]; xw -= l4.x * XW[4 * m + 0]; }
                if (4 * m + 1 < i) { xu -= l4.y * XU[4 * m + 1]; xw -= l4.y * XW[4 * m + 1]; }
                if (4 * m + 2 < i) { xu -= l4.z * XU[4 * m + 2]; xw -= l4.z * XW[4 * m + 2]; }
                if (4 * m + 3 < i) { xu -= l4.w * XU[4 * m + 3]; xw -= l4.w * XW[4 * m + 3]; } }
            XU[i] = xu; XW[i] = xw;
            asm volatile("" ::: "memory");
        }
    }
    { int lz = lane; asm volatile("" : "+v"(lz));
      const unsigned lo = (unsigned)((lz >> 5) * 2048 + (lz & 31)); bf16* U = (bf16*)(rec + OFF_U);
#pragma unroll
      for (int i = 0; i < 64; ++i) { const int rt = i >> 5, ip = i & 31, hi_ = (ip >> 2) & 1, r = (ip & 3) + 4 * (ip >> 3);
          U[lo + (unsigned)((rt * 16 + r) * 64 + 32 * hi_)] = (bf16)f2bf(XU[i]); } }
    asm volatile("" ::: "memory");
    { int lz = lane; asm volatile("" : "+v"(lz)); lane = lz; }
    { const int s = lane >> 4, sw = swz16(lane & 15), hsel = (sw >> 3) & 1, el = sw & 7; bf16* W = (bf16*)(rec + OFF_W); const unsigned lo = (unsigned)((s * 64 + 32 * hsel) * 8 + el);
#pragma unroll
      for (int i = 0; i < 64; ++i) { const int rt = i >> 5, ip = i & 31; W[lo + (unsigned)((rt * 256 + ip) * 8)] = (bf16)f2bf(-XW[i]); } }
}
__device__ __forceinline__ void g1_unit(const Frame& F, int b, int n) {
    int lane_ = F.lane; asm volatile("" : "+v"(lane_));
    const int lane = lane_, h = F.wave, r32 = lane & 31, hi = lane >> 5;
    LAS float* Lm = (LAS float*)(F.lds + RING_OFF) + h * 4096;
    LAS float* gcs = (LAS float*)(F.lds + LDSCTL_OFF + 1024) + h * 128;
    LAS float* bts = gcs + 64;
    const size_t row0 = (size_t)b * SEQ + 64 * n;
    unsigned char* rec = F.GCH + ((size_t)(b * NCH + n) * NH + h) * REC;
    const float beta_l = F.GB[(row0 + lane) * 16 + h]; float gc = F.GB[(row0 + lane) * 16 + 8 + h];
#pragma unroll
    for (int off = 1; off < 64; off <<= 1) { const float t = __int_as_float(__builtin_amdgcn_ds_bpermute((lane - off) << 2, __float_as_int(gc))); if (lane >= off) gc += t; }
    const float gl = rdlane(gc, 63);
    gcs[lane] = gc; bts[lane] = beta_l;
    if (lane == 0) F.EGL[(size_t)(b * NH + h) * NCH + n] = __expf(gl);
    bf16x8 kf[2][4], qf[2][4];
#pragma unroll
    for (int t = 0; t < 2; ++t)
#pragma unroll
        for (int s = 0; s < 4; ++s) { const bf16* base = F.GQKV + (row0 + 32 * t + r32) * 1536 + h * 64 + 16 * s + 8 * hi; qf[t][s] = *(const bf16x8*)base; kf[t][s] = *(const bf16x8*)(base + 512); }
    LDS_WAIT(); asm volatile("" ::: "memory");
    { LAS bf16* kt = (LAS bf16*)Lm;
#pragma unroll
      for (int t = 0; t < 2; ++t)
#pragma unroll
          for (int s = 0; s < 4; ++s) *(LAS bf16x8*)(kt + (32 * t + r32) * 64 + 16 * s + 8 * hi) = kf[t][s];
      LDS_WAIT(); asm volatile("" ::: "memory");
      const int rt = lane >> 5;
#pragma unroll
      for (int s = 0; s < 4; ++s)
#pragma unroll
          for (int hh = 0; hh < 2; ++hh) { float v[8];
#pragma unroll
              for (int j = 0; j < 8; ++j) { const int c = 16 * s + 8 * (j >> 2) + 4 * hh + (j & 3); v[j] = bf2f(kt[c * 64 + lane]) * __expf(gl - gcs[c]); }
              *(bf16x8*)(rec + OFF_KD + (unsigned)(rt * 4096 + (lane & 31) * 16) + (unsigned)(s * 1024 + hh * 512)) = pack8(v[0], v[1], v[2], v[3], v[4], v[5], v[6], v[7]); }
      LDS_WAIT(); asm volatile("" ::: "memory"); }
#pragma unroll
    for (int tt = 0; tt < 3; ++tt) { const int it = tt == 0 ? 0 : 1, jt = tt == 2 ? 1 : 0;
        f32x16 acc;
#pragma unroll
        for (int r = 0; r < 16; ++r) acc[r] = 0.f;
#pragma unroll
        for (int s = 0; s < 4; ++s) acc = __builtin_amdgcn_mfma_f32_32x32x16_bf16(kf[jt][s], kf[it][s], acc, 0, 0, 0);
        const int i = 32 * it + r32; const float gci = gcs[i], bi = bts[i];
#pragma unroll
        for (int r = 0; r < 16; ++r) { const int j = 32 * jt + crow(r, hi); const float v = j < i ? bi * acc[r] * __expf(gci - gcs[j]) : 0.f; Lm[i * 64 + (j ^ ((i & 7) << 2))] = v; } }
#pragma unroll
    for (int tt = 0; tt < 4; ++tt) { const int it = tt >> 1, ct = tt & 1;
        if (ct <= it) {
            f32x16 acc;
#pragma unroll
            for (int r = 0; r < 16; ++r) acc[r] = 0.f;
#pragma unroll
            for (int s = 0; s < 4; ++s) acc = __builtin_amdgcn_mfma_f32_32x32x16_bf16(kf[ct][s], qf[it][s], acc, 0, 0, 0);
            const int i = 32 * it + r32; const float gci = gcs[i];
#pragma unroll
            for (int r = 0; r < 16; ++r) { const int c = 32 * ct + crow(r, hi); acc[r] = c <= i ? acc[r] * __expf(gci - gcs[c]) : 0.f; }
#pragma unroll
            for (int hf = 0; hf < 2; ++hf) *(bf16x8*)(rec + (unsigned)(OFF_QK + (it * 4 + 2 * ct + hf) * 1024) + (unsigned)lane * 16u) =
                pack8(acc[8 * hf], acc[8 * hf + 1], acc[8 * hf + 2], acc[8 * hf + 3], acc[8 * hf + 4], acc[8 * hf + 5], acc[8 * hf + 6], acc[8 * hf + 7]);
        } else { unsigned z = 0u; asm volatile("" : "+v"(z));
#pragma unroll
            for (int hf = 0; hf < 2; ++hf) *(v4u*)(rec + (unsigned)(OFF_QK + (it * 4 + 2 * ct + hf) * 1024) + (unsigned)lane * 16u) = (v4u){z, z, z, z}; } }
    LDS_WAIT(); asm volatile("" ::: "memory");
#pragma unroll
    for (int t = 0; t < 2; ++t) { const float eg = __expf(gcs[32 * t + r32]);
#pragma unroll
        for (int s = 0; s < 4; ++s) { const v4u own = __builtin_bit_cast(v4u, qf[t][s]);
            const unsigned s0 = hi ? own.x : own.z, s1 = hi ? own.y : own.w;
            const unsigned p0 = (unsigned)__builtin_amdgcn_ds_bpermute((lane ^ 32) << 2, (int)s0), p1 = (unsigned)__builtin_amdgcn_ds_bpermute((lane ^ 32) << 2, (int)s1);
            const unsigned d0 = hi ? p0 : own.x, d1 = hi ? p1 : own.y, d2 = hi ? own.z : p0, d3 = hi ? own.w : p1;
            v4u o; o.x = cvt2(__uint_as_float(d0 << 16) * eg, __uint_as_float(d0 & 0xffff0000u) * eg); o.y = cvt2(__uint_as_float(d1 << 16) * eg, __uint_as_float(d1 & 0xffff0000u) * eg);
            o.z = cvt2(__uint_as_float(d2 << 16) * eg, __uint_as_float(d2 & 0xffff0000u) * eg); o.w = cvt2(__uint_as_float(d3 << 16) * eg, __uint_as_float(d3 & 0xffff0000u) * eg);
            *(v4u*)(rec + (unsigned)(OFF_QG + (t * 4 + s) * 1024) + (unsigned)lane * 16u) = o; } }
    const bf16* vcol0 = F.GQKV + row0 * 1536 + 1024 + h * 64; const bf16* kcol0 = F.GQKV + row0 * 1536 + 512 + h * 64;
    { int l2 = lane; asm volatile("" : "+v"(l2)); solve_both(F, Lm, gcs, bts, vcol0, kcol0, rec, l2); }
    LDS_WAIT(); asm volatile("" ::: "memory");
}
__device__ __forceinline__ void chain_short(const Frame& F, int mode, int idx) {
    const int lane = F.lane; int h, total, rbase; float S[64];
    if (mode == 0) { h = idx; total = NMETA; rbase = R_META;
#pragma unroll
        for (int d = 0; d < 64; ++d) S[d] = 0.f; }
    else { h = idx & 7; total = NST; rbase = R_SAMP + (idx >> 3) * NST;
#pragma unroll
        for (int d = 0; d < 64; ++d) S[d] = F.state_ssm[((size_t)idx * 64 + d) * 64 + lane]; }
    for (int i = 0; i < total; ++i) { const size_t r = rbase + i;
        const float q = bf2f(F.GQKV[r * 1536 + h * 64 + lane]), k = bf2f(F.GQKV[r * 1536 + 512 + h * 64 + lane]), v = bf2f(F.GQKV[r * 1536 + 1024 + h * 64 + lane]);
        const float beta = F.GB[r * 16 + h], eg = expf(F.GB[r * 16 + 8 + h]);
        float k0 = 0.f, k1 = 0.f;
#pragma unroll
        for (int d = 0; d < 64; d += 2) { k0 += rdlane(k, d) * S[d]; k1 += rdlane(k, d + 1) * S[d + 1]; }
        const float vnew = beta * (v - eg * (k0 + k1));
        float o0 = 0.f, o1 = 0.f;
#pragma unroll
        for (int d = 0; d < 64; d += 2) { S[d] = eg * S[d] + rdlane(k, d) * vnew; o0 += rdlane(q, d) * S[d]; S[d + 1] = eg * S[d + 1] + rdlane(k, d + 1) * vnew; o1 += rdlane(q, d + 1) * S[d + 1]; }
        F.GO[r * 512 + h * 64 + lane] = o0 + o1; }
    float* so = mode == 0 ? F.S1 + (size_t)h * 4096 : F.out + O_SSMS + (size_t)idx * 4096;
#pragma unroll
    for (int d = 0; d < 64; ++d) so[d * 64 + lane] = S[d];
}
__device__ __forceinline__ void g1_phase(const Frame& F) {
    for (int u = F.vcu; u < NB * NCH; u += F.G) g1_unit(F, u / NCH, u % NCH);
    const int gw = F.vcu * NWAVES + F.wave, NGW = F.G * NWAVES;
    for (int t = NGW - 1 - gw; t < NH + NSB * NH; t += NGW) { if (t < NH) chain_short(F, 0, t); else chain_short(F, 1, t - NH); }
}
__device__ __forceinline__ void g2_task(const Frame& F, int b, int h, int cb) {
    int lane_ = F.lane; asm volatile("" : "+v"(lane_));
    const int lane = lane_, r32 = lane & 31, hi = lane >> 5;
    LAS unsigned char* base = F.lds + RING_OFF;
    constexpr int BUF = 36864;
    const unsigned char* recs = F.GCH + ((size_t)(b * NCH) * NH + h) * REC;
    f32x16 S0, S1, V0, V1, O0, O1;
    { const float* s1 = F.S1 + (size_t)h * 4096 + 32 * cb + r32;
#pragma unroll
      for (int r = 0; r < 16; ++r) { S0[r] = s1[(size_t)crow(r, hi) * 64]; S1[r] = s1[(size_t)(32 + crow(r, hi)) * 64]; } }
    const float egl_l = lane < NCH ? F.EGL[(size_t)(b * NH + h) * NCH + lane] : 0.f;
    const unsigned voff16 = (unsigned)lane * 16u;
#define G2_ISSUE(n, buf) do { const unsigned char* rc_ = recs + (size_t)(n) * NH * REC; LAS unsigned char* d_ = base + (buf) * BUF; \
        _Pragma("unroll") for (int f_ = 0; f_ < 32; ++f_) __builtin_amdgcn_global_load_lds((const unsigned*)(rc_ + f_ * 1024 + voff16), (LAS unsigned*)(d_ + f_ * 1024), 16, 0, 0); \
        _Pragma("unroll") for (int f_ = 0; f_ < 4; ++f_) __builtin_amdgcn_global_load_lds((const unsigned*)(rc_ + OFF_U + (cb * 4 + f_) * 1024 + voff16), (LAS unsigned*)(d_ + 32768 + f_ * 1024), 16, 0, 0); } while (0)
    G2_ISSUE(0, 0);
    for (int n = 0; n < NCH; ++n) {
        asm volatile("s_waitcnt vmcnt(0)" ::: "memory");
        if (n + 1 < NCH) G2_ISSUE(n + 1, (n + 1) & 1);
        const LAS unsigned char* bf = base + (n & 1) * BUF;
#define G2_FR(off, f) (*(const LAS bf16x8*)(bf + (off) + (f) * 1024 + lane * 16))
        bf16x8 sb[4];
        sb[0] = pack8(S0[0], S0[1], S0[2], S0[3], S0[4], S0[5], S0[6], S0[7]); sb[1] = pack8(S0[8], S0[9], S0[10], S0[11], S0[12], S0[13], S0[14], S0[15]);
        sb[2] = pack8(S1[0], S1[1], S1[2], S1[3], S1[4], S1[5], S1[6], S1[7]); sb[3] = pack8(S1[8], S1[9], S1[10], S1[11], S1[12], S1[13], S1[14], S1[15]);
        { const LAS unsigned* up = (const LAS unsigned*)(bf + 32768);
#pragma unroll
          for (int r = 0; r < 16; ++r) { V0[r] = bf2f(((const LAS bf16*)up)[(0 * 16 + r) * 64 + lane]); V1[r] = bf2f(((const LAS bf16*)up)[(1 * 16 + r) * 64 + lane]); O0[r] = 0.f; O1[r] = 0.f; } }
#pragma unroll
        for (int s = 0; s < 4; ++s) { V0 = __builtin_amdgcn_mfma_f32_32x32x16_bf16(G2_FR(OFF_W, s), sb[s], V0, 0, 0, 0); V1 = __builtin_amdgcn_mfma_f32_32x32x16_bf16(G2_FR(OFF_W, 4 + s), sb[s], V1, 0, 0, 0);
            O0 = __builtin_amdgcn_mfma_f32_32x32x16_bf16(G2_FR(OFF_QG, s), sb[s], O0, 0, 0, 0); O1 = __builtin_amdgcn_mfma_f32_32x32x16_bf16(G2_FR(OFF_QG, 4 + s), sb[s], O1, 0, 0, 0); }
        bf16x8 vb[4];
        vb[0] = pack8(V0[0], V0[1], V0[2], V0[3], V0[4], V0[5], V0[6], V0[7]); vb[1] = pack8(V0[8], V0[9], V0[10], V0[11], V0[12], V0[13], V0[14], V0[15]);
        vb[2] = pack8(V1[0], V1[1], V1[2], V1[3], V1[4], V1[5], V1[6], V1[7]); vb[3] = pack8(V1[8], V1[9], V1[10], V1[11], V1[12], V1[13], V1[14], V1[15]);
        const float egl = rdlane(egl_l, n);
#pragma unroll
        for (int r = 0; r < 16; ++r) { S0[r] *= egl; S1[r] *= egl; }
#pragma unroll
        for (int s = 0; s < 4; ++s) { O0 = __builtin_amdgcn_mfma_f32_32x32x16_bf16(G2_FR(OFF_QK, s), vb[s], O0, 0, 0, 0); O1 = __builtin_amdgcn_mfma_f32_32x32x16_bf16(G2_FR(OFF_QK, 4 + s), vb[s], O1, 0, 0, 0);
            S0 = __builtin_amdgcn_mfma_f32_32x32x16_bf16(G2_FR(OFF_KD, s), vb[s], S0, 0, 0, 0); S1 = __builtin_amdgcn_mfma_f32_32x32x16_bf16(G2_FR(OFF_KD, 4 + s), vb[s], S1, 0, 0, 0); }
#undef G2_FR
        { unsigned* go = (unsigned*)F.GO + (size_t)((((b * NCH + n) * NH + h) * 2 + cb) * 2) * 512;
          unsigned lo = (unsigned)lane; asm volatile("" : "+v"(lo));
#pragma unroll
          for (int r = 0; r < 16; r += 2) { go[lo + (unsigned)((r >> 1) * 64)] = cvt2(O0[r], O0[r + 1]); go[lo + (unsigned)(512 + (r >> 1) * 64)] = cvt2(O1[r], O1[r + 1]); } }
    }
#undef G2_ISSUE
    { float* so = F.out + O_SSMP + ((size_t)b * NH + h) * 4096 + 32 * cb + r32;
#pragma unroll
      for (int r = 0; r < 16; ++r) { so[(size_t)crow(r, hi) * 64] = S0[r]; so[(size_t)(32 + crow(r, hi)) * 64] = S1[r]; } }
}
__device__ __forceinline__ void g2_phase(const Frame& F) {
    if (F.wave == 0) for (int t = F.vcu; t < NB * NH * 2; t += F.G) g2_task(F, t >> 4, (t >> 1) & 7, t & 1);
}
}
__device__ __forceinline__ void p4_mixers(Frame& F) {
    if (F.G == 256) {
        const int v = F.vcu, first = v < 128, w = v & 127, bh = w >> 1, b = bh >> 3, h = bh & 7;
        const unsigned ql = first ? ((w & 1) ? 0xF04u : 0xFF5u) : ((w & 1) ? 0x126u : 0xF37u);
        if (first && F.wave == 0) gdn::g2_task(F, b, h, v & 1);
        if (!first) sa::attn_unit(F, v >> 3, v & 7);
        for (int i = 0; i < 3; ++i) { const int qb = (int)((ql >> (4 * i)) & 0xFu); if (qb != 0xF) fa::attn_unit(F, b, h, qb); }
        if (first) sa::attn_unit(F, v >> 3, v & 7);
        __syncthreads();
    } else {
        gdn::g2_phase(F);
        fa::attn_phase(F);
        sa::attn_phase(F);
    }
}
__device__ __forceinline__ void p5_post(Frame& F) {
    const int lane = F.lane; const int gw = F.vcu * NWAVES + F.wave, NGW = F.G * NWAVES;
    LAS float* wl = (LAS float*)(F.lds + RING_OFF) + F.wave * 256;
    const bool bal = (F.G == 256);
    const int t0 = bal ? (F.wave < 4 ? F.wave * 256 + F.vcu : NSB * 32) : gw, tstep = bal ? NSB * 32 : NGW;
    for (int t = t0; t < NSB * 32; t += tstep) { const int bs = t >> 5, rr = t & 31, tt = rr >> 3, h = rr & 7;
        float M = -INFINITY;
        for (int s = 0; s < sa::NSPL; ++s) M = fmaxf(M, F.PSTAT[(((size_t)bs * sa::NSPL + s) * 32 + rr) * 2]);
        float L = 0.f, o[4] = {0.f, 0.f, 0.f, 0.f};
        for (int s = 0; s < sa::NSPL; ++s) { const float* ps = F.PSTAT + (((size_t)bs * sa::NSPL + s) * 32 + rr) * 2; const float w = __builtin_amdgcn_exp2f(ps[0] - M); L += w * ps[1];
            const float* po = F.PART + (((size_t)bs * sa::NSPL + s) * 32 + rr) * 256;
#pragma unroll
            for (int k = 0; k < 4; ++k) o[k] += w * po[lane + 64 * k]; }
        {
          float ql[4];
#pragma unroll
          for (int k = 0; k < 4; ++k) ql[k] = F.QLAT[((size_t)bs * 32 + rr) * 256 + lane + 64 * k];
          const float qp = lane < 32 ? bf2f(F.QM[(size_t)(R_SAMP + bs * NST + tt) * 768 + 512 + h * 32 + lane]) : 0.f;
          for (int j = 0; j <= tt; ++j) { const float* lj = F.out + O_LATS + ((size_t)bs * NST + j) * KVLORA; const float* kj = F.KPE + (size_t)(R_SAMP + bs * NST + j) * 32;
              float lv[4]; float part = lane < 32 ? qp * kj[lane] : 0.f;
#pragma unroll
              for (int k = 0; k < 4; ++k) { lv[k] = lj[lane + 64 * k]; part += ql[k] * lv[k]; }
              const float sj = wave_sum(part); const float M2 = fmaxf(M, sj); const float sc = __builtin_amdgcn_exp2f(M - M2), pj = __builtin_amdgcn_exp2f(sj - M2);
              L = L * sc + pj; M = M2;
#pragma unroll
              for (int k = 0; k < 4; ++k) o[k] = o[k] * sc + pj * lv[k]; } }
        const float inv = 1.0f / L;
#pragma unroll
        for (int k = 0; k < 4; ++k) wl[lane + 64 * k] = o[k] * inv;
        LDS_WAIT(); asm volatile("" ::: "memory");
        float a = 0.f; const float* w = F.w_kv_b + h * 128 + 64 + lane;
        for (int c = 0; c < 256; ++c) a += wl[c] * w[(size_t)c * 1024];
        F.MIX[(size_t)(R_SAMP + bs * NST + tt) * 1024 + 512 + h * 64 + lane] = (bf16)f2bf(a);
        LDS_WAIT(); asm volatile("" ::: "memory"); }
    { const int h = lane >> 3, j = lane & 7;
      const f32x4 gn0 = *(const f32x4*)(F.gdn_norm_g + 8 * j), gn1 = *(const f32x4*)(F.gdn_norm_g + 8 * j + 4);
      const int nr = bal ? (F.wave < 4 ? 5 : (F.wave == 7 ? 12 : 11)) : (MT - gw + NGW - 1) / NGW;
      const int rbase = bal ? F.vcu * 65 + (F.wave < 4 ? F.wave * 5 : 20 + (F.wave - 4) * 11) : gw, rstride = bal ? 1 : NGW;
      static_assert(MT == 256 * 65, "balanced row split");
      for (int k0 = 0; k0 < nr; k0 += 4) {
        f32x4 oa[4], ob[4]; v4u zz[4]; int rq[4];
#pragma unroll
        for (int q = 0; q < 4; ++q) { const int r = (k0 + q < nr) ? rbase + (k0 + q) * rstride : MT; rq[q] = r < MT ? r : -1;
            oa[q] = (f32x4){0.f, 0.f, 0.f, 0.f}; ob[q] = oa[q]; zz[q] = (v4u){0u, 0u, 0u, 0u};
            if (r < R_END) {
                if (r < R_META) { const int b_ = r >> 11, n_ = (r >> 6) & 31, tk = r & 63, rt = tk >> 5, ip = tk & 31, hi_ = (ip >> 2) & 1, rr_ = (ip & 3) + 4 * (ip >> 3);
                    const unsigned* op = (const unsigned*)F.GO + (size_t)((((((b_ * 32 + n_) * NH + h) * 2 + (j >> 2)) * 2 + rt) * 8 + (rr_ >> 1)) * 64) + 8 * (j & 3) + 32 * hi_;
                    const v4u w0 = *(const v4u*)op, w1 = *(const v4u*)(op + 4);
                    if (rr_ & 1) { oa[q] = (f32x4){__uint_as_float(w0.x & 0xffff0000u), __uint_as_float(w0.y & 0xffff0000u), __uint_as_float(w0.z & 0xffff0000u), __uint_as_float(w0.w & 0xffff0000u)};
                                   ob[q] = (f32x4){__uint_as_float(w1.x & 0xffff0000u), __uint_as_float(w1.y & 0xffff0000u), __uint_as_float(w1.z & 0xffff0000u), __uint_as_float(w1.w & 0xffff0000u)}; }
                    else { oa[q] = (f32x4){__uint_as_float(w0.x << 16), __uint_as_float(w0.y << 16), __uint_as_float(w0.z << 16), __uint_as_float(w0.w << 16)};
                           ob[q] = (f32x4){__uint_as_float(w1.x << 16), __uint_as_float(w1.y << 16), __uint_as_float(w1.z << 16), __uint_as_float(w1.w << 16)}; } }
                else { const float* op = F.GO + (size_t)r * 512 + h * 64 + 8 * j; oa[q] = *(const f32x4*)op; ob[q] = *(const f32x4*)(op + 4); }
                zz[q] = *(const v4u*)(F.PRJ + (size_t)r * NPRJ + C_Z + h * 64 + 8 * j); } }
#pragma unroll
        for (int q = 0; q < 4; ++q) { const int r = rq[q]; if (r < 0) continue;
            bf16* mrow = F.MIX + (size_t)r * 1024;
            if (r >= R_END) { *(v4u*)(mrow + 8 * lane) = (v4u){0u, 0u, 0u, 0u}; *(v4u*)(mrow + 512 + 8 * lane) = (v4u){0u, 0u, 0u, 0u}; continue; }
            const f32x4 o0 = oa[q], o1 = ob[q]; const v4u zw = zz[q];
            float ss = (o0.x * o0.x + o0.y * o0.y) + (o0.z * o0.z + o0.w * o0.w) + (o1.x * o1.x + o1.y * o1.y) + (o1.z * o1.z + o1.w * o1.w);
            ss += __shfl_xor(ss, 1); ss += __shfl_xor(ss, 2); ss += __shfl_xor(ss, 4);
            const float rs = 1.0f / sqrtf(ss * (1.0f / 64.0f) + EPS);
            v4u w;
            w.x = pk2(o0.x * rs * gn0.x * silu_f(__uint_as_float(zw.x << 16)), o0.y * rs * gn0.y * silu_f(__uint_as_float(zw.x & 0xffff0000u)));
            w.y = pk2(o0.z * rs * gn0.z * silu_f(__uint_as_float(zw.y << 16)), o0.w * rs * gn0.w * silu_f(__uint_as_float(zw.y & 0xffff0000u)));
            w.z = pk2(o1.x * rs * gn1.x * silu_f(__uint_as_float(zw.z << 16)), o1.y * rs * gn1.y * silu_f(__uint_as_float(zw.z & 0xffff0000u)));
            w.w = pk2(o1.z * rs * gn1.z * silu_f(__uint_as_float(zw.w << 16)), o1.w * rs * gn1.w * silu_f(__uint_as_float(zw.w & 0xffff0000u)));
            *(v4u*)(mrow + h * 64 + 8 * j) = w;
            if (r >= R_META && r < R_SAMP) *(v4u*)(mrow + 512 + 8 * lane) = (v4u){0u, 0u, 0u, 0u}; }
      } }
}
__device__ __forceinline__ void p9_final(Frame& F) {
    const int gw = F.vcu * NWAVES + F.wave, NGW = F.G * NWAVES;
    { int lane = F.lane; asm volatile("" : "+v"(lane));
      const f32x4* gv = (const f32x4*)F.final_g; f32x4 g4[4];
      g4[0] = gv[2 * lane]; g4[1] = gv[2 * lane + 1]; g4[2] = gv[128 + 2 * lane]; g4[3] = gv[128 + 2 * lane + 1];
      for (int i0 = gw; i0 < NREAL; i0 += 4 * NGW) {
        v4u hb[4][2]; int rr[4];
#pragma unroll
        for (int q = 0; q < 4; ++q) { const int r = i0 + q * NGW; rr[q] = r < NREAL ? r : -1;
            if (rr[q] >= 0) { const bf16* hp = F.H2B + (size_t)r * D + 8 * lane; hb[q][0] = *(const v4u*)hp; hb[q][1] = *(const v4u*)(hp + 512); }
            else { hb[q][0] = (v4u){0u, 0u, 0u, 0u}; hb[q][1] = hb[q][0]; } }
#pragma unroll
        for (int q = 0; q < 4; ++q) { if (rr[q] < 0) continue;
            f32x4 v[4];
#pragma unroll
            for (int k = 0; k < 2; ++k) { const v4u w = hb[q][k];
                v[2 * k] = (f32x4){__uint_as_float(w.x << 16), __uint_as_float(w.x & 0xffff0000u), __uint_as_float(w.y << 16), __uint_as_float(w.y & 0xffff0000u)};
                v[2 * k + 1] = (f32x4){__uint_as_float(w.z << 16), __uint_as_float(w.z & 0xffff0000u), __uint_as_float(w.w << 16), __uint_as_float(w.w & 0xffff0000u)}; }
            float s = 0.f;
#pragma unroll
            for (int j = 0; j < 4; ++j) s += (v[j].x * v[j].x + v[j].y * v[j].y) + (v[j].z * v[j].z + v[j].w * v[j].w);
            const float rstd = 1.0f / sqrtf(wave_sum(s) * (1.0f / D) + EPS);
            float* o = F.out + O_YP + (size_t)rr[q] * D + 8 * lane;
            *(f32x4*)o = v[0] * rstd * g4[0]; *(f32x4*)(o + 4) = v[1] * rstd * g4[1]; *(f32x4*)(o + 512) = v[2] * rstd * g4[2]; *(f32x4*)(o + 516) = v[3] * rstd * g4[3]; }
      } }
    { const f32x4* gv = (const f32x4*)F.final_g + F.lane; f32x4 g4[4];
#pragma unroll
      for (int j = 0; j < 4; ++j) g4[j] = gv[64 * j];
      for (int i = gw; i < NSAMP; i += NGW) { const int r = R_SAMP + i;
        const f32x4* hv = (const f32x4*)(F.H2 + (size_t)r * D) + F.lane; f32x4 v[4];
#pragma unroll
        for (int j = 0; j < 4; ++j) v[j] = hv[64 * j];
        float s = 0.f;
#pragma unroll
        for (int j = 0; j < 4; ++j) s += (v[j].x * v[j].x + v[j].y * v[j].y) + (v[j].z * v[j].z + v[j].w * v[j].w);
        const float rstd = 1.0f / sqrtf(wave_sum(s) * (1.0f / D) + EPS);
        float* o = F.out + O_YS + (size_t)i * D;
#pragma unroll
        for (int j = 0; j < 4; ++j) *((f32x4*)o + F.lane + 64 * j) = v[j] * rstd * g4[j]; } }
}

struct Args { const void* in[23]; float* out; unsigned char* ws; int ph_lo, ph_hi, li, pad; };
__global__ void __launch_bounds__(NWAVES * 64, 2) mk_fwd(Args args) {
    extern __shared__ __attribute__((aligned(16))) unsigned char lds[];
    Frame F;
    F.lds = (LAS unsigned char*)lds;
    F.MISC = (volatile LAS unsigned*)(F.lds + MISC_OFF);
    F.tid = threadIdx.x; F.lane = F.tid & 63; F.wave = __builtin_amdgcn_readfirstlane(F.tid >> 6);
    F.G = gridDim.x; F.vcu = blockIdx.x;
    unsigned char* ws = args.ws;
    F.ctl = (gu32*)(ws + WS_CTL);
    F.x_prompt = (const float*)args.in[0]; F.x_sample = (const float*)args.in[1]; F.cache_latent = (const float*)args.in[2]; F.cache_krope = (const float*)args.in[3];
    F.state_conv = (const float*)args.in[4]; F.state_ssm = (const float*)args.in[5]; F.page_table = (const int*)args.in[6]; F.meta = (const float*)args.in[7];
    F.norm_mix_g = (const float*)args.in[8]; F.w_in = (const float*)args.in[9]; F.conv_w = (const float*)args.in[10]; F.a_log = (const float*)args.in[11]; F.dt_bias = (const float*)args.in[12];
    F.gdn_norm_g = (const float*)args.in[13]; F.q_norm_g = (const float*)args.in[14]; F.w_q_b = (const float*)args.in[15]; F.kv_norm_g = (const float*)args.in[16]; F.w_kv_b = (const float*)args.in[17];
    F.w_out = (const float*)args.in[18]; F.norm_mlp_g = (const float*)args.in[19]; F.w_up = (const float*)args.in[20]; F.w_down = (const float*)args.in[21]; F.final_g = (const float*)args.in[22];
    F.out = args.out;
    F.WIN = (bf16*)(ws + WS_WIN); F.WQB = (bf16*)(ws + WS_WQB); F.WKVB = (bf16*)(ws + WS_WKVB); F.WOUT = (bf16*)(ws + WS_WOUT); F.WUP = (bf16*)(ws + WS_WUP); F.WDN = (bf16*)(ws + WS_WDN);
    F.XN = (bf16*)(ws + WS_XN); F.PRJ = (bf16*)(ws + WS_PRJ); F.CQN = (bf16*)(ws + WS_CQN); F.LATN = (bf16*)(ws + WS_LATN); F.QM = (bf16*)(ws + WS_QM); F.KV = (bf16*)(ws + WS_KV);
    F.MIX = (bf16*)(ws + WS_MIX); F.H1B = (bf16*)(ws + WS_H1B); F.HFF = (bf16*)(ws + WS_HFF); F.KPEB = (bf16*)(ws + WS_KPEB); F.ROPE = (float*)(ws + WS_ROPE); F.QLAT = (float*)(ws + WS_QLAT); F.EGL = (float*)(ws + WS_EGL); F.S1 = (float*)(ws + WS_S1); F.GCH = ws + WS_GCH;
    F.KPE = (float*)(ws + WS_KPE); F.GQKV = (bf16*)(ws + WS_GQKV); F.GB = (float*)(ws + WS_GB); F.GO = (float*)(ws + WS_GO); F.H2B = (bf16*)(ws + WS_H2B); F.H2 = (float*)(ws + WS_H2);
    F.PART = (float*)(ws + WS_PART); F.PSTAT = (float*)(ws + WS_PSTAT); F.SS1 = (float*)(ws + WS_CTL) + CW_SS1;
    for (int u = F.tid; u < (LDS_BYTES - LDSCTL_OFF) / 4; u += NWAVES * 64) ((LAS unsigned*)(F.lds + LDSCTL_OFF))[u] = 0u;
    __syncthreads();
    XcdBarrier bar; bar.bar = (unsigned*)(F.ctl + CW_BAR); bar.x = 0; bar.st = nullptr;
    if (N_LAUNCHES == 1) bar = xcd_barrier_post((unsigned*)(F.ctl + CW_BAR), F.MISC + 8);
#define GRID_BAR() do { if (N_LAUNCHES == 1) xcd_barrier(bar); } while (0)
    const int lo = args.ph_lo, hi = args.ph_hi;
#define IN(k) (lo <= (k) && (k) < hi)
#define BOTH(k) (IN(k) && IN((k) + 1))

    if (IN(0)) { p0_prologue(F); VM_WAIT(); __syncthreads(); if (BOTH(0)) GRID_BAR(); }
    if (IN(1)) {
        pg8::Gemm g{F.XN, F.WIN, MT, NPRJ, D, D}; pg8::StaticOrder S; S.init(MT, NPRJ, F.G, (int)blockIdx.x);
        pg8::EpiStoreBf16 E{F.PRJ, NPRJ};
        pg8::gemm_phase<pg8::EpiStoreBf16, pg8::StaticOrder, true, true>(F.lds + RING_OFF, g, S, E);
        if (BOTH(1)) GRID_BAR();
    }
    if (IN(2)) {
        const int gw = F.vcu * NWAVES + F.wave, NGW = F.G * NWAVES;
        { int lane_ = F.lane; asm volatile("" : "+v"(lane_)); P2Consts W; p2_consts(F, W, lane_);
          const int rot = (NGW == SEQ) ? 40 : 0;
#pragma clang loop unroll(disable)
          for (int k = 0; ; ++k) { int r = gw + k * NGW; if (r >= MT) break;
              if (r < R_META) r = (r & ~(SEQ - 1)) | ((r + rot * k) & (SEQ - 1));
              const int s2 = r & (SEQ - 1); if (r < R_META && s2 >= 3 && s2 < SEQ - 3) p2_row_fast(F, r, W, lane_); else p2_row(F, r); } }
        VM_WAIT(); __syncthreads();
        if (BOTH(2)) GRID_BAR();
    }
    if (IN(3)) {
        { pg8::Gemm g{F.CQN, F.WQB, MT, 768, QLORA, QLORA}; pg8::StaticOrder S; S.init(MT, 768, F.G, (int)blockIdx.x);
          pg8::EpiQ E{F.QM, F.ROPE, MLA_SCALE * 1.4426950408889634f};
          pg8::gemm_phase<pg8::EpiQ, pg8::StaticOrder, true, true>(F.lds + RING_OFF, g, S, E); }
        { pg8::Gemm g{F.LATN, F.WKVB, MT, 1024, KVLORA, KVLORA}; pg8::StaticOrder S; S.init(MT, 1024, F.G, ((int)blockIdx.x + 8) % (int)gridDim.x);
          pg8::EpiStoreBf16 E{F.KV, 1024};
          pg8::gemm_phase<pg8::EpiStoreBf16, pg8::StaticOrder, true, true>(F.lds + RING_OFF, g, S, E); }
        gdn::g1_phase(F); VM_WAIT(); __syncthreads();
        if (BOTH(3)) GRID_BAR();
    }
    if (IN(4)) { p4_mixers(F); VM_WAIT(); __syncthreads(); if (BOTH(4)) GRID_BAR(); }
    if (IN(5)) { p5_post(F); VM_WAIT(); __syncthreads(); if (BOTH(5)) GRID_BAR(); }
    const bool split_tail = (F.G == 256);
    if (IN(6)) {
        const int Mrows = split_tail ? NREAL : MT;
        pg8::Gemm g{F.MIX, F.WOUT, Mrows, D, 1024, 1024}; pg8::StaticOrder S; S.init(Mrows, D, F.G, (int)blockIdx.x);
        pg8::EpiResid1 E{F.x_prompt, F.meta, F.x_sample, F.H1B, F.SS1, F.H2};
        pg8::gemm_phase<pg8::EpiResid1, pg8::StaticOrder, true, true>(F.lds + RING_OFF, g, S, E);
        if (BOTH(6)) GRID_BAR();
    }
    if (IN(7)) {
        gu32* cnt6 = F.ctl + CW_CNT6;
        if (split_tail && blockIdx.x < 4) {
            pg8::Gemm g{F.MIX, F.WOUT, MT, D, 1024, 1024}; pg8::OneUnit S{64, (int)blockIdx.x};
            pg8::EpiResid1 E{F.x_prompt, F.meta, F.x_sample, F.H1B, F.SS1, F.H2};
            pg8::gemm_phase<pg8::EpiResid1, pg8::OneUnit, true, true>(F.lds + RING_OFF, g, S, E);
            VM_WAIT(); __syncthreads();
            if (F.tid == 0) { __builtin_amdgcn_fence(__ATOMIC_RELEASE, "agent"); asm volatile("s_waitcnt vmcnt(0)" ::: "memory"); __hip_atomic_fetch_add(cnt6, 1u, RLX_AGENT); }
        }
        { const int Mrows = split_tail ? NREAL : MT;
          pg8::Gemm g{F.H1B, F.WUP, Mrows, FF, D, D}; pg8::StaticOrder S; S.init(Mrows, FF, F.G, (int)blockIdx.x);
          pg8::EpiUp E{F.HFF, FF, F.SS1};
          pg8::gemm_phase<pg8::EpiUp, pg8::StaticOrder, true, true>(F.lds + RING_OFF, g, S, E); }
        if (split_tail && blockIdx.x >= 240) {
            if (F.tid == 0) { unsigned sp = 0; while (__hip_atomic_load(cnt6, RLX_AGENT) < 4u) { __builtin_amdgcn_s_sleep(2); if (++sp > (1u << 22)) break; }
                __builtin_amdgcn_fence(__ATOMIC_ACQUIRE, "agent"); asm volatile("s_waitcnt vmcnt(0)" ::: "memory"); }
            __syncthreads();
            pg8::Gemm g{F.H1B + (size_t)NREAL * D, F.WUP, 256, FF, D, D}; pg8::OneUnit S{0, (int)blockIdx.x - 240};
            pg8::EpiUp E{F.HFF + (size_t)NREAL * FF, FF, F.SS1 + NREAL};
            pg8::gemm_phase<pg8::EpiUp, pg8::OneUnit, true, true>(F.lds + RING_OFF, g, S, E);
        }
        if (BOTH(7)) GRID_BAR();
    }
    if (IN(8)) {
        { pg8::Gemm g{F.HFF, F.WDN, NREAL, D, FF, FF}; pg8::StaticOrder S; S.init(NREAL, D, F.G, (int)blockIdx.x);
          pg8::EpiResid2 E{F.H1B, F.H2B};
          pg8::gemm_phase<pg8::EpiResid2, pg8::StaticOrder, true, true>(F.lds + RING_OFF, g, S, E); }
        { pg8::Gemm g{F.HFF + (size_t)NREAL * FF, F.WDN, 256, D, 256, FF}; pg8::SplitKOrder S; S.init(D, 16, 256, F.G, (int)blockIdx.x);
          pg8::EpiAtomicAdd E{F.H2 + (size_t)NREAL * D};
          pg8::gemm_phase<pg8::EpiAtomicAdd, pg8::SplitKOrder, true, true>(F.lds + RING_OFF, g, S, E); }
        if (BOTH(8)) GRID_BAR();
    }
    if (IN(9)) { p9_final(F); }
#undef IN
#undef BOTH
}

extern "C" void kernel_launch(void* const* d_in, const int* in_sizes, int n_in, void* d_out, int out_size, void* d_ws, size_t ws_size, hipStream_t stream) {
    static int grid = 0;
    if (grid == 0) {
        if (n_in != 23 || out_size != (int)O_END || ws_size < WS_END) { fprintf(stderr, "kernel_launch: unexpected shapes: n_in %d out %d ws %zu (need %zu); nothing launched\n", n_in, out_size, ws_size, (size_t)WS_END); grid = -1; return; }
        int dev = 0, cus = 0, per_cu = 0;
        if (hipGetDevice(&dev) != hipSuccess || hipDeviceGetAttribute(&cus, hipDeviceAttributeMultiprocessorCount, dev) != hipSuccess) { fprintf(stderr, "kernel_launch: device query failed\n"); grid = -1; return; }
        if (hipFuncSetAttribute((const void*)mk_fwd, hipFuncAttributeMaxDynamicSharedMemorySize, LDS_BYTES) != hipSuccess) { fprintf(stderr, "kernel_launch: hipFuncSetAttribute failed\n"); grid = -1; return; }
        if (hipOccupancyMaxActiveBlocksPerMultiprocessor(&per_cu, (const void*)mk_fwd, NWAVES * 64, LDS_BYTES) != hipSuccess || per_cu < 1) { fprintf(stderr, "kernel_launch: occupancy query says %d blocks per CU\n", per_cu); per_cu = 1; }
        (void)hipGetLastError();
        grid = cus;
        fprintf(stderr, "kernel_launch: grid %d (cus %d, per_cu %d)\n", grid, cus, per_cu);
    }
    if (grid < 0) return;
    if (hipMemsetAsync((char*)d_ws + WS_CTL, 0, CTL_ZERO_BYTES, stream) != hipSuccess) { fprintf(stderr, "kernel_launch: memset failed\n"); return; }
    Args a{};
    for (int i = 0; i < 23; ++i) a.in[i] = d_in[i];
    a.out = (float*)d_out; a.ws = (unsigned char*)d_ws;
    for (int li = 0; li < N_LAUNCHES; ++li) {
        if (N_LAUNCHES == 1) { a.ph_lo = 0; a.ph_hi = NPHASES; } else { a.ph_lo = li * NPHASES / N_LAUNCHES; a.ph_hi = (li + 1) * NPHASES / N_LAUNCHES; }
        a.li = li;
        hipLaunchKernelGGL(mk_fwd, dim3(grid), dim3(NWAVES * 64), LDS_BYTES, stream, a);
        if (N_LAUNCHES == NPHASES && li == DUP_PHASE) hipLaunchKernelGGL(mk_fwd, dim3(grid), dim3(NWAVES * 64), LDS_BYTES, stream, a);
        const hipError_t le = hipPeekAtLastError();
        if (le != hipSuccess) { fprintf(stderr, "kernel_launch: launch %d failed: %s\n", li, hipGetErrorName(le)); break; }
    }
}
```

```cpp
#include <hip/hip_runtime.h>
#include <cstdio>
#include <cstdint>
#include <cmath>
namespace pg8 {
#define PG8_LAS __attribute__((address_space(3)))
typedef unsigned short bf16_t;
typedef short bf16x8 __attribute__((ext_vector_type(8)));
typedef float f32x4 __attribute__((ext_vector_type(4)));
typedef unsigned u32x4 __attribute__((ext_vector_type(4)));
constexpr int BM = 256, BK = 64, HALF = 128, HTB = HALF * BK * 2  , STAGE_BYTES = 8 * HTB, NXCD = 8, WGM = 8;

__host__ __device__ __forceinline__ int lds_byte(int r, int c) { const int st = (r >> 4) * 2 + (c >> 5), rr = r & 15, cc = c & 31, ob = rr * 64 + cc * 2; return st * 1024 + (ob ^ (((ob >> 9) & 1) << 5)); }
__host__ __device__ __forceinline__ void stage_rc(int b, int& R, int& C) { const int st = b / 1024, sb = b % 1024, swz = sb ^ (((sb >> 9) & 1) << 5); R = (st >> 1) * 16 + swz / 64; C = (st & 1) * 32 + (swz % 64) / 2; }
__host__ __device__ __forceinline__ int perm32(int rho) { const int n = rho >> 4, i = rho & 15; return 8 * (i >> 2) + 4 * n + (i & 3); }

struct Unit { int pm, pn, ko; };
struct Gemm { const bf16_t* A; const bf16_t* Bt; int M, N, K, ld; };

struct StaticOrder {
    int nM, nN, nwg, G, c;
    __host__ __device__ void init(int M, int N, int G_, int c_) { nM = M / BM; nN = N / BM; nwg = nM * nN; G = G_; c = c_; }
    __host__ __device__ bool next(int i, Unit& u) const {
        const long L = (long)i * G + c; if (L >= nwg) return false;
        int wgid = (int)L; { const int q = nwg / NXCD, r = nwg % NXCD, xcd = wgid % NXCD, off = wgid / NXCD; wgid = (xcd < r ? xcd * (q + 1) : r * (q + 1) + (xcd - r) * q) + off; }
        const int nig = WGM * nN, gid = wgid / nig, fm = gid * WGM, gsz = (nM - fm) < WGM ? (nM - fm) : WGM;
        u.pm = fm + ((wgid % nig) % gsz); u.pn = (wgid % nig) / gsz; u.ko = 0; return true;
    }
    __device__ __forceinline__ void a_ready(const Unit&) const {}
    __device__ __forceinline__ void done(const Unit&) const {}
};

struct OneUnit {
    int pm, pn;
    __host__ __device__ bool next(int i, Unit& u) const { if (i != 0) return false; u.pm = pm; u.pn = pn; u.ko = 0; return true; }
    __device__ __forceinline__ void a_ready(const Unit&) const {}
    __device__ __forceinline__ void done(const Unit&) const {}
};
struct SplitKOrder {
    int nN, nS, ks, G, c;
    __host__ __device__ void init(int N, int nslices, int kslice, int G_, int c_) { nN = N / BM; nS = nslices; ks = kslice; G = G_; c = c_; }
    __host__ __device__ bool next(int i, Unit& u) const { const long L = (long)i * G + c; if (L >= nN * nS) return false; u.pm = 0; u.pn = (int)(L % nN); u.ko = (int)(L / nN) * ks; return true; }
    __device__ __forceinline__ void a_ready(const Unit&) const {}
    __device__ __forceinline__ void done(const Unit&) const {}
};
__device__ __forceinline__ unsigned cvt_pk_bf16(float lo, float hi) { unsigned r; asm volatile("v_cvt_pk_bf16_f32 %0, %1, %2" : "=v"(r) : "v"(lo), "v"(hi)); return r; }
constexpr int ROWS_REAL = 16384, ROW_META = 16384, ROW_SAMP = 16400, ROW_END = 16528;
__device__ __forceinline__ const float* x_row_ptr(const float* xp, const float* xm, const float* xs, int row) {
    if (row < ROW_META) return xp + (size_t)row * 1024;
    if (row < ROW_SAMP) return xm + (size_t)(row - ROW_META) * 1024;
    if (row < ROW_END) return xs + (size_t)(row - ROW_SAMP) * 1024;
    return nullptr;
}
struct EpiStoreBf16 {
    static constexpr bool PERM = true, AFTER_DRAIN = false;
    bf16_t* O; int ldc;
    __device__ __forceinline__ void operator()(const f32x4 (&acc)[2][2][4][2], const Unit& u, int wr, int wc, int fr, int fq) const {
        asm volatile("" : "+v"(fr), "+v"(fq));
        const int row0 = u.pm * BM + wr * 64 + fr, col0 = u.pn * BM + wc * 32 + 8 * fq;
#pragma unroll
        for (int ai = 0; ai < 2; ++ai)
#pragma unroll
            for (int m = 0; m < 4; ++m) { bf16_t* rowp = O + (size_t)(row0 + ai * HALF + m * 16) * ldc + col0;
#pragma unroll
                for (int bj = 0; bj < 2; ++bj) { const f32x4 v0 = acc[ai][bj][m][0], v1 = acc[ai][bj][m][1];
                    u32x4 w; w.x = cvt_pk_bf16(v0[0], v0[1]); w.y = cvt_pk_bf16(v0[2], v0[3]); w.z = cvt_pk_bf16(v1[0], v1[1]); w.w = cvt_pk_bf16(v1[2], v1[3]);
                    *(u32x4*)(rowp + bj * HALF) = w; } }
    }
};
struct EpiResid1 {
    static constexpr bool PERM = true, AFTER_DRAIN = false;
    const float* xp; const float* xm; const float* xs; bf16_t* H1B; float* ss; float* H2;
    __device__ __forceinline__ void operator()(const f32x4 (&acc)[2][2][4][2], const Unit& u, int wr, int wc, int fr, int fq) const {
        asm volatile("" : "+v"(fr), "+v"(fq));
        const int row0 = u.pm * BM + wr * 64 + fr, col0 = u.pn * BM + wc * 32 + 8 * fq;
#pragma unroll
        for (int ai = 0; ai < 2; ++ai)
#pragma unroll
          for (int mh = 0; mh < 2; ++mh) {
            f32x4 xv[2][2][2]; float fl[2];
#pragma unroll
            for (int mm = 0; mm < 2; ++mm) { const int row = row0 + ai * HALF + (2 * mh + mm) * 16;
                const float* xb = row < ROW_META ? xp : (row < ROW_SAMP ? xm : (row < ROW_END ? xs : xp));
                const int rel = row < ROW_META ? row : (row < ROW_SAMP ? row - ROW_META : (row < ROW_END ? row - ROW_SAMP : 0));
                fl[mm] = row < ROW_END ? 1.f : 0.f; const float* xq = xb + (size_t)rel * 1024;
#pragma unroll
                for (int bj = 0; bj < 2; ++bj) { const int col = col0 + bj * HALF; xv[mm][bj][0] = *(const f32x4*)(xq + col); xv[mm][bj][1] = *(const f32x4*)(xq + col + 4); } }
#pragma unroll
            for (int mm = 0; mm < 2; ++mm) { const int m = 2 * mh + mm; const int row = row0 + ai * HALF + m * 16; float part = 0.f;
#pragma unroll
                for (int bj = 0; bj < 2; ++bj) { const int col = col0 + bj * HALF;
                    const f32x4 v0 = acc[ai][bj][m][0] + xv[mm][bj][0] * fl[mm], v1 = acc[ai][bj][m][1] + xv[mm][bj][1] * fl[mm];
                    u32x4 w; w.x = cvt_pk_bf16(v0[0], v0[1]); w.y = cvt_pk_bf16(v0[2], v0[3]); w.z = cvt_pk_bf16(v1[0], v1[1]); w.w = cvt_pk_bf16(v1[2], v1[3]);
                    *(u32x4*)(H1B + (size_t)row * 1024 + col) = w;
                    if (u.pm == 64) { *(f32x4*)(H2 + (size_t)row * 1024 + col) = v0; *(f32x4*)(H2 + (size_t)row * 1024 + col + 4) = v1; }
                    part += (v0[0] * v0[0] + v0[1] * v0[1]) + (v0[2] * v0[2] + v0[3] * v0[3]) + (v1[0] * v1[0] + v1[1] * v1[1]) + (v1[2] * v1[2] + v1[3] * v1[3]); }
                part += __shfl_xor(part, 16); part += __shfl_xor(part, 32);
                if (fq == 0 && ss) __hip_atomic_fetch_add(ss + row, part, __ATOMIC_RELAXED, __HIP_MEMORY_SCOPE_AGENT); } }
    }
};
struct EpiUp {
    static constexpr bool PERM = true, AFTER_DRAIN = false;
    bf16_t* O; int ldc; const float* ss;
    __device__ __forceinline__ void operator()(const f32x4 (&acc)[2][2][4][2], const Unit& u, int wr, int wc, int fr, int fq) const {
        asm volatile("" : "+v"(fr), "+v"(fq));
        const int row0 = u.pm * BM + wr * 64 + fr, col0 = u.pn * BM + wc * 32 + 8 * fq;
        float ssv[2][4];
#pragma unroll
        for (int ai = 0; ai < 2; ++ai)
#pragma unroll
            for (int m = 0; m < 4; ++m) ssv[ai][m] = ss[row0 + ai * HALF + m * 16];
#pragma unroll
        for (int ai = 0; ai < 2; ++ai)
#pragma unroll
            for (int m = 0; m < 4; ++m) { const int row = row0 + ai * HALF + m * 16; bf16_t* rowp = O + (size_t)row * ldc + col0;
                const float rs = 1.0f / sqrtf(ssv[ai][m] * (1.0f / 1024.0f) + 1e-6f);
#pragma unroll
                for (int bj = 0; bj < 2; ++bj) { f32x4 v0 = acc[ai][bj][m][0] * rs, v1 = acc[ai][bj][m][1] * rs;
#pragma unroll
                    for (int e = 0; e < 4; ++e) { const float a = fmaxf(v0[e], 0.f), b = fmaxf(v1[e], 0.f); v0[e] = a * a; v1[e] = b * b; }
                    u32x4 w; w.x = cvt_pk_bf16(v0[0], v0[1]); w.y = cvt_pk_bf16(v0[2], v0[3]); w.z = cvt_pk_bf16(v1[0], v1[1]); w.w = cvt_pk_bf16(v1[2], v1[3]);
                    *(u32x4*)(rowp + bj * HALF) = w; } }
    }
};
struct EpiResid2 {
    static constexpr bool PERM = true, AFTER_DRAIN = false;
    const bf16_t* H1B; bf16_t* H2B;
    __device__ __forceinline__ void operator()(const f32x4 (&acc)[2][2][4][2], const Unit& u, int wr, int wc, int fr, int fq) const {
        asm volatile("" : "+v"(fr), "+v"(fq));
        const int row0 = u.pm * BM + wr * 64 + fr, col0 = u.pn * BM + wc * 32 + 8 * fq;
#pragma unroll
        for (int ai = 0; ai < 2; ++ai) {
            u32x4 hv[4][2];
#pragma unroll
            for (int m = 0; m < 4; ++m)
#pragma unroll
                for (int bj = 0; bj < 2; ++bj) hv[m][bj] = *(const u32x4*)(H1B + (size_t)(row0 + ai * HALF + m * 16) * 1024 + col0 + bj * HALF);
#pragma unroll
            for (int m = 0; m < 4; ++m) { const int row = row0 + ai * HALF + m * 16;
#pragma unroll
                for (int bj = 0; bj < 2; ++bj) { const size_t off = (size_t)row * 1024 + col0 + bj * HALF;
                    const u32x4 hb = hv[m][bj];
                    const f32x4 h0 = (f32x4){__uint_as_float(hb.x << 16), __uint_as_float(hb.x & 0xffff0000u), __uint_as_float(hb.y << 16), __uint_as_float(hb.y & 0xffff0000u)};
                    const f32x4 h1 = (f32x4){__uint_as_float(hb.z << 16), __uint_as_float(hb.z & 0xffff0000u), __uint_as_float(hb.w << 16), __uint_as_float(hb.w & 0xffff0000u)};
                    const f32x4 v0 = acc[ai][bj][m][0] + h0, v1 = acc[ai][bj][m][1] + h1;
                    u32x4 w; w.x = cvt_pk_bf16(v0[0], v0[1]); w.y = cvt_pk_bf16(v0[2], v0[3]); w.z = cvt_pk_bf16(v1[0], v1[1]); w.w = cvt_pk_bf16(v1[2], v1[3]);
                    *(u32x4*)(H2B + off) = w; } } }
    }
};
struct EpiAtomicAdd {
    static constexpr bool PERM = true, AFTER_DRAIN = false;
    float* H2;
    __device__ __forceinline__ void operator()(const f32x4 (&acc)[2][2][4][2], const Unit& u, int wr, int wc, int fr, int fq) const {
        asm volatile("" : "+v"(fr), "+v"(fq));
        const int row0 = wr * 64 + fr, col0 = u.pn * BM + wc * 32 + 8 * fq;
#pragma unroll
        for (int ai = 0; ai < 2; ++ai)
#pragma unroll
            for (int m = 0; m < 4; ++m) { const int row = row0 + ai * HALF + m * 16;
                if (row >= 16 && row < 144) {
#pragma unroll
                    for (int bj = 0; bj < 2; ++bj) { float* p = H2 + (size_t)row * 1024 + col0 + bj * HALF;
#pragma unroll
                        for (int e = 0; e < 4; ++e) { __hip_atomic_fetch_add(p + e, acc[ai][bj][m][0][e], __ATOMIC_RELAXED, __HIP_MEMORY_SCOPE_AGENT); __hip_atomic_fetch_add(p + 4 + e, acc[ai][bj][m][1][e], __ATOMIC_RELAXED, __HIP_MEMORY_SCOPE_AGENT); } } } }
    }
};
struct EpiQ {
    static constexpr bool PERM = true, AFTER_DRAIN = false;
    bf16_t* O; const float* rope; float c2;
    __device__ __forceinline__ void operator()(const f32x4 (&acc)[2][2][4][2], const Unit& u, int wr, int wc, int fr, int fq) const {
        asm volatile("" : "+v"(fr), "+v"(fq));
        const int row0 = u.pm * BM + wr * 64 + fr, col0 = u.pn * BM + wc * 32 + 8 * fq;
        const bool dorope = (u.pn == 2);
#pragma unroll
        for (int ai = 0; ai < 2; ++ai) {
            f32x4 cs[4][4];
            if (dorope) {
#pragma unroll
                for (int m = 0; m < 4; ++m) { const int row = row0 + ai * HALF + m * 16;
                    const int pi = row < ROW_META ? 16 + (row & 2047) : (row < ROW_SAMP ? row - ROW_META : (row < ROW_END ? 2064 + ((row - ROW_SAMP) & 3) : 0));
                    const float* tb = rope + (size_t)pi * 32 + ((8 * fq) & 15);
                    cs[m][0] = *(const f32x4*)(tb); cs[m][1] = *(const f32x4*)(tb + 16); cs[m][2] = *(const f32x4*)(tb + 4); cs[m][3] = *(const f32x4*)(tb + 20); } }
#pragma unroll
            for (int m = 0; m < 4; ++m) { const int row = row0 + ai * HALF + m * 16; bf16_t* rowp = O + (size_t)row * 768 + col0;
#pragma unroll
                for (int bj = 0; bj < 2; ++bj) { f32x4 v0 = acc[ai][bj][m][0] * c2, v1 = acc[ai][bj][m][1] * c2;
                    if (dorope) { const f32x4 c0 = cs[m][0], s0 = cs[m][1], c1 = cs[m][2], s1 = cs[m][3];
                        f32x4 p0, p1;
#pragma unroll
                        for (int e = 0; e < 4; ++e) { p0[e] = __shfl_xor(v0[e], 32); p1[e] = __shfl_xor(v1[e], 32); }
                        if (fq < 2) { v0 = v0 * c0 - p0 * s0; v1 = v1 * c1 - p1 * s1; } else { v0 = v0 * c0 + p0 * s0; v1 = v1 * c1 + p1 * s1; } }
                    u32x4 w; w.x = cvt_pk_bf16(v0[0], v0[1]); w.y = cvt_pk_bf16(v0[2], v0[3]); w.z = cvt_pk_bf16(v1[0], v1[1]); w.w = cvt_pk_bf16(v1[2], v1[3]);
                    *(u32x4*)(rowp + bj * HALF) = w; } } }
    }
};
template <class Epi, class Sched, bool ALIGN_EPI = false, bool SP2 = false>
__device__ __forceinline__ void gemm_phase(PG8_LAS unsigned char* lds, const Gemm g, const Sched& S, const Epi& E) {
    int tid_ = threadIdx.x; asm volatile("" : "+v"(tid_));
    const int tid = tid_, wid = __builtin_amdgcn_readfirstlane(tid >> 6), lane = tid & 63, wr = wid >> 2, wc = wid & 3, fr = lane & 15, fq = lane >> 4;
    const int K = g.ld, nt = g.K / BK;
    unsigned voffA[2], voffB[2];
#pragma unroll
    for (int i = 0; i < 2; ++i) { int R, C; stage_rc(tid * 16 + i * 8192, R, C); const int Rb = Epi::PERM ? ((R & ~31) + perm32(R & 31)) : R;
        voffA[i] = (unsigned)(R * K + C) * 2u; voffB[i] = (unsigned)(Rb * K + C) * 2u; }
    const size_t kstep = (size_t)(BK * 2);
    const size_t hstep = (size_t)HALF * K * 2;
    const size_t tstep = 2 * hstep;
    const unsigned ldsw = (unsigned)wid * 1024u;
    const int aoff = lds_byte(wr * 64 + fr, fq * 8), boff = lds_byte(wc * 32 + fr, fq * 8);
#define PG8_SA(b, h) (((b) * 2 + (h)) * HTB)
#define PG8_SB(b, h) ((4 + (b) * 2 + (h)) * HTB)
#define PG8_STAGE(bufoff, gbase, voff) do { _Pragma("unroll") for (int _i = 0; _i < 2; ++_i) \
        __builtin_amdgcn_global_load_lds((const unsigned*)((const char*)(gbase) + (voff)[_i]), (PG8_LAS unsigned*)(lds + (bufoff) + ldsw + _i * 8192), 16, 0, 0); } while (0)
#define PG8_LDA(dst, b, h) do { _Pragma("unroll") for (int m = 0; m < 4; ++m) _Pragma("unroll") for (int k = 0; k < 2; ++k) dst[m][k] = *(const PG8_LAS bf16x8*)(lds + PG8_SA(b, h) + aoff + m * 2048 + k * 1024); } while (0)
#define PG8_LDB(dst, b, h) do { _Pragma("unroll") for (int n = 0; n < 2; ++n) _Pragma("unroll") for (int k = 0; k < 2; ++k) dst[n][k] = *(const PG8_LAS bf16x8*)(lds + PG8_SB(b, h) + boff + n * 2048 + k * 1024); } while (0)
#define PG8_MMA(ai, bj, At, Bt) do { __builtin_amdgcn_s_setprio(1); _Pragma("unroll") for (int m = 0; m < 4; ++m) _Pragma("unroll") for (int n = 0; n < 2; ++n) _Pragma("unroll") for (int k = 0; k < 2; ++k) \
        acc[ai][bj][m][n] = __builtin_amdgcn_mfma_f32_16x16x32_bf16(Bt[n][k], At[m][k], acc[ai][bj][m][n], 0, 0, 0); __builtin_amdgcn_s_setprio(0); } while (0)
#define PG8_WAIT_V(n) asm volatile("s_waitcnt vmcnt(" #n ")" ::: "memory")
#define PG8_WAIT_L(n) asm volatile("s_waitcnt lgkmcnt(" #n ")" ::: "memory")
#define PG8_BAR __builtin_amdgcn_s_barrier()
#define PG8_SCHED __builtin_amdgcn_sched_barrier(0)
    Unit cur, nxt; int ui = 0;
    if (!S.next(0, cur)) return;
    f32x4 acc[2][2][4][2];
#pragma unroll
    for (int a = 0; a < 2; ++a)
#pragma unroll
        for (int b = 0; b < 2; ++b)
#pragma unroll
            for (int m = 0; m < 4; ++m)
#pragma unroll
                for (int n = 0; n < 2; ++n) acc[a][b][m][n] = (f32x4){0.f, 0.f, 0.f, 0.f};
    bf16x8 At[4][2], B0[2][2], B1[2][2];
    const char* cA = (const char*)g.A + (size_t)cur.pm * tstep + (size_t)cur.ko * 2; const char* cB = (const char*)g.Bt + (size_t)cur.pn * tstep + (size_t)cur.ko * 2;
    S.a_ready(cur);
    if constexpr (SP2) {
        PG8_STAGE(PG8_SB(0, 0), cB, voffB); PG8_STAGE(PG8_SB(0, 1), cB + hstep, voffB); PG8_STAGE(PG8_SA(0, 0), cA, voffA); PG8_STAGE(PG8_SA(0, 1), cA + hstep, voffA);
        if (wr == 1) PG8_BAR;
        PG8_WAIT_V(2); PG8_BAR;
        PG8_STAGE(PG8_SB(1, 0), cB + kstep, voffB); PG8_STAGE(PG8_SA(1, 0), cA + kstep, voffA); PG8_STAGE(PG8_SB(1, 1), cB + hstep + kstep, voffB);
        PG8_WAIT_V(6); PG8_BAR;
    } else {
        PG8_STAGE(PG8_SB(0, 0), cB, voffB); PG8_STAGE(PG8_SA(0, 0), cA, voffA); PG8_STAGE(PG8_SB(0, 1), cB + hstep, voffB); PG8_STAGE(PG8_SA(0, 1), cA + hstep, voffA);
        if (wr == 1) PG8_BAR;
        PG8_WAIT_V(4); PG8_BAR;
        PG8_STAGE(PG8_SB(1, 0), cB + kstep, voffB); PG8_STAGE(PG8_SA(1, 0), cA + kstep, voffA); PG8_STAGE(PG8_SB(1, 1), cB + hstep + kstep, voffB);
        PG8_WAIT_V(6); PG8_BAR;
    }
    for (;;) {
        const bool has_next = S.next(ui + 1, nxt);
        const char* nA = has_next ? (const char*)g.A + (size_t)nxt.pm * tstep + (size_t)nxt.ko * 2 : cA; const char* nB = has_next ? (const char*)g.Bt + (size_t)nxt.pn * tstep + (size_t)nxt.ko * 2 : cB;
        asm volatile(".p2align 8" ::: "memory");
#pragma clang loop unroll(disable)
        for (int t = 0; t < nt; t += 2) {
            const bool last = (t == nt - 2);
            const char* a1 = cA + (size_t)(t + 1) * kstep;
            const char* a2 = last ? nA : cA + (size_t)(t + 2) * kstep; const char* b2 = last ? nB : cB + (size_t)(t + 2) * kstep;
            const char* a3 = a2 + kstep; const char* b3 = b2 + kstep;
            if (last && has_next) S.a_ready(nxt);
            if constexpr (SP2) {
            PG8_LDB(B0, 0, 0); PG8_LDB(B1, 0, 1); PG8_SCHED; PG8_LDA(At, 0, 0); PG8_STAGE(PG8_SA(1, 1), a1 + hstep, voffA);
            PG8_WAIT_V(8); PG8_WAIT_L(0); PG8_BAR; PG8_MMA(0, 0, At, B0); PG8_MMA(0, 1, At, B1); PG8_BAR; PG8_SCHED;
            PG8_LDA(At, 0, 1); PG8_STAGE(PG8_SB(0, 0), b2, voffB); PG8_STAGE(PG8_SB(0, 1), b2 + hstep, voffB); PG8_STAGE(PG8_SA(0, 0), a2, voffA);
            PG8_WAIT_V(8); PG8_WAIT_L(0); PG8_BAR; PG8_MMA(1, 0, At, B0); PG8_MMA(1, 1, At, B1); PG8_BAR; PG8_SCHED;
            PG8_LDB(B0, 1, 0); PG8_LDB(B1, 1, 1); PG8_SCHED; PG8_LDA(At, 1, 0); PG8_STAGE(PG8_SA(0, 1), a2 + hstep, voffA);
            PG8_WAIT_V(8); PG8_WAIT_L(0); PG8_BAR; PG8_MMA(0, 0, At, B0); PG8_MMA(0, 1, At, B1); PG8_BAR; PG8_SCHED;
            PG8_LDA(At, 1, 1); PG8_STAGE(PG8_SB(1, 0), b3, voffB); PG8_STAGE(PG8_SB(1, 1), b3 + hstep, voffB); PG8_STAGE(PG8_SA(1, 0), a3, voffA);
            PG8_WAIT_V(8); PG8_WAIT_L(0); PG8_BAR; PG8_MMA(1, 0, At, B0); PG8_MMA(1, 1, At, B1); PG8_BAR; PG8_SCHED;
            } else {
            PG8_LDB(B0, 0, 0); PG8_SCHED; PG8_LDA(At, 0, 0); PG8_STAGE(PG8_SA(1, 1), a1 + hstep, voffA);
            PG8_WAIT_L(8); PG8_BAR; PG8_WAIT_L(0); PG8_MMA(0, 0, At, B0); PG8_BAR; PG8_SCHED;
            PG8_LDB(B1, 0, 1); PG8_STAGE(PG8_SB(0, 0), b2, voffB);
            PG8_BAR; PG8_WAIT_L(0); PG8_MMA(0, 1, At, B1); PG8_BAR;
            PG8_LDA(At, 0, 1); PG8_STAGE(PG8_SA(0, 0), a2, voffA);
            PG8_BAR; PG8_WAIT_L(0); PG8_MMA(1, 0, At, B0); PG8_BAR; PG8_SCHED;
            PG8_STAGE(PG8_SB(0, 1), b2 + hstep, voffB);
            PG8_WAIT_V(6); PG8_BAR; PG8_MMA(1, 1, At, B1); PG8_BAR;
            PG8_LDB(B0, 1, 0); PG8_SCHED; PG8_LDA(At, 1, 0); PG8_STAGE(PG8_SA(0, 1), a2 + hstep, voffA);
            PG8_WAIT_L(8); PG8_BAR; PG8_WAIT_L(0); PG8_MMA(0, 0, At, B0); PG8_BAR; PG8_SCHED;
            PG8_LDB(B1, 1, 1); PG8_STAGE(PG8_SB(1, 0), b3, voffB);
            PG8_BAR; PG8_WAIT_L(0); PG8_MMA(0, 1, At, B1); PG8_BAR;
            PG8_LDA(At, 1, 1); PG8_STAGE(PG8_SA(1, 0), a3, voffA);
            PG8_BAR; PG8_WAIT_L(0); PG8_MMA(1, 0, At, B0); PG8_BAR; PG8_SCHED;
            PG8_STAGE(PG8_SB(1, 1), b3 + hstep, voffB);
            PG8_WAIT_V(6); PG8_BAR; PG8_MMA(1, 1, At, B1); PG8_BAR;
            }
        }
        if constexpr (ALIGN_EPI) { if (wr == 0) PG8_BAR; }
        if constexpr (!Epi::AFTER_DRAIN) { E(acc, cur, wr, wc, fr, fq); S.done(cur); }
        if (!has_next) break;
#pragma unroll
        for (int a = 0; a < 2; ++a)
#pragma unroll
            for (int b = 0; b < 2; ++b)
#pragma unroll
                for (int m = 0; m < 4; ++m)
#pragma unroll
                    for (int n = 0; n < 2; ++n) acc[a][b][m][n] = (f32x4){0.f, 0.f, 0.f, 0.f};
        cur = nxt; cA = nA; cB = nB; ++ui;
        if constexpr (ALIGN_EPI) { if (wr == 1) PG8_BAR; }
    }
    PG8_WAIT_V(0);
    if constexpr (!ALIGN_EPI) { if (wr == 0) PG8_BAR; }
    PG8_BAR;
    if constexpr (Epi::AFTER_DRAIN) { E.fused(acc, cur, wr, wc, fr, fq, lds, wid, lane); S.done(cur); }
#undef PG8_SA
#undef PG8_SB
#undef PG8_STAGE
#undef PG8_LDA
#undef PG8_LDB
#undef PG8_MMA
#undef PG8_WAIT_V
#undef PG8_WAIT_L
#undef PG8_BAR
#undef PG8_SCHED
}
}
constexpr int NWAVES = 8;
constexpr int NPHASES = 10;
#ifndef MK_N_LAUNCHES
#define MK_N_LAUNCHES 1
#endif
#ifndef DUP_PHASE
#define DUP_PHASE -1
#endif
#ifndef DUP_SUB
#define DUP_SUB 0
#endif
constexpr int N_LAUNCHES = MK_N_LAUNCHES;

constexpr int D = 1024, NB = 8, SEQ = 2048, NREAL = NB * SEQ, NMETA = 16, NSB = 32, NST = 4, NSAMP = NSB * NST;
constexpr int R_META = NREAL, R_SAMP = NREAL + NMETA, R_END = R_SAMP + NSAMP, MT = 16640;
constexpr int TP = NMETA + SEQ;
constexpr int NPRJ = 2816;
constexpr int C_QKV = 0, C_Z = 1536, C_CQ = 2048, C_CKV = 2432, C_KPE = 2688, C_B = 2720, C_A = 2728, C_PAD = 2736;
constexpr int IN_COLS = 2736, FF = 4096, QLORA = 384, KVLORA = 256, NH = 8;
constexpr int PAST = 16384, PAGE = 128, NPAGES = 128;
constexpr float EPS = 1e-6f;
constexpr float MLA_SCALE = 0.10206207261596577f;
constexpr size_t O_YP = 0, O_YS = 16777216, O_LATP = 16908288, O_KRP = 21135360, O_CONVP = 21663744, O_SSMP = 21700608,
                 O_LATS = 21962752, O_KRS = 21995520, O_CONVS = 21999616, O_SSMS = 22147072, O_END = 23195648;
constexpr int NSPLIT = 32, SPLIT_KEYS = PAST / NSPLIT  , NSPLITX = NSPLIT + 1;

constexpr size_t MiB = 1u << 20;
constexpr size_t al(size_t x) { return (x + MiB - 1) / MiB * MiB; }
constexpr size_t WS_CTL = 0, CTL_ZERO_BYTES = 100 * 1024;
constexpr size_t WS_WIN = 1 * MiB;
constexpr size_t WS_WQB = WS_WIN + al((size_t)NPRJ * D * 2);
constexpr size_t WS_WKVB = WS_WQB + al((size_t)768 * 384 * 2);
constexpr size_t WS_WOUT = WS_WKVB + al((size_t)1024 * 256 * 2);
constexpr size_t WS_WUP = WS_WOUT + al((size_t)1024 * 1024 * 2);
constexpr size_t WS_WDN = WS_WUP + al((size_t)4096 * 1024 * 2);
constexpr size_t WS_XN = WS_WDN + al((size_t)4096 * 1024 * 2);
constexpr size_t WS_PRJ = WS_XN + al((size_t)MT * D * 2);
constexpr size_t WS_CQN = WS_PRJ + al((size_t)MT * NPRJ * 2);
constexpr size_t WS_LATN = WS_CQN + al((size_t)MT * QLORA * 2);
constexpr size_t WS_KPE = WS_LATN + al((size_t)MT * KVLORA * 2);
constexpr size_t WS_GQKV = WS_KPE + al((size_t)MT * 32 * 4);
constexpr size_t WS_GB = WS_GQKV + al((size_t)MT * 1536 * 4);
constexpr size_t WS_QM = WS_GB + al((size_t)MT * 16 * 4);
constexpr size_t WS_KV = WS_QM + al((size_t)MT * 768 * 2);
constexpr size_t WS_GO = WS_KV + al((size_t)MT * 1024 * 2);
constexpr size_t WS_MIX = WS_GO + al((size_t)MT * 512 * 4);
constexpr size_t WS_H2B = WS_MIX + al((size_t)MT * D * 2);
constexpr size_t WS_H1B = WS_H2B + al((size_t)MT * D * 2);
constexpr size_t WS_HFF = WS_H1B + al((size_t)MT * D * 2);
constexpr size_t WS_H2 = WS_HFF + al((size_t)MT * FF * 2);
constexpr size_t WS_PART = WS_H2 + al((size_t)MT * D * 4);
constexpr size_t WS_PSTAT = WS_PART + al((size_t)NSB * NSPLITX * 32 * 256 * 4);
constexpr int NROPE = TP + NST;
constexpr size_t WS_KPEB = WS_PSTAT + al((size_t)NSB * NSPLITX * 32 * 2 * 4);
constexpr size_t WS_ROPE = WS_KPEB + al((size_t)MT * 32 * 2);
constexpr size_t WS_QLAT = WS_ROPE + al((size_t)NROPE * 32 * 4);
constexpr size_t WS_EGL = WS_QLAT + al((size_t)NSB * 32 * 256 * 4);
constexpr size_t WS_S1 = WS_EGL + MiB;
constexpr size_t WS_GCH = WS_S1 + MiB;
constexpr size_t WS_END = WS_GCH + al((size_t)NB * 32 * NH * 40960);
constexpr int CW_TMO = 0, CW_CODE = 1, CW_CNT6 = 64, CW_QL = 256;
constexpr int CW_BAR = 4096;
constexpr int CW_SS1 = 8192;
static_assert((size_t)(CW_SS1 + MT) * 4 <= CTL_ZERO_BYTES && CW_BAR + 3456 <= CW_SS1, "CTL words inside the memset region");

constexpr int RING_OFF = 0, RING_BYTES = 131072;
constexpr int LDSCTL_OFF = RING_BYTES, MISC_OFF = LDSCTL_OFF + 320;
constexpr int LDS_BYTES = 147456;
static_assert(MISC_OFF + 128 <= LDS_BYTES, "LDS map");
#define GAS __attribute__((address_space(1)))
#define LAS __attribute__((address_space(3)))
typedef unsigned short bf16;
typedef unsigned v4u __attribute__((ext_vector_type(4)));
typedef float f32x4 __attribute__((ext_vector_type(4)));
typedef short bf16x8 __attribute__((ext_vector_type(8)));
typedef GAS unsigned gu32;
typedef GAS unsigned long long gu64;
#define RLX_AGENT __ATOMIC_RELAXED, __HIP_MEMORY_SCOPE_AGENT
#define LDS_WAIT() asm volatile("s_waitcnt lgkmcnt(0)" ::: "memory")
#define VM_WAIT() asm volatile("s_waitcnt vmcnt(0)" ::: "memory")
__device__ __forceinline__ unsigned long long rt() { return __builtin_amdgcn_s_memrealtime(); }
__device__ __forceinline__ unsigned f2bf(float f) { unsigned u = __builtin_bit_cast(unsigned, f); return (u + 0x7fffu + ((u >> 16) & 1u)) >> 16; }
__device__ __forceinline__ unsigned pk2(float lo, float hi) { return f2bf(lo) | (f2bf(hi) << 16); }

#define XB_TMO      128
#define XB_XCNT(j)  (256  + 64 * (j))
#define XB_XSUB(j)  (1280 + 64 * (j))
#define XB_XGEN(j)  (2304 + 64 * (j))
#define XB_TOP      3328
#define XB_TOPGEN   3392
#define XCD_BAR_WORDS 3456
#define XB_SPIN_CAP (1u << 18)

__device__ __forceinline__ unsigned xb_ld(unsigned* p)              { return __hip_atomic_load(p, __ATOMIC_RELAXED, __HIP_MEMORY_SCOPE_AGENT); }
__device__ __forceinline__ unsigned xb_add(unsigned* p, unsigned v) { return __hip_atomic_fetch_add(p, v, __ATOMIC_RELAXED, __HIP_MEMORY_SCOPE_AGENT); }
__device__ __forceinline__ unsigned xb_xcc_id() { return (unsigned)__builtin_amdgcn_s_getreg((3 << 11) | 20) & 0xFu; }
#define XB_SPIN(cond, bar) do { unsigned _sp = 0; while (cond) { __builtin_amdgcn_s_sleep(1); \
    if ((++_sp & 255u) == 0u) { if (xb_ld(&(bar)[XB_TMO])) break; if (_sp > XB_SPIN_CAP) { atomicAdd(&(bar)[XB_TMO], 1u); break; } } } } while (0)

struct XcdBarrier {
    unsigned* bar; unsigned x;
    volatile LAS unsigned* st;
};

__device__ __forceinline__ XcdBarrier xcd_barrier_post(unsigned* bar, volatile LAS unsigned* st) {
    XcdBarrier b; b.bar = bar; b.x = xb_xcc_id(); b.st = st;
    if (threadIdx.x == 0) (void)xb_add(&bar[XB_XCNT(b.x)], 1u);
    return b;
}
__device__ __forceinline__ void xcd_barrier_complete(unsigned* bar, unsigned x, unsigned& nloc, unsigned& nx) {
    const unsigned G = gridDim.x * gridDim.y * gridDim.z;
    unsigned sum, cnt, mine, sp = 0u;
    for (;;) {
        sum = 0u; cnt = 0u; mine = 0u;
#pragma unroll
        for (unsigned j = 0; j < 16; ++j) { const unsigned c = xb_ld(&bar[XB_XCNT(j)]); sum += c; cnt += (c > 0u) ? 1u : 0u; mine = (j == x) ? c : mine; }
        if (sum == G) break;
        __builtin_amdgcn_s_sleep(1);
        if ((++sp & 255u) == 0u) { if (xb_ld(&bar[XB_TMO])) break; if (sp > XB_SPIN_CAP) { atomicAdd(&bar[XB_TMO], 1u); break; } }
    }
    nloc = mine > 0u ? mine : 1u; nx = cnt > 0u ? cnt : 1u;
}

__device__ __forceinline__ void xcd_barrier(const XcdBarrier& b) {
    asm volatile("s_waitcnt vmcnt(0)" ::: "memory");
    __syncthreads();
    if (threadIdx.x == 0) {
        unsigned* bar = b.bar;
        __builtin_amdgcn_s_waitcnt(0);
        unsigned nloc = b.st[0], nx = b.st[1];
        if (nloc == 0u) { xcd_barrier_complete(bar, b.x, nloc, nx); b.st[0] = nloc; b.st[1] = nx; }
        const unsigned old = xb_add(&bar[XB_XSUB(b.x)], 1u);
        const unsigned gen = old / nloc;
        if (old + 1u == (gen + 1u) * nloc) {
            __builtin_amdgcn_fence(__ATOMIC_RELEASE, "agent");
            asm volatile("s_waitcnt vmcnt(0)" ::: "memory");
            const unsigned og = xb_add(&bar[XB_TOP], 1u);
            const unsigned tg = og / nx;
            if (og + 1u == (tg + 1u) * nx) xb_add(&bar[XB_TOPGEN], 1u);
            else XB_SPIN(xb_ld(&bar[XB_TOPGEN]) == tg, bar);
            __builtin_amdgcn_fence(__ATOMIC_ACQUIRE, "agent");
            xb_add(&bar[XB_XGEN(b.x)], 1u);
            asm volatile("s_waitcnt vmcnt(0)" ::: "memory");
        } else {
            XB_SPIN(xb_ld(&bar[XB_XGEN(b.x)]) == gen, bar);
            __builtin_amdgcn_fence(__ATOMIC_ACQUIRE, "agent");
            asm volatile("s_waitcnt vmcnt(0)" ::: "memory");
        }
    }
    __syncthreads();
}
struct Frame {
    LAS unsigned char* lds;
    volatile LAS unsigned* MISC;
    gu32* ctl;
    int tid, lane, wave, vcu, G;
    const float *x_prompt, *x_sample, *cache_latent, *cache_krope, *state_conv, *state_ssm; const int* page_table;
    const float *meta, *norm_mix_g, *w_in, *conv_w, *a_log, *dt_bias, *gdn_norm_g, *q_norm_g, *w_q_b, *kv_norm_g, *w_kv_b, *w_out, *norm_mlp_g, *w_up, *w_down, *final_g;
    float* out;
    bf16 *WIN, *WQB, *WKVB, *WOUT, *WUP, *WDN, *XN, *PRJ, *CQN, *LATN, *QM, *KV, *MIX, *H1B, *HFF, *KPEB, *GQKV;
    bf16* H2B;
    float *KPE, *GB, *GO, *H2, *PART, *PSTAT, *SS1, *ROPE, *QLAT, *EGL, *S1; unsigned char* GCH;
};
__device__ __forceinline__ float bf2f(bf16 v) { return __uint_as_float((unsigned)v << 16); }
__device__ __forceinline__ float wave_sum(float v) {
#pragma unroll
    for (int o = 1; o < 64; o <<= 1) v += __shfl_xor(v, o);
    return v;
}
__device__ __forceinline__ float wave_max(float v) {
#pragma unroll
    for (int o = 1; o < 64; o <<= 1) v = fmaxf(v, __shfl_xor(v, o));
    return v;
}
__device__ __forceinline__ float silu_f(float y) { return y / (1.0f + __expf(-y)); }
__device__ __forceinline__ float rdlane(float v, int l) { return __int_as_float(__builtin_amdgcn_readlane(__float_as_int(v), l)); }
__device__ __forceinline__ int row_pos(int r) { return r < R_META ? NMETA + (r & (SEQ - 1)) : (r < R_SAMP ? r - R_META : PAST + ((r - R_SAMP) & (NST - 1))); }

__device__ __forceinline__ float wsrc(const Frame& F, int mat, int k, int n) {
    switch (mat) {
    case 0: { int c;
        if (n < C_CQ) c = n; else if (n < C_CKV) c = 2064 + (n - C_CQ); else if (n < C_KPE) c = 2448 + (n - C_CKV); else if (n < C_B) c = 2704 + (n - C_KPE);
        else if (n < C_A) c = 2048 + (n - C_B); else if (n < C_PAD) c = 2056 + (n - C_A); else return 0.f;
        return F.w_in[(size_t)k * IN_COLS + c]; }
    case 1: { const int c = n < 512 ? (n >> 6) * 96 + (n & 63) : ((n - 512) >> 5) * 96 + 64 + ((n - 512) & 31); return F.w_q_b[(size_t)k * 768 + c]; }
    case 2: { const int c = n < 512 ? (n >> 6) * 128 + (n & 63) : ((n - 512) >> 6) * 128 + 64 + ((n - 512) & 63); return F.w_kv_b[(size_t)k * 1024 + c]; }
    case 3: return F.w_out[(size_t)k * 1024 + n];
    case 4: return F.norm_mlp_g[k] * F.w_up[(size_t)k * 4096 + n];
    default: return F.w_down[(size_t)k * 1024 + n];
    }
}
__device__ __forceinline__ void p0_transpose_item(const Frame& F, int mat, int K, int N, bf16* WT, LAS float* scr, int item, int lane) {
    const int nblk = N / 32, kb = item / nblk, nb = item % nblk, k0 = 64 * kb, n0 = 32 * nb;
#pragma unroll 4
    for (int i = 0; i < 32; ++i) { const int kk = 2 * i + (lane >> 5); scr[kk * 33 + (lane & 31)] = wsrc(F, mat, k0 + kk, n0 + (lane & 31)); }
    LDS_WAIT(); asm volatile("" ::: "memory");
    const int c = lane & 7;
#pragma unroll
    for (int j = 0; j < 4; ++j) { const int n = (lane >> 3) + 8 * j; const LAS float* s = scr + (8 * c) * 33 + n;
        v4u o; o.x = pk2(s[0 * 33], s[1 * 33]); o.y = pk2(s[2 * 33], s[3 * 33]); o.z = pk2(s[4 * 33], s[5 * 33]); o.w = pk2(s[6 * 33], s[7 * 33]);
        *(GAS v4u*)(WT + (size_t)(n0 + n) * K + k0 + 8 * c) = o; }
    LDS_WAIT(); asm volatile("" ::: "memory");
}
__device__ __forceinline__ const float* x_row(const Frame& F, int r) {
    if (r < R_META) return F.x_prompt + (size_t)r * D;
    if (r < R_SAMP) return F.meta + (size_t)(r - R_META) * D;
    if (r < R_END) return F.x_sample + (size_t)(r - R_SAMP) * D;
    return nullptr;
}
__device__ __forceinline__ void p0_prologue(Frame& F) {
    LAS float* scr = (LAS float*)(F.lds + RING_OFF + F.wave * 16384);
    const int gw = F.vcu * NWAVES + F.wave, NGW = F.G * NWAVES;
    constexpr int I0 = (D / 64) * (NPRJ / 32), I1 = (QLORA / 64) * (768 / 32), I2 = (KVLORA / 64) * (1024 / 32), I3 = (1024 / 64) * (1024 / 32), I4 = (D / 64) * (FF / 32), I5 = (FF / 64) * (D / 32);
    constexpr int NITEMS = I0 + I1 + I2 + I3 + I4 + I5;
    for (int it = gw; it < NITEMS; it += NGW) {
        int r = it;
        if (r < I0) { p0_transpose_item(F, 0, D, NPRJ, F.WIN, scr, r, F.lane); continue; } r -= I0;
        if (r < I1) { p0_transpose_item(F, 1, QLORA, 768, F.WQB, scr, r, F.lane); continue; } r -= I1;
        if (r < I2) { p0_transpose_item(F, 2, KVLORA, 1024, F.WKVB, scr, r, F.lane); continue; } r -= I2;
        if (r < I3) { p0_transpose_item(F, 3, 1024, 1024, F.WOUT, scr, r, F.lane); continue; } r -= I3;
        if (r < I4) { p0_transpose_item(F, 4, D, FF, F.WUP, scr, r, F.lane); continue; } r -= I4;
        p0_transpose_item(F, 5, FF, D, F.WDN, scr, r, F.lane);
    }
    for (int e = (F.vcu * NWAVES * 64 + F.tid); e < NROPE * 16; e += F.G * NWAVES * 64) { const int pi = e >> 4, i = e & 15; const int pos = pi < TP ? pi : PAST + (pi - TP);
        const double ang = (double)pos * exp2(-(double)i * 0.83048202372184059); const double n = rint(ang * 0.15915494309189535); const float rr = (float)fma(-n, 6.2831853071795862, ang);
        F.ROPE[pi * 32 + i] = cosf(rr); F.ROPE[pi * 32 + 16 + i] = sinf(rr); }
    { const f32x4* gv = (const f32x4*)F.norm_mix_g + F.lane; f32x4 g4[4];
#pragma unroll
      for (int j = 0; j < 4; ++j) g4[j] = gv[64 * j];
      for (int m0 = gw; m0 < MT; m0 += 2 * NGW) { const int m1 = m0 + NGW;
        const float* x0 = x_row(F, m0); const float* x1 = m1 < MT ? x_row(F, m1) : nullptr;
        f32x4 v0[4], v1[4];
#pragma unroll
        for (int j = 0; j < 4; ++j) { v0[j] = x0 ? ((const f32x4*)x0 + F.lane)[64 * j] : (f32x4){0.f, 0.f, 0.f, 0.f}; v1[j] = x1 ? ((const f32x4*)x1 + F.lane)[64 * j] : (f32x4){0.f, 0.f, 0.f, 0.f}; }
        float s0 = 0.f, s1 = 0.f;
#pragma unroll
        for (int j = 0; j < 4; ++j) { s0 += (v0[j].x * v0[j].x + v0[j].y * v0[j].y) + (v0[j].z * v0[j].z + v0[j].w * v0[j].w); s1 += (v1[j].x * v1[j].x + v1[j].y * v1[j].y) + (v1[j].z * v1[j].z + v1[j].w * v1[j].w); }
        const float r0 = 1.0f / sqrtf(wave_sum(s0) * (1.0f / D) + EPS), r1 = 1.0f / sqrtf(wave_sum(s1) * (1.0f / D) + EPS);
        GAS unsigned long long* o0 = (GAS unsigned long long*)(F.XN + (size_t)m0 * D) + F.lane;
#pragma unroll
        for (int j = 0; j < 4; ++j) { const f32x4 y = v0[j] * r0 * g4[j]; o0[64 * j] = (unsigned long long)pk2(y.x, y.y) | ((unsigned long long)pk2(y.z, y.w) << 32); }
        if (m1 < MT) { GAS unsigned long long* o1 = (GAS unsigned long long*)(F.XN + (size_t)m1 * D) + F.lane;
#pragma unroll
            for (int j = 0; j < 4; ++j) { const f32x4 y = v1[j] * r1 * g4[j]; o1[64 * j] = (unsigned long long)pk2(y.x, y.y) | ((unsigned long long)pk2(y.z, y.w) << 32); } }
      } }
}

struct TapSrc { const bf16* pb; const float* pf; };
__device__ __forceinline__ TapSrc tap_src(const Frame& F, int r, int d) {
    TapSrc t; t.pb = nullptr; t.pf = nullptr;
    if (r < R_META) { const int s = r & (SEQ - 1); if (s - d >= 0) t.pb = F.PRJ + (size_t)(r - d) * NPRJ; else t.pb = F.PRJ + (size_t)(R_META + NMETA + (s - d)) * NPRJ; }
    else if (r < R_SAMP) { const int m = r - R_META; if (m - d >= 0) t.pb = F.PRJ + (size_t)(r - d) * NPRJ; }
    else if (r < R_END) { const int i = r - R_SAMP, bs = i >> 2, tt = i & 3; if (tt - d >= 0) t.pb = F.PRJ + (size_t)(r - d) * NPRJ; else t.pf = F.state_conv + ((size_t)bs * 3 + (3 + tt - d)) * 1536; }
    return t;
}
struct P2Consts { f32x4 cw[4][3][2]; float qg[6]; f32x4 kvg; float dtb, nal; };
__device__ __forceinline__ void p2_consts(const Frame& F, P2Consts& W, int lane) {
#pragma unroll
    for (int j = 0; j < 4; ++j)
#pragma unroll
        for (int sg = 0; sg < 3; ++sg) { W.cw[j][sg][0] = *(const f32x4*)(F.conv_w + j * 1536 + sg * 512 + 8 * lane); W.cw[j][sg][1] = *(const f32x4*)(F.conv_w + j * 1536 + sg * 512 + 8 * lane + 4); }
#pragma unroll
    for (int j = 0; j < 3; ++j) { W.qg[2 * j] = F.q_norm_g[128 * j + 2 * lane]; W.qg[2 * j + 1] = F.q_norm_g[128 * j + 2 * lane + 1]; }
    W.kvg = *((const f32x4*)F.kv_norm_g + lane); W.dtb = F.dt_bias[lane & 7]; W.nal = -expf(F.a_log[lane & 7]);
}
__device__ __forceinline__ void p2_row_fast(Frame& F, int r, const P2Consts& W, int lane) {
    const bf16* p = F.PRJ + (size_t)r * NPRJ; const int b = r >> 11, s2 = r & (SEQ - 1);
    unsigned cq[3];
#pragma unroll
    for (int j = 0; j < 3; ++j) cq[j] = *(const unsigned*)(p + C_CQ + 128 * j + 2 * lane);
    const unsigned long long ckv = *(const unsigned long long*)(p + C_CKV + 4 * lane);
    const bf16 kp1 = p[C_KPE + (lane & 15)], kp2 = p[C_KPE + 16 + (lane & 15)], bbr = p[C_B + (lane & 7)], aar = p[C_A + (lane & 7)];
    const float rc = F.ROPE[(NMETA + s2) * 32 + (lane & 15)], rs = F.ROPE[(NMETA + s2) * 32 + 16 + (lane & 15)];
    v4u xt[4][3];
#pragma unroll
    for (int j = 0; j < 4; ++j)
#pragma unroll
        for (int sg = 0; sg < 3; ++sg) xt[j][sg] = *(const v4u*)(p - (size_t)(3 - j) * NPRJ + sg * 512 + 8 * lane);
    { float v[6]; float s = 0.f;
#pragma unroll
      for (int j = 0; j < 3; ++j) { v[2 * j] = __uint_as_float(cq[j] << 16); v[2 * j + 1] = __uint_as_float(cq[j] & 0xffff0000u); s += v[2 * j] * v[2 * j] + v[2 * j + 1] * v[2 * j + 1]; }
      const float rstd = 1.0f / sqrtf(wave_sum(s) * (1.0f / QLORA) + EPS);
#pragma unroll
      for (int j = 0; j < 3; ++j) *(unsigned*)(F.CQN + (size_t)r * QLORA + 128 * j + 2 * lane) = pk2(v[2 * j] * rstd * W.qg[2 * j], v[2 * j + 1] * rstd * W.qg[2 * j + 1]); }
    { float v[4]; v[0] = __uint_as_float((unsigned)(ckv << 16) & 0xffff0000u); v[1] = __uint_as_float((unsigned)ckv & 0xffff0000u); v[2] = __uint_as_float((unsigned)(ckv >> 16) & 0xffff0000u); v[3] = __uint_as_float((unsigned)(ckv >> 32) & 0xffff0000u);
      const float s = (v[0] * v[0] + v[1] * v[1]) + (v[2] * v[2] + v[3] * v[3]);
      const float rstd = 1.0f / sqrtf(wave_sum(s) * (1.0f / KVLORA) + EPS);
      const f32x4 y = {v[0] * rstd * W.kvg.x, v[1] * rstd * W.kvg.y, v[2] * rstd * W.kvg.z, v[3] * rstd * W.kvg.w};
      *(unsigned long long*)(F.LATN + (size_t)r * KVLORA + 4 * lane) = (unsigned long long)pk2(y.x, y.y) | ((unsigned long long)pk2(y.z, y.w) << 32);
      *((f32x4*)(F.out + O_LATP + ((size_t)b * TP + NMETA + s2) * KVLORA) + lane) = y; }
    if (lane < 16) { const float x1 = bf2f(kp1), x2 = bf2f(kp2), o1 = x1 * rc - x2 * rs, o2 = x2 * rc + x1 * rs;
      F.KPE[(size_t)r * 32 + lane] = o1; F.KPE[(size_t)r * 32 + 16 + lane] = o2; F.KPEB[(size_t)r * 32 + lane] = (bf16)f2bf(o1); F.KPEB[(size_t)r * 32 + 16 + lane] = (bf16)f2bf(o2);
      float* o = F.out + O_KRP + ((size_t)b * TP + NMETA + s2) * 32; o[lane] = o1; o[16 + lane] = o2; }
    if (lane < 8) { const float beta = 1.0f / (1.0f + expf(-bf2f(bbr))); const float xx = bf2f(aar) + W.dtb; const float sp = xx > 20.f ? xx : log1pf(expf(xx));
      F.GB[(size_t)r * 16 + lane] = beta; F.GB[(size_t)r * 16 + 8 + lane] = W.nal * sp; }
#pragma unroll
    for (int sg = 0; sg < 3; ++sg) { float y[8];
#pragma unroll
        for (int e = 0; e < 8; ++e) y[e] = 0.f;
#pragma unroll
        for (int j = 0; j < 4; ++j) { const v4u w = xt[j][sg]; const f32x4 w0 = W.cw[j][sg][0], w1 = W.cw[j][sg][1];
            y[0] += __uint_as_float(w.x << 16) * w0.x; y[1] += __uint_as_float(w.x & 0xffff0000u) * w0.y; y[2] += __uint_as_float(w.y << 16) * w0.z; y[3] += __uint_as_float(w.y & 0xffff0000u) * w0.w;
            y[4] += __uint_as_float(w.z << 16) * w1.x; y[5] += __uint_as_float(w.z & 0xffff0000u) * w1.y; y[6] += __uint_as_float(w.w << 16) * w1.z; y[7] += __uint_as_float(w.w & 0xffff0000u) * w1.w; }
        float ss = 0.f;
#pragma unroll
        for (int e = 0; e < 8; ++e) { y[e] = silu_f(y[e]); ss += y[e] * y[e]; }
        if (sg < 2) { ss += __shfl_xor(ss, 1); ss += __shfl_xor(ss, 2); ss += __shfl_xor(ss, 4); const float sc = (sg == 0 ? 0.125f : 1.0f) / sqrtf(ss + EPS);
#pragma unroll
            for (int e = 0; e < 8; ++e) y[e] *= sc; }
        v4u o; o.x = pk2(y[0], y[1]); o.y = pk2(y[2], y[3]); o.z = pk2(y[4], y[5]); o.w = pk2(y[6], y[7]);
        *(v4u*)(F.GQKV + (size_t)r * 1536 + sg * 512 + 8 * lane) = o; }
}
__device__ __forceinline__ void p2_row(Frame& F, int r) {
    int lane_ = F.lane; asm volatile("" : "+v"(lane_)); const int lane = lane_;
    const bf16* p = F.PRJ + (size_t)r * NPRJ;
    if (r >= R_END) {
        for (int c = lane; c < QLORA; c += 64) F.CQN[(size_t)r * QLORA + c] = 0;
        for (int c = lane; c < KVLORA; c += 64) F.LATN[(size_t)r * KVLORA + c] = 0;
        return; }
    { float v[6]; float s = 0.f;
#pragma unroll
      for (int j = 0; j < 3; ++j) { const unsigned w = *(const unsigned*)(p + C_CQ + 128 * j + 2 * lane); v[2 * j] = __uint_as_float(w << 16); v[2 * j + 1] = __uint_as_float(w & 0xffff0000u); s += v[2 * j] * v[2 * j] + v[2 * j + 1] * v[2 * j + 1]; }
      const float rstd = 1.0f / sqrtf(wave_sum(s) * (1.0f / QLORA) + EPS);
#pragma unroll
      for (int j = 0; j < 3; ++j) { const int c = 128 * j + 2 * lane; *(unsigned*)(F.CQN + (size_t)r * QLORA + c) = pk2(v[2 * j] * rstd * F.q_norm_g[c], v[2 * j + 1] * rstd * F.q_norm_g[c + 1]); } }
    { const unsigned long long w = *(const unsigned long long*)(p + C_CKV + 4 * lane); float v[4];
      v[0] = __uint_as_float((unsigned)(w << 16) & 0xffff0000u); v[1] = __uint_as_float((unsigned)w & 0xffff0000u); v[2] = __uint_as_float((unsigned)(w >> 16) & 0xffff0000u); v[3] = __uint_as_float((unsigned)(w >> 32) & 0xffff0000u);
      const float s = (v[0] * v[0] + v[1] * v[1]) + (v[2] * v[2] + v[3] * v[3]);
      const float rstd = 1.0f / sqrtf(wave_sum(s) * (1.0f / KVLORA) + EPS);
      const f32x4 g = *((const f32x4*)F.kv_norm_g + lane);
      const f32x4 y = {v[0] * rstd * g.x, v[1] * rstd * g.y, v[2] * rstd * g.z, v[3] * rstd * g.w};
      *(unsigned long long*)(F.LATN + (size_t)r * KVLORA + 4 * lane) = (unsigned long long)pk2(y.x, y.y) | ((unsigned long long)pk2(y.z, y.w) << 32);
      if (r < R_META) { const int b = r >> 11, s2 = r & (SEQ - 1); *((f32x4*)(F.out + O_LATP + ((size_t)b * TP + NMETA + s2) * KVLORA) + lane) = y; }
      else if (r < R_SAMP) { const int m = r - R_META;
#pragma unroll
          for (int b = 0; b < NB; ++b) *((f32x4*)(F.out + O_LATP + ((size_t)b * TP + m) * KVLORA) + lane) = y; }
      else *((f32x4*)(F.out + O_LATS + (size_t)(r - R_SAMP) * KVLORA) + lane) = y; }
    if (lane < 16) { const float x1 = bf2f(p[C_KPE + lane]), x2 = bf2f(p[C_KPE + 16 + lane]);
      const int pi = r < R_META ? NMETA + (r & (SEQ - 1)) : (r < R_SAMP ? r - R_META : TP + ((r - R_SAMP) & (NST - 1)));
      const float c = F.ROPE[pi * 32 + lane], s = F.ROPE[pi * 32 + 16 + lane], o1 = x1 * c - x2 * s, o2 = x2 * c + x1 * s;
      F.KPE[(size_t)r * 32 + lane] = o1; F.KPE[(size_t)r * 32 + 16 + lane] = o2; F.KPEB[(size_t)r * 32 + lane] = (bf16)f2bf(o1); F.KPEB[(size_t)r * 32 + 16 + lane] = (bf16)f2bf(o2);
      if (r < R_META) { const int b = r >> 11, s2 = r & (SEQ - 1); float* o = F.out + O_KRP + ((size_t)b * TP + NMETA + s2) * 32; o[lane] = o1; o[16 + lane] = o2; }
      else if (r < R_SAMP) { const int m = r - R_META; for (int b = 0; b < NB; ++b) { float* o = F.out + O_KRP + ((size_t)b * TP + m) * 32; o[lane] = o1; o[16 + lane] = o2; } }
      else { float* o = F.out + O_KRS + (size_t)(r - R_SAMP) * 32; o[lane] = o1; o[16 + lane] = o2; } }
    if (lane < 8) { const float bb = bf2f(p[C_B + lane]), aa = bf2f(p[C_A + lane]);
      const float beta = 1.0f / (1.0f + expf(-bb)); const float xx = aa + F.dt_bias[lane];
      const float sp = xx > 20.f ? xx : log1pf(expf(xx));
      F.GB[(size_t)r * 16 + lane] = beta; F.GB[(size_t)r * 16 + 8 + lane] = -expf(F.a_log[lane]) * sp; }
    { TapSrc ts[4];
#pragma unroll
      for (int j = 0; j < 4; ++j) ts[j] = tap_src(F, r, 3 - j);
      float y[3][8];
#pragma unroll
      for (int sg = 0; sg < 3; ++sg)
#pragma unroll
          for (int e = 0; e < 8; ++e) y[sg][e] = 0.f;
#pragma unroll
      for (int j = 0; j < 4; ++j) {
          if (!ts[j].pb && !ts[j].pf) continue;
#pragma unroll
          for (int sg = 0; sg < 3; ++sg) { const int ch = sg * 512 + 8 * lane; float x[8];
              if (ts[j].pb) { const v4u w = *(const v4u*)(ts[j].pb + ch);
                  x[0] = __uint_as_float(w.x << 16); x[1] = __uint_as_float(w.x & 0xffff0000u); x[2] = __uint_as_float(w.y << 16); x[3] = __uint_as_float(w.y & 0xffff0000u);
                  x[4] = __uint_as_float(w.z << 16); x[5] = __uint_as_float(w.z & 0xffff0000u); x[6] = __uint_as_float(w.w << 16); x[7] = __uint_as_float(w.w & 0xffff0000u); }
              else { const f32x4 a = *(const f32x4*)(ts[j].pf + ch), b2 = *(const f32x4*)(ts[j].pf + ch + 4); x[0] = a.x; x[1] = a.y; x[2] = a.z; x[3] = a.w; x[4] = b2.x; x[5] = b2.y; x[6] = b2.z; x[7] = b2.w; }
              const f32x4 w0 = *(const f32x4*)(F.conv_w + j * 1536 + ch), w1 = *(const f32x4*)(F.conv_w + j * 1536 + ch + 4);
              y[sg][0] += x[0] * w0.x; y[sg][1] += x[1] * w0.y; y[sg][2] += x[2] * w0.z; y[sg][3] += x[3] * w0.w;
              y[sg][4] += x[4] * w1.x; y[sg][5] += x[5] * w1.y; y[sg][6] += x[6] * w1.z; y[sg][7] += x[7] * w1.w; } }
#pragma unroll
      for (int sg = 0; sg < 3; ++sg) { float ss = 0.f;
#pragma unroll
          for (int e = 0; e < 8; ++e) { y[sg][e] = silu_f(y[sg][e]); ss += y[sg][e] * y[sg][e]; }
          if (sg < 2) { ss += __shfl_xor(ss, 1); ss += __shfl_xor(ss, 2); ss += __shfl_xor(ss, 4); const float sc = (sg == 0 ? 0.125f : 1.0f) / sqrtf(ss + EPS);
#pragma unroll
              for (int e = 0; e < 8; ++e) y[sg][e] *= sc; }
          v4u o; o.x = pk2(y[sg][0], y[sg][1]); o.y = pk2(y[sg][2], y[sg][3]); o.z = pk2(y[sg][4], y[sg][5]); o.w = pk2(y[sg][6], y[sg][7]);
          *(v4u*)(F.GQKV + (size_t)r * 1536 + sg * 512 + 8 * lane) = o; } }
    { float* o = nullptr;
      if (r < R_META) { const int b = r >> 11, s2 = r & (SEQ - 1); if (s2 >= SEQ - 3) o = F.out + O_CONVP + ((size_t)b * 3 + (s2 - (SEQ - 3))) * 1536; }
      else if (r >= R_SAMP) { const int i = r - R_SAMP, bs = i >> 2, tt = i & 3; if (tt >= 1) o = F.out + O_CONVS + ((size_t)bs * 3 + (tt - 1)) * 1536; }
      if (o) {
          v4u w[3];
#pragma unroll
          for (int k = 0; k < 3; ++k) w[k] = *(const v4u*)(p + 512 * k + 8 * lane);
#pragma unroll
          for (int k = 0; k < 3; ++k) { float* ok = o + 512 * k + 8 * lane;
              *(f32x4*)ok = (f32x4){__uint_as_float(w[k].x << 16), __uint_as_float(w[k].x & 0xffff0000u), __uint_as_float(w[k].y << 16), __uint_as_float(w[k].y & 0xffff0000u)};
              *(f32x4*)(ok + 4) = (f32x4){__uint_as_float(w[k].z << 16), __uint_as_float(w[k].z & 0xffff0000u), __uint_as_float(w[k].w << 16), __uint_as_float(w[k].w & 0xffff0000u)}; } } }
}

namespace fa {
typedef float f32x16 __attribute__((ext_vector_type(16)));
typedef short s16x4 __attribute__((ext_vector_type(4)));
typedef short v4i16_t __attribute__((ext_vector_type(4)));
constexpr int KOFF = 0, VOFF = 12288, STAGE = 20480;
constexpr int LDS_WSF = 2 * STAGE, LDS_OST = LDS_WSF + 8 * 256, LDS_TOTAL = LDS_OST + 8 * 4096;
static_assert(LDS_TOTAL <= RING_BYTES, "attention LDS");
__device__ __forceinline__ int crow(int r, int hi) { return (r & 3) + 8 * (r >> 2) + 4 * hi; }
typedef float f32x2_t __attribute__((ext_vector_type(2))); typedef __bf16 bf16x2_t __attribute__((ext_vector_type(2)));
__device__ __forceinline__ unsigned cvtpk(float lo, float hi) { f32x2_t v = {lo, hi}; bf16x2_t b = __builtin_convertvector(v, bf16x2_t); return __builtin_bit_cast(unsigned, b); }
__device__ __forceinline__ s16x4 vtr(const LAS unsigned char* p) { return __builtin_bit_cast(s16x4, __builtin_amdgcn_ds_read_tr16_b64_v4i16((LAS v4i16_t*)p)); }
__device__ __forceinline__ void issue_tile(const Frame& F, LAS unsigned char* st, int b, int h, int t, bool meta, int wid, int lane) {
    { const int key = lane; const int krow = meta ? R_META + (key < NMETA ? key : NMETA - 1) : b * SEQ + 64 * t + key;
      __builtin_amdgcn_global_load_lds((const unsigned*)(F.KV + (size_t)krow * 1024 + h * 64 + wid * 8), (LAS unsigned*)(st + KOFF + wid * 1024), 16, 0, 0);
      if (wid < 4) __builtin_amdgcn_global_load_lds((const unsigned*)(F.KPEB + (size_t)krow * 32 + wid * 8), (LAS unsigned*)(st + KOFF + (8 + wid) * 1024), 16, 0, 0); }
    { const int key = 16 * (wid & 3) + (lane >> 2); const int vrow = meta ? R_META + (key < NMETA ? key : NMETA - 1) : b * SEQ + 64 * t + key;
      __builtin_amdgcn_global_load_lds((const unsigned*)(F.KV + (size_t)vrow * 1024 + 512 + h * 64 + (wid >> 2) * 32 + (lane & 3) * 8), (LAS unsigned*)(st + VOFF + wid * 1024), 16, 0, 0); }
}
__device__ __forceinline__ void attn_unit(const Frame& F, int b, int h, int qb) {
    const int lane = F.lane, wid = F.wave, r32 = lane & 31, hi = lane >> 5;
    LAS unsigned char* base = F.lds + RING_OFF;
    LAS float* wsf = (LAS float*)(base + LDS_WSF) + wid * 64;
    const int s0 = 256 * qb + 32 * wid; const size_t row0 = (size_t)b * SEQ + s0;
    const int NTR = 4 * (qb + 1), NT = NTR + 1;
    const int td = 4 * qb + (wid >> 1);
    __syncthreads();
    issue_tile(F, base, b, h, 0, false, wid, lane);
    bf16x8 qr[6];
    { const bf16* q = F.QM + (row0 + r32) * 768;
#pragma unroll
      for (int d0 = 0; d0 < 4; ++d0) qr[d0] = *(const bf16x8*)(q + h * 64 + d0 * 16 + hi * 8);
#pragma unroll
      for (int d0 = 0; d0 < 2; ++d0) qr[4 + d0] = *(const bf16x8*)(q + 512 + h * 32 + d0 * 16 + hi * 8); }
    f32x16 o0, o1;
#pragma unroll
    for (int r = 0; r < 16; ++r) { o0[r] = 0.f; o1[r] = 0.f; }
    float m = -INFINITY, l = 0.f;
    const int qrel = 32 * (wid & 1) + r32;
    const int vlane = ((lane >> 4) & 1) * 32 + (lane & 3) * 8 + (4 * hi + ((lane & 15) >> 2)) * 64;
    for (int t = 0; t < NT; ++t) {
        const bool meta = (t == NTR);
        asm volatile("s_waitcnt vmcnt(0)" ::: "memory");
        __syncthreads();
        if (t + 1 < NT) issue_tile(F, base + ((t + 1) & 1) * STAGE, b, h, t + 1, t + 1 == NTR, wid, lane);
        if (!meta && t > td) continue;
        const LAS unsigned char* st = base + (t & 1) * STAGE;
        const LAS unsigned char* kb = st + KOFF + hi * 1024 + r32 * 16;
        f32x16 p0, p1;
#pragma unroll
        for (int r = 0; r < 16; ++r) { p0[r] = 0.f; p1[r] = 0.f; }
        __builtin_amdgcn_s_setprio(1);
#pragma unroll
        for (int d0 = 0; d0 < 6; ++d0) {
            const bf16x8 k0 = *(const LAS bf16x8*)(kb + d0 * 2048);
            p0 = __builtin_amdgcn_mfma_f32_32x32x16_bf16(k0, qr[d0], p0, 0, 0, 0);
            if (!meta) { const bf16x8 k1 = *(const LAS bf16x8*)(kb + d0 * 2048 + 512); p1 = __builtin_amdgcn_mfma_f32_32x32x16_bf16(k1, qr[d0], p1, 0, 0, 0); }
        }
        __builtin_amdgcn_s_setprio(0);
        if (meta) {
#pragma unroll
            for (int r = 8; r < 16; ++r) p0[r] = -INFINITY;
#pragma unroll
            for (int r = 0; r < 16; ++r) p1[r] = -INFINITY;
        } else if (t == td) {
#pragma unroll
            for (int r = 0; r < 16; ++r) { const int kk = crow(r, hi); if (kk > qrel) p0[r] = -INFINITY; if (kk + 32 > qrel) p1[r] = -INFINITY; }
        }
        float mx = fmaxf(p0[0], p1[0]);
#pragma unroll
        for (int r = 1; r < 16; ++r) mx = fmaxf(mx, fmaxf(p0[r], p1[r]));
        mx = fmaxf(mx, __shfl_xor(mx, 32));
        const float mn = fmaxf(m, mx);
        if (__any(mn > m)) {
            const float f = __builtin_amdgcn_exp2f(m - mn);
            l *= f; wsf[r32] = f;
#pragma unroll
            for (int r = 0; r < 16; ++r) { const float fr_ = wsf[crow(r, hi)]; o0[r] *= fr_; o1[r] *= fr_; }
            m = mn;
        }
        float sum = 0.f;
#pragma unroll
        for (int r = 0; r < 16; ++r) { p0[r] = __builtin_amdgcn_exp2f(p0[r] - m); p1[r] = __builtin_amdgcn_exp2f(p1[r] - m); sum += p0[r] + p1[r]; }
        l += sum;
        v4u pa0, pa1, pa2, pa3;
        pa0.x = cvtpk(p0[0], p0[1]); pa0.y = cvtpk(p0[2], p0[3]); pa0.z = cvtpk(p0[4], p0[5]); pa0.w = cvtpk(p0[6], p0[7]);
        pa1.x = cvtpk(p0[8], p0[9]); pa1.y = cvtpk(p0[10], p0[11]); pa1.z = cvtpk(p0[12], p0[13]); pa1.w = cvtpk(p0[14], p0[15]);
        pa2.x = cvtpk(p1[0], p1[1]); pa2.y = cvtpk(p1[2], p1[3]); pa2.z = cvtpk(p1[4], p1[5]); pa2.w = cvtpk(p1[6], p1[7]);
        pa3.x = cvtpk(p1[8], p1[9]); pa3.y = cvtpk(p1[10], p1[11]); pa3.z = cvtpk(p1[12], p1[13]); pa3.w = cvtpk(p1[14], p1[15]);
        const LAS unsigned char* vp = st + VOFF + vlane;
#define FA_PV(O, PA, DB, KS) do { const s16x4 lo_ = vtr(vp + (DB) * 4096 + (KS) * 1024), hi_ = vtr(vp + (DB) * 4096 + (KS) * 1024 + 512); \
        const bf16x8 vf_ = {lo_[0], lo_[1], lo_[2], lo_[3], hi_[0], hi_[1], hi_[2], hi_[3]}; \
        O = __builtin_amdgcn_mfma_f32_32x32x16_bf16(__builtin_bit_cast(bf16x8, PA), vf_, O, 0, 0, 0); } while (0)
        __builtin_amdgcn_s_setprio(1);
        FA_PV(o0, pa0, 0, 0); FA_PV(o1, pa0, 1, 0);
        if (!meta) { FA_PV(o0, pa1, 0, 1); FA_PV(o1, pa1, 1, 1); FA_PV(o0, pa2, 0, 2); FA_PV(o1, pa2, 1, 2); FA_PV(o0, pa3, 0, 3); FA_PV(o1, pa3, 1, 3); }
#undef FA_PV
        __builtin_amdgcn_s_setprio(0);
    }
    l += __shfl_xor(l, 32);
    wsf[32 + r32] = l;
    float rli[16];
#pragma unroll
    for (int r = 0; r < 16; ++r) rli[r] = 1.0f / wsf[32 + crow(r, hi)];
    LAS bf16* stg = (LAS bf16*)(base + LDS_OST) + wid * 2048;
#pragma unroll
    for (int r = 0; r < 16; ++r) { const int orow = crow(r, hi); stg[orow * 64 + r32] = (bf16)f2bf(o0[r] * rli[r]); stg[orow * 64 + 32 + r32] = (bf16)f2bf(o1[r] * rli[r]); }
#pragma unroll
    for (int i = 0; i < 4; ++i) { const int row = i * 8 + (lane >> 3), ch = lane & 7; const v4u v = *(const LAS v4u*)(stg + row * 64 + ch * 8);
        *(v4u*)(F.MIX + (row0 + row) * 1024 + 512 + h * 64 + ch * 8) = v; }
}
__device__ __forceinline__ void attn_phase(const Frame& F) {
    for (int u = F.vcu; u < 256; u += F.G) { const int bh = u >> 2, pr = u & 3;
        attn_unit(F, bh >> 3, bh & 7, pr); attn_unit(F, bh >> 3, bh & 7, 7 - pr); }
    __syncthreads();
}
}

namespace sa {
using fa::f32x16; using fa::s16x4; using fa::crow; using fa::cvtpk; using fa::vtr;
constexpr int CS = 528, TILE = 36 * CS  , QF_OFF = 4 * TILE  , WSF_OFF = QF_OFF + 32 * 288 * 2  , LDS_TOTAL = WSF_OFF + 8 * 256;
static_assert(LDS_TOTAL <= RING_BYTES && QF_OFF % 16 == 0 && WSF_OFF % 16 == 0, "sample attention LDS");
constexpr int NUNIT = 8, KEYS_PER = PAST / NUNIT  , NTC = KEYS_PER / 64  , NSPL = 2 * NUNIT  ;
__device__ __forceinline__ void tile_step(const LAS unsigned char* st, const bf16x8 (&qf)[18], f32x16& o0, f32x16& o1, float& m, float& l, LAS float* wsf, int r32, int hi, int vlane) {
        const LAS unsigned char* kb = st + hi * CS + r32 * 16;
        f32x16 p0;
#pragma unroll
        for (int r = 0; r < 16; ++r) p0[r] = 0.f;
#pragma unroll
        for (int s = 0; s < 18; ++s) { const bf16x8 k0 = *(const LAS bf16x8*)(kb + 2 * s * CS); p0 = __builtin_amdgcn_mfma_f32_32x32x16_bf16(k0, qf[s], p0, 0, 0, 0); }
        float mx = p0[0];
#pragma unroll
        for (int r = 1; r < 16; ++r) mx = fmaxf(mx, p0[r]);
        mx = fmaxf(mx, __shfl_xor(mx, 32));
        const float mn = fmaxf(m, mx);
        if (__any(mn > m)) {
            const float f = __builtin_amdgcn_exp2f(m - mn);
            l *= f; wsf[r32] = f;
#pragma unroll
            for (int r = 0; r < 16; ++r) { const float fr_ = wsf[crow(r, hi)]; o0[r] *= fr_; o1[r] *= fr_; }
            m = mn;
        }
        float sum = 0.f;
#pragma unroll
        for (int r = 0; r < 16; ++r) { p0[r] = __builtin_amdgcn_exp2f(p0[r] - m); sum += p0[r]; }
        l += sum;
        v4u pa0, pa1;
        pa0.x = cvtpk(p0[0], p0[1]); pa0.y = cvtpk(p0[2], p0[3]); pa0.z = cvtpk(p0[4], p0[5]); pa0.w = cvtpk(p0[6], p0[7]);
        pa1.x = cvtpk(p0[8], p0[9]); pa1.y = cvtpk(p0[10], p0[11]); pa1.z = cvtpk(p0[12], p0[13]); pa1.w = cvtpk(p0[14], p0[15]);
        const LAS unsigned char* vp = st + vlane;
#define SA_PV(O, PA, CT, KS) do { const s16x4 lo_ = vtr(vp + (CT) * 4 * CS + (KS) * 256), hi_ = vtr(vp + (CT) * 4 * CS + (KS) * 256 + 128); \
        const bf16x8 vf_ = {lo_[0], lo_[1], lo_[2], lo_[3], hi_[0], hi_[1], hi_[2], hi_[3]}; \
        O = __builtin_amdgcn_mfma_f32_32x32x16_bf16(__builtin_bit_cast(bf16x8, PA), vf_, O, 0, 0, 0); } while (0)
        SA_PV(o0, pa0, 0, 0); SA_PV(o1, pa0, 1, 0); SA_PV(o0, pa1, 0, 1); SA_PV(o1, pa1, 1, 1);
#undef SA_PV
}
__device__ __forceinline__ void attn_unit(const Frame& F, int bs, int split, bool shared) {
    const int tid = F.tid, lane = F.lane, wid = F.wave, r32 = lane & 31, hi = lane >> 5, g = wid >> 2, w4 = wid & 3, tg = tid & 255;
    LAS unsigned char* base = F.lds + RING_OFF;
    LAS bf16* qfb = (LAS bf16*)(base + QF_OFF);
    LAS float* wsf = (LAS float*)(base + WSF_OFF) + wid * 64;
    __syncthreads();
    { LAS float* tmp = (LAS float*)base;
      for (int e = tid; e < 32 * 64; e += 512) { const int rr = e >> 6, n = e & 63, t = rr >> 3, h = rr & 7; tmp[e] = bf2f(F.QM[(size_t)(R_SAMP + bs * 4 + t) * 768 + h * 64 + n]); }
      for (int e = tid; e < 32 * 32; e += 512) { const int rr = e >> 5, i = e & 31, t = rr >> 3, h = rr & 7; qfb[rr * 288 + 256 + i] = F.QM[(size_t)(R_SAMP + bs * 4 + t) * 768 + 512 + h * 32 + i]; }
      __syncthreads();
      if (shared) {
        { int tz = tid; asm volatile("" : "+v"(tz)); const int h = tz & 7, c = split * 32 + ((tz >> 3) & 31), tp = tz >> 8;
          const f32x4* w = (const f32x4*)(F.w_kv_b + (size_t)c * 1024 + h * 128);
          f32x4 wv[16];
#pragma unroll
          for (int k = 0; k < 16; ++k) wv[k] = w[k];
#pragma unroll
          for (int t2 = 0; t2 < 2; ++t2) { const int t = 2 * tp + t2; const LAS f32x4* q4 = (const LAS f32x4*)(tmp + (t * 8 + h) * 64); float a = 0.f;
#pragma unroll
              for (int k = 0; k < 16; ++k) { const f32x4 q = q4[k]; a += (wv[k].x * q.x + wv[k].y * q.y) + (wv[k].z * q.z + wv[k].w * q.w); }
              F.QLAT[((size_t)bs * 32 + t * 8 + h) * 256 + c] = a; } }
        VM_WAIT(); __syncthreads();
        if (tid == 0) { gu32* cq = F.ctl + CW_QL + bs * 64;
            __builtin_amdgcn_fence(__ATOMIC_RELEASE, "agent"); asm volatile("s_waitcnt vmcnt(0)" ::: "memory"); __hip_atomic_fetch_add(cq, 1u, RLX_AGENT);
            unsigned sp = 0; while (__hip_atomic_load(cq, RLX_AGENT) < 8u) { __builtin_amdgcn_s_sleep(1); if (++sp > (1u << 22)) break; }
            __builtin_amdgcn_fence(__ATOMIC_ACQUIRE, "agent"); asm volatile("s_waitcnt vmcnt(0)" ::: "memory"); }
        __syncthreads();
        { const float* ql = F.QLAT + (size_t)bs * 32 * 256;
          for (int e = tid; e < 32 * 64; e += 512) { const int rr = e >> 6, c4 = (e & 63) * 4; const f32x4 v = *(const f32x4*)(ql + rr * 256 + c4);
              *(LAS unsigned long long*)(qfb + rr * 288 + c4) = (unsigned long long)pk2(v.x, v.y) | ((unsigned long long)pk2(v.z, v.w) << 32); } }
      } else
      { int tz = tid; asm volatile("" : "+v"(tz)); const int h = tz & 7;
#pragma unroll 1
        for (int j = 0; j < 4; ++j) { const int c = (tz >> 3) + 64 * j; const f32x4* w = (const f32x4*)(F.w_kv_b + (size_t)c * 1024 + h * 128);
            f32x4 wv[16];
#pragma unroll
            for (int k = 0; k < 16; ++k) wv[k] = w[k];
#pragma unroll
            for (int t = 0; t < 4; ++t) { const LAS f32x4* q4 = (const LAS f32x4*)(tmp + (t * 8 + h) * 64); float a = 0.f;
#pragma unroll
                for (int k = 0; k < 16; ++k) { const f32x4 q = q4[k]; a += (wv[k].x * q.x + wv[k].y * q.y) + (wv[k].z * q.z + wv[k].w * q.w); }
                qfb[(t * 8 + h) * 288 + c] = (bf16)f2bf(a); if (split == 0) F.QLAT[((size_t)bs * 32 + t * 8 + h) * 256 + c] = a; } } }
      __syncthreads(); }
    bf16x8 qf[18];
#pragma unroll
    for (int s = 0; s < 18; ++s) qf[s] = *(const LAS bf16x8*)(qfb + r32 * 288 + 16 * s + 8 * hi);
    const int ptv = F.page_table[bs * NPAGES + split * (KEYS_PER / PAGE) + (lane & 15)];
    f32x4 RA[9], RB[9];
#define SA_LOAD(R, t) do { const int key0_ = (t) * 64 + g * 32; const int page_ = __builtin_amdgcn_readlane(ptv, key0_ >> 7); const size_t rb_ = (size_t)page_ * PAGE + (key0_ & 127); \
        _Pragma("unroll") for (int i_ = 0; i_ < 8; ++i_) R[i_] = *((const f32x4*)(F.cache_latent + (rb_ + i_ * 4 + w4) * 256) + lane); \
        R[8] = *((const f32x4*)(F.cache_krope + (rb_ + (tg >> 3)) * 32) + (tg & 7)); } while (0)
#define SA_WRITE(R, buf) do { LAS unsigned char* b_ = base + (g * 2 + (buf)) * TILE; \
        _Pragma("unroll") for (int i_ = 0; i_ < 8; ++i_) { const unsigned long long w_ = (unsigned long long)cvtpk(R[i_].x, R[i_].y) | ((unsigned long long)cvtpk(R[i_].z, R[i_].w) << 32); \
            *(LAS unsigned long long*)(b_ + (lane >> 1) * CS + (i_ * 4 + w4) * 16 + (lane & 1) * 8) = w_; } \
        { const unsigned long long w_ = (unsigned long long)cvtpk(R[8].x, R[8].y) | ((unsigned long long)cvtpk(R[8].z, R[8].w) << 32); \
          *(LAS unsigned long long*)(b_ + (32 + ((tg & 7) >> 1)) * CS + (tg >> 3) * 16 + (tg & 1) * 8) = w_; } } while (0)
    SA_LOAD(RA, 0); SA_WRITE(RA, 0); SA_LOAD(RB, 1); SA_LOAD(RA, 2);
    f32x16 o0, o1;
#pragma unroll
    for (int r = 0; r < 16; ++r) { o0[r] = 0.f; o1[r] = 0.f; }
    float m = -INFINITY, l = 0.f;
    const int vlane = (8 * w4 + 2 * ((lane >> 4) & 1) + ((lane & 3) >> 1)) * CS + (4 * hi + ((lane & 15) >> 2)) * 16 + 8 * (lane & 1);
    for (int t = 0; t < NTC; t += 2) {
        __syncthreads();
        tile_step(base + (g * 2 + 0) * TILE, qf, o0, o1, m, l, wsf, r32, hi, vlane);
        SA_WRITE(RB, 1);
        if (t + 3 < NTC) SA_LOAD(RB, t + 3);
        __syncthreads();
        tile_step(base + (g * 2 + 1) * TILE, qf, o0, o1, m, l, wsf, r32, hi, vlane);
        if (t + 2 < NTC) { SA_WRITE(RA, 0); if (t + 4 < NTC) SA_LOAD(RA, t + 4); }
    }
#undef SA_LOAD
#undef SA_WRITE
    l += __shfl_xor(l, 32);
    { int lz = lane; asm volatile("" : "+v"(lz));
      const int rz = lz & 31, hz = lz >> 5;
      const int sp = split * 2 + g; float* po = F.PART + ((size_t)(bs * NSPL + sp) * 32) * 256 + 64 * w4 + rz;
#pragma unroll
      for (int r = 0; r < 16; ++r) { po[(size_t)crow(r, hz) * 256] = o0[r]; po[(size_t)crow(r, hz) * 256 + 32] = o1[r]; }
      if (w4 == 0 && hz == 0) { float* ps = F.PSTAT + ((size_t)(bs * NSPL + sp) * 32 + rz) * 2; ps[0] = m; ps[1] = l; } }
}
__device__ __forceinline__ void attn_phase(const Frame& F) {
    for (int u = F.vcu; u < NSB * NUNIT; u += F.G) attn_unit(F, u >> 3, u & 7, false);
    __syncthreads();
}
}

namespace gdn {
using fa::f32x16; using fa::crow;
constexpr int REC = 40960, OFF_W = 0, OFF_QG = 8192, OFF_QK = 16384, OFF_KD = 24576, OFF_U = 32768;
constexpr int NCH = SEQ / 64;
typedef float f32x2_t __attribute__((ext_vector_type(2))); typedef __bf16 bf16x2_t __attribute__((ext_vector_type(2)));
__device__ __forceinline__ unsigned cvt2(float lo, float hi) { f32x2_t v = {lo, hi}; bf16x2_t b = __builtin_convertvector(v, bf16x2_t); return __builtin_bit_cast(unsigned, b); }
__device__ __forceinline__ bf16x8 pack8(float a0, float a1, float a2, float a3, float a4, float a5, float a6, float a7) {
    v4u w; w.x = cvt2(a0, a1); w.y = cvt2(a2, a3); w.z = cvt2(a4, a5); w.w = cvt2(a6, a7); return __builtin_bit_cast(bf16x8, w); }
__device__ __forceinline__ bf16x8 ldfrag_f32(const float* p) { const f32x4 a = *(const f32x4*)p, b = *(const f32x4*)(p + 4); return pack8(a.x, a.y, a.z, a.w, b.x, b.y, b.z, b.w); }
__device__ __forceinline__ int swz16(int c) { return (c & 3) | ((c & 4) << 1) | ((c & 8) >> 1); }

template <int PASS> __device__ __forceinline__ void solve_pass(const Frame& F, const LAS float* Lm, const LAS float* gcs, const LAS float* bts, const bf16* col, unsigned char* rec, int lane) {
    float X[64];
#pragma unroll
    for (int ib = 0; ib < 4; ++ib) {
        float c16[16];
#pragma unroll
        for (int k = 0; k < 16; ++k) c16[k] = bf2f(col[(size_t)(16 * ib + k) * 1536]);
        asm volatile("" ::: "memory");
#pragma unroll
        for (int k = 0; k < 16; ++k) { const int i = 16 * ib + k;
            float x = c16[k] * bts[i]; if (PASS == 1) x *= __expf(gcs[i]);
#pragma unroll
            for (int m = 0; m < (i + 3) / 4; ++m) { const f32x4 l4 = *(const LAS f32x4*)(Lm + i * 64 + ((4 * m) ^ ((i & 7) << 2)));
                if (4 * m + 0 < i) x -= l4.x * X[4 * m + 0];
                if (4 * m + 1 < i) x -= l4.y * X[4 * m + 1];
                if (4 * m + 2 < i) x -= l4.z * X[4 * m + 2];
                if (4 * m + 3 < i) x -= l4.w * X[4 * m + 3]; }
            X[i] = x;
            if ((k & 3) == 3) asm volatile("" ::: "memory");
        }
    }
    if (PASS == 0) { const unsigned lo = (unsigned)((lane >> 5) * 2048 + (lane & 31)); bf16* U = (bf16*)(rec + OFF_U);
#pragma unroll
        for (int i = 0; i < 64; ++i) { const int rt = i >> 5, ip = i & 31, hi_ = (ip >> 2) & 1, r = (ip & 3) + 4 * (ip >> 3);
            U[lo + (unsigned)((rt * 16 + r) * 64 + 32 * hi_)] = (bf16)f2bf(X[i]); } }
    else { const int s = lane >> 4, sw = swz16(lane & 15), hsel = (sw >> 3) & 1, el = sw & 7; bf16* W = (bf16*)(rec + OFF_W); const unsigned lo = (unsigned)((s * 64 + 32 * hsel) * 8 + el);
#pragma unroll
        for (int i = 0; i < 64; ++i) { const int rt = i >> 5, ip = i & 31; W[lo + (unsigned)((rt * 256 + ip) * 8)] = (bf16)f2bf(-X[i]); } }
}
__device__ __forceinline__ void solve_both(const Frame& F, const LAS float* Lm, const LAS float* gcs, const LAS float* bts, const bf16* vcol, const bf16* kcol, unsigned char* rec, int lane) {
    float XU[64], XW[64];
#pragma unroll
    for (int ib = 0; ib < 8; ++ib) {
        float cu[8], cw[8];
        { unsigned lo2 = (unsigned)lane * 2u; asm volatile("" : "+v"(lo2));
          const char* vb = (const char*)vcol + (size_t)(8 * ib) * 3072; const char* kb = (const char*)kcol + (size_t)(8 * ib) * 3072;
#pragma unroll
          for (int k = 0; k < 8; ++k) { cu[k] = bf2f(*(const bf16*)(vb + (size_t)k * 3072 + lo2)); cw[k] = bf2f(*(const bf16*)(kb + (size_t)k * 3072 + lo2)); } }
        asm volatile("" ::: "memory");
#pragma unroll
        for (int k = 0; k < 8; ++k) { const int i = 8 * ib + k;
            const float bi = bts[i]; float xu = cu[k] * bi, xw = cw[k] * bi * __expf(gcs[i]);
#pragma unroll
            for (int m = 0; m < (i + 3) / 4; ++m) { const f32x4 l4 = *(const LAS f32x4*)(Lm + i * 64 + ((4 * m) ^ ((i & 7) << 2)));
                if (4 * m + 0 < i) { xu -= l4.x * XU[4 * m + 0]; xw -= l4.x * XW[4 * m + 0]; }
                if (4 * m + 1 < i) { xu -= l4.y * XU[4 * m + 1]; xw -= l4.y * XW[4 * m + 1]; }
                if (4 * m + 2 < i) { xu -= l4.z * XU[4 * m + 2]; xw -= l4.z * XW[4 * m + 2]; }
                if (4 * m + 3 < i) { xu -= l4.w * XU[4 * m + 3]; xw -= l4.w * XW[4 * m + 3]; } }
            XU[i] = xu; XW[i] = xw;
            asm volatile("" ::: "memory");
        }
    }
    { int lz = lane; asm volatile("" : "+v"(lz));
      const unsigned lo = (unsigned)((lz >> 5) * 2048 + (lz & 31)); bf16* U = (bf16*)(rec + OFF_U);
#pragma unroll
      for (int i = 0; i < 64; ++i) { const int rt = i >> 5, ip = i & 31, hi_ = (ip >> 2) & 1, r = (ip & 3) + 4 * (ip >> 3);
          U[lo + (unsigned)((rt * 16 + r) * 64 + 32 * hi_)] = (bf16)f2bf(XU[i]); } }
    asm volatile("" ::: "memory");
    { int lz = lane; asm volatile("" : "+v"(lz)); lane = lz; }
    { const int s = lane >> 4, sw = swz16(lane & 15), hsel = (sw >> 3) & 1, el = sw & 7; bf16* W = (bf16*)(rec + OFF_W); const unsigned lo = (unsigned)((s * 64 + 32 * hsel) * 8 + el);
#pragma unroll
      for (int i = 0; i < 64; ++i) { const int rt = i >> 5, ip = i & 31; W[lo + (unsigned)((rt * 256 + ip) * 8)] = (bf16)f2bf(-XW[i]); } }
}
__device__ __forceinline__ void g1_unit(const Frame& F, int b, int n) {
    int lane_ = F.lane; asm volatile("" : "+v"(lane_));
    const int lane = lane_, h = F.wave, r32 = lane & 31, hi = lane >> 5;
    LAS float* Lm = (LAS float*)(F.lds + RING_OFF) + h * 4096;
    LAS float* gcs = (LAS float*)(F.lds + LDSCTL_OFF + 1024) + h * 128;
    LAS float* bts = gcs + 64;
    const size_t row0 = (size_t)b * SEQ + 64 * n;
    unsigned char* rec = F.GCH + ((size_t)(b * NCH + n) * NH + h) * REC;
    const float beta_l = F.GB[(row0 + lane) * 16 + h]; float gc = F.GB[(row0 + lane) * 16 + 8 + h];
#pragma unroll
    for (int off = 1; off < 64; off <<= 1) { const float t = __int_as_float(__builtin_amdgcn_ds_bpermute((lane - off) << 2, __float_as_int(gc))); if (lane >= off) gc += t; }
    const float gl = rdlane(gc, 63);
    gcs[lane] = gc; bts[lane] = beta_l;
    if (lane == 0) F.EGL[(size_t)(b * NH + h) * NCH + n] = __expf(gl);
    bf16x8 kf[2][4], qf[2][4];
#pragma unroll
    for (int t = 0; t < 2; ++t)
#pragma unroll
        for (int s = 0; s < 4; ++s) { const bf16* base = F.GQKV + (row0 + 32 * t + r32) * 1536 + h * 64 + 16 * s + 8 * hi; qf[t][s] = *(const bf16x8*)base; kf[t][s] = *(const bf16x8*)(base + 512); }
    LDS_WAIT(); asm volatile("" ::: "memory");
    { LAS bf16* kt = (LAS bf16*)Lm;
#pragma unroll
      for (int t = 0; t < 2; ++t)
#pragma unroll
          for (int s = 0; s < 4; ++s) *(LAS bf16x8*)(kt + (32 * t + r32) * 64 + 16 * s + 8 * hi) = kf[t][s];
      LDS_WAIT(); asm volatile("" ::: "memory");
      const int rt = lane >> 5;
#pragma unroll
      for (int s = 0; s < 4; ++s)
#pragma unroll
          for (int hh = 0; hh < 2; ++hh) { float v[8];
#pragma unroll
              for (int j = 0; j < 8; ++j) { const int c = 16 * s + 8 * (j >> 2) + 4 * hh + (j & 3); v[j] = bf2f(kt[c * 64 + lane]) * __expf(gl - gcs[c]); }
              *(bf16x8*)(rec + OFF_KD + (unsigned)(rt * 4096 + (lane & 31) * 16) + (unsigned)(s * 1024 + hh * 512)) = pack8(v[0], v[1], v[2], v[3], v[4], v[5], v[6], v[7]); }
      LDS_WAIT(); asm volatile("" ::: "memory"); }
#pragma unroll
    for (int tt = 0; tt < 3; ++tt) { const int it = tt == 0 ? 0 : 1, jt = tt == 2 ? 1 : 0;
        f32x16 acc;
#pragma unroll
        for (int r = 0; r < 16; ++r) acc[r] = 0.f;
#pragma unroll
        for (int s = 0; s < 4; ++s) acc = __builtin_amdgcn_mfma_f32_32x32x16_bf16(kf[jt][s], kf[it][s], acc, 0, 0, 0);
        const int i = 32 * it + r32; const float gci = gcs[i], bi = bts[i];
#pragma unroll
        for (int r = 0; r < 16; ++r) { const int j = 32 * jt + crow(r, hi); const float v = j < i ? bi * acc[r] * __expf(gci - gcs[j]) : 0.f; Lm[i * 64 + (j ^ ((i & 7) << 2))] = v; } }
#pragma unroll
    for (int tt = 0; tt < 4; ++tt) { const int it = tt >> 1, ct = tt & 1;
        if (ct <= it) {
            f32x16 acc;
#pragma unroll
            for (int r = 0; r < 16; ++r) acc[r] = 0.f;
#pragma unroll
            for (int s = 0; s < 4; ++s) acc = __builtin_amdgcn_mfma_f32_32x32x16_bf16(kf[ct][s], qf[it][s], acc, 0, 0, 0);
            const int i = 32 * it + r32; const float gci = gcs[i];
#pragma unroll
            for (int r = 0; r < 16; ++r) { const int c = 32 * ct + crow(r, hi); acc[r] = c <= i ? acc[r] * __expf(gci - gcs[c]) : 0.f; }
#pragma unroll
            for (int hf = 0; hf < 2; ++hf) *(bf16x8*)(rec + (unsigned)(OFF_QK + (it * 4 + 2 * ct + hf) * 1024) + (unsigned)lane * 16u) =
                pack8(acc[8 * hf], acc[8 * hf + 1], acc[8 * hf + 2], acc[8 * hf + 3], acc[8 * hf + 4], acc[8 * hf + 5], acc[8 * hf + 6], acc[8 * hf + 7]);
        } else { unsigned z = 0u; asm volatile("" : "+v"(z));
#pragma unroll
            for (int hf = 0; hf < 2; ++hf) *(v4u*)(rec + (unsigned)(OFF_QK + (it * 4 + 2 * ct + hf) * 1024) + (unsigned)lane * 16u) = (v4u){z, z, z, z}; } }
    LDS_WAIT(); asm volatile("" ::: "memory");
#pragma unroll
    for (int t = 0; t < 2; ++t) { const float eg = __expf(gcs[32 * t + r32]);
#pragma unroll
        for (int s = 0; s < 4; ++s) { const v4u own = __builtin_bit_cast(v4u, qf[t][s]);
            const unsigned s0 = hi ? own.x : own.z, s1 = hi ? own.y : own.w;
            const unsigned p0 = (unsigned)__builtin_amdgcn_ds_bpermute((lane ^ 32) << 2, (int)s0), p1 = (unsigned)__builtin_amdgcn_ds_bpermute((lane ^ 32) << 2, (int)s1);
            const unsigned d0 = hi ? p0 : own.x, d1 = hi ? p1 : own.y, d2 = hi ? own.z : p0, d3 = hi ? own.w : p1;
            v4u o; o.x = cvt2(__uint_as_float(d0 << 16) * eg, __uint_as_float(d0 & 0xffff0000u) * eg); o.y = cvt2(__uint_as_float(d1 << 16) * eg, __uint_as_float(d1 & 0xffff0000u) * eg);
            o.z = cvt2(__uint_as_float(d2 << 16) * eg, __uint_as_float(d2 & 0xffff0000u) * eg); o.w = cvt2(__uint_as_float(d3 << 16) * eg, __uint_as_float(d3 & 0xffff0000u) * eg);
            *(v4u*)(rec + (unsigned)(OFF_QG + (t * 4 + s) * 1024) + (unsigned)lane * 16u) = o; } }
    const bf16* vcol0 = F.GQKV + row0 * 1536 + 1024 + h * 64; const bf16* kcol0 = F.GQKV + row0 * 1536 + 512 + h * 64;
    { int l2 = lane; asm volatile("" : "+v"(l2)); solve_both(F, Lm, gcs, bts, vcol0, kcol0, rec, l2); }
    LDS_WAIT(); asm volatile("" ::: "memory");
}
__device__ __forceinline__ void chain_short(const Frame& F, int mode, int idx) {
    const int lane = F.lane; int h, total, rbase; float S[64];
    if (mode == 0) { h = idx; total = NMETA; rbase = R_META;
#pragma unroll
        for (int d = 0; d < 64; ++d) S[d] = 0.f; }
    else { h = idx & 7; total = NST; rbase = R_SAMP + (idx >> 3) * NST;
#pragma unroll
        for (int d = 0; d < 64; ++d) S[d] = F.state_ssm[((size_t)idx * 64 + d) * 64 + lane]; }
    for (int i = 0; i < total; ++i) { const size_t r = rbase + i;
        const float q = bf2f(F.GQKV[r * 1536 + h * 64 + lane]), k = bf2f(F.GQKV[r * 1536 + 512 + h * 64 + lane]), v = bf2f(F.GQKV[r * 1536 + 1024 + h * 64 + lane]);
        const float beta = F.GB[r * 16 + h], eg = expf(F.GB[r * 16 + 8 + h]);
        float k0 = 0.f, k1 = 0.f;
#pragma unroll
        for (int d = 0; d < 64; d += 2) { k0 += rdlane(k, d) * S[d]; k1 += rdlane(k, d + 1) * S[d + 1]; }
        const float vnew = beta * (v - eg * (k0 + k1));
        float o0 = 0.f, o1 = 0.f;
#pragma unroll
        for (int d = 0; d < 64; d += 2) { S[d] = eg * S[d] + rdlane(k, d) * vnew; o0 += rdlane(q, d) * S[d]; S[d + 1] = eg * S[d + 1] + rdlane(k, d + 1) * vnew; o1 += rdlane(q, d + 1) * S[d + 1]; }
        F.GO[r * 512 + h * 64 + lane] = o0 + o1; }
    float* so = mode == 0 ? F.S1 + (size_t)h * 4096 : F.out + O_SSMS + (size_t)idx * 4096;
#pragma unroll
    for (int d = 0; d < 64; ++d) so[d * 64 + lane] = S[d];
}
__device__ __forceinline__ void g1_phase(const Frame& F) {
    for (int u = F.vcu; u < NB * NCH; u += F.G) g1_unit(F, u / NCH, u % NCH);
    const int gw = F.vcu * NWAVES + F.wave, NGW = F.G * NWAVES;
    for (int t = NGW - 1 - gw; t < NH + NSB * NH; t += NGW) { if (t < NH) chain_short(F, 0, t); else chain_short(F, 1, t - NH); }
}
__device__ __forceinline__ void g2_task(const Frame& F, int b, int h, int cb) {
    int lane_ = F.lane; asm volatile("" : "+v"(lane_));
    const int lane = lane_, r32 = lane & 31, hi = lane >> 5;
    LAS unsigned char* base = F.lds + RING_OFF;
    constexpr int BUF = 36864;
    const unsigned char* recs = F.GCH + ((size_t)(b * NCH) * NH + h) * REC;
    f32x16 S0, S1, V0, V1, O0, O1;
    { const float* s1 = F.S1 + (size_t)h * 4096 + 32 * cb + r32;
#pragma unroll
      for (int r = 0; r < 16; ++r) { S0[r] = s1[(size_t)crow(r, hi) * 64]; S1[r] = s1[(size_t)(32 + crow(r, hi)) * 64]; } }
    const float egl_l = lane < NCH ? F.EGL[(size_t)(b * NH + h) * NCH + lane] : 0.f;
    const unsigned voff16 = (unsigned)lane * 16u;
#define G2_ISSUE(n, buf) do { const unsigned char* rc_ = recs + (size_t)(n) * NH * REC; LAS unsigned char* d_ = base + (buf) * BUF; \
        _Pragma("unroll") for (int f_ = 0; f_ < 32; ++f_) __builtin_amdgcn_global_load_lds((const unsigned*)(rc_ + f_ * 1024 + voff16), (LAS unsigned*)(d_ + f_ * 1024), 16, 0, 0); \
        _Pragma("unroll") for (int f_ = 0; f_ < 4; ++f_) __builtin_amdgcn_global_load_lds((const unsigned*)(rc_ + OFF_U + (cb * 4 + f_) * 1024 + voff16), (LAS unsigned*)(d_ + 32768 + f_ * 1024), 16, 0, 0); } while (0)
    G2_ISSUE(0, 0);
    for (int n = 0; n < NCH; ++n) {
        asm volatile("s_waitcnt vmcnt(0)" ::: "memory");
        if (n + 1 < NCH) G2_ISSUE(n + 1, (n + 1) & 1);
        const LAS unsigned char* bf = base + (n & 1) * BUF;
#define G2_FR(off, f) (*(const LAS bf16x8*)(bf + (off) + (f) * 1024 + lane * 16))
        bf16x8 sb[4];
        sb[0] = pack8(S0[0], S0[1], S0[2], S0[3], S0[4], S0[5], S0[6], S0[7]); sb[1] = pack8(S0[8], S0[9], S0[10], S0[11], S0[12], S0[13], S0[14], S0[15]);
        sb[2] = pack8(S1[0], S1[1], S1[2], S1[3], S1[4], S1[5], S1[6], S1[7]); sb[3] = pack8(S1[8], S1[9], S1[10], S1[11], S1[12], S1[13], S1[14], S1[15]);
        { const LAS unsigned* up = (const LAS unsigned*)(bf + 32768);
#pragma unroll
          for (int r = 0; r < 16; ++r) { V0[r] = bf2f(((const LAS bf16*)up)[(0 * 16 + r) * 64 + lane]); V1[r] = bf2f(((const LAS bf16*)up)[(1 * 16 + r) * 64 + lane]); O0[r] = 0.f; O1[r] = 0.f; } }
#pragma unroll
        for (int s = 0; s < 4; ++s) { V0 = __builtin_amdgcn_mfma_f32_32x32x16_bf16(G2_FR(OFF_W, s), sb[s], V0, 0, 0, 0); V1 = __builtin_amdgcn_mfma_f32_32x32x16_bf16(G2_FR(OFF_W, 4 + s), sb[s], V1, 0, 0, 0);
            O0 = __builtin_amdgcn_mfma_f32_32x32x16_bf16(G2_FR(OFF_QG, s), sb[s], O0, 0, 0, 0); O1 = __builtin_amdgcn_mfma_f32_32x32x16_bf16(G2_FR(OFF_QG, 4 + s), sb[s], O1, 0, 0, 0); }
        bf16x8 vb[4];
        vb[0] = pack8(V0[0], V0[1], V0[2], V0[3], V0[4], V0[5], V0[6], V0[7]); vb[1] = pack8(V0[8], V0[9], V0[10], V0[11], V0[12], V0[13], V0[14], V0[15]);
        vb[2] = pack8(V1[0], V1[1], V1[2], V1[3], V1[4], V1[5], V1[6], V1[7]); vb[3] = pack8(V1[8], V1[9], V1[10], V1[11], V1[12], V1[13], V1[14], V1[15]);
        const float egl = rdlane(egl_l, n);
#pragma unroll
        for (int r = 0; r < 16; ++r) { S0[r] *= egl; S1[r] *= egl; }
#pragma unroll
        for (int s = 0; s < 4; ++s) { O0 = __builtin_amdgcn_mfma_f32_32x32x16_bf16(G2_FR(OFF_QK, s), vb[s], O0, 0, 0, 0); O1 = __builtin_amdgcn_mfma_f32_32x32x16_bf16(G2_FR(OFF_QK, 4 + s), vb[s], O1, 0, 0, 0);
            S0 = __builtin_amdgcn_mfma_f32_32x32x16_bf16(G2_FR(OFF_KD, s), vb[s], S0, 0, 0, 0); S1 = __builtin_amdgcn_mfma_f32_32x32x16_bf16(G2_FR(OFF_KD, 4 + s), vb[s], S1, 0, 0, 0); }
#undef G2_FR
        { unsigned* go = (unsigned*)F.GO + (size_t)((((b * NCH + n) * NH + h) * 2 + cb) * 2) * 512;
          unsigned lo = (unsigned)lane; asm volatile("" : "+v"(lo));
#pragma unroll
          for (int r = 0; r < 16; r += 2) { go[lo + (unsigned)((r >> 1) * 64)] = cvt2(O0[r], O0[r + 1]); go[lo + (unsigned)(512 + (r >> 1) * 64)] = cvt2(O1[r], O1[r + 1]); } }
    }
#undef G2_ISSUE
    { float* so = F.out + O_SSMP + ((size_t)b * NH + h) * 4096 + 32 * cb + r32;
#pragma unroll
      for (int r = 0; r < 16; ++r) { so[(size_t)crow(r, hi) * 64] = S0[r]; so[(size_t)(32 + crow(r, hi)) * 64] = S1[r]; } }
}
__device__ __forceinline__ void g2_pair(const Frame& F, int b, int h) {
    const int cb = F.wave & 1; const bool act = F.wave < 2;
    __syncthreads();
    int lane_ = F.lane; asm volatile("" : "+v"(lane_));
    const int lane = lane_, r32 = lane & 31, hi = lane >> 5;
    LAS unsigned char* base = F.lds + RING_OFF;
    constexpr int BUF = 40960;
    const unsigned char* recs = F.GCH + ((size_t)(b * NCH) * NH + h) * REC;
    f32x16 S0, S1, V0, V1, O0, O1;
    { const float* s1 = F.S1 + (size_t)h * 4096 + 32 * cb + r32;
#pragma unroll
      for (int r = 0; r < 16; ++r) { S0[r] = s1[(size_t)crow(r, hi) * 64]; S1[r] = s1[(size_t)(32 + crow(r, hi)) * 64]; } }
    const float egl_l = lane < NCH ? F.EGL[(size_t)(b * NH + h) * NCH + lane] : 0.f;
    const unsigned voff16 = (unsigned)lane * 16u;
#define G2_ISSUE(n, buf) do { const unsigned char* rc_ = recs + (size_t)(n) * NH * REC + cb * 16384; LAS unsigned char* d_ = base + (buf) * BUF + cb * 16384; \
        _Pragma("unroll") for (int f_ = 0; f_ < 16; ++f_) { if (cb == 1 && (f_ == 2 || f_ == 3)) continue;     \
            __builtin_amdgcn_global_load_lds((const unsigned*)(rc_ + f_ * 1024 + voff16), (LAS unsigned*)(d_ + f_ * 1024), 16, 0, 0); } \
        _Pragma("unroll") for (int f_ = 0; f_ < 4; ++f_) __builtin_amdgcn_global_load_lds((const unsigned*)(recs + (size_t)(n) * NH * REC + OFF_U + (cb * 4 + f_) * 1024 + voff16), (LAS unsigned*)(base + (buf) * BUF + 32768 + cb * 4096 + f_ * 1024), 16, 0, 0); } while (0)
    if (act) G2_ISSUE(0, 0);
    for (int n = 0; n < NCH; ++n) {
        if (act) asm volatile("s_waitcnt vmcnt(0)" ::: "memory");
        asm volatile("s_waitcnt lgkmcnt(0)" ::: "memory"); __builtin_amdgcn_s_barrier(); asm volatile("" ::: "memory");
        if (!act) continue;
        if (n + 1 < NCH) G2_ISSUE(n + 1, (n + 1) & 1);
        const LAS unsigned char* bf = base + (n & 1) * BUF;
#define G2_FR(off, f) (*(const LAS bf16x8*)(bf + (off) + (f) * 1024 + lane * 16))
        bf16x8 sb[4];
        sb[0] = pack8(S0[0], S0[1], S0[2], S0[3], S0[4], S0[5], S0[6], S0[7]); sb[1] = pack8(S0[8], S0[9], S0[10], S0[11], S0[12], S0[13], S0[14], S0[15]);
        sb[2] = pack8(S1[0], S1[1], S1[2], S1[3], S1[4], S1[5], S1[6], S1[7]); sb[3] = pack8(S1[8], S1[9], S1[10], S1[11], S1[12], S1[13], S1[14], S1[15]);
        { const LAS unsigned* up = (const LAS unsigned*)(bf + 32768 + cb * 4096);
#pragma unroll
          for (int r = 0; r < 16; ++r) { V0[r] = bf2f(((const LAS bf16*)up)[(0 * 16 + r) * 64 + lane]); V1[r] = bf2f(((const LAS bf16*)up)[(1 * 16 + r) * 64 + lane]); O0[r] = 0.f; O1[r] = 0.f; } }
#pragma unroll
        for (int s = 0; s < 4; ++s) { V0 = __builtin_amdgcn_mfma_f32_32x32x16_bf16(G2_FR(OFF_W, s), sb[s], V0, 0, 0, 0); V1 = __builtin_amdgcn_mfma_f32_32x32x16_bf16(G2_FR(OFF_W, 4 + s), sb[s], V1, 0, 0, 0);
            O0 = __builtin_amdgcn_mfma_f32_32x32x16_bf16(G2_FR(OFF_QG, s), sb[s], O0, 0, 0, 0); O1 = __builtin_amdgcn_mfma_f32_32x32x16_bf16(G2_FR(OFF_QG, 4 + s), sb[s], O1, 0, 0, 0); }
        bf16x8 vb[4];
        vb[0] = pack8(V0[0], V0[1], V0[2], V0[3], V0[4], V0[5], V0[6], V0[7]); vb[1] = pack8(V0[8], V0[9], V0[10], V0[11], V0[12], V0[13], V0[14], V0[15]);
        vb[2] = pack8(V1[0], V1[1], V1[2], V1[3], V1[4], V1[5], V1[6], V1[7]); vb[3] = pack8(V1[8], V1[9], V1[10], V1[11], V1[12], V1[13], V1[14], V1[15]);
        const float egl = rdlane(egl_l, n);
#pragma unroll
        for (int r = 0; r < 16; ++r) { S0[r] *= egl; S1[r] *= egl; }
#pragma unroll
        for (int s = 0; s < 4; ++s) { if (s < 2) O0 = __builtin_amdgcn_mfma_f32_32x32x16_bf16(G2_FR(OFF_QK, s), vb[s], O0, 0, 0, 0); O1 = __builtin_amdgcn_mfma_f32_32x32x16_bf16(G2_FR(OFF_QK, 4 + s), vb[s], O1, 0, 0, 0);
            S0 = __builtin_amdgcn_mfma_f32_32x32x16_bf16(G2_FR(OFF_KD, s), vb[s], S0, 0, 0, 0); S1 = __builtin_amdgcn_mfma_f32_32x32x16_bf16(G2_FR(OFF_KD, 4 + s), vb[s], S1, 0, 0, 0); }
#undef G2_FR
        { unsigned* go = (unsigned*)F.GO + (size_t)((((b * NCH + n) * NH + h) * 2 + cb) * 2) * 512;
          unsigned lo = (unsigned)lane; asm volatile("" : "+v"(lo));
#pragma unroll
          for (int r = 0; r < 16; r += 2) { go[lo + (unsigned)((r >> 1) * 64)] = cvt2(O0[r], O0[r + 1]); go[lo + (unsigned)(512 + (r >> 1) * 64)] = cvt2(O1[r], O1[r + 1]); } }
    }
#undef G2_ISSUE
    if (act) { float* so = F.out + O_SSMP + ((size_t)b * NH + h) * 4096 + 32 * cb + r32;
#pragma unroll
      for (int r = 0; r < 16; ++r) { so[(size_t)crow(r, hi) * 64] = S0[r]; so[(size_t)(32 + crow(r, hi)) * 64] = S1[r]; } }
}
__device__ __forceinline__ void g2_phase(const Frame& F) {
    if (F.wave == 0) for (int t = F.vcu; t < NB * NH * 2; t += F.G) g2_task(F, t >> 4, (t >> 1) & 7, t & 1);
}
}
__device__ __forceinline__ void p4_mixers(Frame& F) {
    if (F.G == 256) {
        const int v = F.vcu, first = v < 128, w = v & 127, bh = w >> 1, b = bh >> 3, h = bh & 7;
        const unsigned ql = first ? ((w & 1) ? 0xF37u : 0xFF4u) : ((w & 1) ? 0x015u : 0xF26u);
        if (first && (w & 1) == 0) gdn::g2_pair(F, b, h);
        if (!first) sa::attn_unit(F, v >> 3, v & 7, true);
        for (int i = 0; i < 3; ++i) { const int qb = (int)((ql >> (4 * i)) & 0xFu); if (qb != 0xF) fa::attn_unit(F, b, h, qb); }
        if (first) sa::attn_unit(F, v >> 3, v & 7, true);
        __syncthreads();
    } else {
        gdn::g2_phase(F);
        fa::attn_phase(F);
        sa::attn_phase(F);
    }
}
__device__ __forceinline__ void p5_post(Frame& F) {
    const int lane = F.lane; const int gw = F.vcu * NWAVES + F.wave, NGW = F.G * NWAVES;
    LAS float* wl = (LAS float*)(F.lds + RING_OFF) + F.wave * 256;
    const bool bal = (F.G == 256);
    const int t0 = bal ? (F.wave < 4 ? F.wave * 256 + F.vcu : NSB * 32) : gw, tstep = bal ? NSB * 32 : NGW;
    for (int t = t0; t < NSB * 32; t += tstep) { const int bs = t >> 5, rr = t & 31, tt = rr >> 3, h = rr & 7;
        float M = -INFINITY;
        for (int s = 0; s < sa::NSPL; ++s) M = fmaxf(M, F.PSTAT[(((size_t)bs * sa::NSPL + s) * 32 + rr) * 2]);
        float L = 0.f, o[4] = {0.f, 0.f, 0.f, 0.f};
        for (int s = 0; s < sa::NSPL; ++s) { const float* ps = F.PSTAT + (((size_t)bs * sa::NSPL + s) * 32 + rr) * 2; const float w = __builtin_amdgcn_exp2f(ps[0] - M); L += w * ps[1];
            const float* po = F.PART + (((size_t)bs * sa::NSPL + s) * 32 + rr) * 256;
#pragma unroll
            for (int k = 0; k < 4; ++k) o[k] += w * po[lane + 64 * k]; }
        {
          float ql[4];
#pragma unroll
          for (int k = 0; k < 4; ++k) ql[k] = F.QLAT[((size_t)bs * 32 + rr) * 256 + lane + 64 * k];
          const float qp = lane < 32 ? bf2f(F.QM[(size_t)(R_SAMP + bs * NST + tt) * 768 + 512 + h * 32 + lane]) : 0.f;
          for (int j = 0; j <= tt; ++j) { const float* lj = F.out + O_LATS + ((size_t)bs * NST + j) * KVLORA; const float* kj = F.KPE + (size_t)(R_SAMP + bs * NST + j) * 32;
              float lv[4]; float part = lane < 32 ? qp * kj[lane] : 0.f;
#pragma unroll
              for (int k = 0; k < 4; ++k) { lv[k] = lj[lane + 64 * k]; part += ql[k] * lv[k]; }
              const float sj = wave_sum(part); const float M2 = fmaxf(M, sj); const float sc = __builtin_amdgcn_exp2f(M - M2), pj = __builtin_amdgcn_exp2f(sj - M2);
              L = L * sc + pj; M = M2;
#pragma unroll
              for (int k = 0; k < 4; ++k) o[k] = o[k] * sc + pj * lv[k]; } }
        const float inv = 1.0f / L;
#pragma unroll
        for (int k = 0; k < 4; ++k) wl[lane + 64 * k] = o[k] * inv;
        LDS_WAIT(); asm volatile("" ::: "memory");
        float a = 0.f; const float* w = F.w_kv_b + h * 128 + 64 + lane;
        for (int c = 0; c < 256; ++c) a += wl[c] * w[(size_t)c * 1024];
        F.MIX[(size_t)(R_SAMP + bs * NST + tt) * 1024 + 512 + h * 64 + lane] = (bf16)f2bf(a);
        LDS_WAIT(); asm volatile("" ::: "memory"); }
    { const int h = lane >> 3, j = lane & 7;
      const f32x4 gn0 = *(const f32x4*)(F.gdn_norm_g + 8 * j), gn1 = *(const f32x4*)(F.gdn_norm_g + 8 * j + 4);
      const int nr = bal ? (F.wave < 4 ? 5 : (F.wave == 7 ? 12 : 11)) : (MT - gw + NGW - 1) / NGW;
      const int rbase = bal ? F.vcu * 65 + (F.wave < 4 ? F.wave * 5 : 20 + (F.wave - 4) * 11) : gw, rstride = bal ? 1 : NGW;
      static_assert(MT == 256 * 65, "balanced row split");
      for (int k0 = 0; k0 < nr; k0 += 4) {
        f32x4 oa[4], ob[4]; v4u zz[4]; int rq[4];
#pragma unroll
        for (int q = 0; q < 4; ++q) { const int r = (k0 + q < nr) ? rbase + (k0 + q) * rstride : MT; rq[q] = r < MT ? r : -1;
            oa[q] = (f32x4){0.f, 0.f, 0.f, 0.f}; ob[q] = oa[q]; zz[q] = (v4u){0u, 0u, 0u, 0u};
            if (r < R_END) {
                if (r < R_META) { const int b_ = r >> 11, n_ = (r >> 6) & 31, tk = r & 63, rt = tk >> 5, ip = tk & 31, hi_ = (ip >> 2) & 1, rr_ = (ip & 3) + 4 * (ip >> 3);
                    const unsigned* op = (const unsigned*)F.GO + (size_t)((((((b_ * 32 + n_) * NH + h) * 2 + (j >> 2)) * 2 + rt) * 8 + (rr_ >> 1)) * 64) + 8 * (j & 3) + 32 * hi_;
                    const v4u w0 = *(const v4u*)op, w1 = *(const v4u*)(op + 4);
                    if (rr_ & 1) { oa[q] = (f32x4){__uint_as_float(w0.x & 0xffff0000u), __uint_as_float(w0.y & 0xffff0000u), __uint_as_float(w0.z & 0xffff0000u), __uint_as_float(w0.w & 0xffff0000u)};
                                   ob[q] = (f32x4){__uint_as_float(w1.x & 0xffff0000u), __uint_as_float(w1.y & 0xffff0000u), __uint_as_float(w1.z & 0xffff0000u), __uint_as_float(w1.w & 0xffff0000u)}; }
                    else { oa[q] = (f32x4){__uint_as_float(w0.x << 16), __uint_as_float(w0.y << 16), __uint_as_float(w0.z << 16), __uint_as_float(w0.w << 16)};
                           ob[q] = (f32x4){__uint_as_float(w1.x << 16), __uint_as_float(w1.y << 16), __uint_as_float(w1.z << 16), __uint_as_float(w1.w << 16)}; } }
                else { const float* op = F.GO + (size_t)r * 512 + h * 64 + 8 * j; oa[q] = *(const f32x4*)op; ob[q] = *(const f32x4*)(op + 4); }
                zz[q] = *(const v4u*)(F.PRJ + (size_t)r * NPRJ + C_Z + h * 64 + 8 * j); } }
#pragma unroll
        for (int q = 0; q < 4; ++q) { const int r = rq[q]; if (r < 0) continue;
            bf16* mrow = F.MIX + (size_t)r * 1024;
            if (r >= R_END) { *(v4u*)(mrow + 8 * lane) = (v4u){0u, 0u, 0u, 0u}; *(v4u*)(mrow + 512 + 8 * lane) = (v4u){0u, 0u, 0u, 0u}; continue; }
            const f32x4 o0 = oa[q], o1 = ob[q]; const v4u zw = zz[q];
            float ss = (o0.x * o0.x + o0.y * o0.y) + (o0.z * o0.z + o0.w * o0.w) + (o1.x * o1.x + o1.y * o1.y) + (o1.z * o1.z + o1.w * o1.w);
            ss += __shfl_xor(ss, 1); ss += __shfl_xor(ss, 2); ss += __shfl_xor(ss, 4);
            const float rs = 1.0f / sqrtf(ss * (1.0f / 64.0f) + EPS);
            v4u w;
            w.x = pk2(o0.x * rs * gn0.x * silu_f(__uint_as_float(zw.x << 16)), o0.y * rs * gn0.y * silu_f(__uint_as_float(zw.x & 0xffff0000u)));
            w.y = pk2(o0.z * rs * gn0.z * silu_f(__uint_as_float(zw.y << 16)), o0.w * rs * gn0.w * silu_f(__uint_as_float(zw.y & 0xffff0000u)));
            w.z = pk2(o1.x * rs * gn1.x * silu_f(__uint_as_float(zw.z << 16)), o1.y * rs * gn1.y * silu_f(__uint_as_float(zw.z & 0xffff0000u)));
            w.w = pk2(o1.z * rs * gn1.z * silu_f(__uint_as_float(zw.w << 16)), o1.w * rs * gn1.w * silu_f(__uint_as_float(zw.w & 0xffff0000u)));
            *(v4u*)(mrow + h * 64 + 8 * j) = w;
            if (r >= R_META && r < R_SAMP) *(v4u*)(mrow + 512 + 8 * lane) = (v4u){0u, 0u, 0u, 0u}; }
      } }
}
__device__ __forceinline__ void p9_final(Frame& F) {
    const int gw = F.vcu * NWAVES + F.wave, NGW = F.G * NWAVES;
    { int lane = F.lane; asm volatile("" : "+v"(lane));
      const f32x4* gv = (const f32x4*)F.final_g; f32x4 g4[4];
      g4[0] = gv[2 * lane]; g4[1] = gv[2 * lane + 1]; g4[2] = gv[128 + 2 * lane]; g4[3] = gv[128 + 2 * lane + 1];
      for (int i0 = gw; i0 < NREAL; i0 += 4 * NGW) {
        v4u hb[4][2]; int rr[4];
#pragma unroll
        for (int q = 0; q < 4; ++q) { const int r = i0 + q * NGW; rr[q] = r < NREAL ? r : -1;
            if (rr[q] >= 0) { const bf16* hp = F.H2B + (size_t)r * D + 8 * lane; hb[q][0] = *(const v4u*)hp; hb[q][1] = *(const v4u*)(hp + 512); }
            else { hb[q][0] = (v4u){0u, 0u, 0u, 0u}; hb[q][1] = hb[q][0]; } }
#pragma unroll
        for (int q = 0; q < 4; ++q) { if (rr[q] < 0) continue;
            f32x4 v[4];
#pragma unroll
            for (int k = 0; k < 2; ++k) { const v4u w = hb[q][k];
                v[2 * k] = (f32x4){__uint_as_float(w.x << 16), __uint_as_float(w.x & 0xffff0000u), __uint_as_float(w.y << 16), __uint_as_float(w.y & 0xffff0000u)};
                v[2 * k + 1] = (f32x4){__uint_as_float(w.z << 16), __uint_as_float(w.z & 0xffff0000u), __uint_as_float(w.w << 16), __uint_as_float(w.w & 0xffff0000u)}; }
            float s = 0.f;
#pragma unroll
            for (int j = 0; j < 4; ++j) s += (v[j].x * v[j].x + v[j].y * v[j].y) + (v[j].z * v[j].z + v[j].w * v[j].w);
            const float rstd = 1.0f / sqrtf(wave_sum(s) * (1.0f / D) + EPS);
            float* o = F.out + O_YP + (size_t)rr[q] * D + 8 * lane;
            *(f32x4*)o = v[0] * rstd * g4[0]; *(f32x4*)(o + 4) = v[1] * rstd * g4[1]; *(f32x4*)(o + 512) = v[2] * rstd * g4[2]; *(f32x4*)(o + 516) = v[3] * rstd * g4[3]; }
      } }
    { const f32x4* gv = (const f32x4*)F.final_g + F.lane; f32x4 g4[4];
#pragma unroll
      for (int j = 0; j < 4; ++j) g4[j] = gv[64 * j];
      for (int i = gw; i < NSAMP; i += NGW) { const int r = R_SAMP + i;
        const f32x4* hv = (const f32x4*)(F.H2 + (size_t)r * D) + F.lane; f32x4 v[4];
#pragma unroll
        for (int j = 0; j < 4; ++j) v[j] = hv[64 * j];
        float s = 0.f;
#pragma unroll
        for (int j = 0; j < 4; ++j) s += (v[j].x * v[j].x + v[j].y * v[j].y) + (v[j].z * v[j].z + v[j].w * v[j].w);
        const float rstd = 1.0f / sqrtf(wave_sum(s) * (1.0f / D) + EPS);
        float* o = F.out + O_YS + (size_t)i * D;
#pragma unroll
        for (int j = 0; j < 4; ++j) *((f32x4*)o + F.lane + 64 * j) = v[j] * rstd * g4[j]; } }
}

struct Args { const void* in[23]; float* out; unsigned char* ws; int ph_lo, ph_hi, li, pad; };
__global__ void __launch_bounds__(NWAVES * 64, 2) mk_fwd(Args args) {
    extern __shared__ __attribute__((aligned(16))) unsigned char lds[];
    Frame F;
    F.lds = (LAS unsigned char*)lds;
    F.MISC = (volatile LAS unsigned*)(F.lds + MISC_OFF);
    F.tid = threadIdx.x; F.lane = F.tid & 63; F.wave = __builtin_amdgcn_readfirstlane(F.tid >> 6);
    F.G = gridDim.x; F.vcu = blockIdx.x;
    unsigned char* ws = args.ws;
    F.ctl = (gu32*)(ws + WS_CTL);
    F.x_prompt = (const float*)args.in[0]; F.x_sample = (const float*)args.in[1]; F.cache_latent = (const float*)args.in[2]; F.cache_krope = (const float*)args.in[3];
    F.state_conv = (const float*)args.in[4]; F.state_ssm = (const float*)args.in[5]; F.page_table = (const int*)args.in[6]; F.meta = (const float*)args.in[7];
    F.norm_mix_g = (const float*)args.in[8]; F.w_in = (const float*)args.in[9]; F.conv_w = (const float*)args.in[10]; F.a_log = (const float*)args.in[11]; F.dt_bias = (const float*)args.in[12];
    F.gdn_norm_g = (const float*)args.in[13]; F.q_norm_g = (const float*)args.in[14]; F.w_q_b = (const float*)args.in[15]; F.kv_norm_g = (const float*)args.in[16]; F.w_kv_b = (const float*)args.in[17];
    F.w_out = (const float*)args.in[18]; F.norm_mlp_g = (const float*)args.in[19]; F.w_up = (const float*)args.in[20]; F.w_down = (const float*)args.in[21]; F.final_g = (const float*)args.in[22];
    F.out = args.out;
    F.WIN = (bf16*)(ws + WS_WIN); F.WQB = (bf16*)(ws + WS_WQB); F.WKVB = (bf16*)(ws + WS_WKVB); F.WOUT = (bf16*)(ws + WS_WOUT); F.WUP = (bf16*)(ws + WS_WUP); F.WDN = (bf16*)(ws + WS_WDN);
    F.XN = (bf16*)(ws + WS_XN); F.PRJ = (bf16*)(ws + WS_PRJ); F.CQN = (bf16*)(ws + WS_CQN); F.LATN = (bf16*)(ws + WS_LATN); F.QM = (bf16*)(ws + WS_QM); F.KV = (bf16*)(ws + WS_KV);
    F.MIX = (bf16*)(ws + WS_MIX); F.H1B = (bf16*)(ws + WS_H1B); F.HFF = (bf16*)(ws + WS_HFF); F.KPEB = (bf16*)(ws + WS_KPEB); F.ROPE = (float*)(ws + WS_ROPE); F.QLAT = (float*)(ws + WS_QLAT); F.EGL = (float*)(ws + WS_EGL); F.S1 = (float*)(ws + WS_S1); F.GCH = ws + WS_GCH;
    F.KPE = (float*)(ws + WS_KPE); F.GQKV = (bf16*)(ws + WS_GQKV); F.GB = (float*)(ws + WS_GB); F.GO = (float*)(ws + WS_GO); F.H2B = (bf16*)(ws + WS_H2B); F.H2 = (float*)(ws + WS_H2);
    F.PART = (float*)(ws + WS_PART); F.PSTAT = (float*)(ws + WS_PSTAT); F.SS1 = (float*)(ws + WS_CTL) + CW_SS1;
    for (int u = F.tid; u < (LDS_BYTES - LDSCTL_OFF) / 4; u += NWAVES * 64) ((LAS unsigned*)(F.lds + LDSCTL_OFF))[u] = 0u;
    __syncthreads();
    XcdBarrier bar; bar.bar = (unsigned*)(F.ctl + CW_BAR); bar.x = 0; bar.st = nullptr;
    if (N_LAUNCHES == 1) bar = xcd_barrier_post((unsigned*)(F.ctl + CW_BAR), F.MISC + 8);
#define GRID_BAR() do { if (N_LAUNCHES == 1) xcd_barrier(bar); } while (0)
    const int lo = args.ph_lo, hi = args.ph_hi;
#define IN(k) (lo <= (k) && (k) < hi)
#define BOTH(k) (IN(k) && IN((k) + 1))

    if (IN(0)) { p0_prologue(F); VM_WAIT(); __syncthreads(); if (BOTH(0)) GRID_BAR(); }
    if (IN(1)) {
        pg8::Gemm g{F.XN, F.WIN, MT, NPRJ, D, D}; pg8::StaticOrder S; S.init(MT, NPRJ, F.G, (int)blockIdx.x);
        pg8::EpiStoreBf16 E{F.PRJ, NPRJ};
        pg8::gemm_phase<pg8::EpiStoreBf16, pg8::StaticOrder, true, true>(F.lds + RING_OFF, g, S, E);
        if (BOTH(1)) GRID_BAR();
    }
    if (IN(2)) {
        const int gw = F.vcu * NWAVES + F.wave, NGW = F.G * NWAVES;
        { int lane_ = F.lane; asm volatile("" : "+v"(lane_)); P2Consts W; p2_consts(F, W, lane_);
          const int rot = (NGW == SEQ) ? 40 : 0;
#pragma clang loop unroll(disable)
          for (int k = 0; ; ++k) { int r = gw + k * NGW; if (r >= MT) break;
              if (r < R_META) r = (r & ~(SEQ - 1)) | ((r + rot * k) & (SEQ - 1));
              const int s2 = r & (SEQ - 1); if (r < R_META && s2 >= 3 && s2 < SEQ - 3) p2_row_fast(F, r, W, lane_); else p2_row(F, r); } }
        VM_WAIT(); __syncthreads();
        if (BOTH(2)) GRID_BAR();
    }
    if (IN(3)) {
        { pg8::Gemm g{F.CQN, F.WQB, MT, 768, QLORA, QLORA}; pg8::StaticOrder S; S.init(MT, 768, F.G, (int)blockIdx.x);
          pg8::EpiQ E{F.QM, F.ROPE, MLA_SCALE * 1.4426950408889634f};
          pg8::gemm_phase<pg8::EpiQ, pg8::StaticOrder, true, true>(F.lds + RING_OFF, g, S, E); }
        { pg8::Gemm g{F.LATN, F.WKVB, MT, 1024, KVLORA, KVLORA}; pg8::StaticOrder S; S.init(MT, 1024, F.G, ((int)blockIdx.x + 8) % (int)gridDim.x);
          pg8::EpiStoreBf16 E{F.KV, 1024};
          pg8::gemm_phase<pg8::EpiStoreBf16, pg8::StaticOrder, true, true>(F.lds + RING_OFF, g, S, E); }
        gdn::g1_phase(F); VM_WAIT(); __syncthreads();
        if (BOTH(3)) GRID_BAR();
    }
    if (IN(4)) { p4_mixers(F); VM_WAIT(); __syncthreads(); if (BOTH(4)) GRID_BAR(); }
    if (IN(5)) { p5_post(F); VM_WAIT(); __syncthreads(); if (BOTH(5)) GRID_BAR(); }
    const bool split_tail = (F.G == 256);
    if (IN(6)) {
        const int Mrows = split_tail ? NREAL : MT;
        pg8::Gemm g{F.MIX, F.WOUT, Mrows, D, 1024, 1024}; pg8::StaticOrder S; S.init(Mrows, D, F.G, (int)blockIdx.x);
        pg8::EpiResid1 E{F.x_prompt, F.meta, F.x_sample, F.H1B, F.SS1, F.H2};
        pg8::gemm_phase<pg8::EpiResid1, pg8::StaticOrder, true, true>(F.lds + RING_OFF, g, S, E);
        if (BOTH(6)) GRID_BAR();
    }
    if (IN(7)) {
        gu32* cnt6 = F.ctl + CW_CNT6;
        if (split_tail && blockIdx.x < 4) {
            pg8::Gemm g{F.MIX, F.WOUT, MT, D, 1024, 1024}; pg8::OneUnit S{64, (int)blockIdx.x};
            pg8::EpiResid1 E{F.x_prompt, F.meta, F.x_sample, F.H1B, F.SS1, F.H2};
            pg8::gemm_phase<pg8::EpiResid1, pg8::OneUnit, true, true>(F.lds + RING_OFF, g, S, E);
            VM_WAIT(); __syncthreads();
            if (F.tid == 0) { __builtin_amdgcn_fence(__ATOMIC_RELEASE, "agent"); asm volatile("s_waitcnt vmcnt(0)" ::: "memory"); __hip_atomic_fetch_add(cnt6, 1u, RLX_AGENT); }
        }
        { const int Mrows = split_tail ? NREAL : MT;
          pg8::Gemm g{F.H1B, F.WUP, Mrows, FF, D, D}; pg8::StaticOrder S; S.init(Mrows, FF, F.G, (int)blockIdx.x);
          pg8::EpiUp E{F.HFF, FF, F.SS1};
          pg8::gemm_phase<pg8::EpiUp, pg8::StaticOrder, true, true>(F.lds + RING_OFF, g, S, E); }
        if (split_tail && blockIdx.x >= 240) {
            if (F.tid == 0) { unsigned sp = 0; while (__hip_atomic_load(cnt6, RLX_AGENT) < 4u) { __builtin_amdgcn_s_sleep(2); if (++sp > (1u << 22)) break; }
                __builtin_amdgcn_fence(__ATOMIC_ACQUIRE, "agent"); asm volatile("s_waitcnt vmcnt(0)" ::: "memory"); }
            __syncthreads();
            pg8::Gemm g{F.H1B + (size_t)NREAL * D, F.WUP, 256, FF, D, D}; pg8::OneUnit S{0, (int)blockIdx.x - 240};
            pg8::EpiUp E{F.HFF + (size_t)NREAL * FF, FF, F.SS1 + NREAL};
            pg8::gemm_phase<pg8::EpiUp, pg8::OneUnit, true, true>(F.lds + RING_OFF, g, S, E);
        }
        if (BOTH(7)) GRID_BAR();
    }
    if (IN(8)) {
        { pg8::Gemm g{F.HFF, F.WDN, NREAL, D, FF, FF}; pg8::StaticOrder S; S.init(NREAL, D, F.G, (int)blockIdx.x);
          pg8::EpiResid2 E{F.H1B, F.H2B};
          pg8::gemm_phase<pg8::EpiResid2, pg8::StaticOrder, true, true>(F.lds + RING_OFF, g, S, E); }
        { pg8::Gemm g{F.HFF + (size_t)NREAL * FF, F.WDN, 256, D, 256, FF}; pg8::SplitKOrder S; S.init(D, 16, 256, F.G, (int)blockIdx.x);
          pg8::EpiAtomicAdd E{F.H2 + (size_t)NREAL * D};
          pg8::gemm_phase<pg8::EpiAtomicAdd, pg8::SplitKOrder, true, true>(F.lds + RING_OFF, g, S, E); }
        if (BOTH(8)) GRID_BAR();
    }
    if (IN(9)) { p9_final(F); }
#undef IN
#undef BOTH
}

extern "C" void kernel_launch(void* const* d_in, const int* in_sizes, int n_in, void* d_out, int out_size, void* d_ws, size_t ws_size, hipStream_t stream) {
    static int grid = 0;
    if (grid == 0) {
        if (n_in != 23 || out_size != (int)O_END || ws_size < WS_END) { fprintf(stderr, "kernel_launch: unexpected shapes: n_in %d out %d ws %zu (need %zu); nothing launched\n", n_in, out_size, ws_size, (size_t)WS_END); grid = -1; return; }
        int dev = 0, cus = 0, per_cu = 0;
        if (hipGetDevice(&dev) != hipSuccess || hipDeviceGetAttribute(&cus, hipDeviceAttributeMultiprocessorCount, dev) != hipSuccess) { fprintf(stderr, "kernel_launch: device query failed\n"); grid = -1; return; }
        if (hipFuncSetAttribute((const void*)mk_fwd, hipFuncAttributeMaxDynamicSharedMemorySize, LDS_BYTES) != hipSuccess) { fprintf(stderr, "kernel_launch: hipFuncSetAttribute failed\n"); grid = -1; return; }
        if (hipOccupancyMaxActiveBlocksPerMultiprocessor(&per_cu, (const void*)mk_fwd, NWAVES * 64, LDS_BYTES) != hipSuccess || per_cu < 1) { fprintf(stderr, "kernel_launch: occupancy query says %d blocks per CU\n", per_cu); per_cu = 1; }
        (void)hipGetLastError();
        grid = cus;
        fprintf(stderr, "kernel_launch: grid %d (cus %d, per_cu %d)\n", grid, cus, per_cu);
    }
    if (grid < 0) return;
    if (hipMemsetAsync((char*)d_ws + WS_CTL, 0, CTL_ZERO_BYTES, stream) != hipSuccess) { fprintf(stderr, "kernel_launch: memset failed\n"); return; }
    Args a{};
    for (int i = 0; i < 23; ++i) a.in[i] = d_in[i];
    a.out = (float*)d_out; a.ws = (unsigned char*)d_ws;
    for (int li = 0; li < N_LAUNCHES; ++li) {
        if (N_LAUNCHES == 1) { a.ph_lo = 0; a.ph_hi = NPHASES; } else { a.ph_lo = li * NPHASES / N_LAUNCHES; a.ph_hi = (li + 1) * NPHASES / N_LAUNCHES; }
        a.li = li;
        hipLaunchKernelGGL(mk_fwd, dim3(grid), dim3(NWAVES * 64), LDS_BYTES, stream, a);
        if (N_LAUNCHES == NPHASES && li == DUP_PHASE) hipLaunchKernelGGL(mk_fwd, dim3(grid), dim3(NWAVES * 64), LDS_BYTES, stream, a);
        const hipError_t le = hipPeekAtLastError();
        if (le != hipSuccess) { fprintf(stderr, "kernel_launch: launch %d failed: %s\n", li, hipGetErrorName(le)); break; }
    }
}
```
